# Optimizing an MI355X kernel written in HIP

```python
import math
import jax, jax.numpy as jnp
from jax import lax
import numpy as np

D_MODEL = 1024
BATCH = 2
SEQ = 16384
DEPTH = 2

GRID_W = 64
CTX_LEN = 256
EPS = 1e-6

ATT_WIDTH = D_MODEL // 2
ATT_HEAD_DIM = 64
ATT_HEADS = ATT_WIDTH // (2 * ATT_HEAD_DIM)
Q_BLOCK = 128
ROPE_BASE = 10000.0
ROPE_PAIRS = ATT_HEAD_DIM // 4

GDN_WIDTH = D_MODEL - ATT_WIDTH
GDN_HEAD_DIM = 128
GDN_HEADS = GDN_WIDTH // GDN_HEAD_DIM
GDN_CHUNK = 64
CONV_W = 5

MIX_WIDTH = ATT_WIDTH + GDN_WIDTH
IN_COLS = 3 * ATT_WIDTH + 4 * GDN_WIDTH + 4 * GDN_HEADS

N_EXPERTS = 32
TOP_K = 4
D_EXPERT = D_MODEL
SWIGLU_ALPHA = 1.702
SWIGLU_LIMIT = 7.0
MOE_BLOCK = 256

kernel_name = 'hybrid_diffattn_gdn_moe_dit'


def rms_norm(x, g):
    xf = x.astype(jnp.float32)
    y = xf * lax.rsqrt(jnp.mean(xf * xf, axis=-1, keepdims=True) + EPS)
    return (y * g.astype(jnp.float32)).astype(x.dtype)


def l2_norm(x):
    xf = x.astype(jnp.float32)
    return (xf * lax.rsqrt(jnp.sum(xf * xf, axis=-1, keepdims=True) + EPS)).astype(x.dtype)


def modulate(x, shift, scale):
    return x * (1 + scale) + shift


def rotate_pairs(x, ang):
    cos = jnp.cos(ang)[:, None, None, :].astype(x.dtype)
    sin = jnp.sin(ang)[:, None, None, :].astype(x.dtype)
    x1, x2 = jnp.split(x, 2, axis=-1)
    return jnp.concatenate([x1 * cos - x2 * sin, x2 * cos + x1 * sin], axis=-1)


def axial_rope(x, ang_row, ang_col):
    x_row, x_col = jnp.split(x, 2, axis=-1)
    return jnp.concatenate([rotate_pairs(x_row, ang_row), rotate_pairs(x_col, ang_col)], axis=-1)


def diff_qkv(p, q_norm_g, k_norm_g, ang_row, ang_col):
    B, L = p.shape[:2]
    q = p[..., :ATT_WIDTH].reshape(B, L, ATT_HEADS, 2, ATT_HEAD_DIM)
    k = p[..., ATT_WIDTH:2 * ATT_WIDTH].reshape(B, L, ATT_HEADS, 2, ATT_HEAD_DIM)
    v = p[..., 2 * ATT_WIDTH:3 * ATT_WIDTH].reshape(B, L, ATT_HEADS, 2 * ATT_HEAD_DIM)
    q = rms_norm(q, q_norm_g)
    k = rms_norm(k, k_norm_g)
    if ang_row is not None:
        q = axial_rope(q, ang_row, ang_col)
        k = axial_rope(k, ang_row, ang_col)
    return q * (ATT_HEAD_DIM ** -0.5), k, v


def diff_attend(q, k, v, lam):
    s = jnp.einsum('bqhpd,bkhpd->bhpqk', q, k).astype(jnp.float32)
    p = jax.nn.softmax(s, axis=-1)
    p = p[:, :, 0] - lam * p[:, :, 1]
    return jnp.einsum('bhqk,bkhe->bqhe', p.astype(v.dtype), v)


def diff_out(o, subln_g, lam_init):
    B, L = o.shape[:2]
    return (rms_norm(o, subln_g) * (1.0 - lam_init)).reshape(B, L, ATT_WIDTH)


def gdn_inputs(p, conv_w, a_log, dt_bias):
    B, L = p.shape[:2]
    off = 3 * ATT_WIDTH
    qkv = p[..., off:off + 3 * GDN_WIDTH]
    taps = conv_w.reshape(CONV_W, 1, 3 * GDN_WIDTH).astype(qkv.dtype)
    qkv = jax.nn.silu(lax.conv_general_dilated(
        qkv, taps, window_strides=(1,), padding=[(CONV_W // 2, CONV_W // 2)],
        dimension_numbers=('NWC', 'WIO', 'NWC'), feature_group_count=3 * GDN_WIDTH))
    qkv = qkv.reshape(B, L, 3, GDN_HEADS, GDN_HEAD_DIM)
    q, k, v = l2_norm(qkv[:, :, 0]), l2_norm(qkv[:, :, 1]), qkv[:, :, 2]
    z = p[..., off + 3 * GDN_WIDTH:off + 4 * GDN_WIDTH].reshape(B, L, GDN_HEADS, GDN_HEAD_DIM)
    ab = p[..., off + 4 * GDN_WIDTH:].astype(jnp.float32).reshape(B, L, 2, 2, GDN_HEADS)
    g = -jnp.exp(a_log.astype(jnp.float32)) * jax.nn.softplus(ab[:, :, 0] + dt_bias.astype(jnp.float32))
    beta = jax.nn.sigmoid(ab[:, :, 1])
    return q, k, v, z, g, beta


def gated_delta_rule(q, k, v, g, beta):
    B, L, H, DK = q.shape
    DV = v.shape[-1]
    C = GDN_CHUNK
    N = L // C
    f32 = jnp.float32

    def to_chunks(t):
        t = t.astype(f32).reshape((B, N, C, H) + t.shape[3:])
        return jnp.moveaxis(t, (1, 3), (0, 2))

    qc = to_chunks(q) * (DK ** -0.5)
    kc, vc, gc, bc = to_chunks(k), to_chunks(v), to_chunks(g), to_chunks(beta)
    gcum = jnp.cumsum(gc, axis=-1)
    causal = jnp.tril(jnp.ones((C, C), bool))
    strict = jnp.tril(jnp.ones((C, C), bool), -1)
    gdiff = gcum[..., :, None] - gcum[..., None, :]
    decay = jnp.where(causal, jnp.exp(jnp.where(causal, gdiff, 0.0)), 0.0)
    kbeta = kc * bc[..., None]
    a_mat = jnp.where(strict, jnp.einsum('nbhcd,nbhsd->nbhcs', kbeta, kc) * decay, 0.0)
    eye = jnp.eye(C, dtype=f32)
    t_mat = lax.linalg.triangular_solve(eye + a_mat, jnp.broadcast_to(eye, a_mat.shape),
                                        left_side=True, lower=True, unit_diagonal=True)
    u = jnp.einsum('nbhcs,nbhse->nbhce', t_mat, vc * bc[..., None])
    w = jnp.einsum('nbhcs,nbhsd->nbhcd', t_mat, kbeta * jnp.exp(gcum)[..., None])
    qk_intra = jnp.where(causal, jnp.einsum('nbhcd,nbhsd->nbhcs', qc, kc) * decay, 0.0)

    def chunk_step(state, xs):
        q_i, k_i, u_i, w_i, g_i, a_i = xs
        v_new = u_i - jnp.einsum('bhcd,bhde->bhce', w_i, state)
        o_i = (jnp.einsum('bhcd,bhde->bhce', q_i * jnp.exp(g_i)[..., None], state)
               + jnp.einsum('bhcs,bhse->bhce', a_i, v_new))
        g_last = g_i[..., -1:]
        k_dec = k_i * jnp.exp(g_last - g_i)[..., None]
        state = state * jnp.exp(g_last)[..., None] + jnp.einsum('bhcd,bhce->bhde', k_dec, v_new)
        return state, o_i

    s0 = jnp.zeros((B, H, DK, DV), f32)
    _, o = lax.scan(chunk_step, s0, (qc, kc, u, w, gcum, qk_intra))
    o = jnp.moveaxis(o, (0, 2), (1, 3)).reshape(B, L, H, DV)
    return o.astype(v.dtype)


def bidir_gdn(ctx_in, lat_in):
    Lc = ctx_in[0].shape[1]

    def run(direction):
        def arrange(t_ctx, t_lat):
            if direction == 1:
                t_ctx, t_lat = jnp.flip(t_ctx, 1), jnp.flip(t_lat, 1)
            return jnp.concatenate([t_ctx, t_lat], axis=1)
        q = arrange(ctx_in[0], lat_in[0])
        k = arrange(ctx_in[1], lat_in[1])
        v = arrange(ctx_in[2], lat_in[2])
        g = arrange(ctx_in[3][:, :, direction], lat_in[3][:, :, direction])
        beta = arrange(ctx_in[4][:, :, direction], lat_in[4][:, :, direction])
        o = gated_delta_rule(q, k, v, g, beta)
        o_ctx, o_lat = o[:, :Lc], o[:, Lc:]
        if direction == 1:
            o_ctx, o_lat = jnp.flip(o_ctx, 1), jnp.flip(o_lat, 1)
        return o_ctx, o_lat

    f_ctx, f_lat = run(0)
    b_ctx, b_lat = run(1)
    return f_ctx + b_ctx, f_lat + b_lat


def gdn_out(o, z, gdn_norm_g):
    B, L = o.shape[:2]
    return (rms_norm(o, gdn_norm_g) * jax.nn.silu(z)).reshape(B, L, GDN_WIDTH)


def hybrid_mixer(u_lat, u_ctx, w_in, w_out, q_norm_g, k_norm_g, lam_full, lam_init, subln_g,
                 conv_w, a_log, dt_bias, gdn_norm_g, ang_row, ang_col, need_ctx):
    B, L, _ = u_lat.shape
    p_lat = u_lat @ w_in
    p_ctx = u_ctx @ w_in

    q_lat, k_lat, v_lat = diff_qkv(p_lat, q_norm_g, k_norm_g, ang_row, ang_col)
    q_ctx, k_ctx, v_ctx = diff_qkv(p_ctx, q_norm_g, k_norm_g, None, None)
    k_all = jnp.concatenate([k_ctx, k_lat], axis=1)
    v_all = jnp.concatenate([v_ctx, v_lat], axis=1)
    n_blk = L // Q_BLOCK
    q_blocks = jnp.moveaxis(q_lat.reshape(B, n_blk, Q_BLOCK, ATT_HEADS, 2, ATT_HEAD_DIM), 1, 0)
    o_att = lax.map(lambda qb: diff_attend(qb, k_all, v_all, lam_full), q_blocks)
    o_att = jnp.moveaxis(o_att, 0, 1).reshape(B, L, ATT_HEADS, 2 * ATT_HEAD_DIM)
    o_att_lat = diff_out(o_att, subln_g, lam_init)

    gq_l, gk_l, gv_l, gz_l, gg_l, gb_l = gdn_inputs(p_lat, conv_w, a_log, dt_bias)
    gq_c, gk_c, gv_c, gz_c, gg_c, gb_c = gdn_inputs(p_ctx, conv_w, a_log, dt_bias)
    o_gdn_ctx, o_gdn_lat = bidir_gdn((gq_c, gk_c, gv_c, gg_c, gb_c), (gq_l, gk_l, gv_l, gg_l, gb_l))

    out_lat = jnp.concatenate([o_att_lat, gdn_out(o_gdn_lat, gz_l, gdn_norm_g)], axis=-1) @ w_out
    if not need_ctx:
        return out_lat, None
    o_att_ctx = diff_out(diff_attend(q_ctx, k_ctx, v_ctx, lam_full), subln_g, lam_init)
    out_ctx = jnp.concatenate([o_att_ctx, gdn_out(o_gdn_ctx, gz_c, gdn_norm_g)], axis=-1) @ w_out
    return out_lat, out_ctx


def moe_ffn(h, router_w, router_b, w_gate_up, b_gate_up, w_down, b_down):
    T, D = h.shape
    n_assign = T * TOP_K
    n_blocks = -(-n_assign // MOE_BLOCK) + N_EXPERTS
    logits = (h @ router_w).astype(jnp.float32) + router_b.astype(jnp.float32)
    top_logit, top_e = lax.top_k(logits, TOP_K)
    gate = jax.nn.softmax(top_logit, axis=-1)
    flat_e = top_e.reshape(-1)
    order = jnp.argsort(flat_e)
    e_sorted = flat_e[order]
    tok_sorted = (order // TOP_K).astype(jnp.int32)
    gate_sorted = gate.reshape(-1)[order]
    counts = jnp.bincount(flat_e, length=N_EXPERTS)
    padded = (counts + MOE_BLOCK - 1) // MOE_BLOCK * MOE_BLOCK
    start = jnp.cumsum(counts) - counts
    pad_end = jnp.cumsum(padded)
    pad_start = pad_end - padded
    slot = pad_start[e_sorted] + (jnp.arange(n_assign, dtype=jnp.int32) - start[e_sorted])
    slot_tok = jnp.full((n_blocks * MOE_BLOCK,), T, jnp.int32).at[slot].set(tok_sorted)
    slot_gate = jnp.zeros((n_blocks * MOE_BLOCK,), jnp.float32).at[slot].set(gate_sorted)
    block_e = jnp.minimum(jnp.searchsorted(pad_end, jnp.arange(n_blocks, dtype=jnp.int32) * MOE_BLOCK,
                                           side='right'), N_EXPERTS - 1)
    h_pad = jnp.concatenate([h, jnp.zeros((1, D), h.dtype)], axis=0)

    def expert_block(args):
        idx, e = args
        xb = h_pad[idx]
        gu = xb @ w_gate_up[e] + b_gate_up[e]
        g_, up = gu[:, :D_EXPERT], gu[:, D_EXPERT:]
        g_ = jnp.minimum(g_, SWIGLU_LIMIT)
        up = jnp.clip(up, -SWIGLU_LIMIT, SWIGLU_LIMIT)
        glu = g_ * jax.nn.sigmoid(SWIGLU_ALPHA * g_)
        return ((up + 1) * glu) @ w_down[e] + b_down[e]

    y = lax.map(expert_block, (slot_tok.reshape(n_blocks, MOE_BLOCK), block_e))
    y = y.reshape(-1, D) * slot_gate[:, None].astype(h.dtype)
    return jnp.zeros((T + 1, D), h.dtype).at[slot_tok].add(y)[:T]


def setup_inputs(seed: int = 0) -> dict:
    key = jax.random.key(seed)
    ks = jax.random.split(key, 28)
    f32 = jnp.float32
    D = D_MODEL

    def nrm(k, shape, scale):
        return jax.random.normal(k, shape, f32) * scale

    def gain(k, shape):
        return 1.0 + 0.02 * jax.random.normal(k, shape, f32)

    dt = jnp.exp(jax.random.uniform(ks[14], (DEPTH, 2, GDN_HEADS), f32, math.log(1e-3), math.log(1e-1)))
    return {
        'x': nrm(ks[0], (BATCH, SEQ, D), 1.0),
        'c': nrm(ks[1], (BATCH, D), 1.0),
        'ctx': nrm(ks[2], (BATCH, CTX_LEN, D), 1.0),
        'c_ctx': nrm(ks[3], (D,), 1.0),
        'w_mod': nrm(ks[4], (DEPTH, D, 6 * D), 0.5 * D ** -0.5),
        'b_mod': nrm(ks[5], (DEPTH, 6 * D), 0.02),
        'norm_mix_g': gain(ks[6], (DEPTH, D)),
        'w_in': nrm(ks[7], (DEPTH, D, IN_COLS), D ** -0.5),
        'q_norm_g': gain(ks[8], (DEPTH, ATT_HEAD_DIM)),
        'k_norm_g': gain(ks[9], (DEPTH, ATT_HEAD_DIM)),
        'lam_q1': nrm(ks[10], (DEPTH, ATT_HEAD_DIM), 0.1),
        'lam_k1': nrm(ks[11], (DEPTH, ATT_HEAD_DIM), 0.1),
        'lam_q2': nrm(ks[12], (DEPTH, ATT_HEAD_DIM), 0.1),
        'lam_k2': nrm(ks[13], (DEPTH, ATT_HEAD_DIM), 0.1),
        'subln_g': gain(ks[15], (DEPTH, 2 * ATT_HEAD_DIM)),
        'conv_w': nrm(ks[16], (DEPTH, CONV_W, 3 * GDN_WIDTH), CONV_W ** -0.5),
        'a_log': jnp.log(jax.random.uniform(ks[17], (DEPTH, 2, GDN_HEADS), f32, 1.0, 16.0)),
        'dt_bias': dt + jnp.log(-jnp.expm1(-dt)),
        'gdn_norm_g': gain(ks[18], (DEPTH, GDN_HEAD_DIM)),
        'w_out': nrm(ks[19], (DEPTH, MIX_WIDTH, D), MIX_WIDTH ** -0.5),
        'norm_ffn_g': gain(ks[20], (DEPTH, D)),
        'router_w': nrm(ks[21], (DEPTH, D, N_EXPERTS), D ** -0.5),
        'router_b': nrm(ks[22], (DEPTH, N_EXPERTS), 0.01),
        'w_gate_up': nrm(ks[23], (DEPTH, N_EXPERTS, D, 2 * D_EXPERT), D ** -0.5),
        'b_gate_up': nrm(ks[24], (DEPTH, N_EXPERTS, 2 * D_EXPERT), 0.02),
        'w_down': nrm(ks[25], (DEPTH, N_EXPERTS, D_EXPERT, D), D_EXPERT ** -0.5),
        'b_down': nrm(ks[26], (DEPTH, N_EXPERTS, D), 0.02),
    }


def reference(x, c, ctx, c_ctx, w_mod, b_mod, norm_mix_g, w_in, q_norm_g, k_norm_g,
              lam_q1, lam_k1, lam_q2, lam_k2, subln_g, conv_w, a_log, dt_bias, gdn_norm_g,
              w_out, norm_ffn_g, router_w, router_b, w_gate_up, b_gate_up, w_down, b_down):
    B, L, D = x.shape
    Lc = ctx.shape[1]
    ROWS = L // GRID_W
    row = jnp.repeat(jnp.arange(ROWS, dtype=jnp.float32), GRID_W)
    col = (jnp.arange(L, dtype=jnp.int32) % GRID_W).astype(jnp.float32)
    inv_freq = ROPE_BASE ** (-jnp.arange(ROPE_PAIRS, dtype=jnp.float32) / ROPE_PAIRS)
    ang_row = row[:, None] * inv_freq
    ang_col = col[:, None] * inv_freq

    silu_c = jax.nn.silu(c)
    silu_cc = jax.nn.silu(c_ctx)
    h_lat, h_ctx = x, ctx
    for layer in range(DEPTH):
        last = layer == DEPTH - 1
        mod_lat = jnp.split((silu_c @ w_mod[layer] + b_mod[layer])[:, None, :], 6, axis=-1)
        mod_ctx = jnp.split((silu_cc @ w_mod[layer] + b_mod[layer])[None, None, :], 6, axis=-1)

        lam_init = 0.8 - 0.6 * math.exp(-0.3 * layer)
        lam_full = (jnp.exp(jnp.sum(lam_q1[layer].astype(jnp.float32) * lam_k1[layer].astype(jnp.float32)))
                    - jnp.exp(jnp.sum(lam_q2[layer].astype(jnp.float32) * lam_k2[layer].astype(jnp.float32)))
                    + lam_init)

        u_lat = modulate(rms_norm(h_lat, norm_mix_g[layer]), mod_lat[0], mod_lat[1])
        u_ctx = modulate(rms_norm(h_ctx, norm_mix_g[layer]), mod_ctx[0], mod_ctx[1])
        mix_lat, mix_ctx = hybrid_mixer(u_lat, u_ctx, w_in[layer], w_out[layer], q_norm_g[layer],
                                        k_norm_g[layer], lam_full, lam_init, subln_g[layer],
                                        conv_w[layer], a_log[layer], dt_bias[layer], gdn_norm_g[layer],
                                        ang_row, ang_col, not last)
        h_lat = h_lat + mod_lat[2] * mix_lat
        v_lat = modulate(rms_norm(h_lat, norm_ffn_g[layer]), mod_lat[3], mod_lat[4])
        moe_args = (router_w[layer], router_b[layer], w_gate_up[layer], b_gate_up[layer],
                    w_down[layer], b_down[layer])
        if last:
            y = moe_ffn(v_lat.reshape(B * L, D), *moe_args)
            h_lat = h_lat + mod_lat[5] * y.reshape(B, L, D)
        else:
            h_ctx = h_ctx + mod_ctx[2] * mix_ctx
            v_ctx = modulate(rms_norm(h_ctx, norm_ffn_g[layer]), mod_ctx[3], mod_ctx[4])
            y = moe_ffn(jnp.concatenate([v_lat.reshape(B * L, D), v_ctx.reshape(B * Lc, D)], axis=0), *moe_args)
            h_lat = h_lat + mod_lat[5] * y[:B * L].reshape(B, L, D)
            h_ctx = h_ctx + mod_ctx[5] * y[B * L:].reshape(B, Lc, D)
    return h_lat
```

```cpp
#include <hip/hip_runtime.h>
#include <cstdio>
#include <cstdint>

#ifndef MK_PER_PHASE
#define MK_PER_PHASE 0
#endif

#define LAS __attribute__((address_space(3)))
#define GAS __attribute__((address_space(1)))
typedef unsigned short bf16_t;
typedef short bf16x8 __attribute__((ext_vector_type(8)));
typedef short s16x4 __attribute__((ext_vector_type(4)));
typedef float f32x2 __attribute__((ext_vector_type(2)));
typedef float f32x4 __attribute__((ext_vector_type(4)));
typedef float f32x16 __attribute__((ext_vector_type(16)));
typedef unsigned u32x2 __attribute__((ext_vector_type(2)));
typedef unsigned u32x4 __attribute__((ext_vector_type(4)));

constexpr int D = 1024, NB = 2, SEQL = 16384, CTXL = 256;
constexpr int NLAT = NB * SEQL, NCTX = NB * CTXL, NTOK = NLAT + NCTX;
constexpr int PW = 3584, INC = 3600;
constexpr int NEXP = 32, MAXBLK = 552, MAXSLOT = MAXBLK * 256;
constexpr int NCHUNK = 260, NTASK = 16 * NCHUNK;
constexpr float EPS = 1e-6f;
constexpr float LOG2E = 1.4426950408889634f;
constexpr int NWAVES = 8, NTHR = 512;

constexpr size_t MiB = 1u << 20;
constexpr size_t WS_CTL = 0, CTL_ZERO_BYTES = 1 * MiB;
constexpr size_t WS_CONST = 1 * MiB;
constexpr size_t WS_WIN = 2 * MiB;
constexpr size_t WS_WOUT = 16 * MiB;
constexpr size_t WS_WGU = 20 * MiB;
constexpr size_t WS_WD = 276 * MiB;
constexpr size_t WS_H = 404 * MiB;
constexpr size_t WS_U = 534 * MiB;
constexpr size_t WS_GB = 599 * MiB;
constexpr size_t WS_MIX = 602 * MiB;
constexpr size_t WS_RT = 667 * MiB;
constexpr size_t WS_BIG = 671 * MiB;
constexpr size_t WS_P = WS_BIG;
constexpr size_t WS_G = WS_P + 228 * MiB;
constexpr size_t WS_CH = WS_G + 98 * MiB;
constexpr size_t WS_OG = WS_CH + 358 * MiB;
constexpr size_t WS_OA = WS_OG + 130 * MiB;
constexpr size_t WS_END = WS_OA + 130 * MiB;
constexpr size_t WS_XS = WS_BIG;
constexpr size_t WS_ACT = WS_BIG + 276 * MiB;
constexpr size_t WS_Y = WS_XS;
static_assert(WS_ACT + 276 * MiB <= WS_END, "moe overlay");
constexpr size_t CH_TASK_BYTES = 90112;
constexpr int CH_WF = 0, CH_QF = 16384, CH_AF = 32768, CH_KF = 40960, CH_UC = 57344, CH_DMA_BYTES = 57344;
static_assert((size_t)NTASK * CH_TASK_BYTES <= 358 * MiB, "chunk buffers");

constexpr int CW_BAR = 4096;
constexpr int CW_CNT = 16384;
constexpr int CF_MODV = 0;
constexpr int CF_ROPE = 40960;
constexpr int CF_SC = 53248;
constexpr int CF_EGL = 53504;
constexpr int CF_MOE = 61440;
constexpr size_t RT_TOPE = 0, RT_GATE = 640 * 1024, RT_RANK = 1280 * 1024, RT_SLOT = 1920 * 1024, RT_SGATE = 2560 * 1024;

constexpr int LDS_BYTES = 147456;
constexpr int MISC_OFF = 143 * 1024;
static_assert(MISC_OFF + 256 <= LDS_BYTES, "lds");

__device__ __forceinline__ unsigned f2bf(float f) { unsigned u = __builtin_bit_cast(unsigned, f); return (u + 0x7fffu + ((u >> 16) & 1u)) >> 16; }
__device__ __forceinline__ unsigned pk2(float lo, float hi) { return f2bf(lo) | (f2bf(hi) << 16); }
__device__ __forceinline__ float bf2f(unsigned short b) { return __builtin_bit_cast(float, (unsigned)b << 16); }
__device__ __forceinline__ float bflo(unsigned w) { return __builtin_bit_cast(float, w << 16); }
__device__ __forceinline__ float bfhi(unsigned w) { return __builtin_bit_cast(float, w & 0xffff0000u); }
__device__ __forceinline__ unsigned cvt_pk_bf16(float lo, float hi) { unsigned r; asm volatile("v_cvt_pk_bf16_f32 %0, %1, %2" : "=v"(r) : "v"(lo), "v"(hi)); return r; }
__device__ __forceinline__ float wave_sum(float v) {
#pragma unroll
    for (int o = 1; o < 64; o <<= 1) v += __shfl_xor(v, o);
    return v;
}
__device__ __forceinline__ float wave_max(float v) {
#pragma unroll
    for (int o = 1; o < 64; o <<= 1) v = fmaxf(v, __shfl_xor(v, o));
    return v;
}
__device__ __forceinline__ float silu_f(float x) { return x / (1.f + __expf(-x)); }
__device__ __forceinline__ int crow(int r, int hi) { return (r & 3) + 8 * (r >> 2) + 4 * hi; }
#define LDS_WAIT() asm volatile("s_waitcnt lgkmcnt(0)" ::: "memory")
#define VM_WAIT() asm volatile("s_waitcnt vmcnt(0)" ::: "memory")
#define MFMA32(a, b, c) __builtin_amdgcn_mfma_f32_32x32x16_bf16(a, b, c, 0, 0, 0)

namespace pg8 {
constexpr int BM = 256, BK = 64, HALF = 128, HTB = HALF * BK * 2, STAGE_BYTES = 8 * HTB;
__host__ __device__ __forceinline__ int lds_byte(int r, int c) { const int st = (r >> 4) * 2 + (c >> 5), rr = r & 15, cc = c & 31, ob = rr * 64 + cc * 2; return st * 1024 + (ob ^ (((ob >> 9) & 1) << 5)); }
__host__ __device__ __forceinline__ void stage_rc(int b, int& R, int& C) { const int st = b / 1024, sb = b % 1024, swz = sb ^ (((sb >> 9) & 1) << 5); R = (st >> 1) * 16 + swz / 64; C = (st & 1) * 32 + (swz % 64) / 2; }
__host__ __device__ __forceinline__ int perm32(int rho) { const int n = rho >> 4, i = rho & 15; return 8 * (i >> 2) + 4 * n + (i & 3); }
struct Unit { int pm, pn; };
template <class Epi, class Sched>
__device__ __forceinline__ void gemm_phase(LAS unsigned char* lds, const int K, const Sched& S, const Epi& E) {
    int tid = threadIdx.x, bid = blockIdx.x, gdim = gridDim.x; asm volatile("" : "+v"(tid), "+s"(bid), "+s"(gdim)); const int wid = __builtin_amdgcn_readfirstlane(tid >> 6), lane = tid & 63, wr = wid >> 2, wc = wid & 3, fr = lane & 15, fq = lane >> 4;
    const int nt = K / BK;
    unsigned voffA[2], voffB[2];
#pragma unroll
    for (int i = 0; i < 2; ++i) { int R, C; stage_rc(tid * 16 + i * 8192, R, C); const int Rb = Epi::PERM ? ((R & ~31) + perm32(R & 31)) : R;
        voffA[i] = (unsigned)(R * K + C) * 2u; voffB[i] = (unsigned)(Rb * K + C) * 2u; }
    const size_t kstep = (size_t)(BK * 2);
    const size_t hstep = (size_t)HALF * K * 2;
    const unsigned ldsw = (unsigned)wid * 1024u;
    const int aoff = lds_byte(wr * 64 + fr, fq * 8), boff = lds_byte(wc * 32 + fr, fq * 8);
#define PG8_SA(b, h) (((b) * 2 + (h)) * HTB)
#define PG8_SB(b, h) ((4 + (b) * 2 + (h)) * HTB)
#define PG8_STAGE(bufoff, gbase, voff) do { _Pragma("unroll") for (int _i = 0; _i < 2; ++_i) \
        __builtin_amdgcn_global_load_lds((const unsigned*)((const char*)(gbase) + (voff)[_i]), (LAS unsigned*)(lds + (bufoff) + ldsw + _i * 8192), 16, 0, 0); } while (0)
#define PG8_LDA(dst, b, h) do { _Pragma("unroll") for (int m = 0; m < 4; ++m) _Pragma("unroll") for (int k = 0; k < 2; ++k) dst[m][k] = *(const LAS bf16x8*)(lds + PG8_SA(b, h) + aoff + m * 2048 + k * 1024); } while (0)
#define PG8_LDB(dst, b, h) do { _Pragma("unroll") for (int n = 0; n < 2; ++n) _Pragma("unroll") for (int k = 0; k < 2; ++k) dst[n][k] = *(const LAS bf16x8*)(lds + PG8_SB(b, h) + boff + n * 2048 + k * 1024); } while (0)
#define PG8_MMA(ai, bj, At, Bt) do { __builtin_amdgcn_s_setprio(1); _Pragma("unroll") for (int m = 0; m < 4; ++m) _Pragma("unroll") for (int n = 0; n < 2; ++n) _Pragma("unroll") for (int k = 0; k < 2; ++k) \
        acc[ai][bj][m][n] = __builtin_amdgcn_mfma_f32_16x16x32_bf16(Bt[n][k], At[m][k], acc[ai][bj][m][n], 0, 0, 0); __builtin_amdgcn_s_setprio(0); } while (0)
#define PG8_WAIT_V(n) asm volatile("s_waitcnt vmcnt(" #n ")" ::: "memory")
#define PG8_WAIT_L(n) asm volatile("s_waitcnt lgkmcnt(" #n ")" ::: "memory")
#define PG8_BAR __builtin_amdgcn_s_barrier()
#define PG8_SCHED __builtin_amdgcn_sched_barrier(0)
    Unit cur, nxt; int ui = 0;
    if (!S.next(0, cur)) return;
    f32x4 acc[2][2][4][2];
#pragma unroll
    for (int a = 0; a < 2; ++a)
#pragma unroll
        for (int b = 0; b < 2; ++b)
#pragma unroll
            for (int m = 0; m < 4; ++m)
#pragma unroll
                for (int n = 0; n < 2; ++n) acc[a][b][m][n] = (f32x4){0.f, 0.f, 0.f, 0.f};
    bf16x8 At[4][2], B0[2][2], B1[2][2];
    const char* cA = S.aptr(cur); const char* cB = S.bptr(cur);
    PG8_STAGE(PG8_SB(0, 0), cB, voffB); PG8_STAGE(PG8_SA(0, 0), cA, voffA); PG8_STAGE(PG8_SB(0, 1), cB + hstep, voffB); PG8_STAGE(PG8_SA(0, 1), cA + hstep, voffA);
    if (wr == 1) PG8_BAR;
    PG8_WAIT_V(4); PG8_BAR;
    PG8_STAGE(PG8_SB(1, 0), cB + kstep, voffB); PG8_STAGE(PG8_SA(1, 0), cA + kstep, voffA); PG8_STAGE(PG8_SB(1, 1), cB + hstep + kstep, voffB);
    PG8_WAIT_V(6); PG8_BAR;
    for (;;) {
        const bool has_next = S.next(ui + 1, nxt);
        const char* nA = has_next ? S.aptr(nxt) : cA; const char* nB = has_next ? S.bptr(nxt) : cB;
        for (int t = 0; t < nt; t += 2) {
            const bool last = (t == nt - 2);
            const char* a1 = cA + (size_t)(t + 1) * kstep;
            const char* a2 = last ? nA : cA + (size_t)(t + 2) * kstep; const char* b2 = last ? nB : cB + (size_t)(t + 2) * kstep;
            const char* a3 = a2 + kstep; const char* b3 = b2 + kstep;
            PG8_LDB(B0, 0, 0); PG8_SCHED; PG8_LDA(At, 0, 0); PG8_STAGE(PG8_SA(1, 1), a1 + hstep, voffA);
            PG8_WAIT_L(8); PG8_BAR; PG8_WAIT_L(0); PG8_MMA(0, 0, At, B0); PG8_BAR; PG8_SCHED;
            PG8_LDB(B1, 0, 1); PG8_STAGE(PG8_SB(0, 0), b2, voffB);
            PG8_BAR; PG8_WAIT_L(0); PG8_MMA(0, 1, At, B1); PG8_BAR;
            PG8_LDA(At, 0, 1); PG8_STAGE(PG8_SA(0, 0), a2, voffA);
            PG8_BAR; PG8_WAIT_L(0); PG8_MMA(1, 0, At, B0); PG8_BAR; PG8_SCHED;
            PG8_STAGE(PG8_SB(0, 1), b2 + hstep, voffB);
            PG8_WAIT_V(6); PG8_BAR; PG8_MMA(1, 1, At, B1); PG8_BAR;
            PG8_LDB(B0, 1, 0); PG8_SCHED; PG8_LDA(At, 1, 0); PG8_STAGE(PG8_SA(0, 1), a2 + hstep, voffA);
            PG8_WAIT_L(8); PG8_BAR; PG8_WAIT_L(0); PG8_MMA(0, 0, At, B0); PG8_BAR; PG8_SCHED;
            PG8_LDB(B1, 1, 1); PG8_STAGE(PG8_SB(1, 0), b3, voffB);
            PG8_BAR; PG8_WAIT_L(0); PG8_MMA(0, 1, At, B1); PG8_BAR;
            PG8_LDA(At, 1, 1); PG8_STAGE(PG8_SA(1, 0), a3, voffA);
            PG8_BAR; PG8_WAIT_L(0); PG8_MMA(1, 0, At, B0); PG8_BAR; PG8_SCHED;
            PG8_STAGE(PG8_SB(1, 1), b3 + hstep, voffB);
            PG8_WAIT_V(6); PG8_BAR; PG8_MMA(1, 1, At, B1); PG8_BAR;
        }
        E(acc, cur, wr, wc, fr, fq);
        if (!has_next) break;
#pragma unroll
        for (int a = 0; a < 2; ++a)
#pragma unroll
            for (int b = 0; b < 2; ++b)
#pragma unroll
                for (int m = 0; m < 4; ++m)
#pragma unroll
                    for (int n = 0; n < 2; ++n) acc[a][b][m][n] = (f32x4){0.f, 0.f, 0.f, 0.f};
        cur = nxt; cA = nA; cB = nB; ++ui;
    }
    PG8_WAIT_V(0);
    if (wr == 0) PG8_BAR;
    PG8_BAR;
#undef PG8_SA
#undef PG8_SB
#undef PG8_STAGE
#undef PG8_LDA
#undef PG8_LDB
#undef PG8_MMA
#undef PG8_WAIT_V
#undef PG8_WAIT_L
#undef PG8_BAR
#undef PG8_SCHED
}
}

#define XB_TMO      128
#define XB_XCNT(j)  (256  + 64 * (j))
#define XB_XSUB(j)  (1280 + 64 * (j))
#define XB_XGEN(j)  (2304 + 64 * (j))
#define XB_TOP      3328
#define XB_TOPGEN   3392
#define XCD_BAR_WORDS 3456
#define XB_SPIN_CAP (1u << 20)
__device__ __forceinline__ unsigned xb_ld(unsigned* p)              { return __hip_atomic_load(p, __ATOMIC_RELAXED, __HIP_MEMORY_SCOPE_AGENT); }
__device__ __forceinline__ unsigned xb_add(unsigned* p, unsigned v) { return __hip_atomic_fetch_add(p, v, __ATOMIC_RELAXED, __HIP_MEMORY_SCOPE_AGENT); }
__device__ __forceinline__ unsigned xb_xcc_id() { return (unsigned)__builtin_amdgcn_s_getreg((3 << 11) | 20) & 0xFu; }
#define XB_SPIN(cond, bar) do { unsigned _sp = 0; while (cond) { __builtin_amdgcn_s_sleep(1); \
    if ((++_sp & 255u) == 0u) { if (xb_ld(&(bar)[XB_TMO])) break; if (_sp > XB_SPIN_CAP) { atomicAdd(&(bar)[XB_TMO], 1u); break; } } } } while (0)
struct XcdBarrier { unsigned* bar; unsigned x; volatile LAS unsigned* st; };
__device__ __forceinline__ XcdBarrier xcd_barrier_post(unsigned* bar, volatile LAS unsigned* st) {
    XcdBarrier b; b.bar = bar; b.x = xb_xcc_id(); b.st = st;
    if (threadIdx.x == 0) (void)xb_add(&bar[XB_XCNT(b.x)], 1u);
    return b;
}
__device__ __forceinline__ void xcd_barrier_complete(unsigned* bar, unsigned x, unsigned& nloc, unsigned& nx) {
    const unsigned G = gridDim.x * gridDim.y * gridDim.z;
    unsigned sum, cnt, mine, sp = 0u;
    for (;;) {
        sum = 0u; cnt = 0u; mine = 0u;
#pragma unroll
        for (unsigned j = 0; j < 16; ++j) { const unsigned c = xb_ld(&bar[XB_XCNT(j)]); sum += c; cnt += (c > 0u) ? 1u : 0u; mine = (j == x) ? c : mine; }
        if (sum == G) break;
        __builtin_amdgcn_s_sleep(1);
        if ((++sp & 255u) == 0u) { if (xb_ld(&bar[XB_TMO])) break; if (sp > XB_SPIN_CAP) { atomicAdd(&bar[XB_TMO], 1u); break; } }
    }
    nloc = mine > 0u ? mine : 1u; nx = cnt > 0u ? cnt : 1u;
}
__device__ __forceinline__ void xcd_barrier(const XcdBarrier& b) {
    asm volatile("s_waitcnt vmcnt(0)" ::: "memory");
    __syncthreads();
    if (threadIdx.x == 0) {
        unsigned* bar = b.bar;
        __builtin_amdgcn_s_waitcnt(0);
        unsigned nloc = b.st[0], nx = b.st[1];
        if (nloc == 0u) { xcd_barrier_complete(bar, b.x, nloc, nx); b.st[0] = nloc; b.st[1] = nx; }
        const unsigned old = xb_add(&bar[XB_XSUB(b.x)], 1u);
        const unsigned gen = old / nloc;
        if (old + 1u == (gen + 1u) * nloc) {
            __builtin_amdgcn_fence(__ATOMIC_RELEASE, "agent");
            asm volatile("s_waitcnt vmcnt(0)" ::: "memory");
            const unsigned og = xb_add(&bar[XB_TOP], 1u);
            const unsigned tg = og / nx;
            if (og + 1u == (tg + 1u) * nx) xb_add(&bar[XB_TOPGEN], 1u);
            else XB_SPIN(xb_ld(&bar[XB_TOPGEN]) == tg, bar);
            __builtin_amdgcn_fence(__ATOMIC_ACQUIRE, "agent");
            xb_add(&bar[XB_XGEN(b.x)], 1u);
            asm volatile("s_waitcnt vmcnt(0)" ::: "memory");
        } else {
            XB_SPIN(xb_ld(&bar[XB_XGEN(b.x)]) == gen, bar);
            __builtin_amdgcn_fence(__ATOMIC_ACQUIRE, "agent");
            asm volatile("s_waitcnt vmcnt(0)" ::: "memory");
        }
    }
    __syncthreads();
}

struct Params {
    const float* in[27];
    float* out;
    unsigned char* ws;
    int ph_lo, ph_hi;
};
typedef const __attribute__((address_space(4))) Params* PP;
enum { I_X = 0, I_C, I_CTX, I_CCTX, I_WMOD, I_BMOD, I_NMIXG, I_WIN, I_QNG, I_KNG, I_LQ1, I_LK1, I_LQ2, I_LK2, I_SUBLN, I_CONVW, I_ALOG, I_DTB, I_GDNG, I_WOUT, I_NFFNG, I_RW, I_RB, I_WGU, I_BGU, I_WD, I_BD };

__device__ __forceinline__ const float* hrow_in(PP p, int layer, int r) {
    if (layer == 0) return r < NLAT ? p->in[I_X] + (size_t)r * D : p->in[I_CTX] + (size_t)(r - NLAT) * D;
    return (const float*)(p->ws + WS_H) + (size_t)r * D;
}
__device__ __forceinline__ int mod_sel(int r) { return r < NLAT ? (r >= SEQL ? 1 : 0) : 2; }

__device__ __forceinline__ void transpose_item(const float* W, size_t ldw, int k0, int n0, bf16_t* WT, int drow0, LAS float* scr, int lane) {
#pragma unroll 8
    for (int i = 0; i < 32; ++i) { const int kk = 2 * i + (lane >> 5); scr[kk * 33 + (lane & 31)] = W[(size_t)(k0 + kk) * ldw + n0 + (lane & 31)]; }
    LDS_WAIT(); asm volatile("" ::: "memory");
    const int c = lane & 7;
#pragma unroll
    for (int j = 0; j < 4; ++j) { const int n = (lane >> 3) + 8 * j; const LAS float* s = scr + (8 * c) * 33 + n;
        u32x4 o; o.x = pk2(s[0 * 33], s[1 * 33]); o.y = pk2(s[2 * 33], s[3 * 33]); o.z = pk2(s[4 * 33], s[5 * 33]); o.w = pk2(s[6 * 33], s[7 * 33]);
        *(u32x4*)(WT + (size_t)(drow0 + n) * 1024 + k0 + 8 * c) = o; }
    LDS_WAIT(); asm volatile("" ::: "memory");
}

__device__ __forceinline__ void phase_prologue(PP p, LAS unsigned char* lds) {
    int tid = threadIdx.x, bid = blockIdx.x, gdim = gridDim.x; asm volatile("" : "+v"(tid), "+s"(bid), "+s"(gdim)); const int lane = tid & 63, wave = __builtin_amdgcn_readfirstlane(tid >> 6);
    float* cf = (float*)(p->ws + WS_CONST);
    if (bid < 192) {
        const int l = bid / 96, cg = bid % 96;
        LAS float* sl = (LAS float*)lds;
        LAS float* red = sl + 3 * 1024;
        for (int i = tid; i < 3 * 1024; i += NTHR) { const int s = i >> 10, k = i & 1023; const float v = s < 2 ? p->in[I_C][s * D + k] : p->in[I_CCTX][k]; sl[i] = silu_f(v); }
        __syncthreads();
        const float* wm = p->in[I_WMOD] + (size_t)l * D * 6144 + cg * 64 + lane;
        float a0 = 0.f, a1 = 0.f, a2 = 0.f;
#pragma unroll 16
        for (int kk = 0; kk < 128; ++kk) { const int k = wave * 128 + kk; const float w = wm[(size_t)k * 6144]; a0 += sl[k] * w; a1 += sl[1024 + k] * w; a2 += sl[2048 + k] * w; }
        red[(wave * 3 + 0) * 64 + lane] = a0; red[(wave * 3 + 1) * 64 + lane] = a1; red[(wave * 3 + 2) * 64 + lane] = a2;
        __syncthreads();
        if (wave < 3) { float s = 0.f;
#pragma unroll
            for (int w = 0; w < 8; ++w) s += red[(w * 3 + wave) * 64 + lane];
            cf[CF_MODV + (l * 3 + wave) * 6144 + cg * 64 + lane] = s + p->in[I_BMOD][l * 6144 + cg * 64 + lane]; }
        __syncthreads();
    }
    if (bid >= 192 && bid < 202) {
        const int idx = (bid - 192) * NTHR + tid;
        if (idx < 320 * 16) { const int pos = idx >> 4, i = idx & 15; const float invf = powf(10000.f, -(float)i / 16.f);
            const float posf = (float)(pos < 256 ? pos : pos - 256); const float ang = posf * invf; const double a = (double)ang;
            const float cs = (float)cos(a), sn = (float)sin(a);
            if (pos < 256) { cf[CF_ROPE + pos * 16 + i] = cs; cf[CF_ROPE + 4096 + pos * 16 + i] = sn; }
            else { cf[CF_ROPE + 8192 + (pos - 256) * 16 + i] = cs; cf[CF_ROPE + 9216 + (pos - 256) * 16 + i] = sn; } }
    }
    if (bid == 202 && wave < 2) {
        const int l = wave;
        const float d1 = wave_sum(p->in[I_LQ1][l * 64 + lane] * p->in[I_LK1][l * 64 + lane]);
        const float d2 = wave_sum(p->in[I_LQ2][l * 64 + lane] * p->in[I_LK2][l * 64 + lane]);
        const float lam_init = 0.8f - 0.6f * expf(-0.3f * (float)l);
        const float mq = wave_max(fabsf(p->in[I_QNG][l * 64 + lane])), mk = wave_max(fabsf(p->in[I_KNG][l * 64 + lane]));
        if (lane == 0) { cf[CF_SC + l * 16 + 0] = expf(d1) - expf(d2) + lam_init; cf[CF_SC + l * 16 + 1] = LOG2E * 0.125f * 64.f * mq * mk * 1.0001f + 0.01f; cf[CF_SC + l * 16 + 2] = 1.f - lam_init; }
    }
    {
        LAS float* scr = (LAS float*)(lds + wave * 16384);
        const int gw = bid * NWAVES + wave, NGW = gdim * NWAVES;
        constexpr int I_IN = 16 * 112, I_OUT = 16 * 32, I_GU = 16 * 64, I_DN = 16 * 32;
        constexpr int PER_LAYER = I_IN + I_OUT + NEXP * I_GU + NEXP * I_DN;
        for (int it = gw; it < 2 * PER_LAYER; it += NGW) {
            const int l = it / PER_LAYER; int r = it % PER_LAYER;
            if (r < I_IN) { const int kb = r / 112, nb = r % 112;
                transpose_item(p->in[I_WIN] + (size_t)l * D * INC, INC, kb * 64, nb * 32, (bf16_t*)(p->ws + WS_WIN) + (size_t)l * PW * 1024, nb * 32, scr, lane); continue; }
            r -= I_IN;
            if (r < I_OUT) { const int kb = r / 32, nb = r % 32;
                transpose_item(p->in[I_WOUT] + (size_t)l * D * D, D, kb * 64, nb * 32, (bf16_t*)(p->ws + WS_WOUT) + (size_t)l * D * 1024, nb * 32, scr, lane); continue; }
            r -= I_OUT;
            if (r < NEXP * I_GU) { const int e = r / I_GU, q = r % I_GU, kb = q / 64, nb = q % 64; const int n0 = nb * 32, j = n0 & 1023, isup = n0 >> 10;
                const int drow = (j >> 7) * 256 + isup * 128 + (j & 127);
                transpose_item(p->in[I_WGU] + (size_t)(l * NEXP + e) * D * 2048, 2048, kb * 64, n0, (bf16_t*)(p->ws + WS_WGU) + (size_t)(l * NEXP + e) * 2048 * 1024, drow, scr, lane); continue; }
            r -= NEXP * I_GU;
            { const int e = r / I_DN, q = r % I_DN, kb = q / 32, nb = q % 32;
                transpose_item(p->in[I_WD] + (size_t)(l * NEXP + e) * D * D, D, kb * 64, nb * 32, (bf16_t*)(p->ws + WS_WD) + (size_t)(l * NEXP + e) * D * 1024, nb * 32, scr, lane); }
        }
    }
}

struct PlainSched {
    const char* A; const char* Bt; int K, nM, nN, nwg, G, c;
    __device__ __forceinline__ void init(const void* A_, const void* Bt_, int K_, int nM_, int nN_, int G_, int c_) { A = (const char*)A_; Bt = (const char*)Bt_; K = K_; nM = nM_; nN = nN_; nwg = nM * nN; G = G_; c = c_; }
    __device__ __forceinline__ bool next(int i, pg8::Unit& u) const {
        const long L = (long)i * G + c; if (L >= nwg) return false;
        int wgid = (int)L; { const int q = nwg / 8, r = nwg % 8, xcd = wgid % 8, off = wgid / 8; wgid = (xcd < r ? xcd * (q + 1) : r * (q + 1) + (xcd - r) * q) + off; }
        const int nig = 8 * nN, gid = wgid / nig, fm = gid * 8, gsz = (nM - fm) < 8 ? (nM - fm) : 8;
        u.pm = fm + ((wgid % nig) % gsz); u.pn = (wgid % nig) / gsz; return true;
    }
    __device__ __forceinline__ const char* aptr(const pg8::Unit& u) const { return A + (size_t)u.pm * 256 * K * 2; }
    __device__ __forceinline__ const char* bptr(const pg8::Unit& u) const { return Bt + (size_t)u.pn * 256 * K * 2; }
};
struct MoeSched {
    const char* A; const char* W; const int* blk_e; int nblk, nN, G, c;
    __device__ __forceinline__ bool next(int i, pg8::Unit& u) const {
        const long L = (long)i * G + c; const int pm = (int)(L / nN); if (pm >= nblk) return false;
        u.pm = pm; u.pn = (int)(L % nN); return true;
    }
    __device__ __forceinline__ const char* aptr(const pg8::Unit& u) const { return A + (size_t)u.pm * 256 * 1024 * 2; }
    __device__ __forceinline__ const char* bptr(const pg8::Unit& u) const { const int e = blk_e[u.pm]; return W + ((size_t)e * nN + u.pn) * 256 * 1024 * 2; }
};
struct EpiStoreBf16 {
    static constexpr bool PERM = true;
    bf16_t* O; int ldc;
    __device__ __forceinline__ void operator()(const f32x4 (&acc)[2][2][4][2], const pg8::Unit& u, int wr, int wc, int fr, int fq) const {
        const int row0 = u.pm * 256 + wr * 64 + fr, col0 = u.pn * 256 + wc * 32 + 8 * fq;
#pragma unroll
        for (int ai = 0; ai < 2; ++ai)
#pragma unroll
            for (int m = 0; m < 4; ++m) { bf16_t* rowp = O + (size_t)(row0 + ai * 128 + m * 16) * ldc + col0;
#pragma unroll
                for (int bj = 0; bj < 2; ++bj) { const f32x4 v0 = acc[ai][bj][m][0], v1 = acc[ai][bj][m][1];
                    u32x4 w; w.x = cvt_pk_bf16(v0[0], v0[1]); w.y = cvt_pk_bf16(v0[2], v0[3]); w.z = cvt_pk_bf16(v1[0], v1[1]); w.w = cvt_pk_bf16(v1[2], v1[3]);
                    *(u32x4*)(rowp + bj * 128) = w; } }
    }
};
struct EpiResidual {
    static constexpr bool PERM = false;
    PP p; int layer; const float* gate;
    __device__ __forceinline__ void operator()(const f32x4 (&acc)[2][2][4][2], const pg8::Unit& u, int wr, int wc, int fr, int fq) const {
        const int row0 = u.pm * 256 + wr * 64 + fr, col0 = u.pn * 256 + wc * 32 + 4 * fq;
        float* H = (float*)(p->ws + WS_H);
#pragma unroll
        for (int ai = 0; ai < 2; ++ai)
#pragma unroll
            for (int m = 0; m < 4; ++m) { const int row = row0 + ai * 128 + m * 16; const float* hin = hrow_in(p, layer, row) + col0; const float* g = gate + mod_sel(row) * 6144 + col0;
                float* ho = H + (size_t)row * D + col0;
#pragma unroll
                for (int bj = 0; bj < 2; ++bj)
#pragma unroll
                    for (int n = 0; n < 2; ++n) { const f32x4 hv = *(const f32x4*)(hin + bj * 128 + n * 16), gv = *(const f32x4*)(g + bj * 128 + n * 16);
                        *(f32x4*)(ho + bj * 128 + n * 16) = hv + gv * acc[ai][bj][m][n]; } }
    }
};
struct EpiGateUp {
    static constexpr bool PERM = true;
    bf16_t* ACT; const float* bgu; const int* blk_e;
    __device__ __forceinline__ void operator()(const f32x4 (&acc)[2][2][4][2], const pg8::Unit& u, int wr, int wc, int fr, int fq) const {
        const int row0 = u.pm * 256 + wr * 64 + fr, col0 = u.pn * 128 + wc * 32 + 8 * fq; const int e = blk_e[u.pm];
        const float* bg = bgu + (size_t)e * 2048 + col0; const float* bu = bg + 1024;
        f32x4 bgv[2], buv[2];
#pragma unroll
        for (int n = 0; n < 2; ++n) { bgv[n] = *(const f32x4*)(bg + 4 * n); buv[n] = *(const f32x4*)(bu + 4 * n); }
#pragma unroll
        for (int ai = 0; ai < 2; ++ai)
#pragma unroll
            for (int m = 0; m < 4; ++m) { float o[8];
#pragma unroll
                for (int n = 0; n < 2; ++n)
#pragma unroll
                    for (int j = 0; j < 4; ++j) { float g = acc[ai][0][m][n][j] + bgv[n][j], up = acc[ai][1][m][n][j] + buv[n][j];
                        g = fminf(g, 7.f); up = fminf(fmaxf(up, -7.f), 7.f);
                        const float glu = g / (1.f + __expf(-1.702f * g)); o[n * 4 + j] = (up + 1.f) * glu; }
                u32x4 w; w.x = cvt_pk_bf16(o[0], o[1]); w.y = cvt_pk_bf16(o[2], o[3]); w.z = cvt_pk_bf16(o[4], o[5]); w.w = cvt_pk_bf16(o[6], o[7]);
                *(u32x4*)(ACT + (size_t)(row0 + ai * 128 + m * 16) * 1024 + col0) = w; }
    }
};
struct EpiDown {
    static constexpr bool PERM = true;
    bf16_t* Y; const float* bd; const int* blk_e; const float* sgate;
    __device__ __forceinline__ void operator()(const f32x4 (&acc)[2][2][4][2], const pg8::Unit& u, int wr, int wc, int fr, int fq) const {
        const int row0 = u.pm * 256 + wr * 64 + fr, col0 = u.pn * 256 + wc * 32 + 8 * fq; const int e = blk_e[u.pm];
        const float* b = bd + (size_t)e * 1024 + col0;
        f32x4 bv[2][2];
#pragma unroll
        for (int bj = 0; bj < 2; ++bj)
#pragma unroll
            for (int n = 0; n < 2; ++n) bv[bj][n] = *(const f32x4*)(b + bj * 128 + 4 * n);
#pragma unroll
        for (int ai = 0; ai < 2; ++ai)
#pragma unroll
            for (int m = 0; m < 4; ++m) { const int row = row0 + ai * 128 + m * 16; const float sg = sgate[row]; bf16_t* rowp = Y + (size_t)row * 1024 + col0;
#pragma unroll
                for (int bj = 0; bj < 2; ++bj) { const f32x4 v0 = (acc[ai][bj][m][0] + bv[bj][0]) * sg, v1 = (acc[ai][bj][m][1] + bv[bj][1]) * sg;
                    u32x4 w; w.x = cvt_pk_bf16(v0[0], v0[1]); w.y = cvt_pk_bf16(v0[2], v0[3]); w.z = cvt_pk_bf16(v1[0], v1[1]); w.w = cvt_pk_bf16(v1[2], v1[3]);
                    *(u32x4*)(rowp + bj * 128) = w; } }
    }
};

__device__ __forceinline__ void norm_mod_row(const float* hrow, const float* g, const float* shift, const float* scale, int lane, f32x4 (&u)[4]) {
    float ss = 0.f;
#pragma unroll
    for (int j = 0; j < 4; ++j) { u[j] = *(const f32x4*)(hrow + 4 * lane + 256 * j); ss += (u[j][0] * u[j][0] + u[j][1] * u[j][1]) + (u[j][2] * u[j][2] + u[j][3] * u[j][3]); }
    const float rstd = rsqrtf(wave_sum(ss) * (1.f / D) + EPS);
#pragma unroll
    for (int j = 0; j < 4; ++j) { const int c = 4 * lane + 256 * j; const f32x4 gv = *(const f32x4*)(g + c), sh = *(const f32x4*)(shift + c), sc = *(const f32x4*)(scale + c);
        u[j] = (u[j] * rstd) * gv * (sc + 1.f) + sh; }
}
__device__ __forceinline__ void store_row_bf16(bf16_t* orow, int lane, const f32x4 (&u)[4]) {
#pragma unroll
    for (int j = 0; j < 4; ++j) { u32x2 w; w.x = cvt_pk_bf16(u[j][0], u[j][1]); w.y = cvt_pk_bf16(u[j][2], u[j][3]); *(u32x2*)(orow + 4 * lane + 256 * j) = w; }
}

__device__ __forceinline__ void phase_norm_mix(PP p, int layer, LAS unsigned char* lds) {
    int tid = threadIdx.x, bid = blockIdx.x, gdim = gridDim.x; asm volatile("" : "+v"(tid), "+s"(bid), "+s"(gdim)); const int lane = tid & 63, wave = __builtin_amdgcn_readfirstlane(tid >> 6);
    LAS float* wab = (LAS float*)lds;
    const float* win = p->in[I_WIN] + (size_t)layer * D * INC;
    for (int i = tid; i < 16 * 1024; i += NTHR) { const int k = i >> 4, j = i & 15; wab[j * 1024 + k] = win[(size_t)k * INC + PW + j]; }
    __syncthreads();
    const float* cf = (const float*)(p->ws + WS_CONST);
    const float* gn = p->in[I_NMIXG] + layer * D;
    float ea = 0.f, dtb = 0.f; if (lane < 8) { ea = -__expf(p->in[I_ALOG][layer * 8 + lane]); dtb = p->in[I_DTB][layer * 8 + lane]; }
    for (int r = bid * NWAVES + wave; r < NTOK; r += gdim * NWAVES) {
        const float* mv = cf + CF_MODV + (layer * 3 + mod_sel(r)) * 6144;
        f32x4 u[4]; norm_mod_row(hrow_in(p, layer, r), gn, mv, mv + 1024, lane, u);
        store_row_bf16((bf16_t*)(p->ws + WS_U) + (size_t)r * D, lane, u);
        float ab = 0.f;
#pragma unroll
        for (int j = 0; j < 16; ++j) { float s = 0.f;
#pragma unroll
            for (int q = 0; q < 4; ++q) { const f32x4 w = *(const LAS f32x4*)(wab + j * 1024 + 4 * lane + 256 * q); s += (u[q][0] * w[0] + u[q][1] * w[1]) + (u[q][2] * w[2] + u[q][3] * w[3]); }
            s = wave_sum(s); if (lane == j) ab = s; }
        float outv;
        if (lane < 8) { const float z = ab + dtb; const float sp = z > 20.f ? z : log1pf(__expf(z)); outv = ea * sp; }
        else outv = 1.f / (1.f + __expf(-ab));
        if (lane < 16) ((float*)(p->ws + WS_GB))[(size_t)r * 16 + lane] = outv;
    }
}

__device__ __forceinline__ void phase_prep(PP p, int layer) {
    int tid = threadIdx.x, bid = blockIdx.x, gdim = gridDim.x; asm volatile("" : "+v"(tid), "+s"(bid), "+s"(gdim)); const int lane = tid & 63, wave = __builtin_amdgcn_readfirstlane(tid >> 6);
    const float* cf = (const float*)(p->ws + WS_CONST);
    bf16_t* P = (bf16_t*)(p->ws + WS_P); bf16_t* G = (bf16_t*)(p->ws + WS_G);
    const float* cw = p->in[I_CONVW] + (size_t)layer * 5 * 1536;
    float gain[16];
    { const float* gsrc = (lane < 32 ? p->in[I_QNG] : p->in[I_KNG]) + layer * 64 + 16 * (lane & 3);
#pragma unroll
      for (int e = 0; e < 16; ++e) gain[e] = gsrc[e]; }
    const float qscale = lane < 32 ? 0.125f * LOG2E : 1.f;
    for (int r = bid * NWAVES + wave; r < NTOK; r += gdim * NWAVES) {
        bf16_t* prow = P + (size_t)r * PW + 16 * lane;
        const u32x4 w0 = *(const u32x4*)prow, w1 = *(const u32x4*)(prow + 8);
        float x[16];
#pragma unroll
        for (int e = 0; e < 4; ++e) { x[2 * e] = bflo(w0[e]); x[2 * e + 1] = bfhi(w0[e]); x[8 + 2 * e] = bflo(w1[e]); x[8 + 2 * e + 1] = bfhi(w1[e]); }
        float ss = 0.f;
#pragma unroll
        for (int e = 0; e < 16; ++e) ss += x[e] * x[e];
        ss += __shfl_xor(ss, 1); ss += __shfl_xor(ss, 2);
        const float rstd = rsqrtf(ss * (1.f / 64.f) + EPS);
#pragma unroll
        for (int e = 0; e < 16; ++e) x[e] = x[e] * rstd * gain[e];
        if (r < NLAT) {
            const int t = r & (SEQL - 1); const int pos = (lane & 2) ? (t & 63) : (t >> 6);
            const float* ct = cf + CF_ROPE + ((lane & 2) ? 8192 : 0) + pos * 16; const float* st = ct + ((lane & 2) ? 1024 : 4096);
            const bool second = lane & 1;
#pragma unroll
            for (int e = 0; e < 16; ++e) { const float other = __shfl_xor(x[e], 1); const float cs = ct[e], sn = st[e];
                x[e] = second ? (x[e] * cs + other * sn) : (x[e] * cs - other * sn); }
        }
        u32x4 o0, o1;
#pragma unroll
        for (int e = 0; e < 4; ++e) { o0[e] = cvt_pk_bf16(x[2 * e] * qscale, x[2 * e + 1] * qscale); o1[e] = cvt_pk_bf16(x[8 + 2 * e] * qscale, x[8 + 2 * e + 1] * qscale); }
        *(u32x4*)prow = o0; *(u32x4*)(prow + 8) = o1;
    }
    for (int r = bid * NWAVES + wave; r < NTOK; r += gdim * NWAVES) {
        int seg0, seglen; if (r < NLAT) { seg0 = r & ~(SEQL - 1); seglen = SEQL; } else { seg0 = NLAT + ((r - NLAT) & ~(CTXL - 1)); seglen = CTXL; }
        const int tpos = r - seg0;
#pragma unroll
        for (int grp = 0; grp < 3; ++grp) {
            const int c0 = grp * 512 + 8 * lane;
            float a[8];
#pragma unroll
            for (int e = 0; e < 8; ++e) a[e] = 0.f;
#pragma unroll
            for (int j = 0; j < 5; ++j) { const int tp = tpos + j - 2;
                if (tp >= 0 && tp < seglen) { const u32x4 w = *(const u32x4*)(P + (size_t)(seg0 + tp) * PW + 1536 + c0);
                    const f32x4 k0 = *(const f32x4*)(cw + j * 1536 + c0), k1 = *(const f32x4*)(cw + j * 1536 + c0 + 4);
                    a[0] += bflo(w[0]) * k0[0]; a[1] += bfhi(w[0]) * k0[1]; a[2] += bflo(w[1]) * k0[2]; a[3] += bfhi(w[1]) * k0[3];
                    a[4] += bflo(w[2]) * k1[0]; a[5] += bfhi(w[2]) * k1[1]; a[6] += bflo(w[3]) * k1[2]; a[7] += bfhi(w[3]) * k1[3]; } }
            float ss = 0.f;
#pragma unroll
            for (int e = 0; e < 8; ++e) { a[e] = silu_f(a[e]); ss += a[e] * a[e]; }
            if (grp < 2) { ss += __shfl_xor(ss, 1); ss += __shfl_xor(ss, 2); ss += __shfl_xor(ss, 4); ss += __shfl_xor(ss, 8);
                const float rn = rsqrtf(ss + EPS);
#pragma unroll
                for (int e = 0; e < 8; ++e) a[e] *= rn; }
            u32x4 o; o.x = cvt_pk_bf16(a[0], a[1]); o.y = cvt_pk_bf16(a[2], a[3]); o.z = cvt_pk_bf16(a[4], a[5]); o.w = cvt_pk_bf16(a[6], a[7]);
            *(u32x4*)(G + (size_t)r * 1536 + c0) = o;
        }
    }
}

__device__ __forceinline__ void gdn_task_rows(int task, int& b, int& h, int& dir, int& rstart, int& rstep) {
    const int chain = task / NCHUNK, n = task % NCHUNK; dir = chain & 1; h = (chain >> 1) & 3; b = chain >> 3;
    if (n < 4) { const int base = NLAT + b * CTXL; if (dir == 0) { rstart = base + 64 * n; rstep = 1; } else { rstart = base + CTXL - 1 - 64 * n; rstep = -1; } }
    else { const int base = b * SEQL, m = n - 4; if (dir == 0) { rstart = base + 64 * m; rstep = 1; } else { rstart = base + SEQL - 1 - 64 * m; rstep = -1; } }
}
constexpr int CL_QL = 0, CL_KL = 17408, CL_KT = 34816, CL_VT = 53248, CL_AM = 71680, CL_AQ = 88064, CL_TL = 105472, CL_VEC = 114688;
constexpr int QLP = 136, KTP = 72, AQP = 68, TLP = 72;
__device__ __forceinline__ void phase_gdn_chunk(PP p, LAS unsigned char* lds) {
    int tid = threadIdx.x, bid = blockIdx.x, gdim = gridDim.x; asm volatile("" : "+v"(tid), "+s"(bid), "+s"(gdim)); const int lane = tid & 63, wave = __builtin_amdgcn_readfirstlane(tid >> 6), r32 = lane & 31, hi = lane >> 5;
    const bf16_t* G = (const bf16_t*)(p->ws + WS_G); const float* GB = (const float*)(p->ws + WS_GB);
    float* cf = (float*)(p->ws + WS_CONST);
    LAS bf16_t* QL = (LAS bf16_t*)(lds + CL_QL); LAS bf16_t* KL = (LAS bf16_t*)(lds + CL_KL); LAS bf16_t* KT = (LAS bf16_t*)(lds + CL_KT); LAS bf16_t* VT = (LAS bf16_t*)(lds + CL_VT);
    LAS float* AM = (LAS float*)(lds + CL_AM); LAS float* AQ = (LAS float*)(lds + CL_AQ); LAS bf16_t* TL = (LAS bf16_t*)(lds + CL_TL);
    LAS float* gc = (LAS float*)(lds + CL_VEC); LAS float* eg = gc + 64; LAS float* be = gc + 128; LAS float* beg = gc + 192; LAS float* kd = gc + 256;
    for (int task = bid; task < NTASK; task += gdim) {
        int b, h, dir, rstart, rstep; gdn_task_rows(task, b, h, dir, rstart, rstep);
        unsigned char* chb = p->ws + WS_CH + (size_t)task * CH_TASK_BYTES;
        if (wave == 0) { const int row = rstart + rstep * lane; float g = GB[(size_t)row * 16 + dir * 4 + h]; const float bt = GB[(size_t)row * 16 + 8 + dir * 4 + h];
#pragma unroll
            for (int o = 1; o < 64; o <<= 1) { const float t = __shfl_up(g, o); if (lane >= o) g += t; }
            const float glast = __shfl(g, 63); const float e = __expf(g);
            gc[lane] = g; eg[lane] = e; be[lane] = bt; beg[lane] = bt * e; kd[lane] = __expf(glast - g);
            if (lane == 0) cf[CF_EGL + task] = __expf(glast); }
        for (int pc = tid; pc < 3072; pc += NTHR) { const int mat = pc >> 10, i = (pc >> 4) & 63, c8 = pc & 15; const int row = rstart + rstep * i;
            const u32x4 w = *(const u32x4*)(G + (size_t)row * 1536 + mat * 512 + h * 128 + 8 * c8);
            if (mat == 0) *(LAS u32x4*)(QL + i * QLP + 8 * c8) = w;
            else { if (mat == 1) *(LAS u32x4*)(KL + i * QLP + 8 * c8) = w;
                LAS bf16_t* T = (mat == 1 ? KT : VT) + (8 * c8) * KTP + i;
#pragma unroll
                for (int e = 0; e < 4; ++e) { T[(2 * e) * KTP] = (bf16_t)(w[e] & 0xffffu); T[(2 * e + 1) * KTP] = (bf16_t)(w[e] >> 16); } } }
        __syncthreads();
        { const int which = wave >> 2, mi = (wave >> 1) & 1, ni = wave & 1; f32x16 acc = {};
          const LAS bf16_t* Arow = (which ? QL : KL) + (32 * mi + r32) * QLP + 8 * hi; const LAS bf16_t* Brow = KL + (32 * ni + r32) * QLP + 8 * hi;
#pragma unroll
          for (int ks = 0; ks < 8; ++ks) acc = MFMA32(*(const LAS bf16x8*)(Arow + 16 * ks), *(const LAS bf16x8*)(Brow + 16 * ks), acc);
          const int sp = 32 * ni + r32; const float gs = gc[sp];
#pragma unroll
          for (int r = 0; r < 16; ++r) { const int c = 32 * mi + crow(r, hi); const float dec = __expf(fminf(gc[c] - gs, 0.f));
              if (which == 0) AM[c * 64 + sp] = (sp < c) ? be[c] * acc[r] * dec : 0.f;
              else AQ[c * AQP + sp] = (sp <= c) ? 0.08838834764831845f * acc[r] * dec : 0.f; } }
        __syncthreads();
        if (wave == 0) {
            float t[64]; const LAS float* amb = AM; asm volatile("" : "+v"(amb));
#pragma unroll
            for (int i = 0; i < 64; ++i) { float a = (lane == i) ? 1.f : 0.f;
#pragma unroll
                for (int m4 = 0; m4 < (i + 3) / 4; ++m4) { const f32x4 av = *(const LAS f32x4*)(amb + i * 64 + 4 * m4);
#pragma unroll
                    for (int e = 0; e < 4; ++e) if (4 * m4 + e < i) a -= av[e] * t[4 * m4 + e]; }
                t[i] = a; }
#pragma unroll
            for (int i = 0; i < 64; ++i) TL[i * TLP + lane] = (bf16_t)f2bf(t[i]);
        } else {
            for (int f = wave - 1; f < 40; f += 7) {
                u32x4 o;
                if (f < 16) {
                    const int m = f >> 3, t = (f >> 1) & 3, s = f & 1, c = 32 * m + r32; const float sc = 0.08838834764831845f * eg[c];
                    const LAS bf16_t* src = QL + c * QLP + 32 * t + 16 * s + 4 * hi; const u32x2 a = *(const LAS u32x2*)src, bq = *(const LAS u32x2*)(src + 8);
                    o.x = cvt_pk_bf16(bflo(a.x) * sc, bfhi(a.x) * sc); o.y = cvt_pk_bf16(bflo(a.y) * sc, bfhi(a.y) * sc); o.z = cvt_pk_bf16(bflo(bq.x) * sc, bfhi(bq.x) * sc); o.w = cvt_pk_bf16(bflo(bq.y) * sc, bfhi(bq.y) * sc);
                    *(u32x4*)(chb + CH_QF + f * 1024 + lane * 16) = o;
                } else if (f < 32) {
                    const int g = f - 16, t = g >> 2, m = (g >> 1) & 1, s = g & 1, dk = 32 * t + r32, c0 = 32 * m + 16 * s + 4 * hi;
                    const LAS bf16_t* src = KT + dk * KTP + c0; const u32x2 a = *(const LAS u32x2*)src, bq = *(const LAS u32x2*)(src + 8);
                    const f32x4 s0 = *(const LAS f32x4*)(kd + c0), s1 = *(const LAS f32x4*)(kd + c0 + 8);
                    o.x = cvt_pk_bf16(bflo(a.x) * s0[0], bfhi(a.x) * s0[1]); o.y = cvt_pk_bf16(bflo(a.y) * s0[2], bfhi(a.y) * s0[3]); o.z = cvt_pk_bf16(bflo(bq.x) * s1[0], bfhi(bq.x) * s1[1]); o.w = cvt_pk_bf16(bflo(bq.y) * s1[2], bfhi(bq.y) * s1[3]);
                    *(u32x4*)(chb + CH_KF + g * 1024 + lane * 16) = o;
                } else {
                    const int g = f - 32, mo = g >> 2, m = (g >> 1) & 1, s = g & 1, c = 32 * mo + r32;
                    const LAS float* src = AQ + c * AQP + 32 * m + 16 * s + 4 * hi; const f32x4 a = *(const LAS f32x4*)src, bq = *(const LAS f32x4*)(src + 8);
                    o.x = cvt_pk_bf16(a[0], a[1]); o.y = cvt_pk_bf16(a[2], a[3]); o.z = cvt_pk_bf16(bq[0], bq[1]); o.w = cvt_pk_bf16(bq[2], bq[3]);
                    *(u32x4*)(chb + CH_AF + g * 1024 + lane * 16) = o;
                }
            }
        }
        __syncthreads();
        { const int t = wave >> 1, m = wave & 1; f32x16 acc = {};
#pragma unroll
          for (int ks = 0; ks < 4; ++ks) { const int s0 = 16 * ks + 8 * hi;
              const u32x4 kw = *(const LAS u32x4*)(KT + (32 * t + r32) * KTP + s0); const f32x4 c0 = *(const LAS f32x4*)(beg + s0), c1 = *(const LAS f32x4*)(beg + s0 + 4);
              u32x4 aw; aw.x = cvt_pk_bf16(bflo(kw.x) * c0[0], bfhi(kw.x) * c0[1]); aw.y = cvt_pk_bf16(bflo(kw.y) * c0[2], bfhi(kw.y) * c0[3]); aw.z = cvt_pk_bf16(bflo(kw.z) * c1[0], bfhi(kw.z) * c1[1]); aw.w = cvt_pk_bf16(bflo(kw.w) * c1[2], bfhi(kw.w) * c1[3]);
              const bf16x8 bfr = *(const LAS bf16x8*)(TL + (32 * m + r32) * TLP + s0);
              acc = MFMA32(__builtin_bit_cast(bf16x8, aw), bfr, acc); }
#pragma unroll
          for (int s = 0; s < 2; ++s) { u32x4 o; o.x = cvt_pk_bf16(-acc[8 * s + 0], -acc[8 * s + 1]); o.y = cvt_pk_bf16(-acc[8 * s + 2], -acc[8 * s + 3]); o.z = cvt_pk_bf16(-acc[8 * s + 4], -acc[8 * s + 5]); o.w = cvt_pk_bf16(-acc[8 * s + 6], -acc[8 * s + 7]);
              *(u32x4*)(chb + CH_WF + ((m * 4 + t) * 2 + s) * 1024 + lane * 16) = o; } }
        { const int m = wave >> 2, nj = wave & 3; f32x16 acc = {};
#pragma unroll
          for (int ks = 0; ks < 4; ++ks) { const int s0 = 16 * ks + 8 * hi;
              const bf16x8 afr = *(const LAS bf16x8*)(TL + (32 * m + r32) * TLP + s0);
              const u32x4 vw = *(const LAS u32x4*)(VT + (32 * nj + r32) * KTP + s0); const f32x4 c0 = *(const LAS f32x4*)(be + s0), c1 = *(const LAS f32x4*)(be + s0 + 4);
              u32x4 bw; bw.x = cvt_pk_bf16(bflo(vw.x) * c0[0], bfhi(vw.x) * c0[1]); bw.y = cvt_pk_bf16(bflo(vw.y) * c0[2], bfhi(vw.y) * c0[3]); bw.z = cvt_pk_bf16(bflo(vw.z) * c1[0], bfhi(vw.z) * c1[1]); bw.w = cvt_pk_bf16(bflo(vw.w) * c1[2], bfhi(vw.w) * c1[3]);
              acc = MFMA32(afr, __builtin_bit_cast(bf16x8, bw), acc); }
          float* uc = (float*)(chb + CH_UC) + ((nj * 2 + m) * 64 + lane) * 16;
#pragma unroll
          for (int q = 0; q < 4; ++q) *(f32x4*)(uc + 4 * q) = (f32x4){acc[4 * q], acc[4 * q + 1], acc[4 * q + 2], acc[4 * q + 3]}; }
        __syncthreads();
    }
}

__device__ __forceinline__ void phase_gdn_scan(PP p, LAS unsigned char* lds) {
    int tid = threadIdx.x, bid = blockIdx.x, gdim = gridDim.x; asm volatile("" : "+v"(tid), "+s"(bid), "+s"(gdim)); const int lane = tid & 63, wave = __builtin_amdgcn_readfirstlane(tid >> 6), r32 = lane & 31, hi = lane >> 5;
    if (bid >= 16) return;
    const int chain = bid; const float* cf = (const float*)(p->ws + WS_CONST);
    float* OG = (float*)(p->ws + WS_OG);
    f32x16 S[4];
#pragma unroll
    for (int t = 0; t < 4; ++t) S[t] = (f32x16){};
    { const unsigned char* src = p->ws + WS_CH + (size_t)(chain * NCHUNK) * CH_TASK_BYTES;
#pragma unroll
      for (int i = 0; i < 7; ++i) { const int pc = wave * 7 + i; __builtin_amdgcn_global_load_lds((const unsigned*)(src + pc * 1024 + lane * 16), (LAS unsigned*)(lds + pc * 1024), 16, 0, 0); } }
    for (int n = 0; n < NCHUNK; ++n) {
        const int task = chain * NCHUNK + n;
        VM_WAIT(); __syncthreads();
        if (n + 1 < NCHUNK) { const unsigned char* src = p->ws + WS_CH + (size_t)(task + 1) * CH_TASK_BYTES; LAS unsigned char* dst = lds + ((n + 1) & 1) * CH_DMA_BYTES;
#pragma unroll
            for (int i = 0; i < 7; ++i) { const int pc = wave * 7 + i; __builtin_amdgcn_global_load_lds((const unsigned*)(src + pc * 1024 + lane * 16), (LAS unsigned*)(dst + pc * 1024), 16, 0, 0); } }
        if (wave < 4) {
            int b, h, dir, rstart, rstep; gdn_task_rows(task, b, h, dir, rstart, rstep);
            const LAS unsigned char* buf = lds + (n & 1) * CH_DMA_BYTES + lane * 16;
            const float* uc = (const float*)(p->ws + WS_CH + (size_t)task * CH_TASK_BYTES + CH_UC) + ((wave * 2) * 64 + lane) * 16;
            f32x16 V[2], O[2];
#pragma unroll
            for (int m = 0; m < 2; ++m) {
#pragma unroll
                for (int q = 0; q < 4; ++q) { const f32x4 t4 = *(const f32x4*)(uc + m * 1024 + 4 * q); V[m][4 * q] = t4[0]; V[m][4 * q + 1] = t4[1]; V[m][4 * q + 2] = t4[2]; V[m][4 * q + 3] = t4[3]; }
                O[m] = (f32x16){}; }
            const float egl = cf[CF_EGL + task];
            bf16x8 Sb[4][2];
#pragma unroll
            for (int t = 0; t < 4; ++t)
#pragma unroll
                for (int s = 0; s < 2; ++s) { u32x4 w; w.x = cvt_pk_bf16(S[t][8 * s], S[t][8 * s + 1]); w.y = cvt_pk_bf16(S[t][8 * s + 2], S[t][8 * s + 3]); w.z = cvt_pk_bf16(S[t][8 * s + 4], S[t][8 * s + 5]); w.w = cvt_pk_bf16(S[t][8 * s + 6], S[t][8 * s + 7]);
                    Sb[t][s] = __builtin_bit_cast(bf16x8, w); }
#pragma unroll
            for (int m = 0; m < 2; ++m)
#pragma unroll
                for (int t = 0; t < 4; ++t)
#pragma unroll
                    for (int s = 0; s < 2; ++s) { const int f = (m * 4 + t) * 2 + s;
                        V[m] = MFMA32(*(const LAS bf16x8*)(buf + CH_WF + f * 1024), Sb[t][s], V[m]);
                        O[m] = MFMA32(*(const LAS bf16x8*)(buf + CH_QF + f * 1024), Sb[t][s], O[m]);
                        if (s == 1 && (t & 1)) __builtin_amdgcn_sched_barrier(0); }
            bf16x8 Vb[2][2];
#pragma unroll
            for (int m = 0; m < 2; ++m)
#pragma unroll
                for (int s = 0; s < 2; ++s) { u32x4 w; w.x = cvt_pk_bf16(V[m][8 * s], V[m][8 * s + 1]); w.y = cvt_pk_bf16(V[m][8 * s + 2], V[m][8 * s + 3]); w.z = cvt_pk_bf16(V[m][8 * s + 4], V[m][8 * s + 5]); w.w = cvt_pk_bf16(V[m][8 * s + 6], V[m][8 * s + 7]);
                    Vb[m][s] = __builtin_bit_cast(bf16x8, w); }
#pragma unroll
            for (int mo = 0; mo < 2; ++mo)
#pragma unroll
                for (int m = 0; m <= mo; ++m)
#pragma unroll
                    for (int s = 0; s < 2; ++s) O[mo] = MFMA32(*(const LAS bf16x8*)(buf + CH_AF + ((mo * 2 + m) * 2 + s) * 1024), Vb[m][s], O[mo]);
#pragma unroll
            for (int t = 0; t < 4; ++t) {
                __builtin_amdgcn_sched_barrier(0);
#pragma unroll
                for (int r = 0; r < 16; ++r) S[t][r] *= egl;
#pragma unroll
                for (int m = 0; m < 2; ++m)
#pragma unroll
                    for (int s = 0; s < 2; ++s) S[t] = MFMA32(*(const LAS bf16x8*)(buf + CH_KF + ((t * 2 + m) * 2 + s) * 1024), Vb[m][s], S[t]); }
            float* og = OG + (size_t)dir * NTOK * 512 + h * 128 + 32 * wave + r32;
#pragma unroll
            for (int m = 0; m < 2; ++m)
#pragma unroll
                for (int r = 0; r < 16; ++r) { const int c = 32 * m + crow(r, hi); og[(size_t)(rstart + rstep * c) * 512] = O[m][r]; }
        }
    }
    VM_WAIT(); __syncthreads();
}

__device__ __forceinline__ void phase_gdn_out(PP p, int layer) {
    int tid = threadIdx.x, bid = blockIdx.x, gdim = gridDim.x; asm volatile("" : "+v"(tid), "+s"(bid), "+s"(gdim)); const int lane = tid & 63, wave = __builtin_amdgcn_readfirstlane(tid >> 6);
    const float* OG = (const float*)(p->ws + WS_OG); const float* OA = (const float*)(p->ws + WS_OA); const bf16_t* P = (const bf16_t*)(p->ws + WS_P); bf16_t* MIX = (bf16_t*)(p->ws + WS_MIX);
    const float* cf = (const float*)(p->ws + WS_CONST);
    const float lam = cf[CF_SC + layer * 16 + 0], oml = cf[CF_SC + layer * 16 + 2];
    const float* gn = p->in[I_GDNG] + layer * 128 + (8 * lane & 127); const float* sg = p->in[I_SUBLN] + layer * 128 + (8 * lane & 127);
    const f32x4 g0 = *(const f32x4*)gn, g1 = *(const f32x4*)(gn + 4), a0 = *(const f32x4*)sg * oml, a1 = *(const f32x4*)(sg + 4) * oml;
    const int nrows = layer == 0 ? NTOK : NLAT;
    for (int r = bid * NWAVES + wave; r < nrows; r += gdim * NWAVES) {
        {
            const float* a = OA + (size_t)r * 512 + 8 * lane; const float* bq = a + (size_t)NTOK * 512;
            f32x4 o0 = *(const f32x4*)a - *(const f32x4*)bq * lam, o1 = *(const f32x4*)(a + 4) - *(const f32x4*)(bq + 4) * lam;
            float ss = (o0[0] * o0[0] + o0[1] * o0[1]) + (o0[2] * o0[2] + o0[3] * o0[3]) + (o1[0] * o1[0] + o1[1] * o1[1]) + (o1[2] * o1[2] + o1[3] * o1[3]);
            ss += __shfl_xor(ss, 1); ss += __shfl_xor(ss, 2); ss += __shfl_xor(ss, 4); ss += __shfl_xor(ss, 8);
            const float rstd = rsqrtf(ss * (1.f / 128.f) + EPS);
            o0 = o0 * rstd * a0; o1 = o1 * rstd * a1;
            u32x4 w; w.x = cvt_pk_bf16(o0[0], o0[1]); w.y = cvt_pk_bf16(o0[2], o0[3]); w.z = cvt_pk_bf16(o1[0], o1[1]); w.w = cvt_pk_bf16(o1[2], o1[3]);
            *(u32x4*)(MIX + (size_t)r * D + 8 * lane) = w; }
        const float* a = OG + (size_t)r * 512 + 8 * lane; const float* bq = a + (size_t)NTOK * 512;
        f32x4 o0 = *(const f32x4*)a + *(const f32x4*)bq, o1 = *(const f32x4*)(a + 4) + *(const f32x4*)(bq + 4);
        float ss = (o0[0] * o0[0] + o0[1] * o0[1]) + (o0[2] * o0[2] + o0[3] * o0[3]) + (o1[0] * o1[0] + o1[1] * o1[1]) + (o1[2] * o1[2] + o1[3] * o1[3]);
        ss += __shfl_xor(ss, 1); ss += __shfl_xor(ss, 2); ss += __shfl_xor(ss, 4); ss += __shfl_xor(ss, 8);
        const float rstd = rsqrtf(ss * (1.f / 128.f) + EPS);
        const u32x4 zw = *(const u32x4*)(P + (size_t)r * PW + 3072 + 8 * lane);
        o0 = o0 * rstd * g0; o1 = o1 * rstd * g1;
        u32x4 w; w.x = cvt_pk_bf16(o0[0] * silu_f(bflo(zw.x)), o0[1] * silu_f(bfhi(zw.x))); w.y = cvt_pk_bf16(o0[2] * silu_f(bflo(zw.y)), o0[3] * silu_f(bfhi(zw.y)));
        w.z = cvt_pk_bf16(o1[0] * silu_f(bflo(zw.z)), o1[1] * silu_f(bfhi(zw.z))); w.w = cvt_pk_bf16(o1[2] * silu_f(bflo(zw.w)), o1[3] * silu_f(bfhi(zw.w)));
        *(u32x4*)(MIX + (size_t)r * D + 512 + 8 * lane) = w;
    }
}

constexpr int AT_K = 0, AT_V = 16384, AT_WS = 49152;
typedef short v4i16_t __attribute__((ext_vector_type(4)));
__device__ __forceinline__ s16x4 vtr(const LAS unsigned char* ptr) { return __builtin_bit_cast(s16x4, __builtin_amdgcn_ds_read_tr16_b64_v4i16((LAS v4i16_t*)ptr)); }
__device__ __forceinline__ int att_keyrow(int b, int t, int nctx_tiles) {
    return t < nctx_tiles ? NLAT + b * CTXL + 64 * t : b * SEQL + 64 * (t - nctx_tiles);
}
__device__ __forceinline__ void attn_unit(PP p, int layer, LAS unsigned char* lds, int b, int h, int sub, int qrow0, int ntile, int nctx_tiles) {
    int tid = threadIdx.x, bid = blockIdx.x, gdim = gridDim.x; asm volatile("" : "+v"(tid), "+s"(bid), "+s"(gdim)); const int lane = tid & 63, wave = __builtin_amdgcn_readfirstlane(tid >> 6), r32 = lane & 31, hi = lane >> 5;
    const bf16_t* P = (const bf16_t*)(p->ws + WS_P); const float* cf = (const float*)(p->ws + WS_CONST);
    const float nbound = -cf[CF_SC + layer * 16 + 1];
    LAS float* wsf = (LAS float*)(lds + AT_WS) + wave * 64;
    const LAS unsigned char* kp0 = lds + AT_K + hi * 1024 + r32 * 16;
    const LAS unsigned char* vp0 = lds + AT_V + ((lane >> 4) & 1) * 32 + (lane & 3) * 8 + (4 * hi + ((lane & 15) >> 2)) * 64;
    const int kcol = 512 + h * 128 + sub * 64 + wave * 8, vcol = 1024 + h * 128;
    bf16x8 qr[4];
    { const bf16_t* qp = P + (size_t)(qrow0 + wave * 32 + r32) * PW + h * 128 + sub * 64 + hi * 8;
#pragma unroll
      for (int d0 = 0; d0 < 4; ++d0) qr[d0] = *(const bf16x8*)(qp + d0 * 16); }
    f32x16 o[4];
#pragma unroll
    for (int dg = 0; dg < 4; ++dg) o[dg] = (f32x16){};
    float l = 0.f;
    { const int kr = att_keyrow(b, 0, nctx_tiles);
      __builtin_amdgcn_global_load_lds((const unsigned*)(P + (size_t)(kr + lane) * PW + kcol), (LAS unsigned*)(lds + AT_K + wave * 1024), 16, 0, 0);
#pragma unroll
      for (int i = 0; i < 2; ++i) { const int j = wave + 8 * i, dg = j >> 2, rg = j & 3;
          __builtin_amdgcn_global_load_lds((const unsigned*)(P + (size_t)(kr + 16 * rg + (lane >> 2)) * PW + vcol + 32 * dg + 8 * (lane & 3)), (LAS unsigned*)(lds + AT_V + j * 1024), 16, 0, 0); } }
    for (int t = 0; t < ntile; ++t) {
        VM_WAIT(); __syncthreads();
        if (t + 1 < ntile) { const int kr = att_keyrow(b, t + 1, nctx_tiles); const int bo = (t + 1) & 1;
            __builtin_amdgcn_global_load_lds((const unsigned*)(P + (size_t)(kr + lane) * PW + kcol), (LAS unsigned*)(lds + AT_K + bo * 8192 + wave * 1024), 16, 0, 0);
#pragma unroll
            for (int i = 0; i < 2; ++i) { const int j = wave + 8 * i, dg = j >> 2, rg = j & 3;
                __builtin_amdgcn_global_load_lds((const unsigned*)(P + (size_t)(kr + 16 * rg + (lane >> 2)) * PW + vcol + 32 * dg + 8 * (lane & 3)), (LAS unsigned*)(lds + AT_V + bo * 16384 + j * 1024), 16, 0, 0); } }
        const LAS unsigned char* kp = kp0 + (t & 1) * 8192; const LAS unsigned char* vp = vp0 + (t & 1) * 16384;
        f32x16 s0, s1;
#pragma unroll
        for (int r = 0; r < 16; ++r) { s0[r] = nbound; s1[r] = nbound; }
#pragma unroll
        for (int d0 = 0; d0 < 4; ++d0) { const bf16x8 k0 = *(const LAS bf16x8*)(kp + d0 * 2048), k1 = *(const LAS bf16x8*)(kp + d0 * 2048 + 512);
            s0 = MFMA32(k0, qr[d0], s0); s1 = MFMA32(k1, qr[d0], s1); }
        __builtin_amdgcn_sched_barrier(0);
        float ls = 0.f;
#pragma unroll
        for (int r = 0; r < 16; ++r) { s0[r] = __builtin_amdgcn_exp2f(s0[r]); s1[r] = __builtin_amdgcn_exp2f(s1[r]); ls += s0[r] + s1[r]; }
        l += ls;
        u32x4 pw[4];
#pragma unroll
        for (int q = 0; q < 4; ++q) { pw[0][q] = cvt_pk_bf16(s0[2 * q], s0[2 * q + 1]); pw[1][q] = cvt_pk_bf16(s0[8 + 2 * q], s0[8 + 2 * q + 1]);
            pw[2][q] = cvt_pk_bf16(s1[2 * q], s1[2 * q + 1]); pw[3][q] = cvt_pk_bf16(s1[8 + 2 * q], s1[8 + 2 * q + 1]); }
#pragma unroll
        for (int ks = 0; ks < 4; ++ks) {
            __builtin_amdgcn_sched_barrier(0);
#pragma unroll
            for (int dg = 0; dg < 4; ++dg) { const s16x4 lo = vtr(vp + dg * 4096 + ks * 1024), hi4 = vtr(vp + dg * 4096 + ks * 1024 + 512);
                const bf16x8 vf = (bf16x8){lo[0], lo[1], lo[2], lo[3], hi4[0], hi4[1], hi4[2], hi4[3]};
                o[dg] = MFMA32(__builtin_bit_cast(bf16x8, pw[ks]), vf, o[dg]); } }
        __builtin_amdgcn_sched_barrier(0);
    }
    __syncthreads();
    l += __shfl_xor(l, 32);
    if (hi == 0) wsf[r32] = l;
    LDS_WAIT();
    float* OA = (float*)(p->ws + WS_OA) + (size_t)sub * NTOK * 512 + h * 128 + r32;
#pragma unroll
    for (int r = 0; r < 16; ++r) { const float rl = 1.f / wsf[crow(r, hi)]; float* orow = OA + (size_t)(qrow0 + wave * 32 + crow(r, hi)) * 512;
#pragma unroll
        for (int dg = 0; dg < 4; ++dg) orow[32 * dg] = o[dg][r] * rl; }
    LDS_WAIT();
}
__device__ __forceinline__ void phase_attention(PP p, int layer, LAS unsigned char* lds) {
    int bid = blockIdx.x, gdim = gridDim.x; asm volatile("" : "+s"(bid), "+s"(gdim));
    const int nlat = NB * 4 * 2 * 64, nunits = nlat + (layer == 0 ? NB * 4 * 2 : 0);
    for (int u = bid; u < nunits; u += gdim) {
        if (u < nlat) { const int b = u >> 9, h = (u >> 7) & 3, sub = (u >> 6) & 1, qb = u & 63; attn_unit(p, layer, lds, b, h, sub, b * SEQL + qb * 256, 260, 4); }
        else { const int v = u - nlat, b = v >> 3, h = (v >> 1) & 3, sub = v & 1; attn_unit(p, layer, lds, b, h, sub, NLAT + b * CTXL, 4, 4); }
    }
}

__device__ __forceinline__ void phase_norm_router(PP p, int layer, LAS unsigned char* lds) {
    int tid = threadIdx.x, bid = blockIdx.x, gdim = gridDim.x; asm volatile("" : "+v"(tid), "+s"(bid), "+s"(gdim)); const int lane = tid & 63, wave = __builtin_amdgcn_readfirstlane(tid >> 6);
    const int T = layer == 0 ? NTOK : NLAT;
    LAS float* rw = (LAS float*)lds;
    LAS int* lcnt = (LAS int*)(lds + 131072);
    LAS int* lbase = lcnt + 32;
    LAS int* ent = lcnt + 64;
    const float* rwg = p->in[I_RW] + (size_t)layer * D * NEXP;
    for (int i = tid; i < NEXP * 1024; i += NTHR) { const int k = i >> 5, e = i & 31; rw[e * 1024 + k] = rwg[(size_t)k * NEXP + e]; }
    if (tid < 64) lcnt[tid] = 0;
    __syncthreads();
    const float* cf = (const float*)(p->ws + WS_CONST);
    const float* gn = p->in[I_NFFNG] + layer * D;
    const float rb = lane < NEXP ? p->in[I_RB][layer * NEXP + lane] : 0.f;
    const int rpw = (T + gdim - 1) / gdim;
    const int r0 = bid * rpw, r1 = (r0 + rpw < T) ? r0 + rpw : T;
    int* tope = (int*)(p->ws + WS_RT + RT_TOPE); float* gate = (float*)(p->ws + WS_RT + RT_GATE); int* rank = (int*)(p->ws + WS_RT + RT_RANK);
    const float* H = (const float*)(p->ws + WS_H);
    for (int r = r0 + wave; r < r1; r += NWAVES) {
        const float* mv = cf + CF_MODV + (layer * 3 + mod_sel(r)) * 6144;
        f32x4 u[4]; norm_mod_row(H + (size_t)r * D, gn, mv + 3 * 1024, mv + 4 * 1024, lane, u);
        store_row_bf16((bf16_t*)(p->ws + WS_U) + (size_t)r * D, lane, u);
        float logit = -INFINITY;
#pragma unroll 4
        for (int e = 0; e < NEXP; ++e) { float s = 0.f;
#pragma unroll
            for (int q = 0; q < 4; ++q) { const f32x4 w = *(const LAS f32x4*)(rw + e * 1024 + 4 * lane + 256 * q); s += (u[q][0] * w[0] + u[q][1] * w[1]) + (u[q][2] * w[2] + u[q][3] * w[3]); }
            s = wave_sum(s); if (lane == e) logit = s + rb; }
        float tl[4]; int te[4];
#pragma unroll
        for (int k = 0; k < 4; ++k) { const float m = wave_max(logit); const unsigned long long bal = __ballot(logit == m); const int idx = __ffsll((long long)bal) - 1;
            tl[k] = m; te[k] = idx; if (lane == idx) logit = -INFINITY; }
        const float e1 = __expf(tl[1] - tl[0]), e2 = __expf(tl[2] - tl[0]), e3 = __expf(tl[3] - tl[0]); const float inv = 1.f / (1.f + e1 + e2 + e3);
        if (lane < 4) { const int e = lane == 0 ? te[0] : lane == 1 ? te[1] : lane == 2 ? te[2] : te[3]; const float gv = (lane == 0 ? 1.f : lane == 1 ? e1 : lane == 2 ? e2 : e3) * inv;
            const int lr = atomicAdd((int*)&lcnt[e], 1);
            ent[(r - r0) * 4 + lane] = (e << 20) | lr; tope[(size_t)r * 4 + lane] = e; gate[(size_t)r * 4 + lane] = gv; }
    }
    __syncthreads();
    if (tid < NEXP) lbase[tid] = (int)atomicAdd((unsigned*)(p->ws + WS_CTL) + CW_CNT + layer * 64 + tid, (unsigned)lcnt[tid]);
    __syncthreads();
    for (int i = tid; i < (r1 - r0) * 4; i += NTHR) { const int v = ent[i]; rank[(size_t)r0 * 4 + i] = lbase[v >> 20] + (v & 0xfffff); }
}

__device__ __forceinline__ void phase_moe_gather(PP p, int layer, LAS unsigned char* lds) {
    int tid = threadIdx.x, bid = blockIdx.x, gdim = gridDim.x; asm volatile("" : "+v"(tid), "+s"(bid), "+s"(gdim)); const int lane = tid & 63, wave = __builtin_amdgcn_readfirstlane(tid >> 6);
    const int T = layer == 0 ? NTOK : NLAT;
    LAS int* pstart = (LAS int*)lds; LAS int* cnt = pstart + 64;
    const unsigned* gcnt = (const unsigned*)(p->ws + WS_CTL) + CW_CNT + layer * 64;
    int* mt = (int*)(p->ws + WS_CONST) + CF_MOE + layer * 1024;
    if (tid == 0) { int acc = 0; for (int e = 0; e < NEXP; ++e) { const int c = (int)__hip_atomic_load(gcnt + e, __ATOMIC_RELAXED, __HIP_MEMORY_SCOPE_AGENT); cnt[e] = c; pstart[e] = acc; acc += (c + 255) & ~255; } pstart[NEXP] = acc; }
    __syncthreads();
    if (bid == 0) {
        if (tid < NEXP) { mt[tid] = pstart[tid]; mt[64 + tid] = cnt[tid]; }
        if (tid == 0) mt[32] = pstart[NEXP] >> 8;
        for (int e = 0; e < NEXP; ++e) { const int b0 = pstart[e] >> 8, b1 = pstart[e + 1] >> 8; for (int bb = b0 + tid; bb < b1; bb += NTHR) mt[128 + bb] = e; }
    }
    const int* tope = (const int*)(p->ws + WS_RT + RT_TOPE); const float* gate = (const float*)(p->ws + WS_RT + RT_GATE); const int* rank = (const int*)(p->ws + WS_RT + RT_RANK);
    int* slot = (int*)(p->ws + WS_RT + RT_SLOT); float* sgate = (float*)(p->ws + WS_RT + RT_SGATE);
    const bf16_t* V = (const bf16_t*)(p->ws + WS_U); bf16_t* XS = (bf16_t*)(p->ws + WS_XS);
    const int gw = bid * NWAVES + wave, NGW = gdim * NWAVES;
    for (int a = gw; a < T * 4; a += NGW) {
        const int r = a >> 2; const int e = tope[a]; const int s = pstart[e] + rank[a];
        if (lane == 0) { slot[a] = s; sgate[s] = gate[a]; }
        const u32x4* src = (const u32x4*)(V + (size_t)r * D); u32x4* dst = (u32x4*)(XS + (size_t)s * D);
        dst[lane] = src[lane]; dst[64 + lane] = src[64 + lane];
    }
    for (int e = 0; e < NEXP; ++e) { const int s0 = pstart[e] + cnt[e], s1 = pstart[e + 1];
        for (int s = s0 + gw; s < s1; s += NGW) { u32x4* dst = (u32x4*)(XS + (size_t)s * D); dst[lane] = (u32x4){0u, 0u, 0u, 0u}; dst[64 + lane] = (u32x4){0u, 0u, 0u, 0u}; if (lane == 0) sgate[s] = 0.f; } }
}

__device__ __forceinline__ void phase_moe_combine(PP p, int layer) {
    int tid = threadIdx.x, bid = blockIdx.x, gdim = gridDim.x; asm volatile("" : "+v"(tid), "+s"(bid), "+s"(gdim)); const int lane = tid & 63, wave = __builtin_amdgcn_readfirstlane(tid >> 6);
    const int T = layer == 0 ? NTOK : NLAT;
    const float* cf = (const float*)(p->ws + WS_CONST); const int* slot = (const int*)(p->ws + WS_RT + RT_SLOT); const bf16_t* Y = (const bf16_t*)(p->ws + WS_Y);
    float* H = (float*)(p->ws + WS_H);
    for (int r = bid * NWAVES + wave; r < T; r += gdim * NWAVES) {
        const float* g5 = cf + CF_MODV + (layer * 3 + mod_sel(r)) * 6144 + 5 * 1024;
        float* ho = layer == 0 ? H + (size_t)r * D : p->out + (size_t)r * D; const float* hi_ = H + (size_t)r * D;
        const int s0 = slot[r * 4], s1 = slot[r * 4 + 1], s2 = slot[r * 4 + 2], s3 = slot[r * 4 + 3];
#pragma unroll
        for (int j = 0; j < 4; ++j) { const int c = 4 * lane + 256 * j;
            const u32x2 a = *(const u32x2*)(Y + (size_t)s0 * D + c), b2 = *(const u32x2*)(Y + (size_t)s1 * D + c), c2 = *(const u32x2*)(Y + (size_t)s2 * D + c), d2 = *(const u32x2*)(Y + (size_t)s3 * D + c);
            f32x4 y; y[0] = (bflo(a.x) + bflo(b2.x)) + (bflo(c2.x) + bflo(d2.x)); y[1] = (bfhi(a.x) + bfhi(b2.x)) + (bfhi(c2.x) + bfhi(d2.x));
            y[2] = (bflo(a.y) + bflo(b2.y)) + (bflo(c2.y) + bflo(d2.y)); y[3] = (bfhi(a.y) + bfhi(b2.y)) + (bfhi(c2.y) + bfhi(d2.y));
            const f32x4 hv = *(const f32x4*)(hi_ + c), gv = *(const f32x4*)(g5 + c);
            *(f32x4*)(ho + c) = hv + gv * y; }
    }
}

constexpr int NPH = 27;
#ifndef PH_MASK
#define PH_MASK 0xFFFF
#endif
#define IN(k) (lo <= (k) && (k) < hi)
#define EN(i) ((PH_MASK >> (i)) & 1)
#define SEAM(k) do { if (IN(k) && IN((k) + 1)) xcd_barrier(bar); } while (0)
#define LAUNDER() PP p = p0; LAS unsigned char* lds = lds0; int bid = blockIdx.x, gdim = gridDim.x; asm volatile("" : "+s"(p), "+s"(lds), "+s"(bid), "+s"(gdim))
template <int l> __device__ __forceinline__ void run_layer(PP p0, LAS unsigned char* lds0, const int lo, const int hi, const XcdBarrier& bar) {
        const int base = 1 + 13 * l;
        if (EN(1) && IN(base + 0)) { LAUNDER(); phase_norm_mix(p, l, lds); __syncthreads(); }
        SEAM(base + 0);
        if (EN(2) && IN(base + 1)) { LAUNDER();
            PlainSched S; S.init(p->ws + WS_U, p->ws + WS_WIN + (size_t)l * PW * 1024 * 2, 1024, NTOK / 256, PW / 256, gdim, bid);
            EpiStoreBf16 E{(bf16_t*)(p->ws + WS_P), PW};
            pg8::gemm_phase<EpiStoreBf16, PlainSched>(lds, 1024, S, E);
        }
        SEAM(base + 1);
        if (EN(3) && IN(base + 2)) { LAUNDER(); phase_prep(p, l); }
        SEAM(base + 2);
        if (EN(4) && IN(base + 3)) { LAUNDER(); phase_attention(p, l, lds); }
        SEAM(base + 3);
        if (EN(5) && IN(base + 4)) { LAUNDER(); phase_gdn_chunk(p, lds); }
        SEAM(base + 4);
        if (EN(6) && IN(base + 5)) { LAUNDER(); phase_gdn_scan(p, lds); }
        SEAM(base + 5);
        if (EN(7) && IN(base + 6)) { LAUNDER(); phase_gdn_out(p, l); }
        SEAM(base + 6);
        if (EN(8) && IN(base + 7)) { LAUNDER();
            const int T = l == 0 ? NTOK : NLAT;
            const float* cf = (const float*)(p->ws + WS_CONST);
            PlainSched S; S.init(p->ws + WS_MIX, p->ws + WS_WOUT + (size_t)l * D * 1024 * 2, 1024, T / 256, D / 256, gdim, bid);
            EpiResidual E{p, l, cf + CF_MODV + (l * 3) * 6144 + 2 * 1024};
            pg8::gemm_phase<EpiResidual, PlainSched>(lds, 1024, S, E);
        }
        SEAM(base + 7);
        if (EN(9) && IN(base + 8)) { LAUNDER(); phase_norm_router(p, l, lds); __syncthreads(); }
        SEAM(base + 8);
        if (EN(10) && IN(base + 9)) { LAUNDER(); phase_moe_gather(p, l, lds); __syncthreads(); }
        SEAM(base + 9);
        if (EN(11) && IN(base + 10)) { LAUNDER();
            const int* mt = (const int*)(p->ws + WS_CONST) + CF_MOE + l * 1024;
            MoeSched S{(const char*)(p->ws + WS_XS), (const char*)(p->ws + WS_WGU + (size_t)l * NEXP * 2048 * 1024 * 2), mt + 128, mt[32], 8, gdim, bid};
            EpiGateUp E{(bf16_t*)(p->ws + WS_ACT), p->in[I_BGU] + (size_t)l * NEXP * 2048, mt + 128};
            pg8::gemm_phase<EpiGateUp, MoeSched>(lds, 1024, S, E);
        }
        SEAM(base + 10);
        if (EN(12) && IN(base + 11)) { LAUNDER();
            const int* mt = (const int*)(p->ws + WS_CONST) + CF_MOE + l * 1024;
            MoeSched S{(const char*)(p->ws + WS_ACT), (const char*)(p->ws + WS_WD + (size_t)l * NEXP * 1024 * 1024 * 2), mt + 128, mt[32], 4, gdim, bid};
            EpiDown E{(bf16_t*)(p->ws + WS_Y), p->in[I_BD] + (size_t)l * NEXP * 1024, mt + 128, (const float*)(p->ws + WS_RT + RT_SGATE)};
            pg8::gemm_phase<EpiDown, MoeSched>(lds, 1024, S, E);
        }
        SEAM(base + 11);
        if (EN(13) && IN(base + 12)) { LAUNDER(); phase_moe_combine(p, l); }
        SEAM(base + 12);
    }

__global__ void __launch_bounds__(NTHR, 2) mega_fwd(Params p_by_value) {
    extern __shared__ __attribute__((aligned(16))) unsigned char lds_raw[];
    LAS unsigned char* lds0 = (LAS unsigned char*)lds_raw;
    PP p0 = (PP)__builtin_amdgcn_kernarg_segment_ptr();
    volatile LAS unsigned* MISC = (volatile LAS unsigned*)(lds0 + MISC_OFF);
    if (threadIdx.x < 64) MISC[threadIdx.x] = 0u;
    __syncthreads();
    const int lo = p0->ph_lo, hi = p0->ph_hi;
    XcdBarrier bar; bar.bar = (unsigned*)(p0->ws + WS_CTL) + CW_BAR; bar.x = 0; bar.st = nullptr;
    if (hi - lo > 1) bar = xcd_barrier_post((unsigned*)(p0->ws + WS_CTL) + CW_BAR, MISC + 8);
    if (EN(0) && IN(0)) { LAUNDER(); phase_prologue(p, lds); __syncthreads(); }
    SEAM(0);
    run_layer<0>(p0, lds0, lo, hi, bar);
    run_layer<1>(p0, lds0, lo, hi, bar);
#undef IN
#undef SEAM
}

extern "C" void kernel_launch(void* const* d_in, const int* in_sizes, int n_in, void* d_out, int out_size, void* d_ws, size_t ws_size, hipStream_t stream) {
    static int grid = 0;
    if (grid == 0) {
        if (n_in != 27 || out_size != NLAT * D || ws_size < WS_END) { fprintf(stderr, "kernel_launch: unexpected problem (n_in %d, out %d, ws %zu < %zu)\n", n_in, out_size, ws_size, (size_t)WS_END); grid = -1; return; }
        int dev = 0, cus = 0, per_cu = 0;
        if (hipGetDevice(&dev) != hipSuccess || hipDeviceGetAttribute(&cus, hipDeviceAttributeMultiprocessorCount, dev) != hipSuccess) { grid = -1; return; }
        if (hipFuncSetAttribute((const void*)mega_fwd, hipFuncAttributeMaxDynamicSharedMemorySize, LDS_BYTES) != hipSuccess) { fprintf(stderr, "kernel_launch: hipFuncSetAttribute failed\n"); grid = -1; return; }
        if (hipOccupancyMaxActiveBlocksPerMultiprocessor(&per_cu, (const void*)mega_fwd, NTHR, LDS_BYTES) != hipSuccess || per_cu < 1) { fprintf(stderr, "kernel_launch: occupancy query says %d\n", per_cu); }
        (void)hipGetLastError();
        grid = cus;
    }
    if (grid < 0) return;
    hipMemsetAsync((char*)d_ws + WS_CTL, 0, CTL_ZERO_BYTES, stream);
    Params p{};
    for (int i = 0; i < 27; ++i) p.in[i] = (const float*)d_in[i];
    p.out = (float*)d_out; p.ws = (unsigned char*)d_ws;
#if MK_PER_PHASE
    for (int ph = 0; ph < NPH; ++ph) { p.ph_lo = ph; p.ph_hi = ph + 1; hipLaunchKernelGGL(mega_fwd, dim3(grid), dim3(NTHR), LDS_BYTES, stream, p); }
#else
    p.ph_lo = 0; p.ph_hi = NPH;
    hipLaunchKernelGGL(mega_fwd, dim3(grid), dim3(NTHR), LDS_BYTES, stream, p);
#endif
}
```

```cpp
#include <hip/hip_runtime.h>
#include <cstdio>
#include <cstdint>

#ifndef MK_PER_PHASE
#define MK_PER_PHASE 0
#endif

#define LAS __attribute__((address_space(3)))
#define GAS __attribute__((address_space(1)))
typedef unsigned short bf16_t;
typedef short bf16x8 __attribute__((ext_vector_type(8)));
typedef short s16x4 __attribute__((ext_vector_type(4)));
typedef float f32x2 __attribute__((ext_vector_type(2)));
typedef float f32x4 __attribute__((ext_vector_type(4)));
typedef float f32x16 __attribute__((ext_vector_type(16)));
typedef unsigned u32x2 __attribute__((ext_vector_type(2)));
typedef unsigned u32x4 __attribute__((ext_vector_type(4)));

constexpr int D = 1024, NB = 2, SEQL = 16384, CTXL = 256;
constexpr int NLAT = NB * SEQL, NCTX = NB * CTXL, NTOK = NLAT + NCTX;
constexpr int PW = 3584, INC = 3600;
constexpr int NEXP = 32, MAXBLK = 552, MAXSLOT = MAXBLK * 256;
constexpr int NCHUNK = 260, NTASK = 16 * NCHUNK;
constexpr float EPS = 1e-6f;
constexpr float LOG2E = 1.4426950408889634f;
constexpr int NWAVES = 8, NTHR = 512;

constexpr size_t MiB = 1u << 20;
constexpr size_t WS_CTL = 0, CTL_ZERO_BYTES = 1 * MiB;
constexpr size_t WS_CONST = 1 * MiB;
constexpr size_t WS_WIN = 2 * MiB;
constexpr size_t WS_WOUT = 16 * MiB;
constexpr size_t WS_WGU = 20 * MiB;
constexpr size_t WS_WD = 276 * MiB;
constexpr size_t WS_H = 404 * MiB;
constexpr size_t WS_U = 534 * MiB;
constexpr size_t WS_GB = 599 * MiB;
constexpr size_t WS_MIX = 602 * MiB;
constexpr size_t WS_RT = 667 * MiB;
constexpr size_t WS_BIG = 671 * MiB;
constexpr size_t WS_P = WS_BIG;
constexpr size_t WS_G = WS_P + 228 * MiB;
constexpr size_t WS_CH = WS_G + 98 * MiB;
constexpr size_t WS_OG = WS_CH + 358 * MiB;
constexpr size_t WS_OA = WS_OG + 130 * MiB;
constexpr size_t WS_END = WS_OA + 130 * MiB;
constexpr size_t WS_XS = WS_BIG;
constexpr size_t WS_ACT = WS_BIG + 276 * MiB;
constexpr size_t WS_Y = WS_XS;
static_assert(WS_ACT + 276 * MiB <= WS_END, "moe overlay");
constexpr size_t CH_TASK_BYTES = 90112;
constexpr int CH_WF = 0, CH_QF = 16384, CH_AF = 32768, CH_KF = 40960, CH_UC = 57344, CH_DMA_BYTES = 57344;
static_assert((size_t)NTASK * CH_TASK_BYTES <= 358 * MiB, "chunk buffers");

constexpr int CW_BAR = 4096;
constexpr int CW_CNT = 16384;
constexpr int CW_ATTQ = 20480;
constexpr int CF_MODV = 0;
constexpr int CF_ROPE = 40960;
constexpr int CF_SC = 53248;
constexpr int CF_EGL = 53504;
constexpr int CF_MOE = 61440;
constexpr size_t RT_TOPE = 0, RT_GATE = 640 * 1024, RT_RANK = 1280 * 1024, RT_SLOT = 1920 * 1024, RT_SGATE = 2560 * 1024;

constexpr int LDS_BYTES = 147456;
constexpr int MISC_OFF = 143 * 1024;
static_assert(MISC_OFF + 256 <= LDS_BYTES, "lds");

__device__ __forceinline__ unsigned f2bf(float f) { unsigned u = __builtin_bit_cast(unsigned, f); return (u + 0x7fffu + ((u >> 16) & 1u)) >> 16; }
__device__ __forceinline__ unsigned pk2(float lo, float hi) { return f2bf(lo) | (f2bf(hi) << 16); }
__device__ __forceinline__ float bf2f(unsigned short b) { return __builtin_bit_cast(float, (unsigned)b << 16); }
__device__ __forceinline__ float bflo(unsigned w) { return __builtin_bit_cast(float, w << 16); }
__device__ __forceinline__ float bfhi(unsigned w) { return __builtin_bit_cast(float, w & 0xffff0000u); }
__device__ __forceinline__ unsigned cvt_pk_bf16(float lo, float hi) { unsigned r; asm volatile("v_cvt_pk_bf16_f32 %0, %1, %2" : "=v"(r) : "v"(lo), "v"(hi)); return r; }
__device__ __forceinline__ float wave_sum(float v) {
#pragma unroll
    for (int o = 1; o < 64; o <<= 1) v += __shfl_xor(v, o);
    return v;
}
__device__ __forceinline__ float wave_max(float v) {
#pragma unroll
    for (int o = 1; o < 64; o <<= 1) v = fmaxf(v, __shfl_xor(v, o));
    return v;
}
__device__ __forceinline__ float silu_f(float x) { return x / (1.f + __expf(-x)); }
__device__ __forceinline__ int crow(int r, int hi) { return (r & 3) + 8 * (r >> 2) + 4 * hi; }
__device__ __forceinline__ void glds16(const void* g, unsigned lds_base) {
    unsigned sv; asm volatile("s_mov_b32 %0, m0\n\ts_mov_b32 m0, %2\n\ts_nop 0\n\tglobal_load_lds_dwordx4 %1, off\n\ts_mov_b32 m0, %0" : "=&s"(sv) : "v"(g), "s"((unsigned)__builtin_amdgcn_readfirstlane((int)lds_base)) : "memory"); }
__device__ __forceinline__ unsigned lds_addr(const LAS void* q) { return (unsigned)__builtin_amdgcn_readfirstlane((int)(unsigned)(uintptr_t)q); }
#define LDS_WAIT() asm volatile("s_waitcnt lgkmcnt(0)" ::: "memory")
#define VM_WAIT() asm volatile("s_waitcnt vmcnt(0)" ::: "memory")
#define MFMA32(a, b, c) __builtin_amdgcn_mfma_f32_32x32x16_bf16(a, b, c, 0, 0, 0)

namespace pg8 {
constexpr int BM = 256, BK = 64, HALF = 128, HTB = HALF * BK * 2, STAGE_BYTES = 8 * HTB;
__host__ __device__ __forceinline__ int lds_byte(int r, int c) { const int st = (r >> 4) * 2 + (c >> 5), rr = r & 15, cc = c & 31, ob = rr * 64 + cc * 2; return st * 1024 + (ob ^ (((ob >> 9) & 1) << 5)); }
__host__ __device__ __forceinline__ void stage_rc(int b, int& R, int& C) { const int st = b / 1024, sb = b % 1024, swz = sb ^ (((sb >> 9) & 1) << 5); R = (st >> 1) * 16 + swz / 64; C = (st & 1) * 32 + (swz % 64) / 2; }
__host__ __device__ __forceinline__ int perm32(int rho) { const int n = rho >> 4, i = rho & 15; return 8 * (i >> 2) + 4 * n + (i & 3); }
struct Unit { int pm, pn; };
template <class Epi, class Sched>
__device__ __forceinline__ void gemm_phase(LAS unsigned char* lds, const int K, const Sched& S, const Epi& E) {
    int tid = threadIdx.x, bid = blockIdx.x, gdim = gridDim.x; asm volatile("" : "+v"(tid), "+s"(bid), "+s"(gdim)); const int wid = __builtin_amdgcn_readfirstlane(tid >> 6), lane = tid & 63, wr = wid >> 2, wc = wid & 3, fr = lane & 15, fq = lane >> 4;
    const int nt = K / BK;
    unsigned voffA[2], voffB[2];
#pragma unroll
    for (int i = 0; i < 2; ++i) { int R, C; stage_rc(tid * 16 + i * 8192, R, C); const int Rb = Epi::PERM ? ((R & ~31) + perm32(R & 31)) : R;
        voffA[i] = (unsigned)(R * K + C) * 2u; voffB[i] = (unsigned)(Rb * K + C) * 2u; }
    const size_t kstep = (size_t)(BK * 2);
    const size_t hstep = (size_t)HALF * K * 2;
    const unsigned ldsw = (unsigned)wid * 1024u;
    const int aoff = lds_byte(wr * 64 + fr, fq * 8), boff = lds_byte(wc * 32 + fr, fq * 8);
#define PG8_SA(b, h) (((b) * 2 + (h)) * HTB)
#define PG8_SB(b, h) ((4 + (b) * 2 + (h)) * HTB)
#define PG8_STAGE(bufoff, gbase, voff) do { _Pragma("unroll") for (int _i = 0; _i < 2; ++_i) \
        __builtin_amdgcn_global_load_lds((const unsigned*)((const char*)(gbase) + (voff)[_i]), (LAS unsigned*)(lds + (bufoff) + ldsw + _i * 8192), 16, 0, 0); } while (0)
#define PG8_LDA(dst, b, h) do { _Pragma("unroll") for (int m = 0; m < 4; ++m) _Pragma("unroll") for (int k = 0; k < 2; ++k) dst[m][k] = *(const LAS bf16x8*)(lds + PG8_SA(b, h) + aoff + m * 2048 + k * 1024); } while (0)
#define PG8_LDB(dst, b, h) do { _Pragma("unroll") for (int n = 0; n < 2; ++n) _Pragma("unroll") for (int k = 0; k < 2; ++k) dst[n][k] = *(const LAS bf16x8*)(lds + PG8_SB(b, h) + boff + n * 2048 + k * 1024); } while (0)
#define PG8_MMA(ai, bj, At, Bt) do { __builtin_amdgcn_s_setprio(1); _Pragma("unroll") for (int m = 0; m < 4; ++m) _Pragma("unroll") for (int n = 0; n < 2; ++n) _Pragma("unroll") for (int k = 0; k < 2; ++k) \
        acc[ai][bj][m][n] = __builtin_amdgcn_mfma_f32_16x16x32_bf16(Bt[n][k], At[m][k], acc[ai][bj][m][n], 0, 0, 0); __builtin_amdgcn_s_setprio(0); } while (0)
#define PG8_WAIT_V(n) asm volatile("s_waitcnt vmcnt(" #n ")" ::: "memory")
#define PG8_WAIT_L(n) asm volatile("s_waitcnt lgkmcnt(" #n ")" ::: "memory")
#define PG8_BAR __builtin_amdgcn_s_barrier()
#define PG8_SCHED __builtin_amdgcn_sched_barrier(0)
    Unit cur, nxt; int ui = 0;
    if (!S.next(0, cur)) return;
    f32x4 acc[2][2][4][2];
#pragma unroll
    for (int a = 0; a < 2; ++a)
#pragma unroll
        for (int b = 0; b < 2; ++b)
#pragma unroll
            for (int m = 0; m < 4; ++m)
#pragma unroll
                for (int n = 0; n < 2; ++n) acc[a][b][m][n] = (f32x4){0.f, 0.f, 0.f, 0.f};
    bf16x8 At[4][2], B0[2][2], B1[2][2];
    const char* cA = S.aptr(cur); const char* cB = S.bptr(cur);
    PG8_STAGE(PG8_SB(0, 0), cB, voffB); PG8_STAGE(PG8_SA(0, 0), cA, voffA); PG8_STAGE(PG8_SB(0, 1), cB + hstep, voffB); PG8_STAGE(PG8_SA(0, 1), cA + hstep, voffA);
    if (wr == 1) PG8_BAR;
    PG8_WAIT_V(4); PG8_BAR;
    PG8_STAGE(PG8_SB(1, 0), cB + kstep, voffB); PG8_STAGE(PG8_SA(1, 0), cA + kstep, voffA); PG8_STAGE(PG8_SB(1, 1), cB + hstep + kstep, voffB);
    PG8_WAIT_V(6); PG8_BAR;
    for (;;) {
        const bool has_next = S.next(ui + 1, nxt);
        const char* nA = has_next ? S.aptr(nxt) : cA; const char* nB = has_next ? S.bptr(nxt) : cB;
        for (int t = 0; t < nt; t += 2) {
            const bool last = (t == nt - 2);
            const char* a1 = cA + (size_t)(t + 1) * kstep;
            const char* a2 = last ? nA : cA + (size_t)(t + 2) * kstep; const char* b2 = last ? nB : cB + (size_t)(t + 2) * kstep;
            const char* a3 = a2 + kstep; const char* b3 = b2 + kstep;
            PG8_LDB(B0, 0, 0); PG8_SCHED; PG8_LDA(At, 0, 0); PG8_STAGE(PG8_SA(1, 1), a1 + hstep, voffA);
            PG8_WAIT_L(8); PG8_BAR; PG8_WAIT_L(0); PG8_MMA(0, 0, At, B0); PG8_BAR; PG8_SCHED;
            PG8_LDB(B1, 0, 1); PG8_STAGE(PG8_SB(0, 0), b2, voffB);
            PG8_BAR; PG8_WAIT_L(0); PG8_MMA(0, 1, At, B1); PG8_BAR;
            PG8_LDA(At, 0, 1); PG8_STAGE(PG8_SA(0, 0), a2, voffA);
            PG8_BAR; PG8_WAIT_L(0); PG8_MMA(1, 0, At, B0); PG8_BAR; PG8_SCHED;
            PG8_STAGE(PG8_SB(0, 1), b2 + hstep, voffB);
            PG8_WAIT_V(6); PG8_BAR; PG8_MMA(1, 1, At, B1); PG8_BAR;
            PG8_LDB(B0, 1, 0); PG8_SCHED; PG8_LDA(At, 1, 0); PG8_STAGE(PG8_SA(0, 1), a2 + hstep, voffA);
            PG8_WAIT_L(8); PG8_BAR; PG8_WAIT_L(0); PG8_MMA(0, 0, At, B0); PG8_BAR; PG8_SCHED;
            PG8_LDB(B1, 1, 1); PG8_STAGE(PG8_SB(1, 0), b3, voffB);
            PG8_BAR; PG8_WAIT_L(0); PG8_MMA(0, 1, At, B1); PG8_BAR;
            PG8_LDA(At, 1, 1); PG8_STAGE(PG8_SA(1, 0), a3, voffA);
            PG8_BAR; PG8_WAIT_L(0); PG8_MMA(1, 0, At, B0); PG8_BAR; PG8_SCHED;
            PG8_STAGE(PG8_SB(1, 1), b3 + hstep, voffB);
            PG8_WAIT_V(6); PG8_BAR; PG8_MMA(1, 1, At, B1); PG8_BAR;
        }
        E(acc, cur, wr, wc, fr, fq);
        if (!has_next) break;
#pragma unroll
        for (int a = 0; a < 2; ++a)
#pragma unroll
            for (int b = 0; b < 2; ++b)
#pragma unroll
                for (int m = 0; m < 4; ++m)
#pragma unroll
                    for (int n = 0; n < 2; ++n) acc[a][b][m][n] = (f32x4){0.f, 0.f, 0.f, 0.f};
        cur = nxt; cA = nA; cB = nB; ++ui;
    }
    PG8_WAIT_V(0);
    if (wr == 0) PG8_BAR;
    PG8_BAR;
#undef PG8_SA
#undef PG8_SB
#undef PG8_STAGE
#undef PG8_LDA
#undef PG8_LDB
#undef PG8_MMA
#undef PG8_WAIT_V
#undef PG8_WAIT_L
#undef PG8_BAR
#undef PG8_SCHED
}
}

#define XB_TMO      128
#define XB_XCNT(j)  (256  + 64 * (j))
#define XB_XSUB(j)  (1280 + 64 * (j))
#define XB_XGEN(j)  (2304 + 64 * (j))
#define XB_TOP      3328
#define XB_TOPGEN   3392
#define XCD_BAR_WORDS 3456
#define XB_SPIN_CAP (1u << 20)
__device__ __forceinline__ unsigned xb_ld(unsigned* p)              { return __hip_atomic_load(p, __ATOMIC_RELAXED, __HIP_MEMORY_SCOPE_AGENT); }
__device__ __forceinline__ unsigned xb_add(unsigned* p, unsigned v) { return __hip_atomic_fetch_add(p, v, __ATOMIC_RELAXED, __HIP_MEMORY_SCOPE_AGENT); }
__device__ __forceinline__ unsigned xb_xcc_id() { return (unsigned)__builtin_amdgcn_s_getreg((3 << 11) | 20) & 0xFu; }
#define XB_SPIN(cond, bar) do { unsigned _sp = 0; while (cond) { __builtin_amdgcn_s_sleep(1); \
    if ((++_sp & 255u) == 0u) { if (xb_ld(&(bar)[XB_TMO])) break; if (_sp > XB_SPIN_CAP) { atomicAdd(&(bar)[XB_TMO], 1u); break; } } } } while (0)
struct XcdBarrier { unsigned* bar; unsigned x; volatile LAS unsigned* st; };
__device__ __forceinline__ XcdBarrier xcd_barrier_post(unsigned* bar, volatile LAS unsigned* st) {
    XcdBarrier b; b.bar = bar; b.x = xb_xcc_id(); b.st = st;
    if (threadIdx.x == 0) (void)xb_add(&bar[XB_XCNT(b.x)], 1u);
    return b;
}
__device__ __forceinline__ void xcd_barrier_complete(unsigned* bar, unsigned x, unsigned& nloc, unsigned& nx) {
    const unsigned G = gridDim.x * gridDim.y * gridDim.z;
    unsigned sum, cnt, mine, sp = 0u;
    for (;;) {
        sum = 0u; cnt = 0u; mine = 0u;
#pragma unroll
        for (unsigned j = 0; j < 16; ++j) { const unsigned c = xb_ld(&bar[XB_XCNT(j)]); sum += c; cnt += (c > 0u) ? 1u : 0u; mine = (j == x) ? c : mine; }
        if (sum == G) break;
        __builtin_amdgcn_s_sleep(1);
        if ((++sp & 255u) == 0u) { if (xb_ld(&bar[XB_TMO])) break; if (sp > XB_SPIN_CAP) { atomicAdd(&bar[XB_TMO], 1u); break; } }
    }
    nloc = mine > 0u ? mine : 1u; nx = cnt > 0u ? cnt : 1u;
}
__device__ __forceinline__ void xcd_barrier(const XcdBarrier& b) {
    asm volatile("s_waitcnt vmcnt(0)" ::: "memory");
    __syncthreads();
    if (threadIdx.x == 0) {
        unsigned* bar = b.bar;
        __builtin_amdgcn_s_waitcnt(0);
        unsigned nloc = b.st[0], nx = b.st[1];
        if (nloc == 0u) { xcd_barrier_complete(bar, b.x, nloc, nx); b.st[0] = nloc; b.st[1] = nx; }
        const unsigned old = xb_add(&bar[XB_XSUB(b.x)], 1u);
        const unsigned gen = old / nloc;
        if (old + 1u == (gen + 1u) * nloc) {
            __builtin_amdgcn_fence(__ATOMIC_RELEASE, "agent");
            asm volatile("s_waitcnt vmcnt(0)" ::: "memory");
            const unsigned og = xb_add(&bar[XB_TOP], 1u);
            const unsigned tg = og / nx;
            if (og + 1u == (tg + 1u) * nx) xb_add(&bar[XB_TOPGEN], 1u);
            else XB_SPIN(xb_ld(&bar[XB_TOPGEN]) == tg, bar);
            __builtin_amdgcn_fence(__ATOMIC_ACQUIRE, "agent");
            xb_add(&bar[XB_XGEN(b.x)], 1u);
            asm volatile("s_waitcnt vmcnt(0)" ::: "memory");
        } else {
            XB_SPIN(xb_ld(&bar[XB_XGEN(b.x)]) == gen, bar);
            __builtin_amdgcn_fence(__ATOMIC_ACQUIRE, "agent");
            asm volatile("s_waitcnt vmcnt(0)" ::: "memory");
        }
    }
    __syncthreads();
}

struct Params {
    const float* in[27];
    float* out;
    unsigned char* ws;
    int ph_lo, ph_hi;
};
typedef const __attribute__((address_space(4))) Params* PP;
enum { I_X = 0, I_C, I_CTX, I_CCTX, I_WMOD, I_BMOD, I_NMIXG, I_WIN, I_QNG, I_KNG, I_LQ1, I_LK1, I_LQ2, I_LK2, I_SUBLN, I_CONVW, I_ALOG, I_DTB, I_GDNG, I_WOUT, I_NFFNG, I_RW, I_RB, I_WGU, I_BGU, I_WD, I_BD };

__device__ __forceinline__ const float* hrow_in(PP p, int layer, int r) {
    if (layer == 0) return r < NLAT ? p->in[I_X] + (size_t)r * D : p->in[I_CTX] + (size_t)(r - NLAT) * D;
    return (const float*)(p->ws + WS_H) + (size_t)r * D;
}
__device__ __forceinline__ int mod_sel(int r) { return r < NLAT ? (r >= SEQL ? 1 : 0) : 2; }

__device__ __forceinline__ void transpose_item(const float* W, size_t ldw, int k0, int n0, bf16_t* WT, int drow0, LAS float* scr, int lane) {
#pragma unroll 8
    for (int i = 0; i < 32; ++i) { const int kk = 2 * i + (lane >> 5); scr[kk * 33 + (lane & 31)] = W[(size_t)(k0 + kk) * ldw + n0 + (lane & 31)]; }
    LDS_WAIT(); asm volatile("" ::: "memory");
    const int c = lane & 7;
#pragma unroll
    for (int j = 0; j < 4; ++j) { const int n = (lane >> 3) + 8 * j; const LAS float* s = scr + (8 * c) * 33 + n;
        u32x4 o; o.x = pk2(s[0 * 33], s[1 * 33]); o.y = pk2(s[2 * 33], s[3 * 33]); o.z = pk2(s[4 * 33], s[5 * 33]); o.w = pk2(s[6 * 33], s[7 * 33]);
        *(u32x4*)(WT + (size_t)(drow0 + n) * 1024 + k0 + 8 * c) = o; }
    LDS_WAIT(); asm volatile("" ::: "memory");
}

__device__ __forceinline__ void phase_prologue(PP p, LAS unsigned char* lds) {
    int tid = threadIdx.x, bid = blockIdx.x, gdim = gridDim.x; asm volatile("" : "+v"(tid), "+s"(bid), "+s"(gdim)); const int lane = tid & 63, wave = __builtin_amdgcn_readfirstlane(tid >> 6);
    float* cf = (float*)(p->ws + WS_CONST);
    if (bid < 192) {
        const int l = bid / 96, cg = bid % 96;
        LAS float* sl = (LAS float*)lds;
        LAS float* red = sl + 3 * 1024;
        for (int i = tid; i < 3 * 1024; i += NTHR) { const int s = i >> 10, k = i & 1023; const float v = s < 2 ? p->in[I_C][s * D + k] : p->in[I_CCTX][k]; sl[i] = silu_f(v); }
        __syncthreads();
        const float* wm = p->in[I_WMOD] + (size_t)l * D * 6144 + cg * 64 + lane;
        float a0 = 0.f, a1 = 0.f, a2 = 0.f;
#pragma unroll 16
        for (int kk = 0; kk < 128; ++kk) { const int k = wave * 128 + kk; const float w = wm[(size_t)k * 6144]; a0 += sl[k] * w; a1 += sl[1024 + k] * w; a2 += sl[2048 + k] * w; }
        red[(wave * 3 + 0) * 64 + lane] = a0; red[(wave * 3 + 1) * 64 + lane] = a1; red[(wave * 3 + 2) * 64 + lane] = a2;
        __syncthreads();
        if (wave < 3) { float s = 0.f;
#pragma unroll
            for (int w = 0; w < 8; ++w) s += red[(w * 3 + wave) * 64 + lane];
            cf[CF_MODV + (l * 3 + wave) * 6144 + cg * 64 + lane] = s + p->in[I_BMOD][l * 6144 + cg * 64 + lane]; }
        __syncthreads();
    }
    if (bid >= 192 && bid < 202) {
        const int idx = (bid - 192) * NTHR + tid;
        if (idx < 320 * 16) { const int pos = idx >> 4, i = idx & 15; const float invf = powf(10000.f, -(float)i / 16.f);
            const float posf = (float)(pos < 256 ? pos : pos - 256); const float ang = posf * invf; const double a = (double)ang;
            const float cs = (float)cos(a), sn = (float)sin(a);
            if (pos < 256) { cf[CF_ROPE + pos * 16 + i] = cs; cf[CF_ROPE + 4096 + pos * 16 + i] = sn; }
            else { cf[CF_ROPE + 8192 + (pos - 256) * 16 + i] = cs; cf[CF_ROPE + 9216 + (pos - 256) * 16 + i] = sn; } }
    }
    if (bid == 202 && wave < 2) {
        const int l = wave;
        const float d1 = wave_sum(p->in[I_LQ1][l * 64 + lane] * p->in[I_LK1][l * 64 + lane]);
        const float d2 = wave_sum(p->in[I_LQ2][l * 64 + lane] * p->in[I_LK2][l * 64 + lane]);
        const float lam_init = 0.8f - 0.6f * expf(-0.3f * (float)l);
        const float mq = wave_max(fabsf(p->in[I_QNG][l * 64 + lane])), mk = wave_max(fabsf(p->in[I_KNG][l * 64 + lane]));
        if (lane == 0) { cf[CF_SC + l * 16 + 0] = expf(d1) - expf(d2) + lam_init; cf[CF_SC + l * 16 + 1] = LOG2E * 0.125f * 64.f * mq * mk * 1.0001f + 0.01f; cf[CF_SC + l * 16 + 2] = 1.f - lam_init; }
    }
    {
        LAS float* scr = (LAS float*)(lds + wave * 16384);
        const int gw = bid * NWAVES + wave, NGW = gdim * NWAVES;
        constexpr int I_IN = 16 * 112, I_OUT = 16 * 32, I_GU = 16 * 64, I_DN = 16 * 32;
        constexpr int PER_LAYER = I_IN + I_OUT + NEXP * I_GU + NEXP * I_DN;
        for (int it = gw; it < 2 * PER_LAYER; it += NGW) {
            const int l = it / PER_LAYER; int r = it % PER_LAYER;
            if (r < I_IN) { const int kb = r / 112, nb = r % 112;
                transpose_item(p->in[I_WIN] + (size_t)l * D * INC, INC, kb * 64, nb * 32, (bf16_t*)(p->ws + WS_WIN) + (size_t)l * PW * 1024, nb * 32, scr, lane); continue; }
            r -= I_IN;
            if (r < I_OUT) { const int kb = r / 32, nb = r % 32;
                transpose_item(p->in[I_WOUT] + (size_t)l * D * D, D, kb * 64, nb * 32, (bf16_t*)(p->ws + WS_WOUT) + (size_t)l * D * 1024, nb * 32, scr, lane); continue; }
            r -= I_OUT;
            if (r < NEXP * I_GU) { const int e = r / I_GU, q = r % I_GU, kb = q / 64, nb = q % 64; const int n0 = nb * 32, j = n0 & 1023, isup = n0 >> 10;
                const int drow = (j >> 7) * 256 + isup * 128 + (j & 127);
                transpose_item(p->in[I_WGU] + (size_t)(l * NEXP + e) * D * 2048, 2048, kb * 64, n0, (bf16_t*)(p->ws + WS_WGU) + (size_t)(l * NEXP + e) * 2048 * 1024, drow, scr, lane); continue; }
            r -= NEXP * I_GU;
            { const int e = r / I_DN, q = r % I_DN, kb = q / 32, nb = q % 32;
                transpose_item(p->in[I_WD] + (size_t)(l * NEXP + e) * D * D, D, kb * 64, nb * 32, (bf16_t*)(p->ws + WS_WD) + (size_t)(l * NEXP + e) * D * 1024, nb * 32, scr, lane); }
        }
    }
}

struct PlainSched {
    const char* A; const char* Bt; int K, nM, nN, nwg, G, c;
    __device__ __forceinline__ void init(const void* A_, const void* Bt_, int K_, int nM_, int nN_, int G_, int c_) { A = (const char*)A_; Bt = (const char*)Bt_; K = K_; nM = nM_; nN = nN_; nwg = nM * nN; G = G_; c = c_; }
    __device__ __forceinline__ bool next(int i, pg8::Unit& u) const {
        const long L = (long)i * G + c; if (L >= nwg) return false;
        int wgid = (int)L; { const int q = nwg / 8, r = nwg % 8, xcd = wgid % 8, off = wgid / 8; wgid = (xcd < r ? xcd * (q + 1) : r * (q + 1) + (xcd - r) * q) + off; }
        const int nig = 8 * nN, gid = wgid / nig, fm = gid * 8, gsz = (nM - fm) < 8 ? (nM - fm) : 8;
        u.pm = fm + ((wgid % nig) % gsz); u.pn = (wgid % nig) / gsz; return true;
    }
    __device__ __forceinline__ const char* aptr(const pg8::Unit& u) const { return A + (size_t)u.pm * 256 * K * 2; }
    __device__ __forceinline__ const char* bptr(const pg8::Unit& u) const { return Bt + (size_t)u.pn * 256 * K * 2; }
};
struct MoeSched {
    const char* A; const char* W; const int* blk_e; int nblk, nN, G, c;
    __device__ __forceinline__ bool next(int i, pg8::Unit& u) const {
        const long L = (long)i * G + c; const int pm = (int)(L / nN); if (pm >= nblk) return false;
        u.pm = pm; u.pn = (int)(L % nN); return true;
    }
    __device__ __forceinline__ const char* aptr(const pg8::Unit& u) const { return A + (size_t)u.pm * 256 * 1024 * 2; }
    __device__ __forceinline__ const char* bptr(const pg8::Unit& u) const { const int e = blk_e[u.pm]; return W + ((size_t)e * nN + u.pn) * 256 * 1024 * 2; }
};
struct EpiStoreBf16 {
    static constexpr bool PERM = true;
    bf16_t* O; int ldc;
    __device__ __forceinline__ void operator()(const f32x4 (&acc)[2][2][4][2], const pg8::Unit& u, int wr, int wc, int fr, int fq) const {
        const int row0 = u.pm * 256 + wr * 64 + fr, col0 = u.pn * 256 + wc * 32 + 8 * fq;
#pragma unroll
        for (int ai = 0; ai < 2; ++ai)
#pragma unroll
            for (int m = 0; m < 4; ++m) { bf16_t* rowp = O + (size_t)(row0 + ai * 128 + m * 16) * ldc + col0;
#pragma unroll
                for (int bj = 0; bj < 2; ++bj) { const f32x4 v0 = acc[ai][bj][m][0], v1 = acc[ai][bj][m][1];
                    u32x4 w; w.x = cvt_pk_bf16(v0[0], v0[1]); w.y = cvt_pk_bf16(v0[2], v0[3]); w.z = cvt_pk_bf16(v1[0], v1[1]); w.w = cvt_pk_bf16(v1[2], v1[3]);
                    *(u32x4*)(rowp + bj * 128) = w; } }
    }
};
struct EpiResidual {
    static constexpr bool PERM = false;
    PP p; int layer; const float* gate;
    __device__ __forceinline__ void operator()(const f32x4 (&acc)[2][2][4][2], const pg8::Unit& u, int wr, int wc, int fr, int fq) const {
        const int row0 = u.pm * 256 + wr * 64 + fr, col0 = u.pn * 256 + wc * 32 + 4 * fq;
        float* H = (float*)(p->ws + WS_H);
#pragma unroll
        for (int ai = 0; ai < 2; ++ai)
#pragma unroll
            for (int m = 0; m < 4; ++m) { const int row = row0 + ai * 128 + m * 16; const float* hin = hrow_in(p, layer, row) + col0; const float* g = gate + mod_sel(row) * 6144 + col0;
                float* ho = H + (size_t)row * D + col0;
#pragma unroll
                for (int bj = 0; bj < 2; ++bj)
#pragma unroll
                    for (int n = 0; n < 2; ++n) { const f32x4 hv = *(const f32x4*)(hin + bj * 128 + n * 16), gv = *(const f32x4*)(g + bj * 128 + n * 16);
                        *(f32x4*)(ho + bj * 128 + n * 16) = hv + gv * acc[ai][bj][m][n]; } }
    }
};
struct EpiGateUp {
    static constexpr bool PERM = true;
    bf16_t* ACT; const float* bgu; const int* blk_e;
    __device__ __forceinline__ void operator()(const f32x4 (&acc)[2][2][4][2], const pg8::Unit& u, int wr, int wc, int fr, int fq) const {
        const int row0 = u.pm * 256 + wr * 64 + fr, col0 = u.pn * 128 + wc * 32 + 8 * fq; const int e = blk_e[u.pm];
        const float* bg = bgu + (size_t)e * 2048 + col0; const float* bu = bg + 1024;
        f32x4 bgv[2], buv[2];
#pragma unroll
        for (int n = 0; n < 2; ++n) { bgv[n] = *(const f32x4*)(bg + 4 * n); buv[n] = *(const f32x4*)(bu + 4 * n); }
#pragma unroll
        for (int ai = 0; ai < 2; ++ai)
#pragma unroll
            for (int m = 0; m < 4; ++m) { float o[8];
#pragma unroll
                for (int n = 0; n < 2; ++n)
#pragma unroll
                    for (int j = 0; j < 4; ++j) { float g = acc[ai][0][m][n][j] + bgv[n][j], up = acc[ai][1][m][n][j] + buv[n][j];
                        g = fminf(g, 7.f); up = fminf(fmaxf(up, -7.f), 7.f);
                        const float glu = g / (1.f + __expf(-1.702f * g)); o[n * 4 + j] = (up + 1.f) * glu; }
                u32x4 w; w.x = cvt_pk_bf16(o[0], o[1]); w.y = cvt_pk_bf16(o[2], o[3]); w.z = cvt_pk_bf16(o[4], o[5]); w.w = cvt_pk_bf16(o[6], o[7]);
                *(u32x4*)(ACT + (size_t)(row0 + ai * 128 + m * 16) * 1024 + col0) = w; }
    }
};
struct EpiDown {
    static constexpr bool PERM = true;
    bf16_t* Y; const float* bd; const int* blk_e; const float* sgate;
    __device__ __forceinline__ void operator()(const f32x4 (&acc)[2][2][4][2], const pg8::Unit& u, int wr, int wc, int fr, int fq) const {
        const int row0 = u.pm * 256 + wr * 64 + fr, col0 = u.pn * 256 + wc * 32 + 8 * fq; const int e = blk_e[u.pm];
        const float* b = bd + (size_t)e * 1024 + col0;
        f32x4 bv[2][2];
#pragma unroll
        for (int bj = 0; bj < 2; ++bj)
#pragma unroll
            for (int n = 0; n < 2; ++n) bv[bj][n] = *(const f32x4*)(b + bj * 128 + 4 * n);
#pragma unroll
        for (int ai = 0; ai < 2; ++ai)
#pragma unroll
            for (int m = 0; m < 4; ++m) { const int row = row0 + ai * 128 + m * 16; const float sg = sgate[row]; bf16_t* rowp = Y + (size_t)row * 1024 + col0;
#pragma unroll
                for (int bj = 0; bj < 2; ++bj) { const f32x4 v0 = (acc[ai][bj][m][0] + bv[bj][0]) * sg, v1 = (acc[ai][bj][m][1] + bv[bj][1]) * sg;
                    u32x4 w; w.x = cvt_pk_bf16(v0[0], v0[1]); w.y = cvt_pk_bf16(v0[2], v0[3]); w.z = cvt_pk_bf16(v1[0], v1[1]); w.w = cvt_pk_bf16(v1[2], v1[3]);
                    *(u32x4*)(rowp + bj * 128) = w; } }
    }
};

__device__ __forceinline__ void norm_mod_row(const float* hrow, const float* g, const float* shift, const float* scale, int lane, f32x4 (&u)[4]) {
    float ss = 0.f;
#pragma unroll
    for (int j = 0; j < 4; ++j) { u[j] = *(const f32x4*)(hrow + 4 * lane + 256 * j); ss += (u[j][0] * u[j][0] + u[j][1] * u[j][1]) + (u[j][2] * u[j][2] + u[j][3] * u[j][3]); }
    const float rstd = rsqrtf(wave_sum(ss) * (1.f / D) + EPS);
#pragma unroll
    for (int j = 0; j < 4; ++j) { const int c = 4 * lane + 256 * j; const f32x4 gv = *(const f32x4*)(g + c), sh = *(const f32x4*)(shift + c), sc = *(const f32x4*)(scale + c);
        u[j] = (u[j] * rstd) * gv * (sc + 1.f) + sh; }
}
__device__ __forceinline__ void store_row_bf16(bf16_t* orow, int lane, const f32x4 (&u)[4]) {
#pragma unroll
    for (int j = 0; j < 4; ++j) { u32x2 w; w.x = cvt_pk_bf16(u[j][0], u[j][1]); w.y = cvt_pk_bf16(u[j][2], u[j][3]); *(u32x2*)(orow + 4 * lane + 256 * j) = w; }
}

__device__ __forceinline__ void phase_norm_mix(PP p, int layer, LAS unsigned char* lds) {
    int tid = threadIdx.x, bid = blockIdx.x, gdim = gridDim.x; asm volatile("" : "+v"(tid), "+s"(bid), "+s"(gdim)); const int lane = tid & 63, wave = __builtin_amdgcn_readfirstlane(tid >> 6);
    LAS float* wab = (LAS float*)lds;
    const float* win = p->in[I_WIN] + (size_t)layer * D * INC;
    for (int i = tid; i < 16 * 1024; i += NTHR) { const int k = i >> 4, j = i & 15; wab[j * 1024 + k] = win[(size_t)k * INC + PW + j]; }
    __syncthreads();
    const float* cf = (const float*)(p->ws + WS_CONST);
    const float* gn = p->in[I_NMIXG] + layer * D;
    float ea = 0.f, dtb = 0.f; if (lane < 8) { ea = -__expf(p->in[I_ALOG][layer * 8 + lane]); dtb = p->in[I_DTB][layer * 8 + lane]; }
    for (int r = bid * NWAVES + wave; r < NTOK; r += gdim * NWAVES) {
        const float* mv = cf + CF_MODV + (layer * 3 + mod_sel(r)) * 6144;
        f32x4 u[4]; norm_mod_row(hrow_in(p, layer, r), gn, mv, mv + 1024, lane, u);
        store_row_bf16((bf16_t*)(p->ws + WS_U) + (size_t)r * D, lane, u);
        float ab = 0.f;
#pragma unroll
        for (int j = 0; j < 16; ++j) { float s = 0.f;
#pragma unroll
            for (int q = 0; q < 4; ++q) { const f32x4 w = *(const LAS f32x4*)(wab + j * 1024 + 4 * lane + 256 * q); s += (u[q][0] * w[0] + u[q][1] * w[1]) + (u[q][2] * w[2] + u[q][3] * w[3]); }
            s = wave_sum(s); if (lane == j) ab = s; }
        float outv;
        if (lane < 8) { const float z = ab + dtb; const float sp = z > 20.f ? z : log1pf(__expf(z)); outv = ea * sp; }
        else outv = 1.f / (1.f + __expf(-ab));
        if (lane < 16) ((float*)(p->ws + WS_GB))[(size_t)r * 16 + lane] = outv;
    }
}

__device__ __forceinline__ void phase_prep(PP p, int layer) {
    int tid = threadIdx.x, bid = blockIdx.x, gdim = gridDim.x; asm volatile("" : "+v"(tid), "+s"(bid), "+s"(gdim)); const int lane = tid & 63, wave = __builtin_amdgcn_readfirstlane(tid >> 6);
    const float* cf = (const float*)(p->ws + WS_CONST);
    bf16_t* P = (bf16_t*)(p->ws + WS_P); bf16_t* G = (bf16_t*)(p->ws + WS_G);
    const float* cw = p->in[I_CONVW] + (size_t)layer * 5 * 1536;
    float gain[16];
    { const float* gsrc = (lane < 32 ? p->in[I_QNG] : p->in[I_KNG]) + layer * 64 + 16 * (lane & 3);
#pragma unroll
      for (int e = 0; e < 16; ++e) gain[e] = gsrc[e]; }
    const float qscale = lane < 32 ? 0.125f * LOG2E : 1.f;
    for (int r = bid * NWAVES + wave; r < NTOK; r += gdim * NWAVES) {
        bf16_t* prow = P + (size_t)r * PW + 16 * lane;
        const u32x4 w0 = *(const u32x4*)prow, w1 = *(const u32x4*)(prow + 8);
        float x[16];
#pragma unroll
        for (int e = 0; e < 4; ++e) { x[2 * e] = bflo(w0[e]); x[2 * e + 1] = bfhi(w0[e]); x[8 + 2 * e] = bflo(w1[e]); x[8 + 2 * e + 1] = bfhi(w1[e]); }
        float ss = 0.f;
#pragma unroll
        for (int e = 0; e < 16; ++e) ss += x[e] * x[e];
        ss += __shfl_xor(ss, 1); ss += __shfl_xor(ss, 2);
        const float rstd = rsqrtf(ss * (1.f / 64.f) + EPS);
#pragma unroll
        for (int e = 0; e < 16; ++e) x[e] = x[e] * rstd * gain[e];
        if (r < NLAT) {
            const int t = r & (SEQL - 1); const int pos = (lane & 2) ? (t & 63) : (t >> 6);
            const float* ct = cf + CF_ROPE + ((lane & 2) ? 8192 : 0) + pos * 16; const float* st = ct + ((lane & 2) ? 1024 : 4096);
            const bool second = lane & 1;
#pragma unroll
            for (int e = 0; e < 16; ++e) { const float other = __shfl_xor(x[e], 1); const float cs = ct[e], sn = st[e];
                x[e] = second ? (x[e] * cs + other * sn) : (x[e] * cs - other * sn); }
        }
        u32x4 o0, o1;
#pragma unroll
        for (int e = 0; e < 4; ++e) { o0[e] = cvt_pk_bf16(x[2 * e] * qscale, x[2 * e + 1] * qscale); o1[e] = cvt_pk_bf16(x[8 + 2 * e] * qscale, x[8 + 2 * e + 1] * qscale); }
        *(u32x4*)prow = o0; *(u32x4*)(prow + 8) = o1;
    }
    for (int r = bid * NWAVES + wave; r < NTOK; r += gdim * NWAVES) {
        int seg0, seglen; if (r < NLAT) { seg0 = r & ~(SEQL - 1); seglen = SEQL; } else { seg0 = NLAT + ((r - NLAT) & ~(CTXL - 1)); seglen = CTXL; }
        const int tpos = r - seg0;
#pragma unroll
        for (int grp = 0; grp < 3; ++grp) {
            const int c0 = grp * 512 + 8 * lane;
            float a[8];
#pragma unroll
            for (int e = 0; e < 8; ++e) a[e] = 0.f;
#pragma unroll
            for (int j = 0; j < 5; ++j) { const int tp = tpos + j - 2;
                if (tp >= 0 && tp < seglen) { const u32x4 w = *(const u32x4*)(P + (size_t)(seg0 + tp) * PW + 1536 + c0);
                    const f32x4 k0 = *(const f32x4*)(cw + j * 1536 + c0), k1 = *(const f32x4*)(cw + j * 1536 + c0 + 4);
                    a[0] += bflo(w[0]) * k0[0]; a[1] += bfhi(w[0]) * k0[1]; a[2] += bflo(w[1]) * k0[2]; a[3] += bfhi(w[1]) * k0[3];
                    a[4] += bflo(w[2]) * k1[0]; a[5] += bfhi(w[2]) * k1[1]; a[6] += bflo(w[3]) * k1[2]; a[7] += bfhi(w[3]) * k1[3]; } }
            float ss = 0.f;
#pragma unroll
            for (int e = 0; e < 8; ++e) { a[e] = silu_f(a[e]); ss += a[e] * a[e]; }
            if (grp < 2) { ss += __shfl_xor(ss, 1); ss += __shfl_xor(ss, 2); ss += __shfl_xor(ss, 4); ss += __shfl_xor(ss, 8);
                const float rn = rsqrtf(ss + EPS);
#pragma unroll
                for (int e = 0; e < 8; ++e) a[e] *= rn; }
            u32x4 o; o.x = cvt_pk_bf16(a[0], a[1]); o.y = cvt_pk_bf16(a[2], a[3]); o.z = cvt_pk_bf16(a[4], a[5]); o.w = cvt_pk_bf16(a[6], a[7]);
            *(u32x4*)(G + (size_t)r * 1536 + c0) = o;
        }
    }
}

__device__ __forceinline__ void gdn_task_rows(int task, int& b, int& h, int& dir, int& rstart, int& rstep) {
    const int chain = task / NCHUNK, n = task % NCHUNK; dir = chain & 1; h = (chain >> 1) & 3; b = chain >> 3;
    if (n < 4) { const int base = NLAT + b * CTXL; if (dir == 0) { rstart = base + 64 * n; rstep = 1; } else { rstart = base + CTXL - 1 - 64 * n; rstep = -1; } }
    else { const int base = b * SEQL, m = n - 4; if (dir == 0) { rstart = base + 64 * m; rstep = 1; } else { rstart = base + SEQL - 1 - 64 * m; rstep = -1; } }
}
constexpr int CL_QL = 0, CL_KL = 17408, CL_KT = 34816, CL_VT = 53248, CL_AM = 71680, CL_AQ = 88064, CL_TL = 105472, CL_VEC = 114688;
constexpr int QLP = 136, KTP = 72, AQP = 68, TLP = 72;
__device__ __forceinline__ void phase_gdn_chunk(PP p, LAS unsigned char* lds) {
    int tid = threadIdx.x, bid = blockIdx.x, gdim = gridDim.x; asm volatile("" : "+v"(tid), "+s"(bid), "+s"(gdim)); const int lane = tid & 63, wave = __builtin_amdgcn_readfirstlane(tid >> 6), r32 = lane & 31, hi = lane >> 5;
    const bf16_t* G = (const bf16_t*)(p->ws + WS_G); const float* GB = (const float*)(p->ws + WS_GB);
    float* cf = (float*)(p->ws + WS_CONST);
    LAS bf16_t* QL = (LAS bf16_t*)(lds + CL_QL); LAS bf16_t* KL = (LAS bf16_t*)(lds + CL_KL); LAS bf16_t* KT = (LAS bf16_t*)(lds + CL_KT); LAS bf16_t* VT = (LAS bf16_t*)(lds + CL_VT);
    LAS float* AM = (LAS float*)(lds + CL_AM); LAS float* AQ = (LAS float*)(lds + CL_AQ); LAS bf16_t* TL = (LAS bf16_t*)(lds + CL_TL);
    LAS float* gc = (LAS float*)(lds + CL_VEC); LAS float* eg = gc + 64; LAS float* be = gc + 128; LAS float* beg = gc + 192; LAS float* kd = gc + 256;
    for (int task = bid; task < NTASK; task += gdim) {
        int b, h, dir, rstart, rstep; gdn_task_rows(task, b, h, dir, rstart, rstep);
        unsigned char* chb = p->ws + WS_CH + (size_t)task * CH_TASK_BYTES;
        if (wave == 0) { const int row = rstart + rstep * lane; float g = GB[(size_t)row * 16 + dir * 4 + h]; const float bt = GB[(size_t)row * 16 + 8 + dir * 4 + h];
#pragma unroll
            for (int o = 1; o < 64; o <<= 1) { const float t = __shfl_up(g, o); if (lane >= o) g += t; }
            const float glast = __shfl(g, 63); const float e = __expf(g);
            gc[lane] = g; eg[lane] = e; be[lane] = bt; beg[lane] = bt * e; kd[lane] = __expf(glast - g);
            if (lane == 0) cf[CF_EGL + task] = __expf(glast); }
        for (int pc = tid; pc < 3072; pc += NTHR) { const int mat = pc >> 10, i = (pc >> 4) & 63, c8 = pc & 15; const int row = rstart + rstep * i;
            const u32x4 w = *(const u32x4*)(G + (size_t)row * 1536 + mat * 512 + h * 128 + 8 * c8);
            if (mat == 0) *(LAS u32x4*)(QL + i * QLP + 8 * c8) = w;
            else { if (mat == 1) *(LAS u32x4*)(KL + i * QLP + 8 * c8) = w;
                LAS bf16_t* T = (mat == 1 ? KT : VT) + (8 * c8) * KTP + i;
#pragma unroll
                for (int e = 0; e < 4; ++e) { T[(2 * e) * KTP] = (bf16_t)(w[e] & 0xffffu); T[(2 * e + 1) * KTP] = (bf16_t)(w[e] >> 16); } } }
        __syncthreads();
        { const int which = wave >> 2, mi = (wave >> 1) & 1, ni = wave & 1; f32x16 acc = {};
          const LAS bf16_t* Arow = (which ? QL : KL) + (32 * mi + r32) * QLP + 8 * hi; const LAS bf16_t* Brow = KL + (32 * ni + r32) * QLP + 8 * hi;
#pragma unroll
          for (int ks = 0; ks < 8; ++ks) acc = MFMA32(*(const LAS bf16x8*)(Arow + 16 * ks), *(const LAS bf16x8*)(Brow + 16 * ks), acc);
          const int sp = 32 * ni + r32; const float gs = gc[sp];
#pragma unroll
          for (int r = 0; r < 16; ++r) { const int c = 32 * mi + crow(r, hi); const float dec = __expf(fminf(gc[c] - gs, 0.f));
              if (which == 0) AM[c * 64 + sp] = (sp < c) ? be[c] * acc[r] * dec : 0.f;
              else AQ[c * AQP + sp] = (sp <= c) ? 0.08838834764831845f * acc[r] * dec : 0.f; } }
        __syncthreads();
        if (wave == 0) {
            float t[64]; const LAS float* amb = AM; asm volatile("" : "+v"(amb));
#pragma unroll
            for (int i = 0; i < 64; ++i) { float a = (lane == i) ? 1.f : 0.f;
#pragma unroll
                for (int m4 = 0; m4 < (i + 3) / 4; ++m4) { const f32x4 av = *(const LAS f32x4*)(amb + i * 64 + 4 * m4);
#pragma unroll
                    for (int e = 0; e < 4; ++e) if (4 * m4 + e < i) a -= av[e] * t[4 * m4 + e]; }
                t[i] = a; }
#pragma unroll
            for (int i = 0; i < 64; ++i) TL[i * TLP + lane] = (bf16_t)f2bf(t[i]);
        } else {
            for (int f = wave - 1; f < 40; f += 7) {
                u32x4 o;
                if (f < 16) {
                    const int m = f >> 3, t = (f >> 1) & 3, s = f & 1, c = 32 * m + r32; const float sc = 0.08838834764831845f * eg[c];
                    const LAS bf16_t* src = QL + c * QLP + 32 * t + 16 * s + 4 * hi; const u32x2 a = *(const LAS u32x2*)src, bq = *(const LAS u32x2*)(src + 8);
                    o.x = cvt_pk_bf16(bflo(a.x) * sc, bfhi(a.x) * sc); o.y = cvt_pk_bf16(bflo(a.y) * sc, bfhi(a.y) * sc); o.z = cvt_pk_bf16(bflo(bq.x) * sc, bfhi(bq.x) * sc); o.w = cvt_pk_bf16(bflo(bq.y) * sc, bfhi(bq.y) * sc);
                    *(u32x4*)(chb + CH_QF + f * 1024 + lane * 16) = o;
                } else if (f < 32) {
                    const int g = f - 16, t = g >> 2, m = (g >> 1) & 1, s = g & 1, dk = 32 * t + r32, c0 = 32 * m + 16 * s + 4 * hi;
                    const LAS bf16_t* src = KT + dk * KTP + c0; const u32x2 a = *(const LAS u32x2*)src, bq = *(const LAS u32x2*)(src + 8);
                    const f32x4 s0 = *(const LAS f32x4*)(kd + c0), s1 = *(const LAS f32x4*)(kd + c0 + 8);
                    o.x = cvt_pk_bf16(bflo(a.x) * s0[0], bfhi(a.x) * s0[1]); o.y = cvt_pk_bf16(bflo(a.y) * s0[2], bfhi(a.y) * s0[3]); o.z = cvt_pk_bf16(bflo(bq.x) * s1[0], bfhi(bq.x) * s1[1]); o.w = cvt_pk_bf16(bflo(bq.y) * s1[2], bfhi(bq.y) * s1[3]);
                    *(u32x4*)(chb + CH_KF + g * 1024 + lane * 16) = o;
                } else {
                    const int g = f - 32, mo = g >> 2, m = (g >> 1) & 1, s = g & 1, c = 32 * mo + r32;
                    const LAS float* src = AQ + c * AQP + 32 * m + 16 * s + 4 * hi; const f32x4 a = *(const LAS f32x4*)src, bq = *(const LAS f32x4*)(src + 8);
                    o.x = cvt_pk_bf16(a[0], a[1]); o.y = cvt_pk_bf16(a[2], a[3]); o.z = cvt_pk_bf16(bq[0], bq[1]); o.w = cvt_pk_bf16(bq[2], bq[3]);
                    *(u32x4*)(chb + CH_AF + g * 1024 + lane * 16) = o;
                }
            }
        }
        __syncthreads();
        { const int t = wave >> 1, m = wave & 1; f32x16 acc = {};
#pragma unroll
          for (int ks = 0; ks < 4; ++ks) { const int s0 = 16 * ks + 8 * hi;
              const u32x4 kw = *(const LAS u32x4*)(KT + (32 * t + r32) * KTP + s0); const f32x4 c0 = *(const LAS f32x4*)(beg + s0), c1 = *(const LAS f32x4*)(beg + s0 + 4);
              u32x4 aw; aw.x = cvt_pk_bf16(bflo(kw.x) * c0[0], bfhi(kw.x) * c0[1]); aw.y = cvt_pk_bf16(bflo(kw.y) * c0[2], bfhi(kw.y) * c0[3]); aw.z = cvt_pk_bf16(bflo(kw.z) * c1[0], bfhi(kw.z) * c1[1]); aw.w = cvt_pk_bf16(bflo(kw.w) * c1[2], bfhi(kw.w) * c1[3]);
              const bf16x8 bfr = *(const LAS bf16x8*)(TL + (32 * m + r32) * TLP + s0);
              acc = MFMA32(__builtin_bit_cast(bf16x8, aw), bfr, acc); }
#pragma unroll
          for (int s = 0; s < 2; ++s) { u32x4 o; o.x = cvt_pk_bf16(-acc[8 * s + 0], -acc[8 * s + 1]); o.y = cvt_pk_bf16(-acc[8 * s + 2], -acc[8 * s + 3]); o.z = cvt_pk_bf16(-acc[8 * s + 4], -acc[8 * s + 5]); o.w = cvt_pk_bf16(-acc[8 * s + 6], -acc[8 * s + 7]);
              *(u32x4*)(chb + CH_WF + ((m * 4 + t) * 2 + s) * 1024 + lane * 16) = o; } }
        { const int m = wave >> 2, nj = wave & 3; f32x16 acc = {};
#pragma unroll
          for (int ks = 0; ks < 4; ++ks) { const int s0 = 16 * ks + 8 * hi;
              const bf16x8 afr = *(const LAS bf16x8*)(TL + (32 * m + r32) * TLP + s0);
              const u32x4 vw = *(const LAS u32x4*)(VT + (32 * nj + r32) * KTP + s0); const f32x4 c0 = *(const LAS f32x4*)(be + s0), c1 = *(const LAS f32x4*)(be + s0 + 4);
              u32x4 bw; bw.x = cvt_pk_bf16(bflo(vw.x) * c0[0], bfhi(vw.x) * c0[1]); bw.y = cvt_pk_bf16(bflo(vw.y) * c0[2], bfhi(vw.y) * c0[3]); bw.z = cvt_pk_bf16(bflo(vw.z) * c1[0], bfhi(vw.z) * c1[1]); bw.w = cvt_pk_bf16(bflo(vw.w) * c1[2], bfhi(vw.w) * c1[3]);
              acc = MFMA32(afr, __builtin_bit_cast(bf16x8, bw), acc); }
          float* uc = (float*)(chb + CH_UC) + ((nj * 2 + m) * 64 + lane) * 16;
#pragma unroll
          for (int q = 0; q < 4; ++q) *(f32x4*)(uc + 4 * q) = (f32x4){acc[4 * q], acc[4 * q + 1], acc[4 * q + 2], acc[4 * q + 3]}; }
        __syncthreads();
    }
}

__device__ __forceinline__ void gdn_scan_chain(PP p, LAS unsigned char* lds, const int chain) {
    int tid = threadIdx.x; asm volatile("" : "+v"(tid)); const int lane = tid & 63, wave = __builtin_amdgcn_readfirstlane(tid >> 6), r32 = lane & 31, hi = lane >> 5;
    const float* cf = (const float*)(p->ws + WS_CONST);
    float* OG = (float*)(p->ws + WS_OG);
    constexpr int STG = 2 * CH_DMA_BYTES;
    const int dir = chain & 1, h = (chain >> 1) & 3;
    f32x16 S[4];
#pragma unroll
    for (int t = 0; t < 4; ++t) S[t] = (f32x16){};
    f32x16 Un[2]; float egn = 0.f;
#pragma unroll
    for (int m = 0; m < 2; ++m) Un[m] = (f32x16){};
#define LOAD_U(task_) do { const float* uc_ = (const float*)(p->ws + WS_CH + (size_t)(task_) * CH_TASK_BYTES + CH_UC) + ((wave * 2) * 64 + lane) * 16; \
        _Pragma("unroll") for (int m = 0; m < 2; ++m) _Pragma("unroll") for (int q = 0; q < 4; ++q) { const f32x4 t4 = *(const f32x4*)(uc_ + m * 1024 + 4 * q); Un[m][4 * q] = t4[0]; Un[m][4 * q + 1] = t4[1]; Un[m][4 * q + 2] = t4[2]; Un[m][4 * q + 3] = t4[3]; } \
        egn = cf[CF_EGL + (task_)]; } while (0)
#define STAGE_CHUNK(task_, bufi) do { const unsigned char* src_ = p->ws + WS_CH + (size_t)(task_) * CH_TASK_BYTES; const unsigned dst_ = lds_addr(lds + (bufi) * CH_DMA_BYTES); \
        _Pragma("unroll") for (int i = 0; i < 14; ++i) { const int pc = wave * 14 + i; glds16(src_ + pc * 1024 + lane * 16, dst_ + pc * 1024); } } while (0)
    if (wave < 4) { LOAD_U(chain * NCHUNK); STAGE_CHUNK(chain * NCHUNK, 0); }
    for (int n = 0; n < NCHUNK; ++n) {
        const int task = chain * NCHUNK + n;
        int bq, hq, dq, rstart, rstep; gdn_task_rows(task, bq, hq, dq, rstart, rstep);
        if (wave < 4) VM_WAIT();
        asm volatile("s_waitcnt lgkmcnt(0)\n\ts_barrier" ::: "memory");
        if (wave < 4) {
            f32x16 V[2], O[2];
#pragma unroll
            for (int m = 0; m < 2; ++m) { V[m] = Un[m]; O[m] = (f32x16){}; }
            const float egl = egn;
            if (n + 1 < NCHUNK) { LOAD_U(task + 1); STAGE_CHUNK(task + 1, (n + 1) & 1); }
            const LAS unsigned char* buf = lds + (n & 1) * CH_DMA_BYTES + lane * 16;
            bf16x8 Sb[4][2];
#pragma unroll
            for (int t = 0; t < 4; ++t)
#pragma unroll
                for (int s = 0; s < 2; ++s) { u32x4 w; w.x = cvt_pk_bf16(S[t][8 * s], S[t][8 * s + 1]); w.y = cvt_pk_bf16(S[t][8 * s + 2], S[t][8 * s + 3]); w.z = cvt_pk_bf16(S[t][8 * s + 4], S[t][8 * s + 5]); w.w = cvt_pk_bf16(S[t][8 * s + 6], S[t][8 * s + 7]);
                    Sb[t][s] = __builtin_bit_cast(bf16x8, w); }
#pragma unroll
            for (int m = 0; m < 2; ++m)
#pragma unroll
                for (int t = 0; t < 4; ++t)
#pragma unroll
                    for (int s = 0; s < 2; ++s) { const int f = (m * 4 + t) * 2 + s;
                        V[m] = MFMA32(*(const LAS bf16x8*)(buf + CH_WF + f * 1024), Sb[t][s], V[m]);
                        O[m] = MFMA32(*(const LAS bf16x8*)(buf + CH_QF + f * 1024), Sb[t][s], O[m]);
                        if (s == 1 && (t & 1)) __builtin_amdgcn_sched_barrier(0); }
            bf16x8 Vb[2][2];
#pragma unroll
            for (int m = 0; m < 2; ++m)
#pragma unroll
                for (int s = 0; s < 2; ++s) { u32x4 w; w.x = cvt_pk_bf16(V[m][8 * s], V[m][8 * s + 1]); w.y = cvt_pk_bf16(V[m][8 * s + 2], V[m][8 * s + 3]); w.z = cvt_pk_bf16(V[m][8 * s + 4], V[m][8 * s + 5]); w.w = cvt_pk_bf16(V[m][8 * s + 6], V[m][8 * s + 7]);
                    Vb[m][s] = __builtin_bit_cast(bf16x8, w); }
#pragma unroll
            for (int mo = 0; mo < 2; ++mo)
#pragma unroll
                for (int m = 0; m <= mo; ++m)
#pragma unroll
                    for (int s = 0; s < 2; ++s) O[mo] = MFMA32(*(const LAS bf16x8*)(buf + CH_AF + ((mo * 2 + m) * 2 + s) * 1024), Vb[m][s], O[mo]);
            { LAS bf16_t* stg = (LAS bf16_t*)(lds + STG) + 32 * wave + r32;
#pragma unroll
              for (int m = 0; m < 2; ++m)
#pragma unroll
                  for (int r = 0; r < 16; ++r) stg[(32 * m + crow(r, hi)) * 128] = (bf16_t)f2bf(O[m][r]); }
#pragma unroll
            for (int t = 0; t < 4; ++t) {
                __builtin_amdgcn_sched_barrier(0);
#pragma unroll
                for (int r = 0; r < 16; ++r) S[t][r] *= egl;
#pragma unroll
                for (int m = 0; m < 2; ++m)
#pragma unroll
                    for (int s = 0; s < 2; ++s) S[t] = MFMA32(*(const LAS bf16x8*)(buf + CH_KF + ((t * 2 + m) * 2 + s) * 1024), Vb[m][s], S[t]); }
        }
        asm volatile("s_waitcnt lgkmcnt(0)\n\ts_barrier" ::: "memory");
        if (wave >= 4) { const int j = tid - 256, row = j >> 2; float* og = OG + (size_t)dir * NTOK * 512 + (size_t)(rstart + rstep * row) * 512 + h * 128 + (j & 3) * 8;
            const LAS bf16_t* stg = (const LAS bf16_t*)(lds + STG) + row * 128 + (j & 3) * 8;
#pragma unroll
            for (int it = 0; it < 4; ++it) { const u32x4 w = *(const LAS u32x4*)(stg + it * 32);
                *(f32x4*)(og + it * 32) = (f32x4){bflo(w.x), bfhi(w.x), bflo(w.y), bfhi(w.y)}; *(f32x4*)(og + it * 32 + 4) = (f32x4){bflo(w.z), bfhi(w.z), bflo(w.w), bfhi(w.w)}; } }
    }
    VM_WAIT(); LDS_WAIT(); __syncthreads();
#undef LOAD_U
#undef STAGE_CHUNK
}

__device__ __forceinline__ void phase_gdn_out(PP p, int layer) {
    int tid = threadIdx.x, bid = blockIdx.x, gdim = gridDim.x; asm volatile("" : "+v"(tid), "+s"(bid), "+s"(gdim)); const int lane = tid & 63, wave = __builtin_amdgcn_readfirstlane(tid >> 6);
    const float* OG = (const float*)(p->ws + WS_OG); const float* OA = (const float*)(p->ws + WS_OA); const bf16_t* P = (const bf16_t*)(p->ws + WS_P); bf16_t* MIX = (bf16_t*)(p->ws + WS_MIX);
    const float* cf = (const float*)(p->ws + WS_CONST);
    const float lam = cf[CF_SC + layer * 16 + 0], oml = cf[CF_SC + layer * 16 + 2];
    const float* gn = p->in[I_GDNG] + layer * 128 + (8 * lane & 127); const float* sg = p->in[I_SUBLN] + layer * 128 + (8 * lane & 127);
    const f32x4 g0 = *(const f32x4*)gn, g1 = *(const f32x4*)(gn + 4), a0 = *(const f32x4*)sg * oml, a1 = *(const f32x4*)(sg + 4) * oml;
    const int nrows = layer == 0 ? NTOK : NLAT;
    for (int r = bid * NWAVES + wave; r < nrows; r += gdim * NWAVES) {
        {
            const float* a = OA + (size_t)r * 512 + 8 * lane; const float* bq = a + (size_t)NTOK * 512;
            f32x4 o0 = *(const f32x4*)a - *(const f32x4*)bq * lam, o1 = *(const f32x4*)(a + 4) - *(const f32x4*)(bq + 4) * lam;
            float ss = (o0[0] * o0[0] + o0[1] * o0[1]) + (o0[2] * o0[2] + o0[3] * o0[3]) + (o1[0] * o1[0] + o1[1] * o1[1]) + (o1[2] * o1[2] + o1[3] * o1[3]);
            ss += __shfl_xor(ss, 1); ss += __shfl_xor(ss, 2); ss += __shfl_xor(ss, 4); ss += __shfl_xor(ss, 8);
            const float rstd = rsqrtf(ss * (1.f / 128.f) + EPS);
            o0 = o0 * rstd * a0; o1 = o1 * rstd * a1;
            u32x4 w; w.x = cvt_pk_bf16(o0[0], o0[1]); w.y = cvt_pk_bf16(o0[2], o0[3]); w.z = cvt_pk_bf16(o1[0], o1[1]); w.w = cvt_pk_bf16(o1[2], o1[3]);
            *(u32x4*)(MIX + (size_t)r * D + 8 * lane) = w; }
        const float* a = OG + (size_t)r * 512 + 8 * lane; const float* bq = a + (size_t)NTOK * 512;
        f32x4 o0 = *(const f32x4*)a + *(const f32x4*)bq, o1 = *(const f32x4*)(a + 4) + *(const f32x4*)(bq + 4);
        float ss = (o0[0] * o0[0] + o0[1] * o0[1]) + (o0[2] * o0[2] + o0[3] * o0[3]) + (o1[0] * o1[0] + o1[1] * o1[1]) + (o1[2] * o1[2] + o1[3] * o1[3]);
        ss += __shfl_xor(ss, 1); ss += __shfl_xor(ss, 2); ss += __shfl_xor(ss, 4); ss += __shfl_xor(ss, 8);
        const float rstd = rsqrtf(ss * (1.f / 128.f) + EPS);
        const u32x4 zw = *(const u32x4*)(P + (size_t)r * PW + 3072 + 8 * lane);
        o0 = o0 * rstd * g0; o1 = o1 * rstd * g1;
        u32x4 w; w.x = cvt_pk_bf16(o0[0] * silu_f(bflo(zw.x)), o0[1] * silu_f(bfhi(zw.x))); w.y = cvt_pk_bf16(o0[2] * silu_f(bflo(zw.y)), o0[3] * silu_f(bfhi(zw.y)));
        w.z = cvt_pk_bf16(o1[0] * silu_f(bflo(zw.z)), o1[1] * silu_f(bfhi(zw.z))); w.w = cvt_pk_bf16(o1[2] * silu_f(bflo(zw.w)), o1[3] * silu_f(bfhi(zw.w)));
        *(u32x4*)(MIX + (size_t)r * D + 512 + 8 * lane) = w;
    }
}

constexpr int AT_SLOTK = 8192, AT_SLOTV = 16384, AT_K = 0, AT_V = 3 * AT_SLOTK, AT_WS = AT_V + 3 * AT_SLOTV;
typedef short v4i16_t __attribute__((ext_vector_type(4)));
__device__ __forceinline__ s16x4 vtr(const LAS unsigned char* ptr) { return __builtin_bit_cast(s16x4, __builtin_amdgcn_ds_read_tr16_b64_v4i16((LAS v4i16_t*)ptr)); }
__device__ __forceinline__ int att_keyrow(int b, int t, int nctx_tiles) {
    return t < nctx_tiles ? NLAT + b * CTXL + 64 * t : b * SEQL + 64 * (t - nctx_tiles);
}
#define AT_SBAR() __builtin_amdgcn_sched_barrier(0)
#define AT_PIN(x) asm volatile("" : "+v"(x))
#define AT_WAIT_BAR(N) asm volatile("s_waitcnt vmcnt(" #N ") lgkmcnt(0)\n\ts_barrier" ::: "memory")
__device__ __forceinline__ void attn_unit(PP p, int layer, LAS unsigned char* lds, int b, int h, int sub, int qrow0, int ntile, int nctx_tiles) {
    int tid = threadIdx.x; asm volatile("" : "+v"(tid)); const int lane = tid & 63, wave = __builtin_amdgcn_readfirstlane(tid >> 6), r32 = lane & 31, hi = lane >> 5;
    const bf16_t* P = (const bf16_t*)(p->ws + WS_P);
    LAS float* wsf = (LAS float*)(lds + AT_WS) + wave * 64;
    const LAS unsigned char* kp0 = lds + AT_K + hi * 1024 + r32 * 16;
    const LAS unsigned char* vp0 = lds + AT_V + ((lane >> 4) & 1) * 32 + (lane & 3) * 8 + (4 * hi + ((lane & 15) >> 2)) * 64;
    const int kcol = 512 + h * 128 + sub * 64 + wave * 8, vcol = 1024 + h * 128;
    const size_t koff = (size_t)lane * PW + kcol;
    const size_t voff0 = (size_t)(16 * (wave & 3) + (lane >> 2)) * PW + vcol + 32 * (wave >> 2) + 8 * (lane & 3);
    const size_t voff1 = voff0 + 64;
    const unsigned kdst = lds_addr(lds + AT_K + wave * 1024), vdst = lds_addr(lds + AT_V + wave * 1024);
#define DMA_K(t, slot) do { if ((t) < ntile) glds16(P + (size_t)att_keyrow(b, (t), nctx_tiles) * PW + koff, kdst + (slot) * AT_SLOTK); } while (0)
#define DMA_V(t, slot) do { if ((t) < ntile) { const bf16_t* vb_ = P + (size_t)att_keyrow(b, (t), nctx_tiles) * PW; \
        glds16(vb_ + voff0, vdst + (slot) * AT_SLOTV); glds16(vb_ + voff1, vdst + (slot) * AT_SLOTV + 8192); } } while (0)
    DMA_K(0, 0); DMA_V(0, 0); DMA_K(1, 1); DMA_K(2, 2);
    bf16x8 qr[4];
    { const bf16_t* qp = P + (size_t)(qrow0 + wave * 32 + r32) * PW + h * 128 + sub * 64 + hi * 8;
#pragma unroll
      for (int d0 = 0; d0 < 4; ++d0) qr[d0] = *(const bf16x8*)(qp + d0 * 16); }
    f32x16 o[4];
#pragma unroll
    for (int dg = 0; dg < 4; ++dg) o[dg] = (f32x16){};
    float l_reg = 0.f;
    f32x16 pA0, pA1, pB0, pB1; bf16x8 kf[8]; u32x4 pw0, pw1, pw2, pw3; s16x4 vlo[4], vhi[4];
    f32x16 zero16 = (f32x16){}; AT_PIN(zero16);
    int sl_prev = 0, sl_cur = 0, sl_next = 1;
#define ROT() do { sl_prev = sl_cur; sl_cur = sl_next; sl_next = (sl_next == 2) ? 0 : sl_next + 1; } while (0)
#define KLD(i, kp_) kf[i] = *(const LAS bf16x8*)((kp_) + ((i) >> 1) * 2048 + ((i) & 1) * 512)
#define PKW(Pv, i) cvt_pk_bf16(Pv[i], Pv[(i) + 1])
#define PAF(k) __builtin_bit_cast(bf16x8, pw##k)
#define VRD(i, vp_) do { vlo[(i) & 3] = vtr((vp_) + ((i) & 3) * 4096 + ((i) >> 2) * 1024); vhi[(i) & 3] = vtr((vp_) + ((i) & 3) * 4096 + ((i) >> 2) * 1024 + 512); } while (0)
#define VFR(i) (bf16x8){vlo[(i) & 3][0], vlo[(i) & 3][1], vlo[(i) & 3][2], vlo[(i) & 3][3], vhi[(i) & 3][0], vhi[(i) & 3][1], vhi[(i) & 3][2], vhi[(i) & 3][3]}
#define EX2(Cv, i) do { Cv[i] = __builtin_amdgcn_exp2f(Cv[i]); Cv[(i) + 1] = __builtin_amdgcn_exp2f(Cv[(i) + 1]); } while (0)
#define GAPA(MF, a0, a1, a2, a3, W0, W1, PW_) do { MF; sacc += a0; sacc += a1; sacc += a2; sacc += a3; W0; W1; AT_PIN(PW_); AT_PIN(sacc); AT_SBAR(); } while (0)
#define GAPB(i, PA_, Cx, ci, GL) do { o[(i) & 3] = MFMA32(PA_, VFR(i), o[(i) & 3]); EX2(Cx, ci); AT_PIN(Cx); \
        if ((i) + 2 < 16) VRD((i) + 2, vpp_); if ((GL) && (i) < 8) KLD(i, kpn_); AT_SBAR(); } while (0)
#define STEP(C0, C1, P0, P1, t, GL) do { AT_SBAR(); \
    const LAS unsigned char* vpp_ = vp0 + sl_prev * AT_SLOTV; const LAS unsigned char* kpn_ = kp0 + sl_next * AT_SLOTK; \
    float sacc = P0[0] + P0[1]; \
    GAPA(C0 = MFMA32(kf[0], qr[0], zero16), P0[2], P0[3], P0[4], P0[5],     pw0[0] = PKW(P0, 0),  pw0[1] = PKW(P0, 2),  pw0); \
    GAPA(C1 = MFMA32(kf[1], qr[0], zero16), P0[6], P0[7], P0[8], P0[9],     pw0[2] = PKW(P0, 4),  pw0[3] = PKW(P0, 6),  pw0); \
    GAPA(C0 = MFMA32(kf[2], qr[1], C0),     P0[10], P0[11], P0[12], P0[13], pw1[0] = PKW(P0, 8),  pw1[1] = PKW(P0, 10), pw1); \
    GAPA(C1 = MFMA32(kf[3], qr[1], C1),     P0[14], P0[15], P1[0], P1[1],   pw1[2] = PKW(P0, 12), pw1[3] = PKW(P0, 14), pw1); \
    GAPA(C0 = MFMA32(kf[4], qr[2], C0),     P1[2], P1[3], P1[4], P1[5],     pw2[0] = PKW(P1, 0),  pw2[1] = PKW(P1, 2),  pw2); \
    GAPA(C1 = MFMA32(kf[5], qr[2], C1),     P1[6], P1[7], P1[8], P1[9],     pw2[2] = PKW(P1, 4),  pw2[3] = PKW(P1, 6),  pw2); \
    VRD(0, vpp_); \
    GAPA(C0 = MFMA32(kf[6], qr[3], C0),     P1[10], P1[11], P1[12], P1[13], pw3[0] = PKW(P1, 8),  pw3[1] = PKW(P1, 10), pw3); \
    VRD(1, vpp_); \
    GAPA(C1 = MFMA32(kf[7], qr[3], C1),     P1[14], P1[15], 0.f, 0.f,       pw3[2] = PKW(P1, 12), pw3[3] = PKW(P1, 14), pw3); \
    l_reg += sacc; \
    DMA_K((t) + 3, sl_cur); DMA_V((t) + 1, sl_next); AT_SBAR(); \
    GAPB(0, PAF(0), C0, 0, GL);  GAPB(1, PAF(0), C0, 2, GL);  GAPB(2, PAF(0), C0, 4, GL);  GAPB(3, PAF(0), C0, 6, GL); \
    GAPB(4, PAF(1), C0, 8, GL);  GAPB(5, PAF(1), C0, 10, GL); GAPB(6, PAF(1), C0, 12, GL); GAPB(7, PAF(1), C0, 14, GL); \
    GAPB(8, PAF(2), C1, 0, GL);  GAPB(9, PAF(2), C1, 2, GL);  GAPB(10, PAF(2), C1, 4, GL); GAPB(11, PAF(2), C1, 6, GL); \
    GAPB(12, PAF(3), C1, 8, GL); GAPB(13, PAF(3), C1, 10, GL); GAPB(14, PAF(3), C1, 12, GL); GAPB(15, PAF(3), C1, 14, GL); \
    } while (0)
#define ENDW(tt) do { if ((tt) + 3 < ntile) { AT_WAIT_BAR(3); } else { AT_WAIT_BAR(0); } } while (0)
    AT_WAIT_BAR(0);
#pragma unroll
    for (int i = 0; i < 8; ++i) KLD(i, kp0);
    pA0 = MFMA32(kf[0], qr[0], zero16); pA1 = MFMA32(kf[1], qr[0], zero16); pA0 = MFMA32(kf[2], qr[1], pA0); pA1 = MFMA32(kf[3], qr[1], pA1);
    pA0 = MFMA32(kf[4], qr[2], pA0); pA1 = MFMA32(kf[5], qr[2], pA1); pA0 = MFMA32(kf[6], qr[3], pA0); pA1 = MFMA32(kf[7], qr[3], pA1);
#pragma unroll
    for (int r = 0; r < 16; ++r) { pA0[r] = __builtin_amdgcn_exp2f(pA0[r]); pA1[r] = __builtin_amdgcn_exp2f(pA1[r]); }
    AT_WAIT_BAR(0);
    DMA_K(3, 0); DMA_V(1, 1); ROT();
#pragma unroll
    for (int i = 0; i < 8; ++i) KLD(i, kp0 + sl_cur * AT_SLOTK);
    if (ntile > 3) { AT_WAIT_BAR(3); } else { AT_WAIT_BAR(0); }
    int t = 1;
    for (; t + 1 < ntile; t += 2) {
        STEP(pB0, pB1, pA0, pA1, t, true);     ENDW(t);     ROT();
        STEP(pA0, pA1, pB0, pB1, t + 1, (t + 2 < ntile)); ENDW(t + 1); ROT();
    }
    if (t < ntile) { STEP(pB0, pB1, pA0, pA1, t, false); ENDW(t); ROT();
#pragma unroll
        for (int r = 0; r < 16; ++r) { pA0[r] = pB0[r]; pA1[r] = pB1[r]; } }
    { float sacc = 0.f;
#pragma unroll
      for (int r = 0; r < 16; ++r) sacc += pA0[r] + pA1[r];
      l_reg += sacc;
      pw0 = (u32x4){PKW(pA0, 0), PKW(pA0, 2), PKW(pA0, 4), PKW(pA0, 6)}; pw1 = (u32x4){PKW(pA0, 8), PKW(pA0, 10), PKW(pA0, 12), PKW(pA0, 14)};
      pw2 = (u32x4){PKW(pA1, 0), PKW(pA1, 2), PKW(pA1, 4), PKW(pA1, 6)}; pw3 = (u32x4){PKW(pA1, 8), PKW(pA1, 10), PKW(pA1, 12), PKW(pA1, 14)};
      const LAS unsigned char* vpp_ = vp0 + sl_prev * AT_SLOTV;
#pragma unroll
      for (int i = 0; i < 16; ++i) { VRD(i, vpp_); const bf16x8 pa = (i >> 2) == 0 ? PAF(0) : (i >> 2) == 1 ? PAF(1) : (i >> 2) == 2 ? PAF(2) : PAF(3); o[i & 3] = MFMA32(pa, VFR(i), o[i & 3]); } }
    l_reg += __shfl_xor(l_reg, 32);
    if (hi == 0) wsf[r32] = l_reg;
    LDS_WAIT();
    float* OA = (float*)(p->ws + WS_OA) + (size_t)sub * NTOK * 512 + h * 128 + r32;
#pragma unroll
    for (int r = 0; r < 16; ++r) { const float rl = 1.f / wsf[crow(r, hi)]; float* orow = OA + (size_t)(qrow0 + wave * 32 + crow(r, hi)) * 512;
#pragma unroll
        for (int dg = 0; dg < 4; ++dg) orow[32 * dg] = o[dg][r] * rl; }
    AT_WAIT_BAR(0);
#undef DMA_K
#undef DMA_V
#undef ROT
#undef KLD
#undef PKW
#undef PAF
#undef VRD
#undef VFR
#undef EX2
#undef GAPA
#undef GAPB
#undef STEP
#undef ENDW
}
__device__ __forceinline__ void phase_attention(PP p, int layer, LAS unsigned char* lds) {
    int bid = blockIdx.x; asm volatile("" : "+s"(bid));
    if (bid < 16) gdn_scan_chain(p, lds, bid);
    const int nlat = NB * 4 * 2 * 64, nunits = nlat + (layer == 0 ? NB * 4 * 2 : 0);
    unsigned* ctr = (unsigned*)(p->ws + WS_CTL) + CW_ATTQ + layer * 64;
    volatile LAS unsigned* slot = (volatile LAS unsigned*)(lds + MISC_OFF) + 16;
    for (;;) {
        if (threadIdx.x == 0) *slot = __hip_atomic_fetch_add(ctr, 1u, __ATOMIC_RELAXED, __HIP_MEMORY_SCOPE_AGENT);
        __syncthreads();
        const int u = (int)__builtin_amdgcn_readfirstlane((int)*slot);
        if (u >= nunits) break;
        if (u < nlat) { const int b = u >> 9, h = (u >> 7) & 3, sub = (u >> 6) & 1, qb = u & 63; attn_unit(p, layer, lds, b, h, sub, b * SEQL + qb * 256, 260, 4); }
        else { const int v = u - nlat, b = v >> 3, h = (v >> 1) & 3, sub = v & 1; attn_unit(p, layer, lds, b, h, sub, NLAT + b * CTXL, 4, 4); }
    }
}

__device__ __forceinline__ void phase_norm_router(PP p, int layer, LAS unsigned char* lds) {
    int tid = threadIdx.x, bid = blockIdx.x, gdim = gridDim.x; asm volatile("" : "+v"(tid), "+s"(bid), "+s"(gdim)); const int lane = tid & 63, wave = __builtin_amdgcn_readfirstlane(tid >> 6);
    const int T = layer == 0 ? NTOK : NLAT;
    LAS float* rw = (LAS float*)lds;
    LAS int* lcnt = (LAS int*)(lds + 131072);
    LAS int* lbase = lcnt + 32;
    LAS int* ent = lcnt + 64;
    const float* rwg = p->in[I_RW] + (size_t)layer * D * NEXP;
    for (int i = tid; i < NEXP * 1024; i += NTHR) { const int k = i >> 5, e = i & 31; rw[e * 1024 + k] = rwg[(size_t)k * NEXP + e]; }
    if (tid < 64) lcnt[tid] = 0;
    __syncthreads();
    const float* cf = (const float*)(p->ws + WS_CONST);
    const float* gn = p->in[I_NFFNG] + layer * D;
    const float rb = lane < NEXP ? p->in[I_RB][layer * NEXP + lane] : 0.f;
    const int rpw = (T + gdim - 1) / gdim;
    const int r0 = bid * rpw, r1 = (r0 + rpw < T) ? r0 + rpw : T;
    int* tope = (int*)(p->ws + WS_RT + RT_TOPE); float* gate = (float*)(p->ws + WS_RT + RT_GATE); int* rank = (int*)(p->ws + WS_RT + RT_RANK);
    const float* H = (const float*)(p->ws + WS_H);
    for (int r = r0 + wave; r < r1; r += NWAVES) {
        const float* mv = cf + CF_MODV + (layer * 3 + mod_sel(r)) * 6144;
        f32x4 u[4]; norm_mod_row(H + (size_t)r * D, gn, mv + 3 * 1024, mv + 4 * 1024, lane, u);
        store_row_bf16((bf16_t*)(p->ws + WS_U) + (size_t)r * D, lane, u);
        float logit = -INFINITY;
#pragma unroll 4
        for (int e = 0; e < NEXP; ++e) { float s = 0.f;
#pragma unroll
            for (int q = 0; q < 4; ++q) { const f32x4 w = *(const LAS f32x4*)(rw + e * 1024 + 4 * lane + 256 * q); s += (u[q][0] * w[0] + u[q][1] * w[1]) + (u[q][2] * w[2] + u[q][3] * w[3]); }
            s = wave_sum(s); if (lane == e) logit = s + rb; }
        float tl[4]; int te[4];
#pragma unroll
        for (int k = 0; k < 4; ++k) { const float m = wave_max(logit); const unsigned long long bal = __ballot(logit == m); const int idx = __ffsll((long long)bal) - 1;
            tl[k] = m; te[k] = idx; if (lane == idx) logit = -INFINITY; }
        const float e1 = __expf(tl[1] - tl[0]), e2 = __expf(tl[2] - tl[0]), e3 = __expf(tl[3] - tl[0]); const float inv = 1.f / (1.f + e1 + e2 + e3);
        if (lane < 4) { const int e = lane == 0 ? te[0] : lane == 1 ? te[1] : lane == 2 ? te[2] : te[3]; const float gv = (lane == 0 ? 1.f : lane == 1 ? e1 : lane == 2 ? e2 : e3) * inv;
            const int lr = atomicAdd((int*)&lcnt[e], 1);
            ent[(r - r0) * 4 + lane] = (e << 20) | lr; tope[(size_t)r * 4 + lane] = e; gate[(size_t)r * 4 + lane] = gv; }
    }
    __syncthreads();
    if (tid < NEXP) lbase[tid] = (int)atomicAdd((unsigned*)(p->ws + WS_CTL) + CW_CNT + layer * 64 + tid, (unsigned)lcnt[tid]);
    __syncthreads();
    for (int i = tid; i < (r1 - r0) * 4; i += NTHR) { const int v = ent[i]; rank[(size_t)r0 * 4 + i] = lbase[v >> 20] + (v & 0xfffff); }
}

__device__ __forceinline__ void phase_moe_gather(PP p, int layer, LAS unsigned char* lds) {
    int tid = threadIdx.x, bid = blockIdx.x, gdim = gridDim.x; asm volatile("" : "+v"(tid), "+s"(bid), "+s"(gdim)); const int lane = tid & 63, wave = __builtin_amdgcn_readfirstlane(tid >> 6);
    const int T = layer == 0 ? NTOK : NLAT;
    LAS int* pstart = (LAS int*)lds; LAS int* cnt = pstart + 64;
    const unsigned* gcnt = (const unsigned*)(p->ws + WS_CTL) + CW_CNT + layer * 64;
    int* mt = (int*)(p->ws + WS_CONST) + CF_MOE + layer * 1024;
    if (tid == 0) { int acc = 0; for (int e = 0; e < NEXP; ++e) { const int c = (int)__hip_atomic_load(gcnt + e, __ATOMIC_RELAXED, __HIP_MEMORY_SCOPE_AGENT); cnt[e] = c; pstart[e] = acc; acc += (c + 255) & ~255; } pstart[NEXP] = acc; }
    __syncthreads();
    if (bid == 0) {
        if (tid < NEXP) { mt[tid] = pstart[tid]; mt[64 + tid] = cnt[tid]; }
        if (tid == 0) mt[32] = pstart[NEXP] >> 8;
        for (int e = 0; e < NEXP; ++e) { const int b0 = pstart[e] >> 8, b1 = pstart[e + 1] >> 8; for (int bb = b0 + tid; bb < b1; bb += NTHR) mt[128 + bb] = e; }
    }
    const int* tope = (const int*)(p->ws + WS_RT + RT_TOPE); const float* gate = (const float*)(p->ws + WS_RT + RT_GATE); const int* rank = (const int*)(p->ws + WS_RT + RT_RANK);
    int* slot = (int*)(p->ws + WS_RT + RT_SLOT); float* sgate = (float*)(p->ws + WS_RT + RT_SGATE);
    const bf16_t* V = (const bf16_t*)(p->ws + WS_U); bf16_t* XS = (bf16_t*)(p->ws + WS_XS);
    const int gw = bid * NWAVES + wave, NGW = gdim * NWAVES;
    for (int a = gw; a < T * 4; a += NGW) {
        const int r = a >> 2; const int e = tope[a]; const int s = pstart[e] + rank[a];
        if (lane == 0) { slot[a] = s; sgate[s] = gate[a]; }
        const u32x4* src = (const u32x4*)(V + (size_t)r * D); u32x4* dst = (u32x4*)(XS + (size_t)s * D);
        dst[lane] = src[lane]; dst[64 + lane] = src[64 + lane];
    }
    for (int e = 0; e < NEXP; ++e) { const int s0 = pstart[e] + cnt[e], s1 = pstart[e + 1];
        for (int s = s0 + gw; s < s1; s += NGW) { u32x4* dst = (u32x4*)(XS + (size_t)s * D); dst[lane] = (u32x4){0u, 0u, 0u, 0u}; dst[64 + lane] = (u32x4){0u, 0u, 0u, 0u}; if (lane == 0) sgate[s] = 0.f; } }
}

__device__ __forceinline__ void phase_moe_combine(PP p, int layer) {
    int tid = threadIdx.x, bid = blockIdx.x, gdim = gridDim.x; asm volatile("" : "+v"(tid), "+s"(bid), "+s"(gdim)); const int lane = tid & 63, wave = __builtin_amdgcn_readfirstlane(tid >> 6);
    const int T = layer == 0 ? NTOK : NLAT;
    const float* cf = (const float*)(p->ws + WS_CONST); const int* slot = (const int*)(p->ws + WS_RT + RT_SLOT); const bf16_t* Y = (const bf16_t*)(p->ws + WS_Y);
    float* H = (float*)(p->ws + WS_H);
    for (int r = bid * NWAVES + wave; r < T; r += gdim * NWAVES) {
        const float* g5 = cf + CF_MODV + (layer * 3 + mod_sel(r)) * 6144 + 5 * 1024;
        float* ho = layer == 0 ? H + (size_t)r * D : p->out + (size_t)r * D; const float* hi_ = H + (size_t)r * D;
        const int s0 = slot[r * 4], s1 = slot[r * 4 + 1], s2 = slot[r * 4 + 2], s3 = slot[r * 4 + 3];
#pragma unroll
        for (int j = 0; j < 4; ++j) { const int c = 4 * lane + 256 * j;
            const u32x2 a = *(const u32x2*)(Y + (size_t)s0 * D + c), b2 = *(const u32x2*)(Y + (size_t)s1 * D + c), c2 = *(const u32x2*)(Y + (size_t)s2 * D + c), d2 = *(const u32x2*)(Y + (size_t)s3 * D + c);
            f32x4 y; y[0] = (bflo(a.x) + bflo(b2.x)) + (bflo(c2.x) + bflo(d2.x)); y[1] = (bfhi(a.x) + bfhi(b2.x)) + (bfhi(c2.x) + bfhi(d2.x));
            y[2] = (bflo(a.y) + bflo(b2.y)) + (bflo(c2.y) + bflo(d2.y)); y[3] = (bfhi(a.y) + bfhi(b2.y)) + (bfhi(c2.y) + bfhi(d2.y));
            const f32x4 hv = *(const f32x4*)(hi_ + c), gv = *(const f32x4*)(g5 + c);
            *(f32x4*)(ho + c) = hv + gv * y; }
    }
}

constexpr int NPH = 27;
#ifndef PH_MASK
#define PH_MASK 0xFFFF
#endif
#define IN(k) (lo <= (k) && (k) < hi)
#define EN(i) ((PH_MASK >> (i)) & 1)
#ifndef DUP_PH
#define DUP_PH -1
#endif
#define REP(i) for (int rep_ = 0; rep_ < ((DUP_PH == (i) && l == 0) ? 2 : 1); ++rep_)
#define SEAM(k) do { if (IN(k) && IN((k) + 1)) xcd_barrier(bar); } while (0)
#define LAUNDER() PP p = p0; LAS unsigned char* lds = lds0; int bid = blockIdx.x, gdim = gridDim.x; asm volatile("" : "+s"(p), "+s"(lds), "+s"(bid), "+s"(gdim))
template <int l> __device__ __forceinline__ void run_layer(PP p0, LAS unsigned char* lds0, const int lo, const int hi, const XcdBarrier& bar) {
        const int base = 1 + 13 * l;
        if (EN(1) && IN(base + 0)) REP(1) { LAUNDER(); phase_norm_mix(p, l, lds); __syncthreads(); }
        SEAM(base + 0);
        if (EN(2) && IN(base + 1)) REP(2) { LAUNDER();
            PlainSched S; S.init(p->ws + WS_U, p->ws + WS_WIN + (size_t)l * PW * 1024 * 2, 1024, NTOK / 256, PW / 256, gdim, bid);
            EpiStoreBf16 E{(bf16_t*)(p->ws + WS_P), PW};
            pg8::gemm_phase<EpiStoreBf16, PlainSched>(lds, 1024, S, E);
        }
        SEAM(base + 1);
        if (EN(3) && IN(base + 2)) REP(3) { LAUNDER(); phase_prep(p, l); }
        SEAM(base + 2);
        if (EN(5) && IN(base + 3)) REP(5) { LAUNDER(); phase_gdn_chunk(p, lds); }
        SEAM(base + 3);
        if (EN(4) && IN(base + 4)) { LAUNDER(); phase_attention(p, l, lds); }
        SEAM(base + 4);
        if (EN(7) && IN(base + 6)) REP(7) { LAUNDER(); phase_gdn_out(p, l); }
        SEAM(base + 6);
        if (EN(8) && IN(base + 7)) REP(8) { LAUNDER();
            const int T = l == 0 ? NTOK : NLAT;
            const float* cf = (const float*)(p->ws + WS_CONST);
            PlainSched S; S.init(p->ws + WS_MIX, p->ws + WS_WOUT + (size_t)l * D * 1024 * 2, 1024, T / 256, D / 256, gdim, bid);
            EpiResidual E{p, l, cf + CF_MODV + (l * 3) * 6144 + 2 * 1024};
            pg8::gemm_phase<EpiResidual, PlainSched>(lds, 1024, S, E);
        }
        SEAM(base + 7);
        if (EN(9) && IN(base + 8)) REP(9) { LAUNDER(); phase_norm_router(p, l, lds); __syncthreads(); }
        SEAM(base + 8);
        if (EN(10) && IN(base + 9)) REP(10) { LAUNDER(); phase_moe_gather(p, l, lds); __syncthreads(); }
        SEAM(base + 9);
        if (EN(11) && IN(base + 10)) REP(11) { LAUNDER();
            const int* mt = (const int*)(p->ws + WS_CONST) + CF_MOE + l * 1024;
            MoeSched S{(const char*)(p->ws + WS_XS), (const char*)(p->ws + WS_WGU + (size_t)l * NEXP * 2048 * 1024 * 2), mt + 128, mt[32], 8, gdim, bid};
            EpiGateUp E{(bf16_t*)(p->ws + WS_ACT), p->in[I_BGU] + (size_t)l * NEXP * 2048, mt + 128};
            pg8::gemm_phase<EpiGateUp, MoeSched>(lds, 1024, S, E);
        }
        SEAM(base + 10);
        if (EN(12) && IN(base + 11)) REP(12) { LAUNDER();
            const int* mt = (const int*)(p->ws + WS_CONST) + CF_MOE + l * 1024;
            MoeSched S{(const char*)(p->ws + WS_ACT), (const char*)(p->ws + WS_WD + (size_t)l * NEXP * 1024 * 1024 * 2), mt + 128, mt[32], 4, gdim, bid};
            EpiDown E{(bf16_t*)(p->ws + WS_Y), p->in[I_BD] + (size_t)l * NEXP * 1024, mt + 128, (const float*)(p->ws + WS_RT + RT_SGATE)};
            pg8::gemm_phase<EpiDown, MoeSched>(lds, 1024, S, E);
        }
        SEAM(base + 11);
        if (EN(13) && IN(base + 12)) REP(13) { LAUNDER(); phase_moe_combine(p, l); }
        SEAM(base + 12);
    }

__global__ void __launch_bounds__(NTHR, 2) mega_fwd(Params p_by_value) {
    extern __shared__ __attribute__((aligned(16))) unsigned char lds_raw[];
    LAS unsigned char* lds0 = (LAS unsigned char*)lds_raw;
    PP p0 = (PP)__builtin_amdgcn_kernarg_segment_ptr();
    volatile LAS unsigned* MISC = (volatile LAS unsigned*)(lds0 + MISC_OFF);
    if (threadIdx.x < 64) MISC[threadIdx.x] = 0u;
    __syncthreads();
    const int lo = p0->ph_lo, hi = p0->ph_hi;
    XcdBarrier bar; bar.bar = (unsigned*)(p0->ws + WS_CTL) + CW_BAR; bar.x = 0; bar.st = nullptr;
    if (hi - lo > 1) bar = xcd_barrier_post((unsigned*)(p0->ws + WS_CTL) + CW_BAR, MISC + 8);
    if (EN(0) && IN(0)) for (int rep_ = 0; rep_ < (DUP_PH == 0 ? 2 : 1); ++rep_) { LAUNDER(); phase_prologue(p, lds); __syncthreads(); }
    SEAM(0);
    run_layer<0>(p0, lds0, lo, hi, bar);
    run_layer<1>(p0, lds0, lo, hi, bar);
#undef IN
#undef SEAM
}

extern "C" void kernel_launch(void* const* d_in, const int* in_sizes, int n_in, void* d_out, int out_size, void* d_ws, size_t ws_size, hipStream_t stream) {
    static int grid = 0;
    if (grid == 0) {
        if (n_in != 27 || out_size != NLAT * D || ws_size < WS_END) { fprintf(stderr, "kernel_launch: unexpected problem (n_in %d, out %d, ws %zu < %zu)\n", n_in, out_size, ws_size, (size_t)WS_END); grid = -1; return; }
        int dev = 0, cus = 0, per_cu = 0;
        if (hipGetDevice(&dev) != hipSuccess || hipDeviceGetAttribute(&cus, hipDeviceAttributeMultiprocessorCount, dev) != hipSuccess) { grid = -1; return; }
        if (hipFuncSetAttribute((const void*)mega_fwd, hipFuncAttributeMaxDynamicSharedMemorySize, LDS_BYTES) != hipSuccess) { fprintf(stderr, "kernel_launch: hipFuncSetAttribute failed\n"); grid = -1; return; }
        if (hipOccupancyMaxActiveBlocksPerMultiprocessor(&per_cu, (const void*)mega_fwd, NTHR, LDS_BYTES) != hipSuccess || per_cu < 1) { fprintf(stderr, "kernel_launch: occupancy query says %d\n", per_cu); }
        (void)hipGetLastError();
        grid = cus;
    }
    if (grid < 0) return;
    hipMemsetAsync((char*)d_ws + WS_CTL, 0, CTL_ZERO_BYTES, stream);
    Params p{};
    for (int i = 0; i < 27; ++i) p.in[i] = (const float*)d_in[i];
    p.out = (float*)d_out; p.ws = (unsigned char*)d_ws;
#if MK_PER_PHASE
    for (int ph = 0; ph < NPH; ++ph) { p.ph_lo = ph; p.ph_hi = ph + 1; hipLaunchKernelGGL(mega_fwd, dim3(grid), dim3(NTHR), LDS_BYTES, stream, p); }
#else
    p.ph_lo = 0; p.ph_hi = NPH;
    hipLaunchKernelGGL(mega_fwd, dim3(grid), dim3(NTHR), LDS_BYTES, stream, p);
#endif
}
```

```cpp
#include <hip/hip_runtime.h>
#include <cstdio>
#include <cstdint>

#ifndef MK_PER_PHASE
#define MK_PER_PHASE 0
#endif

#define LAS __attribute__((address_space(3)))
#define GAS __attribute__((address_space(1)))
typedef unsigned short bf16_t;
typedef short bf16x8 __attribute__((ext_vector_type(8)));
typedef short s16x4 __attribute__((ext_vector_type(4)));
typedef float f32x2 __attribute__((ext_vector_type(2)));
typedef float f32x4 __attribute__((ext_vector_type(4)));
typedef float f32x16 __attribute__((ext_vector_type(16)));
typedef unsigned u32x2 __attribute__((ext_vector_type(2)));
typedef unsigned u32x4 __attribute__((ext_vector_type(4)));

constexpr int D = 1024, NB = 2, SEQL = 16384, CTXL = 256;
constexpr int NLAT = NB * SEQL, NCTX = NB * CTXL, NTOK = NLAT + NCTX;
constexpr int PW = 3584, INC = 3600;
constexpr int NEXP = 32, MAXBLK = 552, MAXSLOT = MAXBLK * 256;
constexpr int NCHUNK = 260, NTASK = 16 * NCHUNK;
constexpr float EPS = 1e-6f;
constexpr float LOG2E = 1.4426950408889634f;
constexpr int NWAVES = 8, NTHR = 512;

constexpr size_t MiB = 1u << 20;
constexpr size_t WS_CTL = 0, CTL_ZERO_BYTES = 1 * MiB;
constexpr size_t WS_CONST = 1 * MiB;
constexpr size_t WS_WIN = 2 * MiB;
constexpr size_t WS_WOUT = 16 * MiB;
constexpr size_t WS_WGU = 20 * MiB;
constexpr size_t WS_WD = 276 * MiB;
constexpr size_t WS_H = 404 * MiB;
constexpr size_t WS_U = 534 * MiB;
constexpr size_t WS_GB = 599 * MiB;
constexpr size_t WS_MIX = 602 * MiB;
constexpr size_t WS_RT = 667 * MiB;
constexpr size_t WS_BIG = 671 * MiB;
constexpr size_t WS_P = WS_BIG;
constexpr size_t WS_G = WS_P + 228 * MiB;
constexpr size_t WS_CH = WS_G + 98 * MiB;
constexpr size_t WS_OG = WS_CH + 358 * MiB;
constexpr size_t WS_OA = WS_OG + 130 * MiB;
constexpr size_t WS_END = WS_OA + 130 * MiB;
constexpr size_t WS_XS = WS_BIG;
constexpr size_t WS_ACT = WS_BIG + 276 * MiB;
constexpr size_t WS_Y = WS_XS;
static_assert(WS_ACT + 276 * MiB <= WS_END, "moe overlay");
constexpr size_t CH_TASK_BYTES = 90112;
constexpr int CH_WF = 0, CH_QF = 16384, CH_AF = 32768, CH_KF = 40960, CH_UC = 57344, CH_DMA_BYTES = 57344;
static_assert((size_t)NTASK * CH_TASK_BYTES <= 358 * MiB, "chunk buffers");

constexpr int CW_BAR = 4096;
constexpr int CW_CNT = 16384;
constexpr int CW_ATTQ = 20480;
constexpr int CF_MODV = 0;
constexpr int CF_ROPE = 40960;
constexpr int CF_SC = 53248;
constexpr int CF_EGL = 53504;
constexpr int CF_MOE = 61440;
constexpr size_t RT_TOPE = 0, RT_GATE = 640 * 1024, RT_RANK = 1280 * 1024, RT_SLOT = 1920 * 1024, RT_SGATE = 2560 * 1024;

constexpr int LDS_BYTES = 147456;
constexpr int MISC_OFF = 143 * 1024;
static_assert(MISC_OFF + 256 <= LDS_BYTES, "lds");

__device__ __forceinline__ unsigned f2bf(float f) { unsigned u = __builtin_bit_cast(unsigned, f); return (u + 0x7fffu + ((u >> 16) & 1u)) >> 16; }
__device__ __forceinline__ unsigned pk2(float lo, float hi) { return f2bf(lo) | (f2bf(hi) << 16); }
__device__ __forceinline__ float bf2f(unsigned short b) { return __builtin_bit_cast(float, (unsigned)b << 16); }
__device__ __forceinline__ float bflo(unsigned w) { return __builtin_bit_cast(float, w << 16); }
__device__ __forceinline__ float bfhi(unsigned w) { return __builtin_bit_cast(float, w & 0xffff0000u); }
__device__ __forceinline__ unsigned cvt_pk_bf16(float lo, float hi) { unsigned r; asm volatile("v_cvt_pk_bf16_f32 %0, %1, %2" : "=v"(r) : "v"(lo), "v"(hi)); return r; }
__device__ __forceinline__ float wave_sum(float v) {
#pragma unroll
    for (int o = 1; o < 64; o <<= 1) v += __shfl_xor(v, o);
    return v;
}
__device__ __forceinline__ float wave_max(float v) {
#pragma unroll
    for (int o = 1; o < 64; o <<= 1) v = fmaxf(v, __shfl_xor(v, o));
    return v;
}
__device__ __forceinline__ float silu_f(float x) { return x / (1.f + __expf(-x)); }
__device__ __forceinline__ int crow(int r, int hi) { return (r & 3) + 8 * (r >> 2) + 4 * hi; }
__device__ __forceinline__ void glds16(const void* g, unsigned lds_base) {
    unsigned sv; asm volatile("s_mov_b32 %0, m0\n\ts_mov_b32 m0, %2\n\ts_nop 0\n\tglobal_load_lds_dwordx4 %1, off\n\ts_mov_b32 m0, %0" : "=&s"(sv) : "v"(g), "s"((unsigned)__builtin_amdgcn_readfirstlane((int)lds_base)) : "memory"); }
__device__ __forceinline__ unsigned lds_addr(const LAS void* q) { return (unsigned)__builtin_amdgcn_readfirstlane((int)(unsigned)(uintptr_t)q); }
#define LDS_WAIT() asm volatile("s_waitcnt lgkmcnt(0)" ::: "memory")
#define VM_WAIT() asm volatile("s_waitcnt vmcnt(0)" ::: "memory")
#define MFMA32(a, b, c) __builtin_amdgcn_mfma_f32_32x32x16_bf16(a, b, c, 0, 0, 0)

namespace pg8 {
constexpr int BM = 256, BK = 64, HALF = 128, HTB = HALF * BK * 2, STAGE_BYTES = 8 * HTB;
__host__ __device__ __forceinline__ int lds_byte(int r, int c) { const int st = (r >> 4) * 2 + (c >> 5), rr = r & 15, cc = c & 31, ob = rr * 64 + cc * 2; return st * 1024 + (ob ^ (((ob >> 9) & 1) << 5)); }
__host__ __device__ __forceinline__ void stage_rc(int b, int& R, int& C) { const int st = b / 1024, sb = b % 1024, swz = sb ^ (((sb >> 9) & 1) << 5); R = (st >> 1) * 16 + swz / 64; C = (st & 1) * 32 + (swz % 64) / 2; }
__host__ __device__ __forceinline__ int perm32(int rho) { const int n = rho >> 4, i = rho & 15; return 8 * (i >> 2) + 4 * n + (i & 3); }
struct Unit { int pm, pn; };
template <class Epi, class Sched>
__device__ __forceinline__ void gemm_phase(LAS unsigned char* lds, const int K, const Sched& S, const Epi& E) {
    int tid = threadIdx.x, bid = blockIdx.x, gdim = gridDim.x; asm volatile("" : "+v"(tid), "+s"(bid), "+s"(gdim)); const int wid = __builtin_amdgcn_readfirstlane(tid >> 6), lane = tid & 63, wr = wid >> 2, wc = wid & 3, fr = lane & 15, fq = lane >> 4;
    const int nt = K / BK;
    unsigned voffA[2], voffB[2];
#pragma unroll
    for (int i = 0; i < 2; ++i) { int R, C; stage_rc(tid * 16 + i * 8192, R, C); const int Rb = Epi::PERM ? ((R & ~31) + perm32(R & 31)) : R;
        voffA[i] = (unsigned)(R * K + C) * 2u; voffB[i] = (unsigned)(Rb * K + C) * 2u; }
    const size_t kstep = (size_t)(BK * 2);
    const size_t hstep = (size_t)HALF * K * 2;
    const unsigned ldsw = (unsigned)wid * 1024u;
    const int aoff = lds_byte(wr * 64 + fr, fq * 8), boff = lds_byte(wc * 32 + fr, fq * 8);
#define PG8_SA(b, h) (((b) * 2 + (h)) * HTB)
#define PG8_SB(b, h) ((4 + (b) * 2 + (h)) * HTB)
#define PG8_STAGE(bufoff, gbase, voff) do { _Pragma("unroll") for (int _i = 0; _i < 2; ++_i) \
        __builtin_amdgcn_global_load_lds((const unsigned*)((const char*)(gbase) + (voff)[_i]), (LAS unsigned*)(lds + (bufoff) + ldsw + _i * 8192), 16, 0, 0); } while (0)
#define PG8_LDA(dst, b, h) do { _Pragma("unroll") for (int m = 0; m < 4; ++m) _Pragma("unroll") for (int k = 0; k < 2; ++k) dst[m][k] = *(const LAS bf16x8*)(lds + PG8_SA(b, h) + aoff + m * 2048 + k * 1024); } while (0)
#define PG8_LDB(dst, b, h) do { _Pragma("unroll") for (int n = 0; n < 2; ++n) _Pragma("unroll") for (int k = 0; k < 2; ++k) dst[n][k] = *(const LAS bf16x8*)(lds + PG8_SB(b, h) + boff + n * 2048 + k * 1024); } while (0)
#define PG8_MMA(ai, bj, At, Bt) do { __builtin_amdgcn_s_setprio(1); _Pragma("unroll") for (int m = 0; m < 4; ++m) _Pragma("unroll") for (int n = 0; n < 2; ++n) _Pragma("unroll") for (int k = 0; k < 2; ++k) \
        acc[ai][bj][m][n] = __builtin_amdgcn_mfma_f32_16x16x32_bf16(Bt[n][k], At[m][k], acc[ai][bj][m][n], 0, 0, 0); __builtin_amdgcn_s_setprio(0); } while (0)
#define PG8_WAIT_V(n) asm volatile("s_waitcnt vmcnt(" #n ")" ::: "memory")
#define PG8_WAIT_L(n) asm volatile("s_waitcnt lgkmcnt(" #n ")" ::: "memory")
#define PG8_BAR __builtin_amdgcn_s_barrier()
#define PG8_SCHED __builtin_amdgcn_sched_barrier(0)
    Unit cur, nxt; int ui = 0;
    if (!S.next(0, cur)) return;
    f32x4 acc[2][2][4][2];
#pragma unroll
    for (int a = 0; a < 2; ++a)
#pragma unroll
        for (int b = 0; b < 2; ++b)
#pragma unroll
            for (int m = 0; m < 4; ++m)
#pragma unroll
                for (int n = 0; n < 2; ++n) acc[a][b][m][n] = (f32x4){0.f, 0.f, 0.f, 0.f};
    bf16x8 At[4][2], B0[2][2], B1[2][2];
    const char* cA = S.aptr(cur); const char* cB = S.bptr(cur);
    PG8_STAGE(PG8_SB(0, 0), cB, voffB); PG8_STAGE(PG8_SA(0, 0), cA, voffA); PG8_STAGE(PG8_SB(0, 1), cB + hstep, voffB); PG8_STAGE(PG8_SA(0, 1), cA + hstep, voffA);
    if (wr == 1) PG8_BAR;
    PG8_WAIT_V(4); PG8_BAR;
    PG8_STAGE(PG8_SB(1, 0), cB + kstep, voffB); PG8_STAGE(PG8_SA(1, 0), cA + kstep, voffA); PG8_STAGE(PG8_SB(1, 1), cB + hstep + kstep, voffB);
    PG8_WAIT_V(6); PG8_BAR;
    for (;;) {
        const bool has_next = S.next(ui + 1, nxt);
        const char* nA = has_next ? S.aptr(nxt) : cA; const char* nB = has_next ? S.bptr(nxt) : cB;
        for (int t = 0; t < nt; t += 2) {
            const bool last = (t == nt - 2);
            const char* a1 = cA + (size_t)(t + 1) * kstep;
            const char* a2 = last ? nA : cA + (size_t)(t + 2) * kstep; const char* b2 = last ? nB : cB + (size_t)(t + 2) * kstep;
            const char* a3 = a2 + kstep; const char* b3 = b2 + kstep;
            PG8_LDB(B0, 0, 0); PG8_SCHED; PG8_LDA(At, 0, 0); PG8_STAGE(PG8_SA(1, 1), a1 + hstep, voffA);
            PG8_WAIT_L(8); PG8_BAR; PG8_WAIT_L(0); PG8_MMA(0, 0, At, B0); PG8_BAR; PG8_SCHED;
            PG8_LDB(B1, 0, 1); PG8_STAGE(PG8_SB(0, 0), b2, voffB);
            PG8_BAR; PG8_WAIT_L(0); PG8_MMA(0, 1, At, B1); PG8_BAR;
            PG8_LDA(At, 0, 1); PG8_STAGE(PG8_SA(0, 0), a2, voffA);
            PG8_BAR; PG8_WAIT_L(0); PG8_MMA(1, 0, At, B0); PG8_BAR; PG8_SCHED;
            PG8_STAGE(PG8_SB(0, 1), b2 + hstep, voffB);
            PG8_WAIT_V(6); PG8_BAR; PG8_MMA(1, 1, At, B1); PG8_BAR;
            PG8_LDB(B0, 1, 0); PG8_SCHED; PG8_LDA(At, 1, 0); PG8_STAGE(PG8_SA(0, 1), a2 + hstep, voffA);
            PG8_WAIT_L(8); PG8_BAR; PG8_WAIT_L(0); PG8_MMA(0, 0, At, B0); PG8_BAR; PG8_SCHED;
            PG8_LDB(B1, 1, 1); PG8_STAGE(PG8_SB(1, 0), b3, voffB);
            PG8_BAR; PG8_WAIT_L(0); PG8_MMA(0, 1, At, B1); PG8_BAR;
            PG8_LDA(At, 1, 1); PG8_STAGE(PG8_SA(1, 0), a3, voffA);
            PG8_BAR; PG8_WAIT_L(0); PG8_MMA(1, 0, At, B0); PG8_BAR; PG8_SCHED;
            PG8_STAGE(PG8_SB(1, 1), b3 + hstep, voffB);
            PG8_WAIT_V(6); PG8_BAR; PG8_MMA(1, 1, At, B1); PG8_BAR;
        }
        E(acc, cur, wr, wc, fr, fq);
        if (!has_next) break;
#pragma unroll
        for (int a = 0; a < 2; ++a)
#pragma unroll
            for (int b = 0; b < 2; ++b)
#pragma unroll
                for (int m = 0; m < 4; ++m)
#pragma unroll
                    for (int n = 0; n < 2; ++n) acc[a][b][m][n] = (f32x4){0.f, 0.f, 0.f, 0.f};
        cur = nxt; cA = nA; cB = nB; ++ui;
    }
    PG8_WAIT_V(0);
    if (wr == 0) PG8_BAR;
    PG8_BAR;
#undef PG8_SA
#undef PG8_SB
#undef PG8_STAGE
#undef PG8_LDA
#undef PG8_LDB
#undef PG8_MMA
#undef PG8_WAIT_V
#undef PG8_WAIT_L
#undef PG8_BAR
#undef PG8_SCHED
}
}

#define XB_TMO      128
#define XB_XCNT(j)  (256  + 64 * (j))
#define XB_XSUB(j)  (1280 + 64 * (j))
#define XB_XGEN(j)  (2304 + 64 * (j))
#define XB_TOP      3328
#define XB_TOPGEN   3392
#define XCD_BAR_WORDS 3456
#define XB_SPIN_CAP (1u << 20)
__device__ __forceinline__ unsigned xb_ld(unsigned* p)              { return __hip_atomic_load(p, __ATOMIC_RELAXED, __HIP_MEMORY_SCOPE_AGENT); }
__device__ __forceinline__ unsigned xb_add(unsigned* p, unsigned v) { return __hip_atomic_fetch_add(p, v, __ATOMIC_RELAXED, __HIP_MEMORY_SCOPE_AGENT); }
__device__ __forceinline__ unsigned xb_xcc_id() { return (unsigned)__builtin_amdgcn_s_getreg((3 << 11) | 20) & 0xFu; }
#define XB_SPIN(cond, bar) do { unsigned _sp = 0; while (cond) { __builtin_amdgcn_s_sleep(1); \
    if ((++_sp & 255u) == 0u) { if (xb_ld(&(bar)[XB_TMO])) break; if (_sp > XB_SPIN_CAP) { atomicAdd(&(bar)[XB_TMO], 1u); break; } } } } while (0)
struct XcdBarrier { unsigned* bar; unsigned x; volatile LAS unsigned* st; };
__device__ __forceinline__ XcdBarrier xcd_barrier_post(unsigned* bar, volatile LAS unsigned* st) {
    XcdBarrier b; b.bar = bar; b.x = xb_xcc_id(); b.st = st;
    if (threadIdx.x == 0) (void)xb_add(&bar[XB_XCNT(b.x)], 1u);
    return b;
}
__device__ __forceinline__ void xcd_barrier_complete(unsigned* bar, unsigned x, unsigned& nloc, unsigned& nx) {
    const unsigned G = gridDim.x * gridDim.y * gridDim.z;
    unsigned sum, cnt, mine, sp = 0u;
    for (;;) {
        sum = 0u; cnt = 0u; mine = 0u;
#pragma unroll
        for (unsigned j = 0; j < 16; ++j) { const unsigned c = xb_ld(&bar[XB_XCNT(j)]); sum += c; cnt += (c > 0u) ? 1u : 0u; mine = (j == x) ? c : mine; }
        if (sum == G) break;
        __builtin_amdgcn_s_sleep(1);
        if ((++sp & 255u) == 0u) { if (xb_ld(&bar[XB_TMO])) break; if (sp > XB_SPIN_CAP) { atomicAdd(&bar[XB_TMO], 1u); break; } }
    }
    nloc = mine > 0u ? mine : 1u; nx = cnt > 0u ? cnt : 1u;
}
__device__ __forceinline__ void xcd_barrier(const XcdBarrier& b) {
    asm volatile("s_waitcnt vmcnt(0)" ::: "memory");
    __syncthreads();
    if (threadIdx.x == 0) {
        unsigned* bar = b.bar;
        __builtin_amdgcn_s_waitcnt(0);
        unsigned nloc = b.st[0], nx = b.st[1];
        if (nloc == 0u) { xcd_barrier_complete(bar, b.x, nloc, nx); b.st[0] = nloc; b.st[1] = nx; }
        const unsigned old = xb_add(&bar[XB_XSUB(b.x)], 1u);
        const unsigned gen = old / nloc;
        if (old + 1u == (gen + 1u) * nloc) {
            __builtin_amdgcn_fence(__ATOMIC_RELEASE, "agent");
            asm volatile("s_waitcnt vmcnt(0)" ::: "memory");
            const unsigned og = xb_add(&bar[XB_TOP], 1u);
            const unsigned tg = og / nx;
            if (og + 1u == (tg + 1u) * nx) xb_add(&bar[XB_TOPGEN], 1u);
            else XB_SPIN(xb_ld(&bar[XB_TOPGEN]) == tg, bar);
            __builtin_amdgcn_fence(__ATOMIC_ACQUIRE, "agent");
            xb_add(&bar[XB_XGEN(b.x)], 1u);
            asm volatile("s_waitcnt vmcnt(0)" ::: "memory");
        } else {
            XB_SPIN(xb_ld(&bar[XB_XGEN(b.x)]) == gen, bar);
            __builtin_amdgcn_fence(__ATOMIC_ACQUIRE, "agent");
            asm volatile("s_waitcnt vmcnt(0)" ::: "memory");
        }
    }
    __syncthreads();
}

struct Params {
    const float* in[27];
    float* out;
    unsigned char* ws;
    int ph_lo, ph_hi;
};
typedef const __attribute__((address_space(4))) Params* PP;
enum { I_X = 0, I_C, I_CTX, I_CCTX, I_WMOD, I_BMOD, I_NMIXG, I_WIN, I_QNG, I_KNG, I_LQ1, I_LK1, I_LQ2, I_LK2, I_SUBLN, I_CONVW, I_ALOG, I_DTB, I_GDNG, I_WOUT, I_NFFNG, I_RW, I_RB, I_WGU, I_BGU, I_WD, I_BD };

__device__ __forceinline__ const float* hrow_in(PP p, int layer, int r) {
    if (layer == 0) return r < NLAT ? p->in[I_X] + (size_t)r * D : p->in[I_CTX] + (size_t)(r - NLAT) * D;
    return (const float*)(p->ws + WS_H) + (size_t)r * D;
}
__device__ __forceinline__ int mod_sel(int r) { return r < NLAT ? (r >= SEQL ? 1 : 0) : 2; }

__device__ __forceinline__ void transpose_item(const float* W, size_t ldw, int k0, int n0, bf16_t* WT, int drow0, LAS float* scr, int lane) {
#pragma unroll 8
    for (int i = 0; i < 32; ++i) { const int kk = 2 * i + (lane >> 5); scr[kk * 33 + (lane & 31)] = W[(size_t)(k0 + kk) * ldw + n0 + (lane & 31)]; }
    LDS_WAIT(); asm volatile("" ::: "memory");
    const int c = lane & 7;
#pragma unroll
    for (int j = 0; j < 4; ++j) { const int n = (lane >> 3) + 8 * j; const LAS float* s = scr + (8 * c) * 33 + n;
        u32x4 o; o.x = pk2(s[0 * 33], s[1 * 33]); o.y = pk2(s[2 * 33], s[3 * 33]); o.z = pk2(s[4 * 33], s[5 * 33]); o.w = pk2(s[6 * 33], s[7 * 33]);
        *(u32x4*)(WT + (size_t)(drow0 + n) * 1024 + k0 + 8 * c) = o; }
    LDS_WAIT(); asm volatile("" ::: "memory");
}

__device__ __forceinline__ void phase_prologue(PP p, LAS unsigned char* lds) {
    int tid = threadIdx.x, bid = blockIdx.x, gdim = gridDim.x; asm volatile("" : "+v"(tid), "+s"(bid), "+s"(gdim)); const int lane = tid & 63, wave = __builtin_amdgcn_readfirstlane(tid >> 6);
    float* cf = (float*)(p->ws + WS_CONST);
    if (bid < 192) {
        const int l = bid / 96, cg = bid % 96;
        LAS float* sl = (LAS float*)lds;
        LAS float* red = sl + 3 * 1024;
        for (int i = tid; i < 3 * 1024; i += NTHR) { const int s = i >> 10, k = i & 1023; const float v = s < 2 ? p->in[I_C][s * D + k] : p->in[I_CCTX][k]; sl[i] = silu_f(v); }
        __syncthreads();
        const float* wm = p->in[I_WMOD] + (size_t)l * D * 6144 + cg * 64 + lane;
        float a0 = 0.f, a1 = 0.f, a2 = 0.f;
#pragma unroll 16
        for (int kk = 0; kk < 128; ++kk) { const int k = wave * 128 + kk; const float w = wm[(size_t)k * 6144]; a0 += sl[k] * w; a1 += sl[1024 + k] * w; a2 += sl[2048 + k] * w; }
        red[(wave * 3 + 0) * 64 + lane] = a0; red[(wave * 3 + 1) * 64 + lane] = a1; red[(wave * 3 + 2) * 64 + lane] = a2;
        __syncthreads();
        if (wave < 3) { float s = 0.f;
#pragma unroll
            for (int w = 0; w < 8; ++w) s += red[(w * 3 + wave) * 64 + lane];
            cf[CF_MODV + (l * 3 + wave) * 6144 + cg * 64 + lane] = s + p->in[I_BMOD][l * 6144 + cg * 64 + lane]; }
        __syncthreads();
    }
    if (bid >= 192 && bid < 202) {
        const int idx = (bid - 192) * NTHR + tid;
        if (idx < 320 * 16) { const int pos = idx >> 4, i = idx & 15; const float invf = powf(10000.f, -(float)i / 16.f);
            const float posf = (float)(pos < 256 ? pos : pos - 256); const float ang = posf * invf; const double a = (double)ang;
            const float cs = (float)cos(a), sn = (float)sin(a);
            if (pos < 256) { cf[CF_ROPE + pos * 16 + i] = cs; cf[CF_ROPE + 4096 + pos * 16 + i] = sn; }
            else { cf[CF_ROPE + 8192 + (pos - 256) * 16 + i] = cs; cf[CF_ROPE + 9216 + (pos - 256) * 16 + i] = sn; } }
    }
    if (bid == 202 && wave < 2) {
        const int l = wave;
        const float d1 = wave_sum(p->in[I_LQ1][l * 64 + lane] * p->in[I_LK1][l * 64 + lane]);
        const float d2 = wave_sum(p->in[I_LQ2][l * 64 + lane] * p->in[I_LK2][l * 64 + lane]);
        const float lam_init = 0.8f - 0.6f * expf(-0.3f * (float)l);
        const float mq = wave_max(fabsf(p->in[I_QNG][l * 64 + lane])), mk = wave_max(fabsf(p->in[I_KNG][l * 64 + lane]));
        if (lane == 0) { cf[CF_SC + l * 16 + 0] = expf(d1) - expf(d2) + lam_init; cf[CF_SC + l * 16 + 1] = LOG2E * 0.125f * 64.f * mq * mk * 1.0001f + 0.01f; cf[CF_SC + l * 16 + 2] = 1.f - lam_init; }
    }
    {
        LAS float* scr = (LAS float*)(lds + wave * 16384);
        const int gw = bid * NWAVES + wave, NGW = gdim * NWAVES;
        constexpr int I_IN = 16 * 112, I_OUT = 16 * 32, I_GU = 16 * 64, I_DN = 16 * 32;
        constexpr int PER_LAYER = I_IN + I_OUT + NEXP * I_GU + NEXP * I_DN;
        for (int it = gw; it < 2 * PER_LAYER; it += NGW) {
            const int l = it / PER_LAYER; int r = it % PER_LAYER;
            if (r < I_IN) { const int kb = r / 112, nb = r % 112;
                transpose_item(p->in[I_WIN] + (size_t)l * D * INC, INC, kb * 64, nb * 32, (bf16_t*)(p->ws + WS_WIN) + (size_t)l * PW * 1024, nb * 32, scr, lane); continue; }
            r -= I_IN;
            if (r < I_OUT) { const int kb = r / 32, nb = r % 32;
                transpose_item(p->in[I_WOUT] + (size_t)l * D * D, D, kb * 64, nb * 32, (bf16_t*)(p->ws + WS_WOUT) + (size_t)l * D * 1024, nb * 32, scr, lane); continue; }
            r -= I_OUT;
            if (r < NEXP * I_GU) { const int e = r / I_GU, q = r % I_GU, kb = q / 64, nb = q % 64; const int n0 = nb * 32, j = n0 & 1023, isup = n0 >> 10;
                const int drow = (j >> 7) * 256 + isup * 128 + (j & 127);
                transpose_item(p->in[I_WGU] + (size_t)(l * NEXP + e) * D * 2048, 2048, kb * 64, n0, (bf16_t*)(p->ws + WS_WGU) + (size_t)(l * NEXP + e) * 2048 * 1024, drow, scr, lane); continue; }
            r -= NEXP * I_GU;
            { const int e = r / I_DN, q = r % I_DN, kb = q / 32, nb = q % 32;
                transpose_item(p->in[I_WD] + (size_t)(l * NEXP + e) * D * D, D, kb * 64, nb * 32, (bf16_t*)(p->ws + WS_WD) + (size_t)(l * NEXP + e) * D * 1024, nb * 32, scr, lane); }
        }
    }
}

struct PlainSched {
    const char* A; const char* Bt; int K, nM, nN, nwg, G, c;
    __device__ __forceinline__ void init(const void* A_, const void* Bt_, int K_, int nM_, int nN_, int G_, int c_) { A = (const char*)A_; Bt = (const char*)Bt_; K = K_; nM = nM_; nN = nN_; nwg = nM * nN; G = G_; c = c_; }
    __device__ __forceinline__ bool next(int i, pg8::Unit& u) const {
        const long L = (long)i * G + c; if (L >= nwg) return false;
        int wgid = (int)L; { const int q = nwg / 8, r = nwg % 8, xcd = wgid % 8, off = wgid / 8; wgid = (xcd < r ? xcd * (q + 1) : r * (q + 1) + (xcd - r) * q) + off; }
        const int nig = 8 * nN, gid = wgid / nig, fm = gid * 8, gsz = (nM - fm) < 8 ? (nM - fm) : 8;
        u.pm = fm + ((wgid % nig) % gsz); u.pn = (wgid % nig) / gsz; return true;
    }
    __device__ __forceinline__ const char* aptr(const pg8::Unit& u) const { return A + (size_t)u.pm * 256 * K * 2; }
    __device__ __forceinline__ const char* bptr(const pg8::Unit& u) const { return Bt + (size_t)u.pn * 256 * K * 2; }
};
struct MoeSched {
    const char* A; const char* W; const int* blk_e; int nblk, nN, G, c;
    __device__ __forceinline__ bool next(int i, pg8::Unit& u) const {
        const int x = c & 7, w = c >> 3, nw = G >> 3;
        const int b0 = (int)(((long)nblk * x) >> 3), b1 = (int)(((long)nblk * (x + 1)) >> 3);
        const int j = i * nw + w, pm = b0 + j / nN; if (pm >= b1) return false;
        u.pm = pm; u.pn = j % nN; return true;
    }
    __device__ __forceinline__ const char* aptr(const pg8::Unit& u) const { return A + (size_t)u.pm * 256 * 1024 * 2; }
    __device__ __forceinline__ const char* bptr(const pg8::Unit& u) const { const int e = blk_e[u.pm]; return W + ((size_t)e * nN + u.pn) * 256 * 1024 * 2; }
};
struct EpiStoreBf16 {
    static constexpr bool PERM = true;
    bf16_t* O; int ldc;
    __device__ __forceinline__ void operator()(const f32x4 (&acc)[2][2][4][2], const pg8::Unit& u, int wr, int wc, int fr, int fq) const {
        const int row0 = u.pm * 256 + wr * 64 + fr, col0 = u.pn * 256 + wc * 32 + 8 * fq;
#pragma unroll
        for (int ai = 0; ai < 2; ++ai)
#pragma unroll
            for (int m = 0; m < 4; ++m) { bf16_t* rowp = O + (size_t)(row0 + ai * 128 + m * 16) * ldc + col0;
#pragma unroll
                for (int bj = 0; bj < 2; ++bj) { const f32x4 v0 = acc[ai][bj][m][0], v1 = acc[ai][bj][m][1];
                    u32x4 w; w.x = cvt_pk_bf16(v0[0], v0[1]); w.y = cvt_pk_bf16(v0[2], v0[3]); w.z = cvt_pk_bf16(v1[0], v1[1]); w.w = cvt_pk_bf16(v1[2], v1[3]);
                    *(u32x4*)(rowp + bj * 128) = w; } }
    }
};
struct EpiResidual {
    static constexpr bool PERM = false;
    PP p; int layer; const float* gate;
    __device__ __forceinline__ void operator()(const f32x4 (&acc)[2][2][4][2], const pg8::Unit& u, int wr, int wc, int fr, int fq) const {
        const int row0 = u.pm * 256 + wr * 64 + fr, col0 = u.pn * 256 + wc * 32 + 4 * fq;
        float* H = (float*)(p->ws + WS_H);
#pragma unroll
        for (int ai = 0; ai < 2; ++ai)
#pragma unroll
            for (int m = 0; m < 4; ++m) { const int row = row0 + ai * 128 + m * 16; const float* hin = hrow_in(p, layer, row) + col0; const float* g = gate + mod_sel(row) * 6144 + col0;
                float* ho = H + (size_t)row * D + col0;
#pragma unroll
                for (int bj = 0; bj < 2; ++bj)
#pragma unroll
                    for (int n = 0; n < 2; ++n) { const f32x4 hv = *(const f32x4*)(hin + bj * 128 + n * 16), gv = *(const f32x4*)(g + bj * 128 + n * 16);
                        *(f32x4*)(ho + bj * 128 + n * 16) = hv + gv * acc[ai][bj][m][n]; } }
    }
};
struct EpiGateUp {
    static constexpr bool PERM = true;
    bf16_t* ACT; const float* bgu; const int* blk_e;
    __device__ __forceinline__ void operator()(const f32x4 (&acc)[2][2][4][2], const pg8::Unit& u, int wr, int wc, int fr, int fq) const {
        const int row0 = u.pm * 256 + wr * 64 + fr, col0 = u.pn * 128 + wc * 32 + 8 * fq; const int e = blk_e[u.pm];
        const float* bg = bgu + (size_t)e * 2048 + col0; const float* bu = bg + 1024;
        f32x4 bgv[2], buv[2];
#pragma unroll
        for (int n = 0; n < 2; ++n) { bgv[n] = *(const f32x4*)(bg + 4 * n); buv[n] = *(const f32x4*)(bu + 4 * n); }
#pragma unroll
        for (int ai = 0; ai < 2; ++ai)
#pragma unroll
            for (int m = 0; m < 4; ++m) { float o[8];
#pragma unroll
                for (int n = 0; n < 2; ++n)
#pragma unroll
                    for (int j = 0; j < 4; ++j) { float g = acc[ai][0][m][n][j] + bgv[n][j], up = acc[ai][1][m][n][j] + buv[n][j];
                        g = fminf(g, 7.f); up = fminf(fmaxf(up, -7.f), 7.f);
                        const float glu = g * __builtin_amdgcn_rcpf(1.f + __builtin_amdgcn_exp2f(-1.702f * LOG2E * g)); o[n * 4 + j] = (up + 1.f) * glu; }
                u32x4 w; w.x = cvt_pk_bf16(o[0], o[1]); w.y = cvt_pk_bf16(o[2], o[3]); w.z = cvt_pk_bf16(o[4], o[5]); w.w = cvt_pk_bf16(o[6], o[7]);
                *(u32x4*)(ACT + (size_t)(row0 + ai * 128 + m * 16) * 1024 + col0) = w; }
    }
};
struct EpiDown {
    static constexpr bool PERM = true;
    bf16_t* Y; const float* bd; const int* blk_e; const float* sgate;
    __device__ __forceinline__ void operator()(const f32x4 (&acc)[2][2][4][2], const pg8::Unit& u, int wr, int wc, int fr, int fq) const {
        const int row0 = u.pm * 256 + wr * 64 + fr, col0 = u.pn * 256 + wc * 32 + 8 * fq; const int e = blk_e[u.pm];
        const float* b = bd + (size_t)e * 1024 + col0;
        f32x4 bv[2][2];
#pragma unroll
        for (int bj = 0; bj < 2; ++bj)
#pragma unroll
            for (int n = 0; n < 2; ++n) bv[bj][n] = *(const f32x4*)(b + bj * 128 + 4 * n);
#pragma unroll
        for (int ai = 0; ai < 2; ++ai)
#pragma unroll
            for (int m = 0; m < 4; ++m) { const int row = row0 + ai * 128 + m * 16; const float sg = sgate[row]; bf16_t* rowp = Y + (size_t)row * 1024 + col0;
#pragma unroll
                for (int bj = 0; bj < 2; ++bj) { const f32x4 v0 = (acc[ai][bj][m][0] + bv[bj][0]) * sg, v1 = (acc[ai][bj][m][1] + bv[bj][1]) * sg;
                    u32x4 w; w.x = cvt_pk_bf16(v0[0], v0[1]); w.y = cvt_pk_bf16(v0[2], v0[3]); w.z = cvt_pk_bf16(v1[0], v1[1]); w.w = cvt_pk_bf16(v1[2], v1[3]);
                    *(u32x4*)(rowp + bj * 128) = w; } }
    }
};

__device__ __forceinline__ void norm_mod_row(const float* hrow, const float* g, const float* shift, const float* scale, int lane, f32x4 (&u)[4]) {
    float ss = 0.f;
#pragma unroll
    for (int j = 0; j < 4; ++j) { u[j] = *(const f32x4*)(hrow + 4 * lane + 256 * j); ss += (u[j][0] * u[j][0] + u[j][1] * u[j][1]) + (u[j][2] * u[j][2] + u[j][3] * u[j][3]); }
    const float rstd = rsqrtf(wave_sum(ss) * (1.f / D) + EPS);
#pragma unroll
    for (int j = 0; j < 4; ++j) { const int c = 4 * lane + 256 * j; const f32x4 gv = *(const f32x4*)(g + c), sh = *(const f32x4*)(shift + c), sc = *(const f32x4*)(scale + c);
        u[j] = (u[j] * rstd) * gv * (sc + 1.f) + sh; }
}
__device__ __forceinline__ void store_row_bf16(bf16_t* orow, int lane, const f32x4 (&u)[4]) {
#pragma unroll
    for (int j = 0; j < 4; ++j) { u32x2 w; w.x = cvt_pk_bf16(u[j][0], u[j][1]); w.y = cvt_pk_bf16(u[j][2], u[j][3]); *(u32x2*)(orow + 4 * lane + 256 * j) = w; }
}

__device__ __forceinline__ void phase_norm_mix(PP p, int layer, LAS unsigned char* lds) {
    int tid = threadIdx.x, bid = blockIdx.x, gdim = gridDim.x; asm volatile("" : "+v"(tid), "+s"(bid), "+s"(gdim)); const int lane = tid & 63, wave = __builtin_amdgcn_readfirstlane(tid >> 6);
    LAS float* wab = (LAS float*)lds;
    const float* win = p->in[I_WIN] + (size_t)layer * D * INC;
    for (int i = tid; i < 16 * 1024; i += NTHR) { const int k = i >> 4, j = i & 15; wab[j * 1024 + k] = win[(size_t)k * INC + PW + j]; }
    __syncthreads();
    const float* cf = (const float*)(p->ws + WS_CONST);
    const float* gn = p->in[I_NMIXG] + layer * D;
    float ea = 0.f, dtb = 0.f; if (lane < 8) { ea = -__expf(p->in[I_ALOG][layer * 8 + lane]); dtb = p->in[I_DTB][layer * 8 + lane]; }
    for (int r = bid * NWAVES + wave; r < NTOK; r += gdim * NWAVES) {
        const float* mv = cf + CF_MODV + (layer * 3 + mod_sel(r)) * 6144;
        f32x4 u[4]; norm_mod_row(hrow_in(p, layer, r), gn, mv, mv + 1024, lane, u);
        store_row_bf16((bf16_t*)(p->ws + WS_U) + (size_t)r * D, lane, u);
        float ab = 0.f;
#pragma unroll
        for (int j = 0; j < 16; ++j) { float s = 0.f;
#pragma unroll
            for (int q = 0; q < 4; ++q) { const f32x4 w = *(const LAS f32x4*)(wab + j * 1024 + 4 * lane + 256 * q); s += (u[q][0] * w[0] + u[q][1] * w[1]) + (u[q][2] * w[2] + u[q][3] * w[3]); }
            s = wave_sum(s); if (lane == j) ab = s; }
        float outv;
        if (lane < 8) { const float z = ab + dtb; const float sp = z > 20.f ? z : log1pf(__expf(z)); outv = ea * sp; }
        else outv = 1.f / (1.f + __expf(-ab));
        if (lane < 16) ((float*)(p->ws + WS_GB))[(size_t)r * 16 + lane] = outv;
    }
}

__device__ __forceinline__ void phase_prep(PP p, int layer) {
    int tid = threadIdx.x, bid = blockIdx.x, gdim = gridDim.x; asm volatile("" : "+v"(tid), "+s"(bid), "+s"(gdim)); const int lane = tid & 63, wave = __builtin_amdgcn_readfirstlane(tid >> 6);
    const float* cf = (const float*)(p->ws + WS_CONST);
    bf16_t* P = (bf16_t*)(p->ws + WS_P); bf16_t* G = (bf16_t*)(p->ws + WS_G);
    const float* cw = p->in[I_CONVW] + (size_t)layer * 5 * 1536;
    float gain[16];
    { const float* gsrc = (lane < 32 ? p->in[I_QNG] : p->in[I_KNG]) + layer * 64 + 16 * (lane & 3);
#pragma unroll
      for (int e = 0; e < 16; ++e) gain[e] = gsrc[e]; }
    const float qscale = lane < 32 ? 0.125f * LOG2E : 1.f;
    for (int r = bid * NWAVES + wave; r < NTOK; r += gdim * NWAVES) {
        bf16_t* prow = P + (size_t)r * PW + 16 * lane;
        const u32x4 w0 = *(const u32x4*)prow, w1 = *(const u32x4*)(prow + 8);
        float x[16];
#pragma unroll
        for (int e = 0; e < 4; ++e) { x[2 * e] = bflo(w0[e]); x[2 * e + 1] = bfhi(w0[e]); x[8 + 2 * e] = bflo(w1[e]); x[8 + 2 * e + 1] = bfhi(w1[e]); }
        float ss = 0.f;
#pragma unroll
        for (int e = 0; e < 16; ++e) ss += x[e] * x[e];
        ss += __shfl_xor(ss, 1); ss += __shfl_xor(ss, 2);
        const float rstd = rsqrtf(ss * (1.f / 64.f) + EPS);
#pragma unroll
        for (int e = 0; e < 16; ++e) x[e] = x[e] * rstd * gain[e];
        if (r < NLAT) {
            const int t = r & (SEQL - 1); const int pos = (lane & 2) ? (t & 63) : (t >> 6);
            const float* ct = cf + CF_ROPE + ((lane & 2) ? 8192 : 0) + pos * 16; const float* st = ct + ((lane & 2) ? 1024 : 4096);
            const bool second = lane & 1;
#pragma unroll
            for (int e = 0; e < 16; ++e) { const float other = __shfl_xor(x[e], 1); const float cs = ct[e], sn = st[e];
                x[e] = second ? (x[e] * cs + other * sn) : (x[e] * cs - other * sn); }
        }
        u32x4 o0, o1;
#pragma unroll
        for (int e = 0; e < 4; ++e) { o0[e] = cvt_pk_bf16(x[2 * e] * qscale, x[2 * e + 1] * qscale); o1[e] = cvt_pk_bf16(x[8 + 2 * e] * qscale, x[8 + 2 * e + 1] * qscale); }
        *(u32x4*)prow = o0; *(u32x4*)(prow + 8) = o1;
    }
    for (int r = bid * NWAVES + wave; r < NTOK; r += gdim * NWAVES) {
        int seg0, seglen; if (r < NLAT) { seg0 = r & ~(SEQL - 1); seglen = SEQL; } else { seg0 = NLAT + ((r - NLAT) & ~(CTXL - 1)); seglen = CTXL; }
        const int tpos = r - seg0;
#pragma unroll
        for (int grp = 0; grp < 3; ++grp) {
            const int c0 = grp * 512 + 8 * lane;
            float a[8];
#pragma unroll
            for (int e = 0; e < 8; ++e) a[e] = 0.f;
#pragma unroll
            for (int j = 0; j < 5; ++j) { const int tp = tpos + j - 2;
                if (tp >= 0 && tp < seglen) { const u32x4 w = *(const u32x4*)(P + (size_t)(seg0 + tp) * PW + 1536 + c0);
                    const f32x4 k0 = *(const f32x4*)(cw + j * 1536 + c0), k1 = *(const f32x4*)(cw + j * 1536 + c0 + 4);
                    a[0] += bflo(w[0]) * k0[0]; a[1] += bfhi(w[0]) * k0[1]; a[2] += bflo(w[1]) * k0[2]; a[3] += bfhi(w[1]) * k0[3];
                    a[4] += bflo(w[2]) * k1[0]; a[5] += bfhi(w[2]) * k1[1]; a[6] += bflo(w[3]) * k1[2]; a[7] += bfhi(w[3]) * k1[3]; } }
            float ss = 0.f;
#pragma unroll
            for (int e = 0; e < 8; ++e) { a[e] = silu_f(a[e]); ss += a[e] * a[e]; }
            if (grp < 2) { ss += __shfl_xor(ss, 1); ss += __shfl_xor(ss, 2); ss += __shfl_xor(ss, 4); ss += __shfl_xor(ss, 8);
                const float rn = rsqrtf(ss + EPS);
#pragma unroll
                for (int e = 0; e < 8; ++e) a[e] *= rn; }
            u32x4 o; o.x = cvt_pk_bf16(a[0], a[1]); o.y = cvt_pk_bf16(a[2], a[3]); o.z = cvt_pk_bf16(a[4], a[5]); o.w = cvt_pk_bf16(a[6], a[7]);
            *(u32x4*)(G + (size_t)r * 1536 + c0) = o;
        }
    }
}

typedef short v4i16c_t __attribute__((ext_vector_type(4)));
__device__ __forceinline__ s16x4 vtr_c(const LAS unsigned char* ptr) { return __builtin_bit_cast(s16x4, __builtin_amdgcn_ds_read_tr16_b64_v4i16((LAS v4i16c_t*)ptr)); }
__device__ __forceinline__ void gdn_task_rows(int task, int& b, int& h, int& dir, int& rstart, int& rstep) {
    const int chain = task / NCHUNK, n = task % NCHUNK; dir = chain & 1; h = (chain >> 1) & 3; b = chain >> 3;
    if (n < 4) { const int base = NLAT + b * CTXL; if (dir == 0) { rstart = base + 64 * n; rstep = 1; } else { rstart = base + CTXL - 1 - 64 * n; rstep = -1; } }
    else { const int base = b * SEQL, m = n - 4; if (dir == 0) { rstart = base + 64 * m; rstep = 1; } else { rstart = base + SEQL - 1 - 64 * m; rstep = -1; } }
}
constexpr int CWL_BYTES = 6144, CWL_STG = 2048;
__device__ __forceinline__ void phase_gdn_chunk(PP p, LAS unsigned char* lds) {
    int tid = threadIdx.x, bid = blockIdx.x, gdim = gridDim.x; asm volatile("" : "+v"(tid), "+s"(bid), "+s"(gdim)); const int lane = tid & 63, wave = __builtin_amdgcn_readfirstlane(tid >> 6), r32 = lane & 31, hi = lane >> 5;
    const bf16_t* G = (const bf16_t*)(p->ws + WS_G); const float* GB = (const float*)(p->ws + WS_GB);
    float* cf = (float*)(p->ws + WS_CONST);
    LAS unsigned char* wl = lds + wave * CWL_BYTES;
    LAS float* gcv = (LAS float*)wl;
    LAS unsigned char* stg = wl + CWL_STG;
    const LAS unsigned char* stgp = stg + ((lane >> 4) & 1) * 32 + (lane & 3) * 8 + (4 * hi + ((lane & 15) >> 2)) * 64;
    const LAS unsigned char* stgn = stg + ((lane >> 4) & 1) * 32 + (lane & 3) * 8 + (8 * hi + ((lane & 15) >> 2)) * 64;
    const float SCALE = 0.08838834764831845f;
    for (int task = bid * NWAVES + wave; task < NTASK; task += gdim * NWAVES) {
        int b, h, dir, rstart, rstep; gdn_task_rows(task, b, h, dir, rstart, rstep);
        unsigned char* chb = p->ws + WS_CH + (size_t)task * CH_TASK_BYTES;
        const int myrow = rstart + rstep * lane;
        float gt = GB[(size_t)myrow * 16 + dir * 4 + h]; const float bt = GB[(size_t)myrow * 16 + 8 + dir * 4 + h];
#pragma unroll
        for (int o = 1; o < 64; o <<= 1) { const float t = __shfl_up(gt, o); if (lane >= o) gt += t; }
        const float glast = __shfl(gt, 63), egt = __expf(gt), begt = bt * egt, kdt = __expf(glast - gt);
        gcv[lane] = gt; gcv[64 + lane] = bt;
        if (lane == 0) cf[CF_EGL + task] = __expf(glast);
        const float gcs0 = __shfl(gt, r32), gcs1 = __shfl(gt, 32 + r32);
        const size_t rowA0 = (size_t)(rstart + rstep * r32) * 1536, rowA1 = (size_t)(rstart + rstep * (32 + r32)) * 1536;
        bf16x8 kfr[2][8];
        { const bf16_t* gk = G + 512 + h * 128 + 8 * hi;
#pragma unroll
          for (int ks = 0; ks < 8; ++ks) { kfr[0][ks] = *(const bf16x8*)(gk + rowA0 + 16 * ks); kfr[1][ks] = *(const bf16x8*)(gk + rowA1 + 16 * ks); } }
        LDS_WAIT();
        f32x16 am00, am10, am11;
#define KK_TILE(dst, mi, ni, gcs_) do { f32x16 acc_ = (f32x16){}; \
            _Pragma("unroll") for (int ks = 0; ks < 8; ++ks) acc_ = MFMA32(kfr[mi][ks], kfr[ni][ks], acc_); \
            _Pragma("unroll") for (int q = 0; q < 4; ++q) { const f32x4 g4 = *(const LAS f32x4*)(gcv + 32 * (mi) + 8 * q + 4 * hi), b4 = *(const LAS f32x4*)(gcv + 64 + 32 * (mi) + 8 * q + 4 * hi); \
                _Pragma("unroll") for (int e = 0; e < 4; ++e) { const int cc = 32 * (mi) + 8 * q + 4 * hi + e, ss = 32 * (ni) + r32; \
                    dst[4 * q + e] = (ss < cc) ? -b4[e] * acc_[4 * q + e] * __expf(fminf(g4[e] - (gcs_), 0.f)) : 0.f; } } } while (0)
        KK_TILE(am00, 0, 0, gcs0); KK_TILE(am10, 1, 0, gcs0); KK_TILE(am11, 1, 1, gcs1);
        __builtin_amdgcn_sched_barrier(0);
        { bf16x8 qfr[8]; const bf16_t* gq = G + h * 128 + 8 * hi;
#define KQ_TILE(n, mo, gcc_) do { f32x16 acc_ = (f32x16){}; \
            _Pragma("unroll") for (int ks = 0; ks < 8; ++ks) acc_ = MFMA32(kfr[n][ks], qfr[ks], acc_); \
            _Pragma("unroll") for (int q = 0; q < 4; ++q) { const f32x4 g4 = *(const LAS f32x4*)(gcv + 32 * (n) + 8 * q + 4 * hi); \
                _Pragma("unroll") for (int e = 0; e < 4; ++e) { const int ss = 32 * (n) + 8 * q + 4 * hi + e, cc = 32 * (mo) + r32; \
                    acc_[4 * q + e] = (ss <= cc) ? SCALE * acc_[4 * q + e] * __expf(fminf((gcc_) - g4[e], 0.f)) : 0.f; } } \
            _Pragma("unroll") for (int s = 0; s < 2; ++s) { u32x4 o_; o_.x = cvt_pk_bf16(acc_[8 * s], acc_[8 * s + 1]); o_.y = cvt_pk_bf16(acc_[8 * s + 2], acc_[8 * s + 3]); o_.z = cvt_pk_bf16(acc_[8 * s + 4], acc_[8 * s + 5]); o_.w = cvt_pk_bf16(acc_[8 * s + 6], acc_[8 * s + 7]); \
                *(u32x4*)(chb + CH_AF + (((mo) * 2 + (n)) * 2 + s) * 1024 + lane * 16) = o_; } } while (0)
#pragma unroll
          for (int ks = 0; ks < 8; ++ks) qfr[ks] = *(const bf16x8*)(gq + rowA0 + 16 * ks);
          KQ_TILE(0, 0, gcs0); __builtin_amdgcn_sched_barrier(0);
#pragma unroll
          for (int ks = 0; ks < 8; ++ks) qfr[ks] = *(const bf16x8*)(gq + rowA1 + 16 * ks);
          KQ_TILE(0, 1, gcs1); KQ_TILE(1, 1, gcs1); }
        __builtin_amdgcn_sched_barrier(0);
        { const float eg0 = __shfl(egt, r32) * SCALE, eg1 = __shfl(egt, 32 + r32) * SCALE;
#pragma unroll
          for (int m = 0; m < 2; ++m) { const bf16_t* gq = G + (m ? rowA1 : rowA0) + h * 128 + 4 * hi; const float sc = m ? eg1 : eg0;
#pragma unroll
              for (int ts = 0; ts < 8; ++ts) { const u32x2 a = *(const u32x2*)(gq + 16 * ts), bq = *(const u32x2*)(gq + 16 * ts + 8); u32x4 o_;
                  o_.x = cvt_pk_bf16(bflo(a.x) * sc, bfhi(a.x) * sc); o_.y = cvt_pk_bf16(bflo(a.y) * sc, bfhi(a.y) * sc); o_.z = cvt_pk_bf16(bflo(bq.x) * sc, bfhi(bq.x) * sc); o_.w = cvt_pk_bf16(bflo(bq.y) * sc, bfhi(bq.y) * sc);
                  *(u32x4*)(chb + CH_QF + (m * 8 + ts) * 1024 + lane * 16) = o_; } } }
        __builtin_amdgcn_sched_barrier(0);
        float x[64]; int lane_v = lane; asm volatile("" : "+v"(lane_v));
#pragma unroll
        for (int i = 63; i >= 0; --i) { float a0 = (lane_v == i) ? 1.f : 0.f, a1 = 0.f;
#pragma unroll
            for (int m = 63; m > i; --m) { const int ml = m & 31, hm = (ml >> 2) & 1, rm = (ml >> 3) * 4 + (ml & 3), ln = (i & 31) + 32 * hm;
                const float tv = (m >= 32) ? ((i >= 32) ? am11[rm] : am10[rm]) : am00[rm];
                const float s_ = __builtin_bit_cast(float, __builtin_amdgcn_readlane(__builtin_bit_cast(int, tv), ln));
                if (m & 1) asm("v_fmac_f32 %0, %1, %2" : "+v"(a1) : "s"(s_), "v"(x[m])); else asm("v_fmac_f32 %0, %1, %2" : "+v"(a0) : "s"(s_), "v"(x[m])); }
            x[i] = a0 + a1; __builtin_amdgcn_sched_barrier(0); }
        __builtin_amdgcn_sched_barrier(0);
        bf16x8 F0[4], F1[4];
#pragma unroll
        for (int ks = 0; ks < 4; ++ks) { u32x4 f0, f1;
#pragma unroll
            for (int w = 0; w < 4; ++w) { const unsigned pa = cvt_pk_bf16(x[16 * ks + 2 * w], x[16 * ks + 2 * w + 1]), pb = cvt_pk_bf16(x[16 * ks + 8 + 2 * w], x[16 * ks + 8 + 2 * w + 1]);
                const auto sw = __builtin_amdgcn_permlane32_swap(pa, pb, false, false);
                f0[w] = sw[0]; f1[w] = sw[1]; }
            F0[ks] = __builtin_bit_cast(bf16x8, f0); F1[ks] = __builtin_bit_cast(bf16x8, f1); }
        __builtin_amdgcn_sched_barrier(0);
#define STAGE_PIECE(col0, scal) do { __builtin_amdgcn_sched_barrier(0); const bf16_t* src_ = G + (size_t)myrow * 1536 + (col0); LDS_WAIT(); \
            _Pragma("unroll") for (int q = 0; q < 4; ++q) { const u32x4 w_ = *(const u32x4*)(src_ + 8 * q); u32x4 o_; \
                o_.x = cvt_pk_bf16(bflo(w_.x) * (scal), bfhi(w_.x) * (scal)); o_.y = cvt_pk_bf16(bflo(w_.y) * (scal), bfhi(w_.y) * (scal)); o_.z = cvt_pk_bf16(bflo(w_.z) * (scal), bfhi(w_.z) * (scal)); o_.w = cvt_pk_bf16(bflo(w_.w) * (scal), bfhi(w_.w) * (scal)); \
                *(LAS u32x4*)(stg + lane * 64 + 16 * q) = o_; } LDS_WAIT(); } while (0)
#define TR_FRAG(ks) ({ const s16x4 lo_ = vtr_c(stgp + (ks) * 1024), hi_ = vtr_c(stgp + (ks) * 1024 + 512); (bf16x8){lo_[0], lo_[1], lo_[2], lo_[3], hi_[0], hi_[1], hi_[2], hi_[3]}; })
#define TR_NAT(ks) ({ const s16x4 lo_ = vtr_c(stgn + (ks) * 1024), hi_ = vtr_c(stgn + (ks) * 1024 + 256); (bf16x8){lo_[0], lo_[1], lo_[2], lo_[3], hi_[0], hi_[1], hi_[2], hi_[3]}; })
#pragma unroll
        for (int t = 0; t < 4; ++t) { STAGE_PIECE(512 + h * 128 + 32 * t, begt);
            f32x16 a0 = (f32x16){}, a1 = (f32x16){};
#pragma unroll
            for (int ks = 0; ks < 4; ++ks) { const bf16x8 fr = TR_NAT(ks); a0 = MFMA32(fr, F0[ks], a0); a1 = MFMA32(fr, F1[ks], a1); }
#pragma unroll
            for (int s = 0; s < 2; ++s) { u32x4 o0, o1;
                o0.x = cvt_pk_bf16(-a0[8 * s], -a0[8 * s + 1]); o0.y = cvt_pk_bf16(-a0[8 * s + 2], -a0[8 * s + 3]); o0.z = cvt_pk_bf16(-a0[8 * s + 4], -a0[8 * s + 5]); o0.w = cvt_pk_bf16(-a0[8 * s + 6], -a0[8 * s + 7]);
                o1.x = cvt_pk_bf16(-a1[8 * s], -a1[8 * s + 1]); o1.y = cvt_pk_bf16(-a1[8 * s + 2], -a1[8 * s + 3]); o1.z = cvt_pk_bf16(-a1[8 * s + 4], -a1[8 * s + 5]); o1.w = cvt_pk_bf16(-a1[8 * s + 6], -a1[8 * s + 7]);
                *(u32x4*)(chb + CH_WF + ((0 * 4 + t) * 2 + s) * 1024 + lane * 16) = o0; *(u32x4*)(chb + CH_WF + ((1 * 4 + t) * 2 + s) * 1024 + lane * 16) = o1; } }
#pragma unroll
        for (int nj = 0; nj < 4; ++nj) { STAGE_PIECE(1024 + h * 128 + 32 * nj, bt);
            f32x16 a0 = (f32x16){}, a1 = (f32x16){};
#pragma unroll
            for (int ks = 0; ks < 4; ++ks) { const bf16x8 fr = TR_NAT(ks); a0 = MFMA32(F0[ks], fr, a0); a1 = MFMA32(F1[ks], fr, a1); }
            float* uc = (float*)(chb + CH_UC) + ((nj * 2) * 64 + lane) * 16;
#pragma unroll
            for (int q = 0; q < 4; ++q) { *(f32x4*)(uc + 4 * q) = (f32x4){a0[4 * q], a0[4 * q + 1], a0[4 * q + 2], a0[4 * q + 3]}; *(f32x4*)(uc + 1024 + 4 * q) = (f32x4){a1[4 * q], a1[4 * q + 1], a1[4 * q + 2], a1[4 * q + 3]}; } }
#pragma unroll
        for (int t = 0; t < 4; ++t) { STAGE_PIECE(512 + h * 128 + 32 * t, kdt);
#pragma unroll
            for (int ms = 0; ms < 4; ++ms) { const bf16x8 fr = TR_FRAG(ms); *(bf16x8*)(chb + CH_KF + (t * 4 + ms) * 1024 + lane * 16) = fr; } }
        LDS_WAIT();
#undef KK_TILE
#undef KQ_TILE
#undef STAGE_PIECE
#undef TR_FRAG
#undef TR_NAT
    }
}

__device__ __forceinline__ void gdn_scan_chain(PP p, LAS unsigned char* lds, const int chain) {
    int tid = threadIdx.x; asm volatile("" : "+v"(tid)); const int lane = tid & 63, wave = __builtin_amdgcn_readfirstlane(tid >> 6), r32 = lane & 31, hi = lane >> 5;
    const float* cf = (const float*)(p->ws + WS_CONST);
    float* OG = (float*)(p->ws + WS_OG);
    constexpr int STG = 2 * CH_DMA_BYTES;
    const int dir = chain & 1, h = (chain >> 1) & 3;
    f32x16 S[4];
#pragma unroll
    for (int t = 0; t < 4; ++t) S[t] = (f32x16){};
    f32x16 Un[2]; float egn = 0.f;
#pragma unroll
    for (int m = 0; m < 2; ++m) Un[m] = (f32x16){};
#define LOAD_U(task_) do { const float* uc_ = (const float*)(p->ws + WS_CH + (size_t)(task_) * CH_TASK_BYTES + CH_UC) + ((wave * 2) * 64 + lane) * 16; \
        _Pragma("unroll") for (int m = 0; m < 2; ++m) _Pragma("unroll") for (int q = 0; q < 4; ++q) { const f32x4 t4 = *(const f32x4*)(uc_ + m * 1024 + 4 * q); Un[m][4 * q] = t4[0]; Un[m][4 * q + 1] = t4[1]; Un[m][4 * q + 2] = t4[2]; Un[m][4 * q + 3] = t4[3]; } \
        egn = cf[CF_EGL + (task_)]; } while (0)
#define STAGE_CHUNK(task_, bufi) do { const unsigned char* src_ = p->ws + WS_CH + (size_t)(task_) * CH_TASK_BYTES; const unsigned dst_ = lds_addr(lds + (bufi) * CH_DMA_BYTES); \
        _Pragma("unroll") for (int i = 0; i < 14; ++i) { const int pc = wave * 14 + i; glds16(src_ + pc * 1024 + lane * 16, dst_ + pc * 1024); } } while (0)
    if (wave < 4) { LOAD_U(chain * NCHUNK); STAGE_CHUNK(chain * NCHUNK, 0); }
    for (int n = 0; n < NCHUNK; ++n) {
        const int task = chain * NCHUNK + n;
        int bq, hq, dq, rstart, rstep; gdn_task_rows(task, bq, hq, dq, rstart, rstep);
        if (wave < 4) VM_WAIT();
        asm volatile("s_waitcnt lgkmcnt(0)\n\ts_barrier" ::: "memory");
        if (wave < 4) {
            f32x16 V[2], O[2];
#pragma unroll
            for (int m = 0; m < 2; ++m) { V[m] = Un[m]; O[m] = (f32x16){}; }
            const float egl = egn;
            if (n + 1 < NCHUNK) { LOAD_U(task + 1); STAGE_CHUNK(task + 1, (n + 1) & 1); }
            const LAS unsigned char* buf = lds + (n & 1) * CH_DMA_BYTES + lane * 16;
            bf16x8 Sb[4][2];
#pragma unroll
            for (int t = 0; t < 4; ++t)
#pragma unroll
                for (int s = 0; s < 2; ++s) { u32x4 w; w.x = cvt_pk_bf16(S[t][8 * s], S[t][8 * s + 1]); w.y = cvt_pk_bf16(S[t][8 * s + 2], S[t][8 * s + 3]); w.z = cvt_pk_bf16(S[t][8 * s + 4], S[t][8 * s + 5]); w.w = cvt_pk_bf16(S[t][8 * s + 6], S[t][8 * s + 7]);
                    Sb[t][s] = __builtin_bit_cast(bf16x8, w); }
#pragma unroll
            for (int m = 0; m < 2; ++m)
#pragma unroll
                for (int t = 0; t < 4; ++t)
#pragma unroll
                    for (int s = 0; s < 2; ++s) { const int f = (m * 4 + t) * 2 + s;
                        V[m] = MFMA32(*(const LAS bf16x8*)(buf + CH_WF + f * 1024), Sb[t][s], V[m]);
                        O[m] = MFMA32(*(const LAS bf16x8*)(buf + CH_QF + f * 1024), Sb[t][s], O[m]);
                        if (s == 1 && (t & 1)) __builtin_amdgcn_sched_barrier(0); }
            bf16x8 Vb[2][2];
#pragma unroll
            for (int m = 0; m < 2; ++m)
#pragma unroll
                for (int s = 0; s < 2; ++s) { u32x4 w; w.x = cvt_pk_bf16(V[m][8 * s], V[m][8 * s + 1]); w.y = cvt_pk_bf16(V[m][8 * s + 2], V[m][8 * s + 3]); w.z = cvt_pk_bf16(V[m][8 * s + 4], V[m][8 * s + 5]); w.w = cvt_pk_bf16(V[m][8 * s + 6], V[m][8 * s + 7]);
                    Vb[m][s] = __builtin_bit_cast(bf16x8, w); }
#pragma unroll
            for (int mo = 0; mo < 2; ++mo)
#pragma unroll
                for (int m = 0; m <= mo; ++m)
#pragma unroll
                    for (int s = 0; s < 2; ++s) O[mo] = MFMA32(*(const LAS bf16x8*)(buf + CH_AF + ((mo * 2 + m) * 2 + s) * 1024), Vb[m][s], O[mo]);
            { LAS bf16_t* stg = (LAS bf16_t*)(lds + STG) + 32 * wave + r32;
#pragma unroll
              for (int m = 0; m < 2; ++m)
#pragma unroll
                  for (int r = 0; r < 16; ++r) stg[(32 * m + crow(r, hi)) * 128] = (bf16_t)f2bf(O[m][r]); }
#pragma unroll
            for (int t = 0; t < 4; ++t) {
                __builtin_amdgcn_sched_barrier(0);
#pragma unroll
                for (int r = 0; r < 16; ++r) S[t][r] *= egl;
#pragma unroll
                for (int m = 0; m < 2; ++m)
#pragma unroll
                    for (int s = 0; s < 2; ++s) S[t] = MFMA32(*(const LAS bf16x8*)(buf + CH_KF + ((t * 2 + m) * 2 + s) * 1024), Vb[m][s], S[t]); }
        }
        asm volatile("s_waitcnt lgkmcnt(0)\n\ts_barrier" ::: "memory");
        if (wave >= 4) { const int j = tid - 256, row = j >> 2; float* og = OG + (size_t)dir * NTOK * 512 + (size_t)(rstart + rstep * row) * 512 + h * 128 + (j & 3) * 8;
            const LAS bf16_t* stg = (const LAS bf16_t*)(lds + STG) + row * 128 + (j & 3) * 8;
#pragma unroll
            for (int it = 0; it < 4; ++it) { const u32x4 w = *(const LAS u32x4*)(stg + it * 32);
                *(f32x4*)(og + it * 32) = (f32x4){bflo(w.x), bfhi(w.x), bflo(w.y), bfhi(w.y)}; *(f32x4*)(og + it * 32 + 4) = (f32x4){bflo(w.z), bfhi(w.z), bflo(w.w), bfhi(w.w)}; } }
    }
    VM_WAIT(); LDS_WAIT(); __syncthreads();
#undef LOAD_U
#undef STAGE_CHUNK
}

__device__ __forceinline__ void phase_gdn_out(PP p, int layer) {
    int tid = threadIdx.x, bid = blockIdx.x, gdim = gridDim.x; asm volatile("" : "+v"(tid), "+s"(bid), "+s"(gdim)); const int lane = tid & 63, wave = __builtin_amdgcn_readfirstlane(tid >> 6);
    const float* OG = (const float*)(p->ws + WS_OG); const float* OA = (const float*)(p->ws + WS_OA); const bf16_t* P = (const bf16_t*)(p->ws + WS_P); bf16_t* MIX = (bf16_t*)(p->ws + WS_MIX);
    const float* cf = (const float*)(p->ws + WS_CONST);
    const float lam = cf[CF_SC + layer * 16 + 0], oml = cf[CF_SC + layer * 16 + 2];
    const float* gn = p->in[I_GDNG] + layer * 128 + (8 * lane & 127); const float* sg = p->in[I_SUBLN] + layer * 128 + (8 * lane & 127);
    const f32x4 g0 = *(const f32x4*)gn, g1 = *(const f32x4*)(gn + 4), a0 = *(const f32x4*)sg * oml, a1 = *(const f32x4*)(sg + 4) * oml;
    const int nrows = layer == 0 ? NTOK : NLAT;
    for (int r = bid * NWAVES + wave; r < nrows; r += gdim * NWAVES) {
        {
            const float* a = OA + (size_t)r * 512 + 8 * lane; const float* bq = a + (size_t)NTOK * 512;
            f32x4 o0 = *(const f32x4*)a - *(const f32x4*)bq * lam, o1 = *(const f32x4*)(a + 4) - *(const f32x4*)(bq + 4) * lam;
            float ss = (o0[0] * o0[0] + o0[1] * o0[1]) + (o0[2] * o0[2] + o0[3] * o0[3]) + (o1[0] * o1[0] + o1[1] * o1[1]) + (o1[2] * o1[2] + o1[3] * o1[3]);
            ss += __shfl_xor(ss, 1); ss += __shfl_xor(ss, 2); ss += __shfl_xor(ss, 4); ss += __shfl_xor(ss, 8);
            const float rstd = rsqrtf(ss * (1.f / 128.f) + EPS);
            o0 = o0 * rstd * a0; o1 = o1 * rstd * a1;
            u32x4 w; w.x = cvt_pk_bf16(o0[0], o0[1]); w.y = cvt_pk_bf16(o0[2], o0[3]); w.z = cvt_pk_bf16(o1[0], o1[1]); w.w = cvt_pk_bf16(o1[2], o1[3]);
            *(u32x4*)(MIX + (size_t)r * D + 8 * lane) = w; }
        const float* a = OG + (size_t)r * 512 + 8 * lane; const float* bq = a + (size_t)NTOK * 512;
        f32x4 o0 = *(const f32x4*)a + *(const f32x4*)bq, o1 = *(const f32x4*)(a + 4) + *(const f32x4*)(bq + 4);
        float ss = (o0[0] * o0[0] + o0[1] * o0[1]) + (o0[2] * o0[2] + o0[3] * o0[3]) + (o1[0] * o1[0] + o1[1] * o1[1]) + (o1[2] * o1[2] + o1[3] * o1[3]);
        ss += __shfl_xor(ss, 1); ss += __shfl_xor(ss, 2); ss += __shfl_xor(ss, 4); ss += __shfl_xor(ss, 8);
        const float rstd = rsqrtf(ss * (1.f / 128.f) + EPS);
        const u32x4 zw = *(const u32x4*)(P + (size_t)r * PW + 3072 + 8 * lane);
        o0 = o0 * rstd * g0; o1 = o1 * rstd * g1;
        u32x4 w; w.x = cvt_pk_bf16(o0[0] * silu_f(bflo(zw.x)), o0[1] * silu_f(bfhi(zw.x))); w.y = cvt_pk_bf16(o0[2] * silu_f(bflo(zw.y)), o0[3] * silu_f(bfhi(zw.y)));
        w.z = cvt_pk_bf16(o1[0] * silu_f(bflo(zw.z)), o1[1] * silu_f(bfhi(zw.z))); w.w = cvt_pk_bf16(o1[2] * silu_f(bflo(zw.w)), o1[3] * silu_f(bfhi(zw.w)));
        *(u32x4*)(MIX + (size_t)r * D + 512 + 8 * lane) = w;
    }
}

constexpr int AT_NS = 4, AT_SLOTK = 8192, AT_SLOTV = 16384, AT_K = 0, AT_V = AT_NS * AT_SLOTK, AT_WS = AT_V + AT_NS * AT_SLOTV;
typedef short v4i16_t __attribute__((ext_vector_type(4)));
__device__ __forceinline__ s16x4 vtr(const LAS unsigned char* ptr) { return __builtin_bit_cast(s16x4, __builtin_amdgcn_ds_read_tr16_b64_v4i16((LAS v4i16_t*)ptr)); }
__device__ __forceinline__ int att_keyrow(int b, int t, int nctx_tiles) {
    return t < nctx_tiles ? NLAT + b * CTXL + 64 * t : b * SEQL + 64 * (t - nctx_tiles);
}
#define AT_SBAR() __builtin_amdgcn_sched_barrier(0)
#define AT_PIN(x) asm volatile("" : "+v"(x))
#define AT_WAIT_BAR(N) asm volatile("s_waitcnt vmcnt(" #N ") lgkmcnt(0)\n\ts_barrier" ::: "memory")
__device__ __forceinline__ void attn_unit(PP p, int layer, LAS unsigned char* lds, int b, int h, int sub, int qrow0, int ntile, int nctx_tiles) {
    int tid = threadIdx.x; asm volatile("" : "+v"(tid)); const int lane = tid & 63, wave = __builtin_amdgcn_readfirstlane(tid >> 6), r32 = lane & 31, hi = lane >> 5;
    const bf16_t* P = (const bf16_t*)(p->ws + WS_P);
    LAS float* wsf = (LAS float*)(lds + AT_WS) + wave * 64;
    const LAS unsigned char* kp0 = lds + AT_K + hi * 1024 + r32 * 16;
    const LAS unsigned char* vp0 = lds + AT_V + ((lane >> 4) & 1) * 32 + (lane & 3) * 8 + (4 * hi + ((lane & 15) >> 2)) * 64;
    const int kcol = 512 + h * 128 + sub * 64 + wave * 8, vcol = 1024 + h * 128;
    const size_t koff = (size_t)lane * PW + kcol;
    const size_t voff0 = (size_t)(16 * (wave & 3) + (lane >> 2)) * PW + vcol + 32 * (wave >> 2) + 8 * (lane & 3);
    const size_t voff1 = voff0 + 64;
    const unsigned kdst = lds_addr(lds + AT_K + wave * 1024), vdst = lds_addr(lds + AT_V + wave * 1024);
#define DMA_K(t, slot) do { if ((t) < ntile) glds16(P + (size_t)att_keyrow(b, (t), nctx_tiles) * PW + koff, kdst + (slot) * AT_SLOTK); } while (0)
#define DMA_V(t, slot) do { if ((t) < ntile) { const bf16_t* vb_ = P + (size_t)att_keyrow(b, (t), nctx_tiles) * PW; \
        glds16(vb_ + voff0, vdst + (slot) * AT_SLOTV); glds16(vb_ + voff1, vdst + (slot) * AT_SLOTV + 8192); } } while (0)
    DMA_K(0, 0); DMA_V(0, 0); DMA_K(1, 1); DMA_K(2, 2); DMA_K(3, 3); DMA_V(1, 1);
    bf16x8 qr[4];
    { const bf16_t* qp = P + (size_t)(qrow0 + wave * 32 + r32) * PW + h * 128 + sub * 64 + hi * 8;
#pragma unroll
      for (int d0 = 0; d0 < 4; ++d0) qr[d0] = *(const bf16x8*)(qp + d0 * 16); }
    f32x16 o[4];
#pragma unroll
    for (int dg = 0; dg < 4; ++dg) o[dg] = (f32x16){};
    float l_reg = 0.f;
    f32x16 pA0, pA1, pB0, pB1; bf16x8 kf[8]; u32x4 pw0, pw1, pw2, pw3; s16x4 vlo[4], vhi[4];
    f32x16 zero16 = (f32x16){}; AT_PIN(zero16);
    int sl_prev = 0, sl_cur = 0, sl_next = 1;
#define ROT() do { sl_prev = sl_cur; sl_cur = sl_next; sl_next = (sl_next + 1) & 3; } while (0)
#define KLD(i, kp_) kf[i] = *(const LAS bf16x8*)((kp_) + ((i) >> 1) * 2048 + ((i) & 1) * 512)
#define PKW(Pv, i) cvt_pk_bf16(Pv[i], Pv[(i) + 1])
#define PAF(k) __builtin_bit_cast(bf16x8, pw##k)
#define VRD(i, vp_) do { vlo[(i) & 3] = vtr((vp_) + ((i) & 3) * 4096 + ((i) >> 2) * 1024); vhi[(i) & 3] = vtr((vp_) + ((i) & 3) * 4096 + ((i) >> 2) * 1024 + 512); } while (0)
#define VFR(i) (bf16x8){vlo[(i) & 3][0], vlo[(i) & 3][1], vlo[(i) & 3][2], vlo[(i) & 3][3], vhi[(i) & 3][0], vhi[(i) & 3][1], vhi[(i) & 3][2], vhi[(i) & 3][3]}
#define EX2(Cv, i) do { Cv[i] = __builtin_amdgcn_exp2f(Cv[i]); Cv[(i) + 1] = __builtin_amdgcn_exp2f(Cv[(i) + 1]); } while (0)
#define GAPA(MF, a0, a1, a2, a3, W0, W1, PW_) do { MF; sacc += a0; sacc += a1; sacc += a2; sacc += a3; W0; W1; AT_PIN(PW_); AT_PIN(sacc); AT_SBAR(); } while (0)
#define GAPB(i, PA_, Cx, ci, GL) do { o[(i) & 3] = MFMA32(PA_, VFR(i), o[(i) & 3]); EX2(Cx, ci); AT_PIN(Cx); \
        if ((i) + 2 < 16) VRD((i) + 2, vpp_); if ((GL) && (i) < 8) KLD(i, kpn_); AT_SBAR(); } while (0)
#define STEP(C0, C1, P0, P1, t, GL) do { AT_SBAR(); \
    const LAS unsigned char* vpp_ = vp0 + sl_prev * AT_SLOTV; const LAS unsigned char* kpn_ = kp0 + sl_next * AT_SLOTK; \
    float sacc = P0[0] + P0[1]; \
    GAPA(C0 = MFMA32(kf[0], qr[0], zero16), P0[2], P0[3], P0[4], P0[5],     pw0[0] = PKW(P0, 0),  pw0[1] = PKW(P0, 2),  pw0); \
    GAPA(C1 = MFMA32(kf[1], qr[0], zero16), P0[6], P0[7], P0[8], P0[9],     pw0[2] = PKW(P0, 4),  pw0[3] = PKW(P0, 6),  pw0); \
    GAPA(C0 = MFMA32(kf[2], qr[1], C0),     P0[10], P0[11], P0[12], P0[13], pw1[0] = PKW(P0, 8),  pw1[1] = PKW(P0, 10), pw1); \
    GAPA(C1 = MFMA32(kf[3], qr[1], C1),     P0[14], P0[15], P1[0], P1[1],   pw1[2] = PKW(P0, 12), pw1[3] = PKW(P0, 14), pw1); \
    GAPA(C0 = MFMA32(kf[4], qr[2], C0),     P1[2], P1[3], P1[4], P1[5],     pw2[0] = PKW(P1, 0),  pw2[1] = PKW(P1, 2),  pw2); \
    GAPA(C1 = MFMA32(kf[5], qr[2], C1),     P1[6], P1[7], P1[8], P1[9],     pw2[2] = PKW(P1, 4),  pw2[3] = PKW(P1, 6),  pw2); \
    VRD(0, vpp_); \
    GAPA(C0 = MFMA32(kf[6], qr[3], C0),     P1[10], P1[11], P1[12], P1[13], pw3[0] = PKW(P1, 8),  pw3[1] = PKW(P1, 10), pw3); \
    VRD(1, vpp_); \
    GAPA(C1 = MFMA32(kf[7], qr[3], C1),     P1[14], P1[15], 0.f, 0.f,       pw3[2] = PKW(P1, 12), pw3[3] = PKW(P1, 14), pw3); \
    l_reg += sacc; \
    DMA_K((t) + 4, sl_cur); DMA_V((t) + 2, (sl_next + 1) & 3); AT_SBAR(); \
    GAPB(0, PAF(0), C0, 0, GL);  GAPB(1, PAF(0), C0, 2, GL);  GAPB(2, PAF(0), C0, 4, GL);  GAPB(3, PAF(0), C0, 6, GL); \
    GAPB(4, PAF(1), C0, 8, GL);  GAPB(5, PAF(1), C0, 10, GL); GAPB(6, PAF(1), C0, 12, GL); GAPB(7, PAF(1), C0, 14, GL); \
    GAPB(8, PAF(2), C1, 0, GL);  GAPB(9, PAF(2), C1, 2, GL);  GAPB(10, PAF(2), C1, 4, GL); GAPB(11, PAF(2), C1, 6, GL); \
    GAPB(12, PAF(3), C1, 8, GL); GAPB(13, PAF(3), C1, 10, GL); GAPB(14, PAF(3), C1, 12, GL); GAPB(15, PAF(3), C1, 14, GL); \
    } while (0)
#define ENDW(tt) do { if ((tt) + 4 < ntile) { AT_WAIT_BAR(6); } else { AT_WAIT_BAR(0); } } while (0)
    AT_WAIT_BAR(0);
#pragma unroll
    for (int i = 0; i < 8; ++i) KLD(i, kp0);
    pA0 = MFMA32(kf[0], qr[0], zero16); pA1 = MFMA32(kf[1], qr[0], zero16); pA0 = MFMA32(kf[2], qr[1], pA0); pA1 = MFMA32(kf[3], qr[1], pA1);
    pA0 = MFMA32(kf[4], qr[2], pA0); pA1 = MFMA32(kf[5], qr[2], pA1); pA0 = MFMA32(kf[6], qr[3], pA0); pA1 = MFMA32(kf[7], qr[3], pA1);
#pragma unroll
    for (int r = 0; r < 16; ++r) { pA0[r] = __builtin_amdgcn_exp2f(pA0[r]); pA1[r] = __builtin_amdgcn_exp2f(pA1[r]); }
    AT_WAIT_BAR(0);
    DMA_K(4, 0); DMA_V(2, 2); ROT();
#pragma unroll
    for (int i = 0; i < 8; ++i) KLD(i, kp0 + sl_cur * AT_SLOTK);
    if (ntile > 4) { AT_WAIT_BAR(3); } else { AT_WAIT_BAR(0); }
    int t = 1;
    for (; t + 1 < ntile; t += 2) {
        STEP(pB0, pB1, pA0, pA1, t, true);     ENDW(t);     ROT();
        STEP(pA0, pA1, pB0, pB1, t + 1, (t + 2 < ntile)); ENDW(t + 1); ROT();
    }
    if (t < ntile) { STEP(pB0, pB1, pA0, pA1, t, false); ENDW(t); ROT();
#pragma unroll
        for (int r = 0; r < 16; ++r) { pA0[r] = pB0[r]; pA1[r] = pB1[r]; } }
    { float sacc = 0.f;
#pragma unroll
      for (int r = 0; r < 16; ++r) sacc += pA0[r] + pA1[r];
      l_reg += sacc;
      pw0 = (u32x4){PKW(pA0, 0), PKW(pA0, 2), PKW(pA0, 4), PKW(pA0, 6)}; pw1 = (u32x4){PKW(pA0, 8), PKW(pA0, 10), PKW(pA0, 12), PKW(pA0, 14)};
      pw2 = (u32x4){PKW(pA1, 0), PKW(pA1, 2), PKW(pA1, 4), PKW(pA1, 6)}; pw3 = (u32x4){PKW(pA1, 8), PKW(pA1, 10), PKW(pA1, 12), PKW(pA1, 14)};
      const LAS unsigned char* vpp_ = vp0 + sl_prev * AT_SLOTV;
#pragma unroll
      for (int i = 0; i < 16; ++i) { VRD(i, vpp_); const bf16x8 pa = (i >> 2) == 0 ? PAF(0) : (i >> 2) == 1 ? PAF(1) : (i >> 2) == 2 ? PAF(2) : PAF(3); o[i & 3] = MFMA32(pa, VFR(i), o[i & 3]); } }
    l_reg += __shfl_xor(l_reg, 32);
    if (hi == 0) wsf[r32] = l_reg;
    LDS_WAIT();
    float* OA = (float*)(p->ws + WS_OA) + (size_t)sub * NTOK * 512 + h * 128 + r32;
#pragma unroll
    for (int r = 0; r < 16; ++r) { const float rl = 1.f / wsf[crow(r, hi)]; float* orow = OA + (size_t)(qrow0 + wave * 32 + crow(r, hi)) * 512;
#pragma unroll
        for (int dg = 0; dg < 4; ++dg) orow[32 * dg] = o[dg][r] * rl; }
    AT_WAIT_BAR(0);
#undef DMA_K
#undef DMA_V
#undef ROT
#undef KLD
#undef PKW
#undef PAF
#undef VRD
#undef VFR
#undef EX2
#undef GAPA
#undef GAPB
#undef STEP
#undef ENDW
}
__device__ __forceinline__ void phase_attention(PP p, int layer, LAS unsigned char* lds) {
    int bid = blockIdx.x; asm volatile("" : "+s"(bid));
    if (bid < 16) gdn_scan_chain(p, lds, bid);
    const int nlat = NB * 4 * 2 * 64, nunits = nlat + (layer == 0 ? NB * 4 * 2 : 0);
    unsigned* ctr = (unsigned*)(p->ws + WS_CTL) + CW_ATTQ + layer * 64;
    volatile LAS unsigned* slot = (volatile LAS unsigned*)(lds + MISC_OFF) + 16;
    for (;;) {
        if (threadIdx.x == 0) *slot = __hip_atomic_fetch_add(ctr, 1u, __ATOMIC_RELAXED, __HIP_MEMORY_SCOPE_AGENT);
        __syncthreads();
        const int u = (int)__builtin_amdgcn_readfirstlane((int)*slot);
        if (u >= nunits) break;
        if (u < nlat) { const int b = u >> 9, h = (u >> 7) & 3, sub = (u >> 6) & 1, qb = u & 63; attn_unit(p, layer, lds, b, h, sub, b * SEQL + qb * 256, 260, 4); }
        else { const int v = u - nlat, b = v >> 3, h = (v >> 1) & 3, sub = v & 1; attn_unit(p, layer, lds, b, h, sub, NLAT + b * CTXL, 4, 4); }
    }
}

__device__ __forceinline__ void phase_norm_router(PP p, int layer, LAS unsigned char* lds) {
    int tid = threadIdx.x, bid = blockIdx.x, gdim = gridDim.x; asm volatile("" : "+v"(tid), "+s"(bid), "+s"(gdim)); const int lane = tid & 63, wave = __builtin_amdgcn_readfirstlane(tid >> 6);
    const int T = layer == 0 ? NTOK : NLAT;
    LAS float* rw = (LAS float*)lds;
    LAS int* lcnt = (LAS int*)(lds + 131072);
    LAS int* lbase = lcnt + 32;
    LAS int* ent = lcnt + 64;
    const float* rwg = p->in[I_RW] + (size_t)layer * D * NEXP;
    for (int i = tid; i < NEXP * 1024; i += NTHR) { const int k = i >> 5, e = i & 31; rw[e * 1024 + k] = rwg[(size_t)k * NEXP + e]; }
    if (tid < 64) lcnt[tid] = 0;
    __syncthreads();
    const float* cf = (const float*)(p->ws + WS_CONST);
    const float* gn = p->in[I_NFFNG] + layer * D;
    const float rb = lane < NEXP ? p->in[I_RB][layer * NEXP + lane] : 0.f;
    const int rpw = (T + gdim - 1) / gdim;
    const int r0 = bid * rpw, r1 = (r0 + rpw < T) ? r0 + rpw : T;
    int* tope = (int*)(p->ws + WS_RT + RT_TOPE); float* gate = (float*)(p->ws + WS_RT + RT_GATE); int* rank = (int*)(p->ws + WS_RT + RT_RANK);
    const float* H = (const float*)(p->ws + WS_H);
    for (int r = r0 + wave; r < r1; r += NWAVES) {
        const float* mv = cf + CF_MODV + (layer * 3 + mod_sel(r)) * 6144;
        f32x4 u[4]; norm_mod_row(H + (size_t)r * D, gn, mv + 3 * 1024, mv + 4 * 1024, lane, u);
        store_row_bf16((bf16_t*)(p->ws + WS_U) + (size_t)r * D, lane, u);
        float logit = -INFINITY;
#pragma unroll 4
        for (int e = 0; e < NEXP; ++e) { float s = 0.f;
#pragma unroll
            for (int q = 0; q < 4; ++q) { const f32x4 w = *(const LAS f32x4*)(rw + e * 1024 + 4 * lane + 256 * q); s += (u[q][0] * w[0] + u[q][1] * w[1]) + (u[q][2] * w[2] + u[q][3] * w[3]); }
            s = wave_sum(s); if (lane == e) logit = s + rb; }
        float tl[4]; int te[4];
#pragma unroll
        for (int k = 0; k < 4; ++k) { const float m = wave_max(logit); const unsigned long long bal = __ballot(logit == m); const int idx = __ffsll((long long)bal) - 1;
            tl[k] = m; te[k] = idx; if (lane == idx) logit = -INFINITY; }
        const float e1 = __expf(tl[1] - tl[0]), e2 = __expf(tl[2] - tl[0]), e3 = __expf(tl[3] - tl[0]); const float inv = 1.f / (1.f + e1 + e2 + e3);
        if (lane < 4) { const int e = lane == 0 ? te[0] : lane == 1 ? te[1] : lane == 2 ? te[2] : te[3]; const float gv = (lane == 0 ? 1.f : lane == 1 ? e1 : lane == 2 ? e2 : e3) * inv;
            const int lr = atomicAdd((int*)&lcnt[e], 1);
            ent[(r - r0) * 4 + lane] = (e << 20) | lr; tope[(size_t)r * 4 + lane] = e; gate[(size_t)r * 4 + lane] = gv; }
    }
    __syncthreads();
    if (tid < NEXP) lbase[tid] = (int)atomicAdd((unsigned*)(p->ws + WS_CTL) + CW_CNT + layer * 64 + tid, (unsigned)lcnt[tid]);
    __syncthreads();
    for (int i = tid; i < (r1 - r0) * 4; i += NTHR) { const int v = ent[i]; rank[(size_t)r0 * 4 + i] = lbase[v >> 20] + (v & 0xfffff); }
}

__device__ __forceinline__ void phase_moe_gather(PP p, int layer, LAS unsigned char* lds) {
    int tid = threadIdx.x, bid = blockIdx.x, gdim = gridDim.x; asm volatile("" : "+v"(tid), "+s"(bid), "+s"(gdim)); const int lane = tid & 63, wave = __builtin_amdgcn_readfirstlane(tid >> 6);
    const int T = layer == 0 ? NTOK : NLAT;
    LAS int* pstart = (LAS int*)lds; LAS int* cnt = pstart + 64;
    const unsigned* gcnt = (const unsigned*)(p->ws + WS_CTL) + CW_CNT + layer * 64;
    int* mt = (int*)(p->ws + WS_CONST) + CF_MOE + layer * 1024;
    if (tid == 0) { int acc = 0; for (int e = 0; e < NEXP; ++e) { const int c = (int)__hip_atomic_load(gcnt + e, __ATOMIC_RELAXED, __HIP_MEMORY_SCOPE_AGENT); cnt[e] = c; pstart[e] = acc; acc += (c + 255) & ~255; } pstart[NEXP] = acc; }
    __syncthreads();
    if (bid == 0) {
        if (tid < NEXP) { mt[tid] = pstart[tid]; mt[64 + tid] = cnt[tid]; }
        if (tid == 0) mt[32] = pstart[NEXP] >> 8;
        for (int e = 0; e < NEXP; ++e) { const int b0 = pstart[e] >> 8, b1 = pstart[e + 1] >> 8; for (int bb = b0 + tid; bb < b1; bb += NTHR) mt[128 + bb] = e; }
    }
    const int* tope = (const int*)(p->ws + WS_RT + RT_TOPE); const float* gate = (const float*)(p->ws + WS_RT + RT_GATE); const int* rank = (const int*)(p->ws + WS_RT + RT_RANK);
    int* slot = (int*)(p->ws + WS_RT + RT_SLOT); float* sgate = (float*)(p->ws + WS_RT + RT_SGATE);
    const bf16_t* V = (const bf16_t*)(p->ws + WS_U); bf16_t* XS = (bf16_t*)(p->ws + WS_XS);
    const int gw = bid * NWAVES + wave, NGW = gdim * NWAVES;
    for (int a = gw; a < T * 4; a += NGW) {
        const int r = a >> 2; const int e = tope[a]; const int s = pstart[e] + rank[a];
        if (lane == 0) { slot[a] = s; sgate[s] = gate[a]; }
        const u32x4* src = (const u32x4*)(V + (size_t)r * D); u32x4* dst = (u32x4*)(XS + (size_t)s * D);
        dst[lane] = src[lane]; dst[64 + lane] = src[64 + lane];
    }
    for (int e = 0; e < NEXP; ++e) { const int s0 = pstart[e] + cnt[e], s1 = pstart[e + 1];
        for (int s = s0 + gw; s < s1; s += NGW) { u32x4* dst = (u32x4*)(XS + (size_t)s * D); dst[lane] = (u32x4){0u, 0u, 0u, 0u}; dst[64 + lane] = (u32x4){0u, 0u, 0u, 0u}; if (lane == 0) sgate[s] = 0.f; } }
}

__device__ __forceinline__ void phase_moe_combine(PP p, int layer) {
    int tid = threadIdx.x, bid = blockIdx.x, gdim = gridDim.x; asm volatile("" : "+v"(tid), "+s"(bid), "+s"(gdim)); const int lane = tid & 63, wave = __builtin_amdgcn_readfirstlane(tid >> 6);
    const int T = layer == 0 ? NTOK : NLAT;
    const float* cf = (const float*)(p->ws + WS_CONST); const int* slot = (const int*)(p->ws + WS_RT + RT_SLOT); const bf16_t* Y = (const bf16_t*)(p->ws + WS_Y);
    float* H = (float*)(p->ws + WS_H);
    for (int r = bid * NWAVES + wave; r < T; r += gdim * NWAVES) {
        const float* g5 = cf + CF_MODV + (layer * 3 + mod_sel(r)) * 6144 + 5 * 1024;
        float* ho = layer == 0 ? H + (size_t)r * D : p->out + (size_t)r * D; const float* hi_ = H + (size_t)r * D;
        const int s0 = slot[r * 4], s1 = slot[r * 4 + 1], s2 = slot[r * 4 + 2], s3 = slot[r * 4 + 3];
#pragma unroll
        for (int j = 0; j < 4; ++j) { const int c = 4 * lane + 256 * j;
            const u32x2 a = *(const u32x2*)(Y + (size_t)s0 * D + c), b2 = *(const u32x2*)(Y + (size_t)s1 * D + c), c2 = *(const u32x2*)(Y + (size_t)s2 * D + c), d2 = *(const u32x2*)(Y + (size_t)s3 * D + c);
            f32x4 y; y[0] = (bflo(a.x) + bflo(b2.x)) + (bflo(c2.x) + bflo(d2.x)); y[1] = (bfhi(a.x) + bfhi(b2.x)) + (bfhi(c2.x) + bfhi(d2.x));
            y[2] = (bflo(a.y) + bflo(b2.y)) + (bflo(c2.y) + bflo(d2.y)); y[3] = (bfhi(a.y) + bfhi(b2.y)) + (bfhi(c2.y) + bfhi(d2.y));
            const f32x4 hv = *(const f32x4*)(hi_ + c), gv = *(const f32x4*)(g5 + c);
            *(f32x4*)(ho + c) = hv + gv * y; }
    }
}

constexpr int NPH = 27;
#ifndef PH_MASK
#define PH_MASK 0xFFFF
#endif
#define IN(k) (lo <= (k) && (k) < hi)
#define EN(i) ((PH_MASK >> (i)) & 1)
#ifndef DUP_PH
#define DUP_PH -1
#endif
#define REP(i) for (int rep_ = 0; rep_ < ((DUP_PH == (i) && l == 0) ? 2 : 1); ++rep_)
#define SEAM(k) do { if (IN(k) && IN((k) + 1)) xcd_barrier(bar); } while (0)
#define LAUNDER() PP p = p0; LAS unsigned char* lds = lds0; int bid = blockIdx.x, gdim = gridDim.x; asm volatile("" : "+s"(p), "+s"(lds), "+s"(bid), "+s"(gdim))
template <int l> __device__ __forceinline__ void run_layer(PP p0, LAS unsigned char* lds0, const int lo, const int hi, const XcdBarrier& bar) {
        const int base = 1 + 13 * l;
        if (EN(1) && IN(base + 0)) REP(1) { LAUNDER(); phase_norm_mix(p, l, lds); __syncthreads(); }
        SEAM(base + 0);
        if (EN(2) && IN(base + 1)) REP(2) { LAUNDER();
            PlainSched S; S.init(p->ws + WS_U, p->ws + WS_WIN + (size_t)l * PW * 1024 * 2, 1024, NTOK / 256, PW / 256, gdim, bid);
            EpiStoreBf16 E{(bf16_t*)(p->ws + WS_P), PW};
            pg8::gemm_phase<EpiStoreBf16, PlainSched>(lds, 1024, S, E);
        }
        SEAM(base + 1);
        if (EN(3) && IN(base + 2)) REP(3) { LAUNDER(); phase_prep(p, l); }
        SEAM(base + 2);
        if (EN(5) && IN(base + 3)) REP(5) { LAUNDER(); phase_gdn_chunk(p, lds); }
        SEAM(base + 3);
        if (EN(4) && IN(base + 4)) { LAUNDER(); phase_attention(p, l, lds); }
        SEAM(base + 4);
        if (EN(7) && IN(base + 6)) REP(7) { LAUNDER(); phase_gdn_out(p, l); }
        SEAM(base + 6);
        if (EN(8) && IN(base + 7)) REP(8) { LAUNDER();
            const int T = l == 0 ? NTOK : NLAT;
            const float* cf = (const float*)(p->ws + WS_CONST);
            PlainSched S; S.init(p->ws + WS_MIX, p->ws + WS_WOUT + (size_t)l * D * 1024 * 2, 1024, T / 256, D / 256, gdim, bid);
            EpiResidual E{p, l, cf + CF_MODV + (l * 3) * 6144 + 2 * 1024};
            pg8::gemm_phase<EpiResidual, PlainSched>(lds, 1024, S, E);
        }
        SEAM(base + 7);
        if (EN(9) && IN(base + 8)) REP(9) { LAUNDER(); phase_norm_router(p, l, lds); __syncthreads(); }
        SEAM(base + 8);
        if (EN(10) && IN(base + 9)) REP(10) { LAUNDER(); phase_moe_gather(p, l, lds); __syncthreads(); }
        SEAM(base + 9);
        if (EN(11) && IN(base + 10)) REP(11) { LAUNDER();
            const int* mt = (const int*)(p->ws + WS_CONST) + CF_MOE + l * 1024;
            MoeSched S{(const char*)(p->ws + WS_XS), (const char*)(p->ws + WS_WGU + (size_t)l * NEXP * 2048 * 1024 * 2), mt + 128, mt[32], 8, gdim, bid};
            EpiGateUp E{(bf16_t*)(p->ws + WS_ACT), p->in[I_BGU] + (size_t)l * NEXP * 2048, mt + 128};
            pg8::gemm_phase<EpiGateUp, MoeSched>(lds, 1024, S, E);
        }
        SEAM(base + 10);
        if (EN(12) && IN(base + 11)) REP(12) { LAUNDER();
            const int* mt = (const int*)(p->ws + WS_CONST) + CF_MOE + l * 1024;
            MoeSched S{(const char*)(p->ws + WS_ACT), (const char*)(p->ws + WS_WD + (size_t)l * NEXP * 1024 * 1024 * 2), mt + 128, mt[32], 4, gdim, bid};
            EpiDown E{(bf16_t*)(p->ws + WS_Y), p->in[I_BD] + (size_t)l * NEXP * 1024, mt + 128, (const float*)(p->ws + WS_RT + RT_SGATE)};
            pg8::gemm_phase<EpiDown, MoeSched>(lds, 1024, S, E);
        }
        SEAM(base + 11);
        if (EN(13) && IN(base + 12)) REP(13) { LAUNDER(); phase_moe_combine(p, l); }
        SEAM(base + 12);
    }

__global__ void __launch_bounds__(NTHR, 2) mega_fwd(Params p_by_value) {
    extern __shared__ __attribute__((aligned(16))) unsigned char lds_raw[];
    LAS unsigned char* lds0 = (LAS unsigned char*)lds_raw;
    PP p0 = (PP)__builtin_amdgcn_kernarg_segment_ptr();
    volatile LAS unsigned* MISC = (volatile LAS unsigned*)(lds0 + MISC_OFF);
    if (threadIdx.x < 64) MISC[threadIdx.x] = 0u;
    __syncthreads();
    const int lo = p0->ph_lo, hi = p0->ph_hi;
    XcdBarrier bar; bar.bar = (unsigned*)(p0->ws + WS_CTL) + CW_BAR; bar.x = 0; bar.st = nullptr;
    if (hi - lo > 1) bar = xcd_barrier_post((unsigned*)(p0->ws + WS_CTL) + CW_BAR, MISC + 8);
    if (EN(0) && IN(0)) for (int rep_ = 0; rep_ < (DUP_PH == 0 ? 2 : 1); ++rep_) { LAUNDER(); phase_prologue(p, lds); __syncthreads(); }
    SEAM(0);
    run_layer<0>(p0, lds0, lo, hi, bar);
    run_layer<1>(p0, lds0, lo, hi, bar);
#undef IN
#undef SEAM
}

extern "C" void kernel_launch(void* const* d_in, const int* in_sizes, int n_in, void* d_out, int out_size, void* d_ws, size_t ws_size, hipStream_t stream) {
    static int grid = 0;
    if (grid == 0) {
        if (n_in != 27 || out_size != NLAT * D || ws_size < WS_END) { fprintf(stderr, "kernel_launch: unexpected problem (n_in %d, out %d, ws %zu < %zu)\n", n_in, out_size, ws_size, (size_t)WS_END); grid = -1; return; }
        int dev = 0, cus = 0, per_cu = 0;
        if (hipGetDevice(&dev) != hipSuccess || hipDeviceGetAttribute(&cus, hipDeviceAttributeMultiprocessorCount, dev) != hipSuccess) { grid = -1; return; }
        if (hipFuncSetAttribute((const void*)mega_fwd, hipFuncAttributeMaxDynamicSharedMemorySize, LDS_BYTES) != hipSuccess) { fprintf(stderr, "kernel_launch: hipFuncSetAttribute failed\n"); grid = -1; return; }
        if (hipOccupancyMaxActiveBlocksPerMultiprocessor(&per_cu, (const void*)mega_fwd, NTHR, LDS_BYTES) != hipSuccess || per_cu < 1) { fprintf(stderr, "kernel_launch: occupancy query says %d\n", per_cu); }
        (void)hipGetLastError();
        grid = cus;
    }
    if (grid < 0) return;
    hipMemsetAsync((char*)d_ws + WS_CTL, 0, CTL_ZERO_BYTES, stream);
    Params p{};
    for (int i = 0; i < 27; ++i) p.in[i] = (const float*)d_in[i];
    p.out = (float*)d_out; p.ws = (unsigned char*)d_ws;
#if MK_PER_PHASE
    for (int ph = 0; ph < NPH; ++ph) { p.ph_lo = ph; p.ph_hi = ph + 1; hipLaunchKernelGGL(mega_fwd, dim3(grid), dim3(NTHR), LDS_BYTES, stream, p); }
#else
    p.ph_lo = 0; p.ph_hi = NPH;
    hipLaunchKernelGGL(mega_fwd, dim3(grid), dim3(NTHR), LDS_BYTES, stream, p);
#endif
}
```

```cpp
#include <hip/hip_runtime.h>
#include <cstdio>
#include <cstdint>

#ifndef MK_PER_PHASE
#define MK_PER_PHASE 0
#endif

#define LAS __attribute__((address_space(3)))
#define GAS __attribute__((address_space(1)))
typedef unsigned short bf16_t;
typedef short bf16x8 __attribute__((ext_vector_type(8)));
typedef short s16x4 __attribute__((ext_vector_type(4)));
typedef float f32x2 __attribute__((ext_vector_type(2)));
typedef float f32x4 __attribute__((ext_vector_type(4)));
typedef float f32x16 __attribute__((ext_vector_type(16)));
typedef unsigned u32x2 __attribute__((ext_vector_type(2)));
typedef unsigned u32x4 __attribute__((ext_vector_type(4)));

constexpr int D = 1024, NB = 2, SEQL = 16384, CTXL = 256;
constexpr int NLAT = NB * SEQL, NCTX = NB * CTXL, NTOK = NLAT + NCTX;
constexpr int PW = 3584, INC = 3600;
constexpr int NEXP = 32, MAXBLK = 552, MAXSLOT = MAXBLK * 256;
constexpr int NCHUNK = 260, NTASK = 16 * NCHUNK;
constexpr float EPS = 1e-6f;
constexpr float LOG2E = 1.4426950408889634f;
constexpr int NWAVES = 8, NTHR = 512;

constexpr size_t MiB = 1u << 20;
constexpr size_t WS_CTL = 0, CTL_ZERO_BYTES = 1 * MiB;
constexpr size_t WS_CONST = 1 * MiB;
constexpr size_t WS_WIN = 2 * MiB;
constexpr size_t WS_WOUT = 16 * MiB;
constexpr size_t WS_WGU = 20 * MiB;
constexpr size_t WS_WD = 276 * MiB;
constexpr size_t WS_H = 404 * MiB;
constexpr size_t WS_U = 534 * MiB;
constexpr size_t WS_GB = 599 * MiB;
constexpr size_t WS_MIX = 602 * MiB;
constexpr size_t WS_RT = 667 * MiB;
constexpr size_t WS_BIG = 671 * MiB;
constexpr size_t WS_P = WS_BIG;
constexpr size_t WS_G = WS_P + 228 * MiB;
constexpr size_t WS_CH = WS_G + 98 * MiB;
constexpr size_t WS_OG = WS_CH + 358 * MiB;
constexpr size_t WS_OA = WS_OG + 130 * MiB;
constexpr size_t WS_LA = WS_OA + 260 * MiB;
constexpr size_t WS_END = WS_LA + 3 * MiB;
constexpr size_t WS_XS = WS_BIG;
constexpr size_t WS_ACT = WS_BIG + 276 * MiB;
constexpr size_t WS_Y = WS_XS;
static_assert(WS_ACT + 276 * MiB <= WS_END, "moe overlay");
constexpr size_t CH_TASK_BYTES = 90112;
constexpr int CH_WF = 0, CH_QF = 16384, CH_AF = 32768, CH_KF = 40960, CH_UC = 57344, CH_DMA_BYTES = 57344;
static_assert((size_t)NTASK * CH_TASK_BYTES <= 358 * MiB, "chunk buffers");

constexpr int CW_BAR = 4096;
constexpr int CW_CNT = 16384;
constexpr int CW_ATTQ = 20480;
constexpr int CF_MODV = 0;
constexpr int CF_ROPE = 40960;
constexpr int CF_SC = 53248;
constexpr int CF_EGL = 53504;
constexpr int CF_MOE = 61440;
constexpr size_t RT_TOPE = 0, RT_GATE = 640 * 1024, RT_RANK = 1280 * 1024, RT_SLOT = 1920 * 1024, RT_SGATE = 2560 * 1024, RT_STOK = 3200 * 1024;

constexpr int LDS_BYTES = 147456;
constexpr int MISC_OFF = 143 * 1024;
static_assert(MISC_OFF + 256 <= LDS_BYTES, "lds");

__device__ __forceinline__ unsigned f2bf(float f) { unsigned u = __builtin_bit_cast(unsigned, f); return (u + 0x7fffu + ((u >> 16) & 1u)) >> 16; }
__device__ __forceinline__ unsigned pk2(float lo, float hi) { return f2bf(lo) | (f2bf(hi) << 16); }
__device__ __forceinline__ float bf2f(unsigned short b) { return __builtin_bit_cast(float, (unsigned)b << 16); }
__device__ __forceinline__ float bflo(unsigned w) { return __builtin_bit_cast(float, w << 16); }
__device__ __forceinline__ float bfhi(unsigned w) { return __builtin_bit_cast(float, w & 0xffff0000u); }
__device__ __forceinline__ unsigned cvt_pk_bf16(float lo, float hi) { unsigned r; asm volatile("v_cvt_pk_bf16_f32 %0, %1, %2" : "=v"(r) : "v"(lo), "v"(hi)); return r; }
__device__ __forceinline__ float wave_sum(float v) {
#pragma unroll
    for (int o = 1; o < 64; o <<= 1) v += __shfl_xor(v, o);
    return v;
}
__device__ __forceinline__ float wave_max(float v) {
#pragma unroll
    for (int o = 1; o < 64; o <<= 1) v = fmaxf(v, __shfl_xor(v, o));
    return v;
}
__device__ __forceinline__ float silu_f(float x) { return x / (1.f + __expf(-x)); }
__device__ __forceinline__ int crow(int r, int hi) { return (r & 3) + 8 * (r >> 2) + 4 * hi; }
__device__ __forceinline__ void glds16(const void* g, unsigned lds_base) {
    unsigned sv; asm volatile("s_mov_b32 %0, m0\n\ts_mov_b32 m0, %2\n\ts_nop 0\n\tglobal_load_lds_dwordx4 %1, off\n\ts_mov_b32 m0, %0" : "=&s"(sv) : "v"(g), "s"((unsigned)__builtin_amdgcn_readfirstlane((int)lds_base)) : "memory"); }
__device__ __forceinline__ unsigned lds_addr(const LAS void* q) { return (unsigned)__builtin_amdgcn_readfirstlane((int)(unsigned)(uintptr_t)q); }
#define LDS_WAIT() asm volatile("s_waitcnt lgkmcnt(0)" ::: "memory")
#define VM_WAIT() asm volatile("s_waitcnt vmcnt(0)" ::: "memory")
#define MFMA32(a, b, c) __builtin_amdgcn_mfma_f32_32x32x16_bf16(a, b, c, 0, 0, 0)

namespace pg8 {
constexpr int BM = 256, BK = 64, HALF = 128, HTB = HALF * BK * 2, STAGE_BYTES = 8 * HTB;
__host__ __device__ __forceinline__ int lds_byte(int r, int c) { const int st = (r >> 4) * 2 + (c >> 5), rr = r & 15, cc = c & 31, ob = rr * 64 + cc * 2; return st * 1024 + (ob ^ (((ob >> 9) & 1) << 5)); }
__host__ __device__ __forceinline__ void stage_rc(int b, int& R, int& C) { const int st = b / 1024, sb = b % 1024, swz = sb ^ (((sb >> 9) & 1) << 5); R = (st >> 1) * 16 + swz / 64; C = (st & 1) * 32 + (swz % 64) / 2; }
__host__ __device__ __forceinline__ int perm32(int rho) { const int n = rho >> 4, i = rho & 15; return 8 * (i >> 2) + 4 * n + (i & 3); }
struct Unit { int pm, pn; };
template <class Epi, class Sched, bool GA = false>
__device__ __forceinline__ void gemm_phase(LAS unsigned char* lds, const int K, const Sched& S, const Epi& E) {
    int tid = threadIdx.x, bid = blockIdx.x, gdim = gridDim.x; asm volatile("" : "+v"(tid), "+s"(bid), "+s"(gdim)); const int wid = __builtin_amdgcn_readfirstlane(tid >> 6), lane = tid & 63, wr = wid >> 2, wc = wid & 3, fr = lane & 15, fq = lane >> 4;
    const int nt = K / BK;
    unsigned voffA[2], voffB[2], colA2[2]; int rowA[2];
    unsigned vAc[2][2], vAn[2][2], vAnn[2][2];
#pragma unroll
    for (int i = 0; i < 2; ++i) { int R, C; stage_rc(tid * 16 + i * 8192, R, C); const int Rb = Epi::PERM ? ((R & ~31) + perm32(R & 31)) : R;
        voffA[i] = (unsigned)(R * K + C) * 2u; voffB[i] = (unsigned)(Rb * K + C) * 2u; rowA[i] = R; colA2[i] = (unsigned)C * 2u; }
    const size_t kstep = (size_t)(BK * 2);
    const size_t hstep = (size_t)HALF * K * 2;
    const unsigned ldsw = (unsigned)wid * 1024u;
    const int aoff = lds_byte(wr * 64 + fr, fq * 8), boff = lds_byte(wc * 32 + fr, fq * 8);
#define PG8_SA(b, h) (((b) * 2 + (h)) * HTB)
#define PG8_SB(b, h) ((4 + (b) * 2 + (h)) * HTB)
#define PG8_STAGE(bufoff, gbase, voff) do { _Pragma("unroll") for (int _i = 0; _i < 2; ++_i) \
        __builtin_amdgcn_global_load_lds((const unsigned*)((const char*)(gbase) + (voff)[_i]), (LAS unsigned*)(lds + (bufoff) + ldsw + _i * 8192), 16, 0, 0); } while (0)
#define PG8_TOK(v, u) do { if constexpr (GA) { const int* tk_ = S.atok(u); _Pragma("unroll") for (int h_ = 0; h_ < 2; ++h_) _Pragma("unroll") for (int i_ = 0; i_ < 2; ++i_) v[h_][i_] = (unsigned)tk_[rowA[i_] + 128 * h_] * (unsigned)(K * 2) + colA2[i_]; } } while (0)
#define PG8_STAGE_A(bufoff, gptr, koff, half, nx) do { if constexpr (GA) { const char* gb_ = S.abase() + (koff); _Pragma("unroll") for (int _i = 0; _i < 2; ++_i) { const unsigned vo_ = (nx) ? vAn[half][_i] : vAc[half][_i]; \
        __builtin_amdgcn_global_load_lds((const unsigned*)(gb_ + vo_), (LAS unsigned*)(lds + (bufoff) + ldsw + _i * 8192), 16, 0, 0); } } else { PG8_STAGE(bufoff, (gptr) + (half) * hstep, voffA); } } while (0)
#define PG8_LDA(dst, b, h) do { _Pragma("unroll") for (int m = 0; m < 4; ++m) _Pragma("unroll") for (int k = 0; k < 2; ++k) dst[m][k] = *(const LAS bf16x8*)(lds + PG8_SA(b, h) + aoff + m * 2048 + k * 1024); } while (0)
#define PG8_LDB(dst, b, h) do { _Pragma("unroll") for (int n = 0; n < 2; ++n) _Pragma("unroll") for (int k = 0; k < 2; ++k) dst[n][k] = *(const LAS bf16x8*)(lds + PG8_SB(b, h) + boff + n * 2048 + k * 1024); } while (0)
#define PG8_MMA(ai, bj, At, Bt) do { __builtin_amdgcn_s_setprio(1); _Pragma("unroll") for (int m = 0; m < 4; ++m) _Pragma("unroll") for (int n = 0; n < 2; ++n) _Pragma("unroll") for (int k = 0; k < 2; ++k) \
        acc[ai][bj][m][n] = __builtin_amdgcn_mfma_f32_16x16x32_bf16(Bt[n][k], At[m][k], acc[ai][bj][m][n], 0, 0, 0); __builtin_amdgcn_s_setprio(0); } while (0)
#define PG8_WAIT_V(n) asm volatile("s_waitcnt vmcnt(" #n ")" ::: "memory")
#define PG8_WAIT_L(n) asm volatile("s_waitcnt lgkmcnt(" #n ")" ::: "memory")
#define PG8_BAR __builtin_amdgcn_s_barrier()
#define PG8_SCHED __builtin_amdgcn_sched_barrier(0)
    Unit cur, nxt; int ui = 0;
    if (!S.next(0, cur)) return;
    f32x4 acc[2][2][4][2];
#pragma unroll
    for (int a = 0; a < 2; ++a)
#pragma unroll
        for (int b = 0; b < 2; ++b)
#pragma unroll
            for (int m = 0; m < 4; ++m)
#pragma unroll
                for (int n = 0; n < 2; ++n) acc[a][b][m][n] = (f32x4){0.f, 0.f, 0.f, 0.f};
    bf16x8 At[4][2], B0[2][2], B1[2][2];
    const char* cA = S.aptr(cur); const char* cB = S.bptr(cur);
    PG8_TOK(vAc, cur);
    if constexpr (GA) { Unit u1_; if (S.next(1, u1_)) { PG8_TOK(vAn, u1_); } else { _Pragma("unroll") for (int h_ = 0; h_ < 2; ++h_) _Pragma("unroll") for (int i_ = 0; i_ < 2; ++i_) vAn[h_][i_] = vAc[h_][i_]; } }
    PG8_STAGE(PG8_SB(0, 0), cB, voffB); PG8_STAGE_A(PG8_SA(0, 0), cA, 0, 0, false); PG8_STAGE(PG8_SB(0, 1), cB + hstep, voffB); PG8_STAGE_A(PG8_SA(0, 1), cA, 0, 1, false);
    if (wr == 1) PG8_BAR;
    PG8_WAIT_V(4); PG8_BAR;
    PG8_STAGE(PG8_SB(1, 0), cB + kstep, voffB); PG8_STAGE_A(PG8_SA(1, 0), cA + kstep, kstep, 0, false); PG8_STAGE(PG8_SB(1, 1), cB + hstep + kstep, voffB);
    PG8_WAIT_V(6); PG8_BAR;
    for (;;) {
        const bool has_next = S.next(ui + 1, nxt);
        const char* nA = has_next ? S.aptr(nxt) : cA; const char* nB = has_next ? S.bptr(nxt) : cB;
        for (int t = 0; t < nt; t += 2) {
            const bool last = (t == nt - 2);
            const char* a1 = cA + (size_t)(t + 1) * kstep;
            const char* a2 = last ? nA : cA + (size_t)(t + 2) * kstep; const char* b2 = last ? nB : cB + (size_t)(t + 2) * kstep;
            const char* a3 = a2 + kstep; const char* b3 = b2 + kstep;
            const size_t k1 = (size_t)(t + 1) * kstep, k2 = last ? 0 : (size_t)(t + 2) * kstep, k3 = k2 + kstep;
            PG8_LDB(B0, 0, 0); PG8_SCHED; PG8_LDA(At, 0, 0); PG8_STAGE_A(PG8_SA(1, 1), a1, k1, 1, false);
            PG8_WAIT_L(8); PG8_BAR; PG8_WAIT_L(0); PG8_MMA(0, 0, At, B0); PG8_BAR; PG8_SCHED;
            PG8_LDB(B1, 0, 1); PG8_STAGE(PG8_SB(0, 0), b2, voffB);
            PG8_BAR; PG8_WAIT_L(0); PG8_MMA(0, 1, At, B1); PG8_BAR;
            PG8_LDA(At, 0, 1); PG8_STAGE_A(PG8_SA(0, 0), a2, k2, 0, last);
            PG8_BAR; PG8_WAIT_L(0); PG8_MMA(1, 0, At, B0); PG8_BAR; PG8_SCHED;
            PG8_STAGE(PG8_SB(0, 1), b2 + hstep, voffB);
            PG8_WAIT_V(6); PG8_BAR; PG8_MMA(1, 1, At, B1); PG8_BAR;
            PG8_LDB(B0, 1, 0); PG8_SCHED; PG8_LDA(At, 1, 0); PG8_STAGE_A(PG8_SA(0, 1), a2, k2, 1, last);
            PG8_WAIT_L(8); PG8_BAR; PG8_WAIT_L(0); PG8_MMA(0, 0, At, B0); PG8_BAR; PG8_SCHED;
            PG8_LDB(B1, 1, 1); PG8_STAGE(PG8_SB(1, 0), b3, voffB);
            PG8_BAR; PG8_WAIT_L(0); PG8_MMA(0, 1, At, B1); PG8_BAR;
            PG8_LDA(At, 1, 1); PG8_STAGE_A(PG8_SA(1, 0), a3, k3, 0, last);
            PG8_BAR; PG8_WAIT_L(0); PG8_MMA(1, 0, At, B0); PG8_BAR; PG8_SCHED;
            PG8_STAGE(PG8_SB(1, 1), b3 + hstep, voffB);
            PG8_WAIT_V(6); PG8_BAR; PG8_MMA(1, 1, At, B1); PG8_BAR;
        }
        E(acc, cur, wr, wc, fr, fq);
        if (!has_next) break;
        if constexpr (GA) { Unit u2_; if (S.next(ui + 2, u2_)) { PG8_TOK(vAnn, u2_); } else { _Pragma("unroll") for (int h_ = 0; h_ < 2; ++h_) _Pragma("unroll") for (int i_ = 0; i_ < 2; ++i_) vAnn[h_][i_] = vAn[h_][i_]; } }
#pragma unroll
        for (int a = 0; a < 2; ++a)
#pragma unroll
            for (int b = 0; b < 2; ++b)
#pragma unroll
                for (int m = 0; m < 4; ++m)
#pragma unroll
                    for (int n = 0; n < 2; ++n) acc[a][b][m][n] = (f32x4){0.f, 0.f, 0.f, 0.f};
        cur = nxt; cA = nA; cB = nB; ++ui;
        if constexpr (GA) { _Pragma("unroll") for (int h_ = 0; h_ < 2; ++h_) _Pragma("unroll") for (int i_ = 0; i_ < 2; ++i_) { vAc[h_][i_] = vAn[h_][i_]; vAn[h_][i_] = vAnn[h_][i_]; } }
    }
    PG8_WAIT_V(0);
    if (wr == 0) PG8_BAR;
    PG8_BAR;
#undef PG8_SA
#undef PG8_SB
#undef PG8_STAGE
#undef PG8_STAGE_A
#undef PG8_TOK
#undef PG8_LDA
#undef PG8_LDB
#undef PG8_MMA
#undef PG8_WAIT_V
#undef PG8_WAIT_L
#undef PG8_BAR
#undef PG8_SCHED
}
}

#define XB_TMO      128
#define XB_XCNT(j)  (256  + 64 * (j))
#define XB_XSUB(j)  (1280 + 64 * (j))
#define XB_XGEN(j)  (2304 + 64 * (j))
#define XB_TOP      3328
#define XB_TOPGEN   3392
#define XCD_BAR_WORDS 3456
#define XB_SPIN_CAP (1u << 20)
__device__ __forceinline__ unsigned xb_ld(unsigned* p)              { return __hip_atomic_load(p, __ATOMIC_RELAXED, __HIP_MEMORY_SCOPE_AGENT); }
__device__ __forceinline__ unsigned xb_add(unsigned* p, unsigned v) { return __hip_atomic_fetch_add(p, v, __ATOMIC_RELAXED, __HIP_MEMORY_SCOPE_AGENT); }
__device__ __forceinline__ unsigned xb_xcc_id() { return (unsigned)__builtin_amdgcn_s_getreg((3 << 11) | 20) & 0xFu; }
#define XB_SPIN(cond, bar) do { unsigned _sp = 0; while (cond) { __builtin_amdgcn_s_sleep(1); \
    if ((++_sp & 255u) == 0u) { if (xb_ld(&(bar)[XB_TMO])) break; if (_sp > XB_SPIN_CAP) { atomicAdd(&(bar)[XB_TMO], 1u); break; } } } } while (0)
struct XcdBarrier { unsigned* bar; unsigned x; volatile LAS unsigned* st; };
__device__ __forceinline__ XcdBarrier xcd_barrier_post(unsigned* bar, volatile LAS unsigned* st) {
    XcdBarrier b; b.bar = bar; b.x = xb_xcc_id(); b.st = st;
    if (threadIdx.x == 0) (void)xb_add(&bar[XB_XCNT(b.x)], 1u);
    return b;
}
__device__ __forceinline__ void xcd_barrier_complete(unsigned* bar, unsigned x, unsigned& nloc, unsigned& nx) {
    const unsigned G = gridDim.x * gridDim.y * gridDim.z;
    unsigned sum, cnt, mine, sp = 0u;
    for (;;) {
        sum = 0u; cnt = 0u; mine = 0u;
#pragma unroll
        for (unsigned j = 0; j < 16; ++j) { const unsigned c = xb_ld(&bar[XB_XCNT(j)]); sum += c; cnt += (c > 0u) ? 1u : 0u; mine = (j == x) ? c : mine; }
        if (sum == G) break;
        __builtin_amdgcn_s_sleep(1);
        if ((++sp & 255u) == 0u) { if (xb_ld(&bar[XB_TMO])) break; if (sp > XB_SPIN_CAP) { atomicAdd(&bar[XB_TMO], 1u); break; } }
    }
    nloc = mine > 0u ? mine : 1u; nx = cnt > 0u ? cnt : 1u;
}
__device__ __forceinline__ void xcd_barrier(const XcdBarrier& b) {
    asm volatile("s_waitcnt vmcnt(0)" ::: "memory");
    __syncthreads();
    if (threadIdx.x == 0) {
        unsigned* bar = b.bar;
        __builtin_amdgcn_s_waitcnt(0);
        unsigned nloc = b.st[0], nx = b.st[1];
        if (nloc == 0u) { xcd_barrier_complete(bar, b.x, nloc, nx); b.st[0] = nloc; b.st[1] = nx; }
        const unsigned old = xb_add(&bar[XB_XSUB(b.x)], 1u);
        const unsigned gen = old / nloc;
        if (old + 1u == (gen + 1u) * nloc) {
            __builtin_amdgcn_fence(__ATOMIC_RELEASE, "agent");
            asm volatile("s_waitcnt vmcnt(0)" ::: "memory");
            const unsigned og = xb_add(&bar[XB_TOP], 1u);
            const unsigned tg = og / nx;
            if (og + 1u == (tg + 1u) * nx) xb_add(&bar[XB_TOPGEN], 1u);
            else XB_SPIN(xb_ld(&bar[XB_TOPGEN]) == tg, bar);
            __builtin_amdgcn_fence(__ATOMIC_ACQUIRE, "agent");
            xb_add(&bar[XB_XGEN(b.x)], 1u);
            asm volatile("s_waitcnt vmcnt(0)" ::: "memory");
        } else {
            XB_SPIN(xb_ld(&bar[XB_XGEN(b.x)]) == gen, bar);
            __builtin_amdgcn_fence(__ATOMIC_ACQUIRE, "agent");
            asm volatile("s_waitcnt vmcnt(0)" ::: "memory");
        }
    }
    __syncthreads();
}

struct Params {
    const float* in[27];
    float* out;
    unsigned char* ws;
    int ph_lo, ph_hi;
};
typedef const __attribute__((address_space(4))) Params* PP;
enum { I_X = 0, I_C, I_CTX, I_CCTX, I_WMOD, I_BMOD, I_NMIXG, I_WIN, I_QNG, I_KNG, I_LQ1, I_LK1, I_LQ2, I_LK2, I_SUBLN, I_CONVW, I_ALOG, I_DTB, I_GDNG, I_WOUT, I_NFFNG, I_RW, I_RB, I_WGU, I_BGU, I_WD, I_BD };

__device__ __forceinline__ const float* hrow_in(PP p, int layer, int r) {
    if (layer == 0) return r < NLAT ? p->in[I_X] + (size_t)r * D : p->in[I_CTX] + (size_t)(r - NLAT) * D;
    return (const float*)(p->ws + WS_H) + (size_t)r * D;
}
__device__ __forceinline__ int mod_sel(int r) { return r < NLAT ? (r >= SEQL ? 1 : 0) : 2; }

__device__ __forceinline__ void transpose_item(const float* W, size_t ldw, int k0, int n0, bf16_t* WT, int drow0, LAS float* scr, int lane) {
#pragma unroll 8
    for (int i = 0; i < 32; ++i) { const int kk = 2 * i + (lane >> 5); scr[kk * 33 + (lane & 31)] = W[(size_t)(k0 + kk) * ldw + n0 + (lane & 31)]; }
    LDS_WAIT(); asm volatile("" ::: "memory");
    const int c = lane & 7;
#pragma unroll
    for (int j = 0; j < 4; ++j) { const int n = (lane >> 3) + 8 * j; const LAS float* s = scr + (8 * c) * 33 + n;
        u32x4 o; o.x = pk2(s[0 * 33], s[1 * 33]); o.y = pk2(s[2 * 33], s[3 * 33]); o.z = pk2(s[4 * 33], s[5 * 33]); o.w = pk2(s[6 * 33], s[7 * 33]);
        *(u32x4*)(WT + (size_t)(drow0 + n) * 1024 + k0 + 8 * c) = o; }
    LDS_WAIT(); asm volatile("" ::: "memory");
}

__device__ __forceinline__ void phase_prologue(PP p, LAS unsigned char* lds) {
    int tid = threadIdx.x, bid = blockIdx.x, gdim = gridDim.x; asm volatile("" : "+v"(tid), "+s"(bid), "+s"(gdim)); const int lane = tid & 63, wave = __builtin_amdgcn_readfirstlane(tid >> 6);
    float* cf = (float*)(p->ws + WS_CONST);
    if (bid < 192) {
        const int l = bid / 96, cg = bid % 96;
        LAS float* sl = (LAS float*)lds;
        LAS float* red = sl + 3 * 1024;
        for (int i = tid; i < 3 * 1024; i += NTHR) { const int s = i >> 10, k = i & 1023; const float v = s < 2 ? p->in[I_C][s * D + k] : p->in[I_CCTX][k]; sl[i] = silu_f(v); }
        __syncthreads();
        const float* wm = p->in[I_WMOD] + (size_t)l * D * 6144 + cg * 64 + lane;
        float a0 = 0.f, a1 = 0.f, a2 = 0.f;
#pragma unroll 16
        for (int kk = 0; kk < 128; ++kk) { const int k = wave * 128 + kk; const float w = wm[(size_t)k * 6144]; a0 += sl[k] * w; a1 += sl[1024 + k] * w; a2 += sl[2048 + k] * w; }
        red[(wave * 3 + 0) * 64 + lane] = a0; red[(wave * 3 + 1) * 64 + lane] = a1; red[(wave * 3 + 2) * 64 + lane] = a2;
        __syncthreads();
        if (wave < 3) { float s = 0.f;
#pragma unroll
            for (int w = 0; w < 8; ++w) s += red[(w * 3 + wave) * 64 + lane];
            cf[CF_MODV + (l * 3 + wave) * 6144 + cg * 64 + lane] = s + p->in[I_BMOD][l * 6144 + cg * 64 + lane]; }
        __syncthreads();
    }
    if (bid >= 192 && bid < 202) {
        const int idx = (bid - 192) * NTHR + tid;
        if (idx < 320 * 16) { const int pos = idx >> 4, i = idx & 15; const float invf = powf(10000.f, -(float)i / 16.f);
            const float posf = (float)(pos < 256 ? pos : pos - 256); const float ang = posf * invf; const double a = (double)ang;
            const float cs = (float)cos(a), sn = (float)sin(a);
            if (pos < 256) { cf[CF_ROPE + pos * 16 + i] = cs; cf[CF_ROPE + 4096 + pos * 16 + i] = sn; }
            else { cf[CF_ROPE + 8192 + (pos - 256) * 16 + i] = cs; cf[CF_ROPE + 9216 + (pos - 256) * 16 + i] = sn; } }
    }
    if (bid == 202 && wave < 2) {
        const int l = wave;
        const float d1 = wave_sum(p->in[I_LQ1][l * 64 + lane] * p->in[I_LK1][l * 64 + lane]);
        const float d2 = wave_sum(p->in[I_LQ2][l * 64 + lane] * p->in[I_LK2][l * 64 + lane]);
        const float lam_init = 0.8f - 0.6f * expf(-0.3f * (float)l);
        const float mq = wave_max(fabsf(p->in[I_QNG][l * 64 + lane])), mk = wave_max(fabsf(p->in[I_KNG][l * 64 + lane]));
        if (lane == 0) { cf[CF_SC + l * 16 + 0] = expf(d1) - expf(d2) + lam_init; cf[CF_SC + l * 16 + 1] = LOG2E * 0.125f * 64.f * mq * mk * 1.0001f + 0.01f; cf[CF_SC + l * 16 + 2] = 1.f - lam_init; }
    }
    {
        LAS float* scr = (LAS float*)(lds + wave * 16384);
        const int gw = bid * NWAVES + wave, NGW = gdim * NWAVES;
        constexpr int I_IN = 16 * 112, I_OUT = 16 * 32, I_GU = 16 * 64, I_DN = 16 * 32;
        constexpr int PER_LAYER = I_IN + I_OUT + NEXP * I_GU + NEXP * I_DN;
        for (int it = gw; it < 2 * PER_LAYER; it += NGW) {
            const int l = it / PER_LAYER; int r = it % PER_LAYER;
            if (r < I_IN) { const int kb = r / 112, nb = r % 112;
                transpose_item(p->in[I_WIN] + (size_t)l * D * INC, INC, kb * 64, nb * 32, (bf16_t*)(p->ws + WS_WIN) + (size_t)l * PW * 1024, nb * 32, scr, lane); continue; }
            r -= I_IN;
            if (r < I_OUT) { const int kb = r / 32, nb = r % 32;
                transpose_item(p->in[I_WOUT] + (size_t)l * D * D, D, kb * 64, nb * 32, (bf16_t*)(p->ws + WS_WOUT) + (size_t)l * D * 1024, nb * 32, scr, lane); continue; }
            r -= I_OUT;
            if (r < NEXP * I_GU) { const int e = r / I_GU, q = r % I_GU, kb = q / 64, nb = q % 64; const int n0 = nb * 32, j = n0 & 1023, isup = n0 >> 10;
                const int drow = (j >> 7) * 256 + isup * 128 + (j & 127);
                transpose_item(p->in[I_WGU] + (size_t)(l * NEXP + e) * D * 2048, 2048, kb * 64, n0, (bf16_t*)(p->ws + WS_WGU) + (size_t)(l * NEXP + e) * 2048 * 1024, drow, scr, lane); continue; }
            r -= NEXP * I_GU;
            { const int e = r / I_DN, q = r % I_DN, kb = q / 32, nb = q % 32;
                transpose_item(p->in[I_WD] + (size_t)(l * NEXP + e) * D * D, D, kb * 64, nb * 32, (bf16_t*)(p->ws + WS_WD) + (size_t)(l * NEXP + e) * D * 1024, nb * 32, scr, lane); }
        }
    }
}

struct PlainSched {
    const char* A; const char* Bt; int K, nM, nN, nwg, G, c;
    __device__ __forceinline__ void init(const void* A_, const void* Bt_, int K_, int nM_, int nN_, int G_, int c_) { A = (const char*)A_; Bt = (const char*)Bt_; K = K_; nM = nM_; nN = nN_; nwg = nM * nN; G = G_; c = c_; }
    __device__ __forceinline__ bool next(int i, pg8::Unit& u) const {
        const long L = (long)i * G + c; if (L >= nwg) return false;
        int wgid = (int)L; { const int q = nwg / 8, r = nwg % 8, xcd = wgid % 8, off = wgid / 8; wgid = (xcd < r ? xcd * (q + 1) : r * (q + 1) + (xcd - r) * q) + off; }
        const int nig = 8 * nN, gid = wgid / nig, fm = gid * 8, gsz = (nM - fm) < 8 ? (nM - fm) : 8;
        u.pm = fm + ((wgid % nig) % gsz); u.pn = (wgid % nig) / gsz; return true;
    }
    __device__ __forceinline__ const char* aptr(const pg8::Unit& u) const { return A + (size_t)u.pm * 256 * K * 2; }
    __device__ __forceinline__ const char* bptr(const pg8::Unit& u) const { return Bt + (size_t)u.pn * 256 * K * 2; }
};
struct MoeSched {
    const char* A; const char* W; const int* blk_e; int nblk, nN, G, c;
    __device__ __forceinline__ bool next(int i, pg8::Unit& u) const {
        const int x = c & 7, w = c >> 3, nw = G >> 3;
        const int b0 = (int)(((long)nblk * x) >> 3), b1 = (int)(((long)nblk * (x + 1)) >> 3);
        const int j = i * nw + w, pm = b0 + j / nN; if (pm >= b1) return false;
        u.pm = pm; u.pn = j % nN; return true;
    }
    const int* tok;
    __device__ __forceinline__ const char* aptr(const pg8::Unit& u) const { return A + (size_t)u.pm * 256 * 1024 * 2; }
    __device__ __forceinline__ const char* abase() const { return A; }
    __device__ __forceinline__ const int* atok(const pg8::Unit& u) const { return tok + u.pm * 256; }
    __device__ __forceinline__ const char* bptr(const pg8::Unit& u) const { const int e = ((const __attribute__((address_space(4))) int*)blk_e)[u.pm];
        return W + ((size_t)e * nN + u.pn) * 256 * 1024 * 2; }
};
struct EpiStoreBf16 {
    static constexpr bool PERM = true;
    bf16_t* O; int ldc;
    __device__ __forceinline__ void operator()(const f32x4 (&acc)[2][2][4][2], const pg8::Unit& u, int wr, int wc, int fr, int fq) const {
        const int row0 = u.pm * 256 + wr * 64 + fr, col0 = u.pn * 256 + wc * 32 + 8 * fq;
#pragma unroll
        for (int ai = 0; ai < 2; ++ai)
#pragma unroll
            for (int m = 0; m < 4; ++m) { bf16_t* rowp = O + (size_t)(row0 + ai * 128 + m * 16) * ldc + col0;
#pragma unroll
                for (int bj = 0; bj < 2; ++bj) { const f32x4 v0 = acc[ai][bj][m][0], v1 = acc[ai][bj][m][1];
                    u32x4 w; w.x = cvt_pk_bf16(v0[0], v0[1]); w.y = cvt_pk_bf16(v0[2], v0[3]); w.z = cvt_pk_bf16(v1[0], v1[1]); w.w = cvt_pk_bf16(v1[2], v1[3]);
                    *(u32x4*)(rowp + bj * 128) = w; } }
    }
};
struct EpiResidual {
    static constexpr bool PERM = false;
    PP p; int layer; const float* gate;
    __device__ __forceinline__ void operator()(const f32x4 (&acc)[2][2][4][2], const pg8::Unit& u, int wr, int wc, int fr, int fq) const {
        const int row0 = u.pm * 256 + wr * 64 + fr, col0 = u.pn * 256 + wc * 32 + 4 * fq;
        float* H = (float*)(p->ws + WS_H);
#pragma unroll
        for (int ai = 0; ai < 2; ++ai)
#pragma unroll
            for (int m = 0; m < 4; ++m) { const int row = row0 + ai * 128 + m * 16; const float* hin = hrow_in(p, layer, row) + col0; const float* g = gate + mod_sel(row) * 6144 + col0;
                float* ho = H + (size_t)row * D + col0;
#pragma unroll
                for (int bj = 0; bj < 2; ++bj)
#pragma unroll
                    for (int n = 0; n < 2; ++n) { const f32x4 hv = *(const f32x4*)(hin + bj * 128 + n * 16), gv = *(const f32x4*)(g + bj * 128 + n * 16);
                        *(f32x4*)(ho + bj * 128 + n * 16) = hv + gv * acc[ai][bj][m][n]; } }
    }
};
struct EpiGateUp {
    static constexpr bool PERM = true;
    bf16_t* ACT; const float* bgu; const int* blk_e;
    __device__ __forceinline__ void operator()(const f32x4 (&acc)[2][2][4][2], const pg8::Unit& u, int wr, int wc, int fr, int fq) const {
        const int row0 = u.pm * 256 + wr * 64 + fr, col0 = u.pn * 128 + wc * 32 + 8 * fq; const int e = blk_e[u.pm];
        const float* bg = bgu + (size_t)e * 2048 + col0; const float* bu = bg + 1024;
        f32x4 bgv[2], buv[2];
#pragma unroll
        for (int n = 0; n < 2; ++n) { bgv[n] = *(const f32x4*)(bg + 4 * n); buv[n] = *(const f32x4*)(bu + 4 * n); }
#pragma unroll
        for (int ai = 0; ai < 2; ++ai)
#pragma unroll
            for (int m = 0; m < 4; ++m) { float o[8];
#pragma unroll
                for (int n = 0; n < 2; ++n)
#pragma unroll
                    for (int j = 0; j < 4; ++j) { float g = acc[ai][0][m][n][j] + bgv[n][j], up = acc[ai][1][m][n][j] + buv[n][j];
                        g = fminf(g, 7.f); up = fminf(fmaxf(up, -7.f), 7.f);
                        const float glu = g * __builtin_amdgcn_rcpf(1.f + __builtin_amdgcn_exp2f(-1.702f * LOG2E * g)); o[n * 4 + j] = (up + 1.f) * glu; }
                u32x4 w; w.x = cvt_pk_bf16(o[0], o[1]); w.y = cvt_pk_bf16(o[2], o[3]); w.z = cvt_pk_bf16(o[4], o[5]); w.w = cvt_pk_bf16(o[6], o[7]);
                *(u32x4*)(ACT + (size_t)(row0 + ai * 128 + m * 16) * 1024 + col0) = w; }
    }
};
struct EpiDown {
    static constexpr bool PERM = true;
    bf16_t* Y; const float* bd; const int* blk_e; const float* sgate;
    __device__ __forceinline__ void operator()(const f32x4 (&acc)[2][2][4][2], const pg8::Unit& u, int wr, int wc, int fr, int fq) const {
        const int row0 = u.pm * 256 + wr * 64 + fr, col0 = u.pn * 256 + wc * 32 + 8 * fq; const int e = blk_e[u.pm];
        const float* b = bd + (size_t)e * 1024 + col0;
        f32x4 bv[2][2];
#pragma unroll
        for (int bj = 0; bj < 2; ++bj)
#pragma unroll
            for (int n = 0; n < 2; ++n) bv[bj][n] = *(const f32x4*)(b + bj * 128 + 4 * n);
#pragma unroll
        for (int ai = 0; ai < 2; ++ai)
#pragma unroll
            for (int m = 0; m < 4; ++m) { const int row = row0 + ai * 128 + m * 16; const float sg = sgate[row]; bf16_t* rowp = Y + (size_t)row * 1024 + col0;
#pragma unroll
                for (int bj = 0; bj < 2; ++bj) { const f32x4 v0 = (acc[ai][bj][m][0] + bv[bj][0]) * sg, v1 = (acc[ai][bj][m][1] + bv[bj][1]) * sg;
                    u32x4 w; w.x = cvt_pk_bf16(v0[0], v0[1]); w.y = cvt_pk_bf16(v0[2], v0[3]); w.z = cvt_pk_bf16(v1[0], v1[1]); w.w = cvt_pk_bf16(v1[2], v1[3]);
                    *(u32x4*)(rowp + bj * 128) = w; } }
    }
};

__device__ __forceinline__ void norm_mod_row(const float* hrow, const float* g, const float* shift, const float* scale, int lane, f32x4 (&u)[4]) {
    float ss = 0.f;
#pragma unroll
    for (int j = 0; j < 4; ++j) { u[j] = *(const f32x4*)(hrow + 4 * lane + 256 * j); ss += (u[j][0] * u[j][0] + u[j][1] * u[j][1]) + (u[j][2] * u[j][2] + u[j][3] * u[j][3]); }
    const float rstd = rsqrtf(wave_sum(ss) * (1.f / D) + EPS);
#pragma unroll
    for (int j = 0; j < 4; ++j) { const int c = 4 * lane + 256 * j; const f32x4 gv = *(const f32x4*)(g + c), sh = *(const f32x4*)(shift + c), sc = *(const f32x4*)(scale + c);
        u[j] = (u[j] * rstd) * gv * (sc + 1.f) + sh; }
}
__device__ __forceinline__ void store_row_bf16(bf16_t* orow, int lane, const f32x4 (&u)[4]) {
#pragma unroll
    for (int j = 0; j < 4; ++j) { u32x2 w; w.x = cvt_pk_bf16(u[j][0], u[j][1]); w.y = cvt_pk_bf16(u[j][2], u[j][3]); *(u32x2*)(orow + 4 * lane + 256 * j) = w; }
}

__device__ __forceinline__ void phase_norm_mix(PP p, int layer, LAS unsigned char* lds) {
    int tid = threadIdx.x, bid = blockIdx.x, gdim = gridDim.x; asm volatile("" : "+v"(tid), "+s"(bid), "+s"(gdim)); const int lane = tid & 63, wave = __builtin_amdgcn_readfirstlane(tid >> 6);
    LAS float* wab = (LAS float*)lds;
    const float* win = p->in[I_WIN] + (size_t)layer * D * INC;
    for (int i = tid; i < 16 * 1024; i += NTHR) { const int k = i >> 4, j = i & 15; wab[j * 1024 + k] = win[(size_t)k * INC + PW + j]; }
    __syncthreads();
    const float* cf = (const float*)(p->ws + WS_CONST);
    const float* gn = p->in[I_NMIXG] + layer * D;
    float ea = 0.f, dtb = 0.f; if (lane < 8) { ea = -__expf(p->in[I_ALOG][layer * 8 + lane]); dtb = p->in[I_DTB][layer * 8 + lane]; }
    for (int r = bid * NWAVES + wave; r < NTOK; r += gdim * NWAVES) {
        const float* mv = cf + CF_MODV + (layer * 3 + mod_sel(r)) * 6144;
        f32x4 u[4]; norm_mod_row(hrow_in(p, layer, r), gn, mv, mv + 1024, lane, u);
        store_row_bf16((bf16_t*)(p->ws + WS_U) + (size_t)r * D, lane, u);
        float ab = 0.f;
#pragma unroll
        for (int j = 0; j < 16; ++j) { float s = 0.f;
#pragma unroll
            for (int q = 0; q < 4; ++q) { const f32x4 w = *(const LAS f32x4*)(wab + j * 1024 + 4 * lane + 256 * q); s += (u[q][0] * w[0] + u[q][1] * w[1]) + (u[q][2] * w[2] + u[q][3] * w[3]); }
            s = wave_sum(s); if (lane == j) ab = s; }
        float outv;
        if (lane < 8) { const float z = ab + dtb; const float sp = z > 20.f ? z : log1pf(__expf(z)); outv = ea * sp; }
        else outv = 1.f / (1.f + __expf(-ab));
        if (lane < 16) ((float*)(p->ws + WS_GB))[(size_t)r * 16 + lane] = outv;
    }
}

__device__ __forceinline__ void phase_prep(PP p, int layer) {
    int tid = threadIdx.x, bid = blockIdx.x, gdim = gridDim.x; asm volatile("" : "+v"(tid), "+s"(bid), "+s"(gdim)); const int lane = tid & 63, wave = __builtin_amdgcn_readfirstlane(tid >> 6);
    const float* cf = (const float*)(p->ws + WS_CONST);
    bf16_t* P = (bf16_t*)(p->ws + WS_P); bf16_t* G = (bf16_t*)(p->ws + WS_G);
    const float* cw = p->in[I_CONVW] + (size_t)layer * 5 * 1536;
    float gain[16];
    { const float* gsrc = (lane < 32 ? p->in[I_QNG] : p->in[I_KNG]) + layer * 64 + 16 * (lane & 3);
#pragma unroll
      for (int e = 0; e < 16; ++e) gain[e] = gsrc[e]; }
    const float qscale = lane < 32 ? 0.125f * LOG2E : 1.f;
    for (int r = bid * NWAVES + wave; r < NTOK; r += gdim * NWAVES) {
        bf16_t* prow = P + (size_t)r * PW + 16 * lane;
        const u32x4 w0 = *(const u32x4*)prow, w1 = *(const u32x4*)(prow + 8);
        float x[16];
#pragma unroll
        for (int e = 0; e < 4; ++e) { x[2 * e] = bflo(w0[e]); x[2 * e + 1] = bfhi(w0[e]); x[8 + 2 * e] = bflo(w1[e]); x[8 + 2 * e + 1] = bfhi(w1[e]); }
        float ss = 0.f;
#pragma unroll
        for (int e = 0; e < 16; ++e) ss += x[e] * x[e];
        ss += __shfl_xor(ss, 1); ss += __shfl_xor(ss, 2);
        const float rstd = rsqrtf(ss * (1.f / 64.f) + EPS);
#pragma unroll
        for (int e = 0; e < 16; ++e) x[e] = x[e] * rstd * gain[e];
        if (r < NLAT) {
            const int t = r & (SEQL - 1); const int pos = (lane & 2) ? (t & 63) : (t >> 6);
            const float* ct = cf + CF_ROPE + ((lane & 2) ? 8192 : 0) + pos * 16; const float* st = ct + ((lane & 2) ? 1024 : 4096);
            const bool second = lane & 1;
#pragma unroll
            for (int e = 0; e < 16; ++e) { const float other = __shfl_xor(x[e], 1); const float cs = ct[e], sn = st[e];
                x[e] = second ? (x[e] * cs + other * sn) : (x[e] * cs - other * sn); }
        }
        u32x4 o0, o1;
#pragma unroll
        for (int e = 0; e < 4; ++e) { o0[e] = cvt_pk_bf16(x[2 * e] * qscale, x[2 * e + 1] * qscale); o1[e] = cvt_pk_bf16(x[8 + 2 * e] * qscale, x[8 + 2 * e + 1] * qscale); }
        *(u32x4*)prow = o0; *(u32x4*)(prow + 8) = o1;
    }
    for (int r = bid * NWAVES + wave; r < NTOK; r += gdim * NWAVES) {
        int seg0, seglen; if (r < NLAT) { seg0 = r & ~(SEQL - 1); seglen = SEQL; } else { seg0 = NLAT + ((r - NLAT) & ~(CTXL - 1)); seglen = CTXL; }
        const int tpos = r - seg0;
#pragma unroll
        for (int grp = 0; grp < 3; ++grp) {
            const int c0 = grp * 512 + 8 * lane;
            float a[8];
#pragma unroll
            for (int e = 0; e < 8; ++e) a[e] = 0.f;
#pragma unroll
            for (int j = 0; j < 5; ++j) { const int tp = tpos + j - 2;
                if (tp >= 0 && tp < seglen) { const u32x4 w = *(const u32x4*)(P + (size_t)(seg0 + tp) * PW + 1536 + c0);
                    const f32x4 k0 = *(const f32x4*)(cw + j * 1536 + c0), k1 = *(const f32x4*)(cw + j * 1536 + c0 + 4);
                    a[0] += bflo(w[0]) * k0[0]; a[1] += bfhi(w[0]) * k0[1]; a[2] += bflo(w[1]) * k0[2]; a[3] += bfhi(w[1]) * k0[3];
                    a[4] += bflo(w[2]) * k1[0]; a[5] += bfhi(w[2]) * k1[1]; a[6] += bflo(w[3]) * k1[2]; a[7] += bfhi(w[3]) * k1[3]; } }
            float ss = 0.f;
#pragma unroll
            for (int e = 0; e < 8; ++e) { a[e] = silu_f(a[e]); ss += a[e] * a[e]; }
            if (grp < 2) { ss += __shfl_xor(ss, 1); ss += __shfl_xor(ss, 2); ss += __shfl_xor(ss, 4); ss += __shfl_xor(ss, 8);
                const float rn = rsqrtf(ss + EPS);
#pragma unroll
                for (int e = 0; e < 8; ++e) a[e] *= rn; }
            u32x4 o; o.x = cvt_pk_bf16(a[0], a[1]); o.y = cvt_pk_bf16(a[2], a[3]); o.z = cvt_pk_bf16(a[4], a[5]); o.w = cvt_pk_bf16(a[6], a[7]);
            *(u32x4*)(G + (size_t)r * 1536 + c0) = o;
        }
    }
}

typedef short v4i16c_t __attribute__((ext_vector_type(4)));
__device__ __forceinline__ s16x4 vtr_c(const LAS unsigned char* ptr) { return __builtin_bit_cast(s16x4, __builtin_amdgcn_ds_read_tr16_b64_v4i16((LAS v4i16c_t*)ptr)); }
__device__ __forceinline__ void gdn_task_rows(int task, int& b, int& h, int& dir, int& rstart, int& rstep) {
    const int chain = task / NCHUNK, n = task % NCHUNK; dir = chain & 1; h = (chain >> 1) & 3; b = chain >> 3;
    if (n < 4) { const int base = NLAT + b * CTXL; if (dir == 0) { rstart = base + 64 * n; rstep = 1; } else { rstart = base + CTXL - 1 - 64 * n; rstep = -1; } }
    else { const int base = b * SEQL, m = n - 4; if (dir == 0) { rstart = base + 64 * m; rstep = 1; } else { rstart = base + SEQL - 1 - 64 * m; rstep = -1; } }
}
constexpr int CWL_BYTES = 6144, CWL_STG = 2048;
__device__ __forceinline__ void phase_gdn_chunk(PP p, LAS unsigned char* lds) {
    int tid = threadIdx.x, bid = blockIdx.x, gdim = gridDim.x; asm volatile("" : "+v"(tid), "+s"(bid), "+s"(gdim)); const int lane = tid & 63, wave = __builtin_amdgcn_readfirstlane(tid >> 6), r32 = lane & 31, hi = lane >> 5;
    const bf16_t* G = (const bf16_t*)(p->ws + WS_G); const float* GB = (const float*)(p->ws + WS_GB);
    float* cf = (float*)(p->ws + WS_CONST);
    LAS unsigned char* wl = lds + wave * CWL_BYTES;
    LAS float* gcv = (LAS float*)wl;
    LAS unsigned char* stg = wl + CWL_STG;
    const LAS unsigned char* stgp = stg + ((lane >> 4) & 1) * 32 + (lane & 3) * 8 + (4 * hi + ((lane & 15) >> 2)) * 64;
    const LAS unsigned char* stgn = stg + ((lane >> 4) & 1) * 32 + (lane & 3) * 8 + (8 * hi + ((lane & 15) >> 2)) * 64;
    const float SCALE = 0.08838834764831845f;
    for (int task = bid * NWAVES + wave; task < NTASK; task += gdim * NWAVES) {
        int b, h, dir, rstart, rstep; gdn_task_rows(task, b, h, dir, rstart, rstep);
        unsigned char* chb = p->ws + WS_CH + (size_t)task * CH_TASK_BYTES;
        const int myrow = rstart + rstep * lane;
        float gt = GB[(size_t)myrow * 16 + dir * 4 + h]; const float bt = GB[(size_t)myrow * 16 + 8 + dir * 4 + h];
#pragma unroll
        for (int o = 1; o < 64; o <<= 1) { const float t = __shfl_up(gt, o); if (lane >= o) gt += t; }
        const float glast = __shfl(gt, 63), egt = __expf(gt), begt = bt * egt, kdt = __expf(glast - gt);
        gcv[lane] = gt; gcv[64 + lane] = bt;
        if (lane == 0) cf[CF_EGL + task] = __expf(glast);
        const float gcs0 = __shfl(gt, r32), gcs1 = __shfl(gt, 32 + r32);
        const size_t rowA0 = (size_t)(rstart + rstep * r32) * 1536, rowA1 = (size_t)(rstart + rstep * (32 + r32)) * 1536;
        bf16x8 kfr[2][8];
        { const bf16_t* gk = G + 512 + h * 128 + 8 * hi;
#pragma unroll
          for (int ks = 0; ks < 8; ++ks) { kfr[0][ks] = *(const bf16x8*)(gk + rowA0 + 16 * ks); kfr[1][ks] = *(const bf16x8*)(gk + rowA1 + 16 * ks); } }
        LDS_WAIT();
        f32x16 am00, am10, am11;
#define KK_TILE(dst, mi, ni, gcs_) do { f32x16 acc_ = (f32x16){}; \
            _Pragma("unroll") for (int ks = 0; ks < 8; ++ks) acc_ = MFMA32(kfr[mi][ks], kfr[ni][ks], acc_); \
            _Pragma("unroll") for (int q = 0; q < 4; ++q) { const f32x4 g4 = *(const LAS f32x4*)(gcv + 32 * (mi) + 8 * q + 4 * hi), b4 = *(const LAS f32x4*)(gcv + 64 + 32 * (mi) + 8 * q + 4 * hi); \
                _Pragma("unroll") for (int e = 0; e < 4; ++e) { const int cc = 32 * (mi) + 8 * q + 4 * hi + e, ss = 32 * (ni) + r32; \
                    dst[4 * q + e] = (ss < cc) ? -b4[e] * acc_[4 * q + e] * __expf(fminf(g4[e] - (gcs_), 0.f)) : 0.f; } } } while (0)
        KK_TILE(am00, 0, 0, gcs0); KK_TILE(am10, 1, 0, gcs0); KK_TILE(am11, 1, 1, gcs1);
        __builtin_amdgcn_sched_barrier(0);
        { bf16x8 qfr[8]; const bf16_t* gq = G + h * 128 + 8 * hi;
#define KQ_TILE(n, mo, gcc_) do { f32x16 acc_ = (f32x16){}; \
            _Pragma("unroll") for (int ks = 0; ks < 8; ++ks) acc_ = MFMA32(kfr[n][ks], qfr[ks], acc_); \
            _Pragma("unroll") for (int q = 0; q < 4; ++q) { const f32x4 g4 = *(const LAS f32x4*)(gcv + 32 * (n) + 8 * q + 4 * hi); \
                _Pragma("unroll") for (int e = 0; e < 4; ++e) { const int ss = 32 * (n) + 8 * q + 4 * hi + e, cc = 32 * (mo) + r32; \
                    acc_[4 * q + e] = (ss <= cc) ? SCALE * acc_[4 * q + e] * __expf(fminf((gcc_) - g4[e], 0.f)) : 0.f; } } \
            _Pragma("unroll") for (int s = 0; s < 2; ++s) { u32x4 o_; o_.x = cvt_pk_bf16(acc_[8 * s], acc_[8 * s + 1]); o_.y = cvt_pk_bf16(acc_[8 * s + 2], acc_[8 * s + 3]); o_.z = cvt_pk_bf16(acc_[8 * s + 4], acc_[8 * s + 5]); o_.w = cvt_pk_bf16(acc_[8 * s + 6], acc_[8 * s + 7]); \
                *(u32x4*)(chb + CH_AF + (((mo) * 2 + (n)) * 2 + s) * 1024 + lane * 16) = o_; } } while (0)
#pragma unroll
          for (int ks = 0; ks < 8; ++ks) qfr[ks] = *(const bf16x8*)(gq + rowA0 + 16 * ks);
          KQ_TILE(0, 0, gcs0); __builtin_amdgcn_sched_barrier(0);
#pragma unroll
          for (int ks = 0; ks < 8; ++ks) qfr[ks] = *(const bf16x8*)(gq + rowA1 + 16 * ks);
          KQ_TILE(0, 1, gcs1); KQ_TILE(1, 1, gcs1); }
        __builtin_amdgcn_sched_barrier(0);
        { const float eg0 = __shfl(egt, r32) * SCALE, eg1 = __shfl(egt, 32 + r32) * SCALE;
#pragma unroll
          for (int m = 0; m < 2; ++m) { const bf16_t* gq = G + (m ? rowA1 : rowA0) + h * 128 + 4 * hi; const float sc = m ? eg1 : eg0;
#pragma unroll
              for (int ts = 0; ts < 8; ++ts) { const u32x2 a = *(const u32x2*)(gq + 16 * ts), bq = *(const u32x2*)(gq + 16 * ts + 8); u32x4 o_;
                  o_.x = cvt_pk_bf16(bflo(a.x) * sc, bfhi(a.x) * sc); o_.y = cvt_pk_bf16(bflo(a.y) * sc, bfhi(a.y) * sc); o_.z = cvt_pk_bf16(bflo(bq.x) * sc, bfhi(bq.x) * sc); o_.w = cvt_pk_bf16(bflo(bq.y) * sc, bfhi(bq.y) * sc);
                  *(u32x4*)(chb + CH_QF + (m * 8 + ts) * 1024 + lane * 16) = o_; } } }
        __builtin_amdgcn_sched_barrier(0);
        float x[64]; int lane_v = lane; asm volatile("" : "+v"(lane_v));
#pragma unroll
        for (int i = 63; i >= 0; --i) { float a0 = (lane_v == i) ? 1.f : 0.f, a1 = 0.f;
#pragma unroll
            for (int m = 63; m > i; --m) { const int ml = m & 31, hm = (ml >> 2) & 1, rm = (ml >> 3) * 4 + (ml & 3), ln = (i & 31) + 32 * hm;
                const float tv = (m >= 32) ? ((i >= 32) ? am11[rm] : am10[rm]) : am00[rm];
                const float s_ = __builtin_bit_cast(float, __builtin_amdgcn_readlane(__builtin_bit_cast(int, tv), ln));
                if (m & 1) asm("v_fmac_f32 %0, %1, %2" : "+v"(a1) : "s"(s_), "v"(x[m])); else asm("v_fmac_f32 %0, %1, %2" : "+v"(a0) : "s"(s_), "v"(x[m])); }
            x[i] = a0 + a1; __builtin_amdgcn_sched_barrier(0); }
        __builtin_amdgcn_sched_barrier(0);
        bf16x8 F0[4], F1[4];
#pragma unroll
        for (int ks = 0; ks < 4; ++ks) { u32x4 f0, f1;
#pragma unroll
            for (int w = 0; w < 4; ++w) { const unsigned pa = cvt_pk_bf16(x[16 * ks + 2 * w], x[16 * ks + 2 * w + 1]), pb = cvt_pk_bf16(x[16 * ks + 8 + 2 * w], x[16 * ks + 8 + 2 * w + 1]);
                const auto sw = __builtin_amdgcn_permlane32_swap(pa, pb, false, false);
                f0[w] = sw[0]; f1[w] = sw[1]; }
            F0[ks] = __builtin_bit_cast(bf16x8, f0); F1[ks] = __builtin_bit_cast(bf16x8, f1); }
        __builtin_amdgcn_sched_barrier(0);
#define STAGE_PIECE(col0, scal) do { __builtin_amdgcn_sched_barrier(0); const bf16_t* src_ = G + (size_t)myrow * 1536 + (col0); LDS_WAIT(); \
            _Pragma("unroll") for (int q = 0; q < 4; ++q) { const u32x4 w_ = *(const u32x4*)(src_ + 8 * q); u32x4 o_; \
                o_.x = cvt_pk_bf16(bflo(w_.x) * (scal), bfhi(w_.x) * (scal)); o_.y = cvt_pk_bf16(bflo(w_.y) * (scal), bfhi(w_.y) * (scal)); o_.z = cvt_pk_bf16(bflo(w_.z) * (scal), bfhi(w_.z) * (scal)); o_.w = cvt_pk_bf16(bflo(w_.w) * (scal), bfhi(w_.w) * (scal)); \
                *(LAS u32x4*)(stg + lane * 64 + 16 * q) = o_; } LDS_WAIT(); } while (0)
#define TR_FRAG(ks) ({ const s16x4 lo_ = vtr_c(stgp + (ks) * 1024), hi_ = vtr_c(stgp + (ks) * 1024 + 512); (bf16x8){lo_[0], lo_[1], lo_[2], lo_[3], hi_[0], hi_[1], hi_[2], hi_[3]}; })
#define TR_NAT(ks) ({ const s16x4 lo_ = vtr_c(stgn + (ks) * 1024), hi_ = vtr_c(stgn + (ks) * 1024 + 256); (bf16x8){lo_[0], lo_[1], lo_[2], lo_[3], hi_[0], hi_[1], hi_[2], hi_[3]}; })
#pragma unroll
        for (int t = 0; t < 4; ++t) { STAGE_PIECE(512 + h * 128 + 32 * t, begt);
            f32x16 a0 = (f32x16){}, a1 = (f32x16){};
#pragma unroll
            for (int ks = 0; ks < 4; ++ks) { const bf16x8 fr = TR_NAT(ks); a0 = MFMA32(fr, F0[ks], a0); a1 = MFMA32(fr, F1[ks], a1); }
#pragma unroll
            for (int s = 0; s < 2; ++s) { u32x4 o0, o1;
                o0.x = cvt_pk_bf16(-a0[8 * s], -a0[8 * s + 1]); o0.y = cvt_pk_bf16(-a0[8 * s + 2], -a0[8 * s + 3]); o0.z = cvt_pk_bf16(-a0[8 * s + 4], -a0[8 * s + 5]); o0.w = cvt_pk_bf16(-a0[8 * s + 6], -a0[8 * s + 7]);
                o1.x = cvt_pk_bf16(-a1[8 * s], -a1[8 * s + 1]); o1.y = cvt_pk_bf16(-a1[8 * s + 2], -a1[8 * s + 3]); o1.z = cvt_pk_bf16(-a1[8 * s + 4], -a1[8 * s + 5]); o1.w = cvt_pk_bf16(-a1[8 * s + 6], -a1[8 * s + 7]);
                *(u32x4*)(chb + CH_WF + ((0 * 4 + t) * 2 + s) * 1024 + lane * 16) = o0; *(u32x4*)(chb + CH_WF + ((1 * 4 + t) * 2 + s) * 1024 + lane * 16) = o1; } }
#pragma unroll
        for (int nj = 0; nj < 4; ++nj) { STAGE_PIECE(1024 + h * 128 + 32 * nj, bt);
            f32x16 a0 = (f32x16){}, a1 = (f32x16){};
#pragma unroll
            for (int ks = 0; ks < 4; ++ks) { const bf16x8 fr = TR_NAT(ks); a0 = MFMA32(F0[ks], fr, a0); a1 = MFMA32(F1[ks], fr, a1); }
            float* uc = (float*)(chb + CH_UC) + ((nj * 2) * 64 + lane) * 16;
#pragma unroll
            for (int q = 0; q < 4; ++q) { *(f32x4*)(uc + 4 * q) = (f32x4){a0[4 * q], a0[4 * q + 1], a0[4 * q + 2], a0[4 * q + 3]}; *(f32x4*)(uc + 1024 + 4 * q) = (f32x4){a1[4 * q], a1[4 * q + 1], a1[4 * q + 2], a1[4 * q + 3]}; } }
#pragma unroll
        for (int t = 0; t < 4; ++t) { STAGE_PIECE(512 + h * 128 + 32 * t, kdt);
#pragma unroll
            for (int ms = 0; ms < 4; ++ms) { const bf16x8 fr = TR_FRAG(ms); *(bf16x8*)(chb + CH_KF + (t * 4 + ms) * 1024 + lane * 16) = fr; } }
        LDS_WAIT();
#undef KK_TILE
#undef KQ_TILE
#undef STAGE_PIECE
#undef TR_FRAG
#undef TR_NAT
    }
}

__device__ __forceinline__ void gdn_scan_chain(PP p, LAS unsigned char* lds, const int chain) {
    int tid = threadIdx.x; asm volatile("" : "+v"(tid)); const int lane = tid & 63, wave = __builtin_amdgcn_readfirstlane(tid >> 6), r32 = lane & 31, hi = lane >> 5;
    const float* cf = (const float*)(p->ws + WS_CONST);
    float* OG = (float*)(p->ws + WS_OG);
    constexpr int STG = 2 * CH_DMA_BYTES;
    const int dir = chain & 1, h = (chain >> 1) & 3;
    f32x16 S[4];
#pragma unroll
    for (int t = 0; t < 4; ++t) S[t] = (f32x16){};
    f32x16 Un[2]; float egn = 0.f;
#pragma unroll
    for (int m = 0; m < 2; ++m) Un[m] = (f32x16){};
#define LOAD_U(task_) do { const float* uc_ = (const float*)(p->ws + WS_CH + (size_t)(task_) * CH_TASK_BYTES + CH_UC) + ((wave * 2) * 64 + lane) * 16; \
        _Pragma("unroll") for (int m = 0; m < 2; ++m) _Pragma("unroll") for (int q = 0; q < 4; ++q) { const f32x4 t4 = *(const f32x4*)(uc_ + m * 1024 + 4 * q); Un[m][4 * q] = t4[0]; Un[m][4 * q + 1] = t4[1]; Un[m][4 * q + 2] = t4[2]; Un[m][4 * q + 3] = t4[3]; } \
        egn = cf[CF_EGL + (task_)]; } while (0)
#define STAGE_CHUNK(task_, bufi) do { const unsigned char* src_ = p->ws + WS_CH + (size_t)(task_) * CH_TASK_BYTES; const unsigned dst_ = lds_addr(lds + (bufi) * CH_DMA_BYTES); \
        _Pragma("unroll") for (int i = 0; i < 14; ++i) { const int pc = wave * 14 + i; glds16(src_ + pc * 1024 + lane * 16, dst_ + pc * 1024); } } while (0)
    if (wave < 4) { LOAD_U(chain * NCHUNK); STAGE_CHUNK(chain * NCHUNK, 0); }
    for (int n = 0; n < NCHUNK; ++n) {
        const int task = chain * NCHUNK + n;
        int bq, hq, dq, rstart, rstep; gdn_task_rows(task, bq, hq, dq, rstart, rstep);
        if (wave < 4) VM_WAIT();
        asm volatile("s_waitcnt lgkmcnt(0)\n\ts_barrier" ::: "memory");
        if (wave < 4) {
            f32x16 V[2], O[2];
#pragma unroll
            for (int m = 0; m < 2; ++m) { V[m] = Un[m]; O[m] = (f32x16){}; }
            const float egl = egn;
            if (n + 1 < NCHUNK) { LOAD_U(task + 1); STAGE_CHUNK(task + 1, (n + 1) & 1); }
            const LAS unsigned char* buf = lds + (n & 1) * CH_DMA_BYTES + lane * 16;
            bf16x8 Sb[4][2];
#pragma unroll
            for (int t = 0; t < 4; ++t)
#pragma unroll
                for (int s = 0; s < 2; ++s) { u32x4 w; w.x = cvt_pk_bf16(S[t][8 * s], S[t][8 * s + 1]); w.y = cvt_pk_bf16(S[t][8 * s + 2], S[t][8 * s + 3]); w.z = cvt_pk_bf16(S[t][8 * s + 4], S[t][8 * s + 5]); w.w = cvt_pk_bf16(S[t][8 * s + 6], S[t][8 * s + 7]);
                    Sb[t][s] = __builtin_bit_cast(bf16x8, w); }
#pragma unroll
            for (int m = 0; m < 2; ++m)
#pragma unroll
                for (int t = 0; t < 4; ++t)
#pragma unroll
                    for (int s = 0; s < 2; ++s) { const int f = (m * 4 + t) * 2 + s;
                        V[m] = MFMA32(*(const LAS bf16x8*)(buf + CH_WF + f * 1024), Sb[t][s], V[m]);
                        O[m] = MFMA32(*(const LAS bf16x8*)(buf + CH_QF + f * 1024), Sb[t][s], O[m]);
                        if (s == 1 && (t & 1)) __builtin_amdgcn_sched_barrier(0); }
            bf16x8 Vb[2][2];
#pragma unroll
            for (int m = 0; m < 2; ++m)
#pragma unroll
                for (int s = 0; s < 2; ++s) { u32x4 w; w.x = cvt_pk_bf16(V[m][8 * s], V[m][8 * s + 1]); w.y = cvt_pk_bf16(V[m][8 * s + 2], V[m][8 * s + 3]); w.z = cvt_pk_bf16(V[m][8 * s + 4], V[m][8 * s + 5]); w.w = cvt_pk_bf16(V[m][8 * s + 6], V[m][8 * s + 7]);
                    Vb[m][s] = __builtin_bit_cast(bf16x8, w); }
#pragma unroll
            for (int mo = 0; mo < 2; ++mo)
#pragma unroll
                for (int m = 0; m <= mo; ++m)
#pragma unroll
                    for (int s = 0; s < 2; ++s) O[mo] = MFMA32(*(const LAS bf16x8*)(buf + CH_AF + ((mo * 2 + m) * 2 + s) * 1024), Vb[m][s], O[mo]);
            { LAS bf16_t* stg = (LAS bf16_t*)(lds + STG) + 32 * wave + r32;
#pragma unroll
              for (int m = 0; m < 2; ++m)
#pragma unroll
                  for (int r = 0; r < 16; ++r) stg[(32 * m + crow(r, hi)) * 128] = (bf16_t)f2bf(O[m][r]); }
#pragma unroll
            for (int t = 0; t < 4; ++t) {
                __builtin_amdgcn_sched_barrier(0);
#pragma unroll
                for (int r = 0; r < 16; ++r) S[t][r] *= egl;
#pragma unroll
                for (int m = 0; m < 2; ++m)
#pragma unroll
                    for (int s = 0; s < 2; ++s) S[t] = MFMA32(*(const LAS bf16x8*)(buf + CH_KF + ((t * 2 + m) * 2 + s) * 1024), Vb[m][s], S[t]); }
        }
        asm volatile("s_waitcnt lgkmcnt(0)\n\ts_barrier" ::: "memory");
        if (wave >= 4) { const int j = tid - 256, row = j >> 2; float* og = OG + (size_t)dir * NTOK * 512 + (size_t)(rstart + rstep * row) * 512 + h * 128 + (j & 3) * 8;
            const LAS bf16_t* stg = (const LAS bf16_t*)(lds + STG) + row * 128 + (j & 3) * 8;
#pragma unroll
            for (int it = 0; it < 4; ++it) { const u32x4 w = *(const LAS u32x4*)(stg + it * 32);
                *(f32x4*)(og + it * 32) = (f32x4){bflo(w.x), bfhi(w.x), bflo(w.y), bfhi(w.y)}; *(f32x4*)(og + it * 32 + 4) = (f32x4){bflo(w.z), bfhi(w.z), bflo(w.w), bfhi(w.w)}; } }
    }
    VM_WAIT(); LDS_WAIT(); __syncthreads();
#undef LOAD_U
#undef STAGE_CHUNK
}

__device__ __forceinline__ void phase_gdn_out(PP p, int layer) {
    int tid = threadIdx.x, bid = blockIdx.x, gdim = gridDim.x; asm volatile("" : "+v"(tid), "+s"(bid), "+s"(gdim)); const int lane = tid & 63, wave = __builtin_amdgcn_readfirstlane(tid >> 6);
    const float* OG = (const float*)(p->ws + WS_OG); const float* OA = (const float*)(p->ws + WS_OA); const bf16_t* P = (const bf16_t*)(p->ws + WS_P); bf16_t* MIX = (bf16_t*)(p->ws + WS_MIX);
    const float* cf = (const float*)(p->ws + WS_CONST);
    const float lam = cf[CF_SC + layer * 16 + 0], oml = cf[CF_SC + layer * 16 + 2];
    const float* gn = p->in[I_GDNG] + layer * 128 + (8 * lane & 127); const float* sg = p->in[I_SUBLN] + layer * 128 + (8 * lane & 127);
    const f32x4 g0 = *(const f32x4*)gn, g1 = *(const f32x4*)(gn + 4), a0 = *(const f32x4*)sg * oml, a1 = *(const f32x4*)(sg + 4) * oml;
    const int nrows = layer == 0 ? NTOK : NLAT;
    for (int r = bid * NWAVES + wave; r < nrows; r += gdim * NWAVES) {
        {
            const float* a = OA + (size_t)r * 512 + 8 * lane; const float* la = (const float*)(p->ws + WS_LA) + (size_t)r * 4 + (lane >> 4);
            constexpr size_t PS = (size_t)NTOK * 512, LS = (size_t)NTOK * 4;
            f32x4 s0a = *(const f32x4*)a, s0b = *(const f32x4*)(a + 4), s1a = *(const f32x4*)(a + PS), s1b = *(const f32x4*)(a + PS + 4); float l0 = la[0], l1 = la[LS];
            if (r < NLAT) { s0a += *(const f32x4*)(a + 2 * PS); s0b += *(const f32x4*)(a + 2 * PS + 4); s1a += *(const f32x4*)(a + 3 * PS); s1b += *(const f32x4*)(a + 3 * PS + 4); l0 += la[2 * LS]; l1 += la[3 * LS]; }
            const float r0 = 1.f / l0, r1 = lam / l1;
            f32x4 o0 = s0a * r0 - s1a * r1, o1 = s0b * r0 - s1b * r1;
            float ss = (o0[0] * o0[0] + o0[1] * o0[1]) + (o0[2] * o0[2] + o0[3] * o0[3]) + (o1[0] * o1[0] + o1[1] * o1[1]) + (o1[2] * o1[2] + o1[3] * o1[3]);
            ss += __shfl_xor(ss, 1); ss += __shfl_xor(ss, 2); ss += __shfl_xor(ss, 4); ss += __shfl_xor(ss, 8);
            const float rstd = rsqrtf(ss * (1.f / 128.f) + EPS);
            o0 = o0 * rstd * a0; o1 = o1 * rstd * a1;
            u32x4 w; w.x = cvt_pk_bf16(o0[0], o0[1]); w.y = cvt_pk_bf16(o0[2], o0[3]); w.z = cvt_pk_bf16(o1[0], o1[1]); w.w = cvt_pk_bf16(o1[2], o1[3]);
            *(u32x4*)(MIX + (size_t)r * D + 8 * lane) = w; }
        const float* a = OG + (size_t)r * 512 + 8 * lane; const float* bq = a + (size_t)NTOK * 512;
        f32x4 o0 = *(const f32x4*)a + *(const f32x4*)bq, o1 = *(const f32x4*)(a + 4) + *(const f32x4*)(bq + 4);
        float ss = (o0[0] * o0[0] + o0[1] * o0[1]) + (o0[2] * o0[2] + o0[3] * o0[3]) + (o1[0] * o1[0] + o1[1] * o1[1]) + (o1[2] * o1[2] + o1[3] * o1[3]);
        ss += __shfl_xor(ss, 1); ss += __shfl_xor(ss, 2); ss += __shfl_xor(ss, 4); ss += __shfl_xor(ss, 8);
        const float rstd = rsqrtf(ss * (1.f / 128.f) + EPS);
        const u32x4 zw = *(const u32x4*)(P + (size_t)r * PW + 3072 + 8 * lane);
        o0 = o0 * rstd * g0; o1 = o1 * rstd * g1;
        u32x4 w; w.x = cvt_pk_bf16(o0[0] * silu_f(bflo(zw.x)), o0[1] * silu_f(bfhi(zw.x))); w.y = cvt_pk_bf16(o0[2] * silu_f(bflo(zw.y)), o0[3] * silu_f(bfhi(zw.y)));
        w.z = cvt_pk_bf16(o1[0] * silu_f(bflo(zw.z)), o1[1] * silu_f(bfhi(zw.z))); w.w = cvt_pk_bf16(o1[2] * silu_f(bflo(zw.w)), o1[3] * silu_f(bfhi(zw.w)));
        *(u32x4*)(MIX + (size_t)r * D + 512 + 8 * lane) = w;
    }
}

constexpr int AT_NS = 4, AT_SLOTK = 8192, AT_SLOTV = 16384, AT_K = 0, AT_V = AT_NS * AT_SLOTK, AT_WS = AT_V + AT_NS * AT_SLOTV;
typedef short v4i16_t __attribute__((ext_vector_type(4)));
__device__ __forceinline__ s16x4 vtr(const LAS unsigned char* ptr) { return __builtin_bit_cast(s16x4, __builtin_amdgcn_ds_read_tr16_b64_v4i16((LAS v4i16_t*)ptr)); }
__device__ __forceinline__ int att_keyrow(int b, int t, int nctx_tiles) {
    return t < nctx_tiles ? NLAT + b * CTXL + 64 * t : b * SEQL + 64 * (t - nctx_tiles);
}
#define AT_SBAR() __builtin_amdgcn_sched_barrier(0)
#define AT_PIN(x) asm volatile("" : "+v"(x))
#define AT_WAIT_BAR(N) asm volatile("s_waitcnt vmcnt(" #N ") lgkmcnt(0)\n\ts_barrier" ::: "memory")
__device__ __forceinline__ void attn_unit(PP p, int layer, LAS unsigned char* lds, int b, int h, int sub, int qrow0, int t0, int ntile, int nctx_tiles, int ksp) {
    int tid = threadIdx.x; asm volatile("" : "+v"(tid)); const int lane = tid & 63, wave = __builtin_amdgcn_readfirstlane(tid >> 6), r32 = lane & 31, hi = lane >> 5;
    const bf16_t* P = (const bf16_t*)(p->ws + WS_P);
    LAS float* wsf = (LAS float*)(lds + AT_WS) + wave * 64;
    const LAS unsigned char* kp0 = lds + AT_K + hi * 1024 + r32 * 16;
    const LAS unsigned char* vp0 = lds + AT_V + ((lane >> 4) & 1) * 32 + (lane & 3) * 8 + (4 * hi + ((lane & 15) >> 2)) * 64;
    const int kcol = 512 + h * 128 + sub * 64 + wave * 8, vcol = 1024 + h * 128;
    const size_t koff = (size_t)lane * PW + kcol;
    const size_t voff0 = (size_t)(16 * (wave & 3) + (lane >> 2)) * PW + vcol + 32 * (wave >> 2) + 8 * (lane & 3);
    const size_t voff1 = voff0 + 64;
    const unsigned kdst = lds_addr(lds + AT_K + wave * 1024), vdst = lds_addr(lds + AT_V + wave * 1024);
#define DMA_K(t, slot) do { if ((t) < ntile) glds16(P + (size_t)att_keyrow(b, t0 + (t), nctx_tiles) * PW + koff, kdst + (slot) * AT_SLOTK); } while (0)
#define DMA_V(t, slot) do { if ((t) < ntile) { const bf16_t* vb_ = P + (size_t)att_keyrow(b, t0 + (t), nctx_tiles) * PW; \
        glds16(vb_ + voff0, vdst + (slot) * AT_SLOTV); glds16(vb_ + voff1, vdst + (slot) * AT_SLOTV + 8192); } } while (0)
    DMA_K(0, 0); DMA_V(0, 0); DMA_K(1, 1); DMA_K(2, 2); DMA_K(3, 3); DMA_V(1, 1);
    bf16x8 qr[4];
    { const bf16_t* qp = P + (size_t)(qrow0 + wave * 32 + r32) * PW + h * 128 + sub * 64 + hi * 8;
#pragma unroll
      for (int d0 = 0; d0 < 4; ++d0) qr[d0] = *(const bf16x8*)(qp + d0 * 16); }
    f32x16 o[4];
#pragma unroll
    for (int dg = 0; dg < 4; ++dg) o[dg] = (f32x16){};
    float l_reg = 0.f;
    f32x16 pA0, pA1, pB0, pB1; bf16x8 kf[8]; u32x4 pw0, pw1, pw2, pw3; s16x4 vlo[4], vhi[4];
    f32x16 zero16 = (f32x16){}; AT_PIN(zero16);
    int sl_prev = 0, sl_cur = 0, sl_next = 1;
#define ROT() do { sl_prev = sl_cur; sl_cur = sl_next; sl_next = (sl_next + 1) & 3; } while (0)
#define KLD(i, kp_) kf[i] = *(const LAS bf16x8*)((kp_) + ((i) >> 1) * 2048 + ((i) & 1) * 512)
#define PKW(Pv, i) cvt_pk_bf16(Pv[i], Pv[(i) + 1])
#define PAF(k) __builtin_bit_cast(bf16x8, pw##k)
#define VRD(i, vp_) do { vlo[(i) & 3] = vtr((vp_) + ((i) & 3) * 4096 + ((i) >> 2) * 1024); vhi[(i) & 3] = vtr((vp_) + ((i) & 3) * 4096 + ((i) >> 2) * 1024 + 512); } while (0)
#define VFR(i) (bf16x8){vlo[(i) & 3][0], vlo[(i) & 3][1], vlo[(i) & 3][2], vlo[(i) & 3][3], vhi[(i) & 3][0], vhi[(i) & 3][1], vhi[(i) & 3][2], vhi[(i) & 3][3]}
#define EX2(Cv, i) do { Cv[i] = __builtin_amdgcn_exp2f(Cv[i]); Cv[(i) + 1] = __builtin_amdgcn_exp2f(Cv[(i) + 1]); } while (0)
#define GAPA(MF, a0, a1, a2, a3, W0, W1, PW_) do { MF; sacc += a0; sacc += a1; sacc += a2; sacc += a3; W0; W1; AT_PIN(PW_); AT_PIN(sacc); AT_SBAR(); } while (0)
#define GAPB(i, PA_, Cx, ci, GL) do { o[(i) & 3] = MFMA32(PA_, VFR(i), o[(i) & 3]); EX2(Cx, ci); AT_PIN(Cx); \
        if ((i) + 2 < 16) VRD((i) + 2, vpp_); if ((GL) && (i) < 8) KLD(i, kpn_); AT_SBAR(); } while (0)
#define STEP(C0, C1, P0, P1, t, GL) do { AT_SBAR(); \
    const LAS unsigned char* vpp_ = vp0 + sl_prev * AT_SLOTV; const LAS unsigned char* kpn_ = kp0 + sl_next * AT_SLOTK; \
    float sacc = P0[0] + P0[1]; \
    GAPA(C0 = MFMA32(kf[0], qr[0], zero16), P0[2], P0[3], P0[4], P0[5],     pw0[0] = PKW(P0, 0),  pw0[1] = PKW(P0, 2),  pw0); \
    GAPA(C1 = MFMA32(kf[1], qr[0], zero16), P0[6], P0[7], P0[8], P0[9],     pw0[2] = PKW(P0, 4),  pw0[3] = PKW(P0, 6),  pw0); \
    GAPA(C0 = MFMA32(kf[2], qr[1], C0),     P0[10], P0[11], P0[12], P0[13], pw1[0] = PKW(P0, 8),  pw1[1] = PKW(P0, 10), pw1); \
    GAPA(C1 = MFMA32(kf[3], qr[1], C1),     P0[14], P0[15], P1[0], P1[1],   pw1[2] = PKW(P0, 12), pw1[3] = PKW(P0, 14), pw1); \
    GAPA(C0 = MFMA32(kf[4], qr[2], C0),     P1[2], P1[3], P1[4], P1[5],     pw2[0] = PKW(P1, 0),  pw2[1] = PKW(P1, 2),  pw2); \
    GAPA(C1 = MFMA32(kf[5], qr[2], C1),     P1[6], P1[7], P1[8], P1[9],     pw2[2] = PKW(P1, 4),  pw2[3] = PKW(P1, 6),  pw2); \
    VRD(0, vpp_); \
    GAPA(C0 = MFMA32(kf[6], qr[3], C0),     P1[10], P1[11], P1[12], P1[13], pw3[0] = PKW(P1, 8),  pw3[1] = PKW(P1, 10), pw3); \
    VRD(1, vpp_); \
    GAPA(C1 = MFMA32(kf[7], qr[3], C1),     P1[14], P1[15], 0.f, 0.f,       pw3[2] = PKW(P1, 12), pw3[3] = PKW(P1, 14), pw3); \
    l_reg += sacc; \
    DMA_K((t) + 4, sl_cur); DMA_V((t) + 2, (sl_next + 1) & 3); AT_SBAR(); \
    GAPB(0, PAF(0), C0, 0, GL);  GAPB(1, PAF(0), C0, 2, GL);  GAPB(2, PAF(0), C0, 4, GL);  GAPB(3, PAF(0), C0, 6, GL); \
    GAPB(4, PAF(1), C0, 8, GL);  GAPB(5, PAF(1), C0, 10, GL); GAPB(6, PAF(1), C0, 12, GL); GAPB(7, PAF(1), C0, 14, GL); \
    GAPB(8, PAF(2), C1, 0, GL);  GAPB(9, PAF(2), C1, 2, GL);  GAPB(10, PAF(2), C1, 4, GL); GAPB(11, PAF(2), C1, 6, GL); \
    GAPB(12, PAF(3), C1, 8, GL); GAPB(13, PAF(3), C1, 10, GL); GAPB(14, PAF(3), C1, 12, GL); GAPB(15, PAF(3), C1, 14, GL); \
    } while (0)
#define ENDW(tt) do { if ((tt) + 4 < ntile) { AT_WAIT_BAR(6); } else { AT_WAIT_BAR(0); } } while (0)
    AT_WAIT_BAR(0);
#pragma unroll
    for (int i = 0; i < 8; ++i) KLD(i, kp0);
    pA0 = MFMA32(kf[0], qr[0], zero16); pA1 = MFMA32(kf[1], qr[0], zero16); pA0 = MFMA32(kf[2], qr[1], pA0); pA1 = MFMA32(kf[3], qr[1], pA1);
    pA0 = MFMA32(kf[4], qr[2], pA0); pA1 = MFMA32(kf[5], qr[2], pA1); pA0 = MFMA32(kf[6], qr[3], pA0); pA1 = MFMA32(kf[7], qr[3], pA1);
#pragma unroll
    for (int r = 0; r < 16; ++r) { pA0[r] = __builtin_amdgcn_exp2f(pA0[r]); pA1[r] = __builtin_amdgcn_exp2f(pA1[r]); }
    AT_WAIT_BAR(0);
    DMA_K(4, 0); DMA_V(2, 2); ROT();
#pragma unroll
    for (int i = 0; i < 8; ++i) KLD(i, kp0 + sl_cur * AT_SLOTK);
    if (ntile > 4) { AT_WAIT_BAR(3); } else { AT_WAIT_BAR(0); }
    int t = 1;
    for (; t + 1 < ntile; t += 2) {
        STEP(pB0, pB1, pA0, pA1, t, true);     ENDW(t);     ROT();
        STEP(pA0, pA1, pB0, pB1, t + 1, (t + 2 < ntile)); ENDW(t + 1); ROT();
    }
    if (t < ntile) { STEP(pB0, pB1, pA0, pA1, t, false); ENDW(t); ROT();
#pragma unroll
        for (int r = 0; r < 16; ++r) { pA0[r] = pB0[r]; pA1[r] = pB1[r]; } }
    { float sacc = 0.f;
#pragma unroll
      for (int r = 0; r < 16; ++r) sacc += pA0[r] + pA1[r];
      l_reg += sacc;
      pw0 = (u32x4){PKW(pA0, 0), PKW(pA0, 2), PKW(pA0, 4), PKW(pA0, 6)}; pw1 = (u32x4){PKW(pA0, 8), PKW(pA0, 10), PKW(pA0, 12), PKW(pA0, 14)};
      pw2 = (u32x4){PKW(pA1, 0), PKW(pA1, 2), PKW(pA1, 4), PKW(pA1, 6)}; pw3 = (u32x4){PKW(pA1, 8), PKW(pA1, 10), PKW(pA1, 12), PKW(pA1, 14)};
      const LAS unsigned char* vpp_ = vp0 + sl_prev * AT_SLOTV;
#pragma unroll
      for (int i = 0; i < 16; ++i) { VRD(i, vpp_); const bf16x8 pa = (i >> 2) == 0 ? PAF(0) : (i >> 2) == 1 ? PAF(1) : (i >> 2) == 2 ? PAF(2) : PAF(3); o[i & 3] = MFMA32(pa, VFR(i), o[i & 3]); } }
    l_reg += __shfl_xor(l_reg, 32);
    const size_t part = (size_t)(ksp * 2 + sub) * NTOK;
    if (hi == 0) ((float*)(p->ws + WS_LA))[(part + qrow0 + wave * 32 + r32) * 4 + h] = l_reg;
    float* OA = (float*)(p->ws + WS_OA) + part * 512 + h * 128 + r32;
#pragma unroll
    for (int r = 0; r < 16; ++r) { float* orow = OA + (size_t)(qrow0 + wave * 32 + crow(r, hi)) * 512;
#pragma unroll
        for (int dg = 0; dg < 4; ++dg) orow[32 * dg] = o[dg][r]; }
    AT_WAIT_BAR(0);
#undef DMA_K
#undef DMA_V
#undef ROT
#undef KLD
#undef PKW
#undef PAF
#undef VRD
#undef VFR
#undef EX2
#undef GAPA
#undef GAPB
#undef STEP
#undef ENDW
}
__device__ __forceinline__ void phase_attention(PP p, int layer, LAS unsigned char* lds, int qsel) {
    int bid = blockIdx.x; asm volatile("" : "+s"(bid));
    if (bid < 16) gdn_scan_chain(p, lds, bid);
    const int nlat = NB * 4 * 2 * 2 * 64, nunits = nlat + (layer == 0 ? NB * 4 * 2 : 0);
    unsigned* ctr = (unsigned*)(p->ws + WS_CTL) + CW_ATTQ + layer * 64 + qsel * 32;
    volatile LAS unsigned* slot = (volatile LAS unsigned*)(lds + MISC_OFF) + 16;
    for (;;) {
        if (threadIdx.x == 0) *slot = __hip_atomic_fetch_add(ctr, 1u, __ATOMIC_RELAXED, __HIP_MEMORY_SCOPE_AGENT);
        __syncthreads();
        const int u = (int)__builtin_amdgcn_readfirstlane((int)*slot);
        if (u >= nunits) break;
        if (u < nlat) { const int b = u >> 10, h = (u >> 8) & 3, sub = (u >> 7) & 1, ksp = (u >> 6) & 1, qb = u & 63; attn_unit(p, layer, lds, b, h, sub, b * SEQL + qb * 256, ksp * 130, 130, 4, ksp); }
        else { const int v = u - nlat, b = v >> 3, h = (v >> 1) & 3, sub = v & 1; attn_unit(p, layer, lds, b, h, sub, NLAT + b * CTXL, 0, 4, 4, 0); }
    }
}

__device__ __forceinline__ void phase_norm_router(PP p, int layer, LAS unsigned char* lds) {
    int tid = threadIdx.x, bid = blockIdx.x, gdim = gridDim.x; asm volatile("" : "+v"(tid), "+s"(bid), "+s"(gdim)); const int lane = tid & 63, wave = __builtin_amdgcn_readfirstlane(tid >> 6);
    const int T = layer == 0 ? NTOK : NLAT;
    LAS float* rw = (LAS float*)lds;
    LAS int* lcnt = (LAS int*)(lds + 131072);
    LAS int* lbase = lcnt + 32;
    LAS int* ent = lcnt + 64;
    const float* rwg = p->in[I_RW] + (size_t)layer * D * NEXP;
    for (int i = tid; i < NEXP * 1024; i += NTHR) { const int k = i >> 5, e = i & 31; rw[e * 1024 + k] = rwg[(size_t)k * NEXP + e]; }
    if (tid < 64) lcnt[tid] = 0;
    __syncthreads();
    const float* cf = (const float*)(p->ws + WS_CONST);
    const float* gn = p->in[I_NFFNG] + layer * D;
    const float rb = lane < NEXP ? p->in[I_RB][layer * NEXP + lane] : 0.f;
    const int rpw = (T + gdim - 1) / gdim;
    const int r0 = bid * rpw, r1 = (r0 + rpw < T) ? r0 + rpw : T;
    int* tope = (int*)(p->ws + WS_RT + RT_TOPE); float* gate = (float*)(p->ws + WS_RT + RT_GATE); int* rank = (int*)(p->ws + WS_RT + RT_RANK);
    const float* H = (const float*)(p->ws + WS_H);
    for (int r = r0 + wave; r < r1; r += NWAVES) {
        const float* mv = cf + CF_MODV + (layer * 3 + mod_sel(r)) * 6144;
        f32x4 u[4]; norm_mod_row(H + (size_t)r * D, gn, mv + 3 * 1024, mv + 4 * 1024, lane, u);
        store_row_bf16((bf16_t*)(p->ws + WS_U) + (size_t)r * D, lane, u);
        float logit = -INFINITY;
#pragma unroll 4
        for (int e = 0; e < NEXP; ++e) { float s = 0.f;
#pragma unroll
            for (int q = 0; q < 4; ++q) { const f32x4 w = *(const LAS f32x4*)(rw + e * 1024 + 4 * lane + 256 * q); s += (u[q][0] * w[0] + u[q][1] * w[1]) + (u[q][2] * w[2] + u[q][3] * w[3]); }
            s = wave_sum(s); if (lane == e) logit = s + rb; }
        float tl[4]; int te[4];
#pragma unroll
        for (int k = 0; k < 4; ++k) { const float m = wave_max(logit); const unsigned long long bal = __ballot(logit == m); const int idx = __ffsll((long long)bal) - 1;
            tl[k] = m; te[k] = idx; if (lane == idx) logit = -INFINITY; }
        const float e1 = __expf(tl[1] - tl[0]), e2 = __expf(tl[2] - tl[0]), e3 = __expf(tl[3] - tl[0]); const float inv = 1.f / (1.f + e1 + e2 + e3);
        if (lane < 4) { const int e = lane == 0 ? te[0] : lane == 1 ? te[1] : lane == 2 ? te[2] : te[3]; const float gv = (lane == 0 ? 1.f : lane == 1 ? e1 : lane == 2 ? e2 : e3) * inv;
            const int lr = atomicAdd((int*)&lcnt[e], 1);
            ent[(r - r0) * 4 + lane] = (e << 20) | lr; tope[(size_t)r * 4 + lane] = e; gate[(size_t)r * 4 + lane] = gv; }
    }
    __syncthreads();
    if (tid < NEXP) lbase[tid] = (int)atomicAdd((unsigned*)(p->ws + WS_CTL) + CW_CNT + layer * 64 + tid, (unsigned)lcnt[tid]);
    __syncthreads();
    for (int i = tid; i < (r1 - r0) * 4; i += NTHR) { const int v = ent[i]; rank[(size_t)r0 * 4 + i] = lbase[v >> 20] + (v & 0xfffff); }
}

__device__ __forceinline__ void phase_moe_gather(PP p, int layer, LAS unsigned char* lds) {
    int tid = threadIdx.x, bid = blockIdx.x, gdim = gridDim.x; asm volatile("" : "+v"(tid), "+s"(bid), "+s"(gdim)); const int lane = tid & 63, wave = __builtin_amdgcn_readfirstlane(tid >> 6);
    const int T = layer == 0 ? NTOK : NLAT;
    LAS int* pstart = (LAS int*)lds; LAS int* cnt = pstart + 64;
    const unsigned* gcnt = (const unsigned*)(p->ws + WS_CTL) + CW_CNT + layer * 64;
    int* mt = (int*)(p->ws + WS_CONST) + CF_MOE + layer * 1024;
    if (tid == 0) { int acc = 0; for (int e = 0; e < NEXP; ++e) { const int c = (int)__hip_atomic_load(gcnt + e, __ATOMIC_RELAXED, __HIP_MEMORY_SCOPE_AGENT); cnt[e] = c; pstart[e] = acc; acc += (c + 255) & ~255; } pstart[NEXP] = acc; }
    __syncthreads();
    if (bid == 0) {
        if (tid < NEXP) { mt[tid] = pstart[tid]; mt[64 + tid] = cnt[tid]; }
        if (tid == 0) mt[32] = pstart[NEXP] >> 8;
        for (int e = 0; e < NEXP; ++e) { const int b0 = pstart[e] >> 8, b1 = pstart[e + 1] >> 8; for (int bb = b0 + tid; bb < b1; bb += NTHR) mt[128 + bb] = e; }
    }
    const int* tope = (const int*)(p->ws + WS_RT + RT_TOPE); const float* gate = (const float*)(p->ws + WS_RT + RT_GATE); const int* rank = (const int*)(p->ws + WS_RT + RT_RANK);
    int* slot = (int*)(p->ws + WS_RT + RT_SLOT); float* sgate = (float*)(p->ws + WS_RT + RT_SGATE); int* stok = (int*)(p->ws + WS_RT + RT_STOK);
    const int gt = bid * NTHR + tid, NGT = gdim * NTHR;
    for (int a = gt; a < T * 4; a += NGT) {
        const int e = tope[a]; const int s = pstart[e] + rank[a];
        slot[a] = s; sgate[s] = gate[a]; stok[s] = a >> 2;
    }
    for (int e = 0; e < NEXP; ++e) { const int s0 = pstart[e] + cnt[e], s1 = pstart[e + 1];
        for (int s = s0 + gt; s < s1; s += NGT) { stok[s] = 0; sgate[s] = 0.f; } }
}

__device__ __forceinline__ void phase_moe_combine(PP p, int layer) {
    int tid = threadIdx.x, bid = blockIdx.x, gdim = gridDim.x; asm volatile("" : "+v"(tid), "+s"(bid), "+s"(gdim)); const int lane = tid & 63, wave = __builtin_amdgcn_readfirstlane(tid >> 6);
    const int T = layer == 0 ? NTOK : NLAT;
    const float* cf = (const float*)(p->ws + WS_CONST); const int* slot = (const int*)(p->ws + WS_RT + RT_SLOT); const bf16_t* Y = (const bf16_t*)(p->ws + WS_Y);
    float* H = (float*)(p->ws + WS_H);
    for (int r = bid * NWAVES + wave; r < T; r += gdim * NWAVES) {
        const float* g5 = cf + CF_MODV + (layer * 3 + mod_sel(r)) * 6144 + 5 * 1024;
        float* ho = layer == 0 ? H + (size_t)r * D : p->out + (size_t)r * D; const float* hi_ = H + (size_t)r * D;
        const int s0 = slot[r * 4], s1 = slot[r * 4 + 1], s2 = slot[r * 4 + 2], s3 = slot[r * 4 + 3];
#pragma unroll
        for (int j = 0; j < 4; ++j) { const int c = 4 * lane + 256 * j;
            const u32x2 a = *(const u32x2*)(Y + (size_t)s0 * D + c), b2 = *(const u32x2*)(Y + (size_t)s1 * D + c), c2 = *(const u32x2*)(Y + (size_t)s2 * D + c), d2 = *(const u32x2*)(Y + (size_t)s3 * D + c);
            f32x4 y; y[0] = (bflo(a.x) + bflo(b2.x)) + (bflo(c2.x) + bflo(d2.x)); y[1] = (bfhi(a.x) + bfhi(b2.x)) + (bfhi(c2.x) + bfhi(d2.x));
            y[2] = (bflo(a.y) + bflo(b2.y)) + (bflo(c2.y) + bflo(d2.y)); y[3] = (bfhi(a.y) + bfhi(b2.y)) + (bfhi(c2.y) + bfhi(d2.y));
            const f32x4 hv = *(const f32x4*)(hi_ + c), gv = *(const f32x4*)(g5 + c);
            *(f32x4*)(ho + c) = hv + gv * y; }
    }
}

constexpr int NPH = 27;
#ifndef PH_MASK
#define PH_MASK 0xFFFF
#endif
#define IN(k) (lo <= (k) && (k) < hi)
#define EN(i) ((PH_MASK >> (i)) & 1)
#ifndef DUP_PH
#define DUP_PH -1
#endif
#define REP(i) for (int rep_ = 0; rep_ < ((DUP_PH == (i) && l == 0) ? 2 : 1); ++rep_)
#define SEAM(k) do { if (IN(k) && IN((k) + 1)) xcd_barrier(bar); } while (0)
#define LAUNDER() PP p = p0; LAS unsigned char* lds = lds0; int bid = blockIdx.x, gdim = gridDim.x; asm volatile("" : "+s"(p), "+s"(lds), "+s"(bid), "+s"(gdim))
template <int l> __device__ __forceinline__ void run_layer(PP p0, LAS unsigned char* lds0, const int lo, const int hi, const XcdBarrier& bar) {
        const int base = 1 + 13 * l;
        if (EN(1) && IN(base + 0)) REP(1) { LAUNDER(); phase_norm_mix(p, l, lds); __syncthreads(); }
        SEAM(base + 0);
        if (EN(2) && IN(base + 1)) REP(2) { LAUNDER();
            PlainSched S; S.init(p->ws + WS_U, p->ws + WS_WIN + (size_t)l * PW * 1024 * 2, 1024, NTOK / 256, PW / 256, gdim, bid);
            EpiStoreBf16 E{(bf16_t*)(p->ws + WS_P), PW};
            pg8::gemm_phase<EpiStoreBf16, PlainSched>(lds, 1024, S, E);
        }
        SEAM(base + 1);
        if (EN(3) && IN(base + 2)) REP(3) { LAUNDER(); phase_prep(p, l); }
        SEAM(base + 2);
        if (EN(5) && IN(base + 3)) REP(5) { LAUNDER(); phase_gdn_chunk(p, lds); }
        SEAM(base + 3);
        if (EN(4) && IN(base + 4)) REP(4) { LAUNDER(); phase_attention(p, l, lds, rep_); }
        SEAM(base + 4);
        if (EN(7) && IN(base + 6)) REP(7) { LAUNDER(); phase_gdn_out(p, l); }
        SEAM(base + 6);
        if (EN(8) && IN(base + 7)) REP(8) { LAUNDER();
            const int T = l == 0 ? NTOK : NLAT;
            const float* cf = (const float*)(p->ws + WS_CONST);
            PlainSched S; S.init(p->ws + WS_MIX, p->ws + WS_WOUT + (size_t)l * D * 1024 * 2, 1024, T / 256, D / 256, gdim, bid);
            EpiResidual E{p, l, cf + CF_MODV + (l * 3) * 6144 + 2 * 1024};
            pg8::gemm_phase<EpiResidual, PlainSched>(lds, 1024, S, E);
        }
        SEAM(base + 7);
        if (EN(9) && IN(base + 8)) REP(9) { LAUNDER(); phase_norm_router(p, l, lds); __syncthreads(); }
        SEAM(base + 8);
        if (EN(10) && IN(base + 9)) REP(10) { LAUNDER(); phase_moe_gather(p, l, lds); __syncthreads(); }
        SEAM(base + 9);
        if (EN(11) && IN(base + 10)) REP(11) { LAUNDER();
            const int* mt = (const int*)(p->ws + WS_CONST) + CF_MOE + l * 1024;
            MoeSched S{(const char*)(p->ws + WS_U), (const char*)(p->ws + WS_WGU + (size_t)l * NEXP * 2048 * 1024 * 2), mt + 128, mt[32], 8, gdim, bid, (const int*)(p->ws + WS_RT + RT_STOK)};
            EpiGateUp E{(bf16_t*)(p->ws + WS_ACT), p->in[I_BGU] + (size_t)l * NEXP * 2048, mt + 128};
            pg8::gemm_phase<EpiGateUp, MoeSched, true>(lds, 1024, S, E);
        }
        SEAM(base + 10);
        if (EN(12) && IN(base + 11)) REP(12) { LAUNDER();
            const int* mt = (const int*)(p->ws + WS_CONST) + CF_MOE + l * 1024;
            MoeSched S{(const char*)(p->ws + WS_ACT), (const char*)(p->ws + WS_WD + (size_t)l * NEXP * 1024 * 1024 * 2), mt + 128, mt[32], 4, gdim, bid, nullptr};
            EpiDown E{(bf16_t*)(p->ws + WS_Y), p->in[I_BD] + (size_t)l * NEXP * 1024, mt + 128, (const float*)(p->ws + WS_RT + RT_SGATE)};
            pg8::gemm_phase<EpiDown, MoeSched>(lds, 1024, S, E);
        }
        SEAM(base + 11);
        if (EN(13) && IN(base + 12)) REP(13) { LAUNDER(); phase_moe_combine(p, l); }
        SEAM(base + 12);
    }

__global__ void __launch_bounds__(NTHR, 2) mega_fwd(Params p_by_value) {
    extern __shared__ __attribute__((aligned(16))) unsigned char lds_raw[];
    LAS unsigned char* lds0 = (LAS unsigned char*)lds_raw;
    PP p0 = (PP)__builtin_amdgcn_kernarg_segment_ptr();
    volatile LAS unsigned* MISC = (volatile LAS unsigned*)(lds0 + MISC_OFF);
    if (threadIdx.x < 64) MISC[threadIdx.x] = 0u;
    __syncthreads();
    const int lo = p0->ph_lo, hi = p0->ph_hi;
    XcdBarrier bar; bar.bar = (unsigned*)(p0->ws + WS_CTL) + CW_BAR; bar.x = 0; bar.st = nullptr;
    if (hi - lo > 1) bar = xcd_barrier_post((unsigned*)(p0->ws + WS_CTL) + CW_BAR, MISC + 8);
    if (EN(0) && IN(0)) for (int rep_ = 0; rep_ < (DUP_PH == 0 ? 2 : 1); ++rep_) { LAUNDER(); phase_prologue(p, lds); __syncthreads(); }
    SEAM(0);
    run_layer<0>(p0, lds0, lo, hi, bar);
    run_layer<1>(p0, lds0, lo, hi, bar);
#undef IN
#undef SEAM
}

extern "C" void kernel_launch(void* const* d_in, const int* in_sizes, int n_in, void* d_out, int out_size, void* d_ws, size_t ws_size, hipStream_t stream) {
    static int grid = 0;
    if (grid == 0) {
        if (n_in != 27 || out_size != NLAT * D || ws_size < WS_END) { fprintf(stderr, "kernel_launch: unexpected problem (n_in %d, out %d, ws %zu < %zu)\n", n_in, out_size, ws_size, (size_t)WS_END); grid = -1; return; }
        int dev = 0, cus = 0, per_cu = 0;
        if (hipGetDevice(&dev) != hipSuccess || hipDeviceGetAttribute(&cus, hipDeviceAttributeMultiprocessorCount, dev) != hipSuccess) { grid = -1; return; }
        if (hipFuncSetAttribute((const void*)mega_fwd, hipFuncAttributeMaxDynamicSharedMemorySize, LDS_BYTES) != hipSuccess) { fprintf(stderr, "kernel_launch: hipFuncSetAttribute failed\n"); grid = -1; return; }
        if (hipOccupancyMaxActiveBlocksPerMultiprocessor(&per_cu, (const void*)mega_fwd, NTHR, LDS_BYTES) != hipSuccess || per_cu < 1) { fprintf(stderr, "kernel_launch: occupancy query says %d\n", per_cu); }
        (void)hipGetLastError();
        grid = cus;
    }
    if (grid < 0) return;
    hipMemsetAsync((char*)d_ws + WS_CTL, 0, CTL_ZERO_BYTES, stream);
    Params p{};
    for (int i = 0; i < 27; ++i) p.in[i] = (const float*)d_in[i];
    p.out = (float*)d_out; p.ws = (unsigned char*)d_ws;
#if MK_PER_PHASE
    for (int ph = 0; ph < NPH; ++ph) { p.ph_lo = ph; p.ph_hi = ph + 1; hipLaunchKernelGGL(mega_fwd, dim3(grid), dim3(NTHR), LDS_BYTES, stream, p); }
#else
    p.ph_lo = 0; p.ph_hi = NPH;
    hipLaunchKernelGGL(mega_fwd, dim3(grid), dim3(NTHR), LDS_BYTES, stream, p);
#endif
}
```

```cpp
#include <hip/hip_runtime.h>
#include <cstdio>
#include <cstdint>

#ifndef MK_PER_PHASE
#define MK_PER_PHASE 0
#endif

#define LAS __attribute__((address_space(3)))
#define GAS __attribute__((address_space(1)))
typedef unsigned short bf16_t;
typedef short bf16x8 __attribute__((ext_vector_type(8)));
typedef short s16x4 __attribute__((ext_vector_type(4)));
typedef float f32x2 __attribute__((ext_vector_type(2)));
typedef float f32x4 __attribute__((ext_vector_type(4)));
typedef float f32x16 __attribute__((ext_vector_type(16)));
typedef unsigned u32x2 __attribute__((ext_vector_type(2)));
typedef unsigned u32x4 __attribute__((ext_vector_type(4)));

constexpr int D = 1024, NB = 2, SEQL = 16384, CTXL = 256;
constexpr int NLAT = NB * SEQL, NCTX = NB * CTXL, NTOK = NLAT + NCTX;
constexpr int PW = 3584, INC = 3600;
constexpr int NEXP = 32, MAXBLK = 552, MAXSLOT = MAXBLK * 256;
constexpr int NCHUNK = 260, NTASK = 16 * NCHUNK;
constexpr float EPS = 1e-6f;
constexpr float LOG2E = 1.4426950408889634f;
constexpr int NWAVES = 8, NTHR = 512;

constexpr size_t MiB = 1u << 20;
constexpr size_t WS_CTL = 0, CTL_ZERO_BYTES = 1 * MiB;
constexpr size_t WS_CONST = 1 * MiB;
constexpr size_t WS_WIN = 2 * MiB;
constexpr size_t WS_WOUT = 16 * MiB;
constexpr size_t WS_WGU = 20 * MiB;
constexpr size_t WS_WD = 276 * MiB;
constexpr size_t WS_H = 404 * MiB;
constexpr size_t WS_U = 534 * MiB;
constexpr size_t WS_GB = 599 * MiB;
constexpr size_t WS_MIX = 602 * MiB;
constexpr size_t WS_RT = 667 * MiB;
constexpr size_t WS_BIG = 671 * MiB;
constexpr size_t WS_P = WS_BIG;
constexpr size_t WS_G = WS_P + 228 * MiB;
constexpr size_t WS_CH = WS_G + 98 * MiB;
constexpr size_t WS_OG = WS_CH + 358 * MiB;
constexpr size_t WS_OA = WS_OG + 130 * MiB;
constexpr size_t WS_LA = WS_OA + 260 * MiB;
constexpr size_t WS_END = WS_LA + 3 * MiB;
constexpr size_t WS_XS = WS_BIG;
constexpr size_t WS_ACT = WS_BIG + 276 * MiB;
constexpr size_t WS_Y = WS_XS;
static_assert(WS_ACT + 276 * MiB <= WS_END, "moe overlay");
constexpr size_t CH_TASK_BYTES = 90112;
constexpr int CH_WF = 0, CH_QF = 16384, CH_AF = 32768, CH_KF = 40960, CH_UC = 57344, CH_DMA_BYTES = 57344;
static_assert((size_t)NTASK * CH_TASK_BYTES <= 358 * MiB, "chunk buffers");

constexpr int CW_BAR = 4096;
constexpr int CW_CNT = 16384;
constexpr int CW_ATTQ = 20480;
constexpr int CF_MODV = 0;
constexpr int CF_ROPE = 40960;
constexpr int CF_SC = 53248;
constexpr int CF_EGL = 53504;
constexpr int CF_MOE = 61440;
constexpr size_t RT_TOPE = 0, RT_GATE = 640 * 1024, RT_RANK = 1280 * 1024, RT_SLOT = 1920 * 1024, RT_SGATE = 2560 * 1024, RT_STOK = 3200 * 1024;

constexpr int LDS_BYTES = 147456;
constexpr int MISC_OFF = 143 * 1024;
static_assert(MISC_OFF + 256 <= LDS_BYTES, "lds");

__device__ __forceinline__ unsigned f2bf(float f) { unsigned u = __builtin_bit_cast(unsigned, f); return (u + 0x7fffu + ((u >> 16) & 1u)) >> 16; }
__device__ __forceinline__ unsigned pk2(float lo, float hi) { return f2bf(lo) | (f2bf(hi) << 16); }
__device__ __forceinline__ float bf2f(unsigned short b) { return __builtin_bit_cast(float, (unsigned)b << 16); }
__device__ __forceinline__ float bflo(unsigned w) { return __builtin_bit_cast(float, w << 16); }
__device__ __forceinline__ float bfhi(unsigned w) { return __builtin_bit_cast(float, w & 0xffff0000u); }
__device__ __forceinline__ unsigned cvt_pk_bf16(float lo, float hi) { unsigned r; asm volatile("v_cvt_pk_bf16_f32 %0, %1, %2" : "=v"(r) : "v"(lo), "v"(hi)); return r; }
__device__ __forceinline__ float wave_sum(float v) {
#pragma unroll
    for (int o = 1; o < 64; o <<= 1) v += __shfl_xor(v, o);
    return v;
}
__device__ __forceinline__ float wave_max(float v) {
#pragma unroll
    for (int o = 1; o < 64; o <<= 1) v = fmaxf(v, __shfl_xor(v, o));
    return v;
}
__device__ __forceinline__ float silu_f(float x) { return x / (1.f + __expf(-x)); }
__device__ __forceinline__ int crow(int r, int hi) { return (r & 3) + 8 * (r >> 2) + 4 * hi; }
__device__ __forceinline__ void glds16(const void* g, unsigned lds_base) {
    unsigned sv; asm volatile("s_mov_b32 %0, m0\n\ts_mov_b32 m0, %2\n\ts_nop 0\n\tglobal_load_lds_dwordx4 %1, off\n\ts_mov_b32 m0, %0" : "=&s"(sv) : "v"(g), "s"((unsigned)__builtin_amdgcn_readfirstlane((int)lds_base)) : "memory"); }
__device__ __forceinline__ unsigned lds_addr(const LAS void* q) { return (unsigned)__builtin_amdgcn_readfirstlane((int)(unsigned)(uintptr_t)q); }
#define LDS_WAIT() asm volatile("s_waitcnt lgkmcnt(0)" ::: "memory")
#define VM_WAIT() asm volatile("s_waitcnt vmcnt(0)" ::: "memory")
#define MFMA32(a, b, c) __builtin_amdgcn_mfma_f32_32x32x16_bf16(a, b, c, 0, 0, 0)

namespace pg8 {
constexpr int BM = 256, BK = 64, HALF = 128, HTB = HALF * BK * 2, STAGE_BYTES = 8 * HTB;
__host__ __device__ __forceinline__ int lds_byte(int r, int c) { const int st = (r >> 4) * 2 + (c >> 5), rr = r & 15, cc = c & 31, ob = rr * 64 + cc * 2; return st * 1024 + (ob ^ (((ob >> 9) & 1) << 5)); }
__host__ __device__ __forceinline__ void stage_rc(int b, int& R, int& C) { const int st = b / 1024, sb = b % 1024, swz = sb ^ (((sb >> 9) & 1) << 5); R = (st >> 1) * 16 + swz / 64; C = (st & 1) * 32 + (swz % 64) / 2; }
__host__ __device__ __forceinline__ int perm32(int rho) { const int n = rho >> 4, i = rho & 15; return 8 * (i >> 2) + 4 * n + (i & 3); }
struct Unit { int pm, pn; };
template <class Epi, class Sched, bool GA = false>
__device__ __forceinline__ void gemm_phase(LAS unsigned char* lds, const int K, const Sched& S, const Epi& E) {
    int tid = threadIdx.x, bid = blockIdx.x, gdim = gridDim.x; asm volatile("" : "+v"(tid), "+s"(bid), "+s"(gdim)); const int wid = __builtin_amdgcn_readfirstlane(tid >> 6), lane = tid & 63, wr = wid >> 2, wc = wid & 3, fr = lane & 15, fq = lane >> 4;
    const int nt = K / BK;
    unsigned voffA[2], voffB[2], colA2[2]; int rowA[2];
    unsigned vAc[2][2], vAn[2][2], vAnn[2][2];
#pragma unroll
    for (int i = 0; i < 2; ++i) { int R, C; stage_rc(tid * 16 + i * 8192, R, C); const int Rb = Epi::PERM ? ((R & ~31) + perm32(R & 31)) : R;
        voffA[i] = (unsigned)(R * K + C) * 2u; voffB[i] = (unsigned)(Rb * K + C) * 2u; rowA[i] = R; colA2[i] = (unsigned)C * 2u; }
    const size_t kstep = (size_t)(BK * 2);
    const size_t hstep = (size_t)HALF * K * 2;
    const unsigned ldsw = (unsigned)wid * 1024u;
    const int aoff = lds_byte(wr * 64 + fr, fq * 8), boff = lds_byte(wc * 32 + fr, fq * 8);
#define PG8_SA(b, h) (((b) * 2 + (h)) * HTB)
#define PG8_SB(b, h) ((4 + (b) * 2 + (h)) * HTB)
#define PG8_STAGE(bufoff, gbase, voff) do { _Pragma("unroll") for (int _i = 0; _i < 2; ++_i) \
        __builtin_amdgcn_global_load_lds((const unsigned*)((const char*)(gbase) + (voff)[_i]), (LAS unsigned*)(lds + (bufoff) + ldsw + _i * 8192), 16, 0, 0); } while (0)
#define PG8_TOK(v, u) do { if constexpr (GA) { const int* tk_ = S.atok(u); _Pragma("unroll") for (int h_ = 0; h_ < 2; ++h_) _Pragma("unroll") for (int i_ = 0; i_ < 2; ++i_) v[h_][i_] = (unsigned)tk_[rowA[i_] + 128 * h_] * (unsigned)(K * 2) + colA2[i_]; } } while (0)
#define PG8_STAGE_A(bufoff, gptr, koff, half, nx) do { if constexpr (GA) { const char* gb_ = S.abase() + (koff); _Pragma("unroll") for (int _i = 0; _i < 2; ++_i) { const unsigned vo_ = (nx) ? vAn[half][_i] : vAc[half][_i]; \
        __builtin_amdgcn_global_load_lds((const unsigned*)(gb_ + vo_), (LAS unsigned*)(lds + (bufoff) + ldsw + _i * 8192), 16, 0, 0); } } else { PG8_STAGE(bufoff, (gptr) + (half) * hstep, voffA); } } while (0)
#define PG8_LDA(dst, b, h) do { _Pragma("unroll") for (int m = 0; m < 4; ++m) _Pragma("unroll") for (int k = 0; k < 2; ++k) dst[m][k] = *(const LAS bf16x8*)(lds + PG8_SA(b, h) + aoff + m * 2048 + k * 1024); } while (0)
#define PG8_LDB(dst, b, h) do { _Pragma("unroll") for (int n = 0; n < 2; ++n) _Pragma("unroll") for (int k = 0; k < 2; ++k) dst[n][k] = *(const LAS bf16x8*)(lds + PG8_SB(b, h) + boff + n * 2048 + k * 1024); } while (0)
#define PG8_MMA(ai, bj, At, Bt) do { __builtin_amdgcn_s_setprio(1); _Pragma("unroll") for (int m = 0; m < 4; ++m) _Pragma("unroll") for (int n = 0; n < 2; ++n) _Pragma("unroll") for (int k = 0; k < 2; ++k) \
        acc[ai][bj][m][n] = __builtin_amdgcn_mfma_f32_16x16x32_bf16(Bt[n][k], At[m][k], acc[ai][bj][m][n], 0, 0, 0); __builtin_amdgcn_s_setprio(0); } while (0)
#define PG8_WAIT_V(n) asm volatile("s_waitcnt vmcnt(" #n ")" ::: "memory")
#define PG8_WAIT_L(n) asm volatile("s_waitcnt lgkmcnt(" #n ")" ::: "memory")
#define PG8_BAR __builtin_amdgcn_s_barrier()
#define PG8_SCHED __builtin_amdgcn_sched_barrier(0)
    Unit cur, nxt; int ui = 0;
    if (!S.next(0, cur)) return;
    f32x4 acc[2][2][4][2];
#pragma unroll
    for (int a = 0; a < 2; ++a)
#pragma unroll
        for (int b = 0; b < 2; ++b)
#pragma unroll
            for (int m = 0; m < 4; ++m)
#pragma unroll
                for (int n = 0; n < 2; ++n) acc[a][b][m][n] = (f32x4){0.f, 0.f, 0.f, 0.f};
    bf16x8 At[4][2], B0[2][2], B1[2][2];
    const char* cA = S.aptr(cur); const char* cB = S.bptr(cur);
    PG8_TOK(vAc, cur);
    if constexpr (GA) { Unit u1_; if (S.next(1, u1_)) { PG8_TOK(vAn, u1_); } else { _Pragma("unroll") for (int h_ = 0; h_ < 2; ++h_) _Pragma("unroll") for (int i_ = 0; i_ < 2; ++i_) vAn[h_][i_] = vAc[h_][i_]; } }
    PG8_STAGE(PG8_SB(0, 0), cB, voffB); PG8_STAGE_A(PG8_SA(0, 0), cA, 0, 0, false); PG8_STAGE(PG8_SB(0, 1), cB + hstep, voffB); PG8_STAGE_A(PG8_SA(0, 1), cA, 0, 1, false);
    if (wr == 1) PG8_BAR;
    PG8_WAIT_V(4); PG8_BAR;
    PG8_STAGE(PG8_SB(1, 0), cB + kstep, voffB); PG8_STAGE_A(PG8_SA(1, 0), cA + kstep, kstep, 0, false); PG8_STAGE(PG8_SB(1, 1), cB + hstep + kstep, voffB);
    PG8_WAIT_V(6); PG8_BAR;
    for (;;) {
        const bool has_next = S.next(ui + 1, nxt);
        const char* nA = has_next ? S.aptr(nxt) : cA; const char* nB = has_next ? S.bptr(nxt) : cB;
        for (int t = 0; t < nt; t += 2) {
            const bool last = (t == nt - 2);
            const char* a1 = cA + (size_t)(t + 1) * kstep;
            const char* a2 = last ? nA : cA + (size_t)(t + 2) * kstep; const char* b2 = last ? nB : cB + (size_t)(t + 2) * kstep;
            const char* a3 = a2 + kstep; const char* b3 = b2 + kstep;
            const size_t k1 = (size_t)(t + 1) * kstep, k2 = last ? 0 : (size_t)(t + 2) * kstep, k3 = k2 + kstep;
            PG8_LDB(B0, 0, 0); PG8_SCHED; PG8_LDA(At, 0, 0); PG8_STAGE_A(PG8_SA(1, 1), a1, k1, 1, false);
            PG8_WAIT_L(8); PG8_BAR; PG8_WAIT_L(0); PG8_MMA(0, 0, At, B0); PG8_BAR; PG8_SCHED;
            PG8_LDB(B1, 0, 1); PG8_STAGE(PG8_SB(0, 0), b2, voffB);
            PG8_BAR; PG8_WAIT_L(0); PG8_MMA(0, 1, At, B1); PG8_BAR;
            PG8_LDA(At, 0, 1); PG8_STAGE_A(PG8_SA(0, 0), a2, k2, 0, last);
            PG8_BAR; PG8_WAIT_L(0); PG8_MMA(1, 0, At, B0); PG8_BAR; PG8_SCHED;
            PG8_STAGE(PG8_SB(0, 1), b2 + hstep, voffB);
            PG8_WAIT_V(6); PG8_BAR; PG8_MMA(1, 1, At, B1); PG8_BAR;
            PG8_LDB(B0, 1, 0); PG8_SCHED; PG8_LDA(At, 1, 0); PG8_STAGE_A(PG8_SA(0, 1), a2, k2, 1, last);
            PG8_WAIT_L(8); PG8_BAR; PG8_WAIT_L(0); PG8_MMA(0, 0, At, B0); PG8_BAR; PG8_SCHED;
            PG8_LDB(B1, 1, 1); PG8_STAGE(PG8_SB(1, 0), b3, voffB);
            PG8_BAR; PG8_WAIT_L(0); PG8_MMA(0, 1, At, B1); PG8_BAR;
            PG8_LDA(At, 1, 1); PG8_STAGE_A(PG8_SA(1, 0), a3, k3, 0, last);
            PG8_BAR; PG8_WAIT_L(0); PG8_MMA(1, 0, At, B0); PG8_BAR; PG8_SCHED;
            PG8_STAGE(PG8_SB(1, 1), b3 + hstep, voffB);
            PG8_WAIT_V(6); PG8_BAR; PG8_MMA(1, 1, At, B1); PG8_BAR;
        }
        E(acc, cur, wr, wc, fr, fq);
        if (!has_next) break;
        if constexpr (GA) { Unit u2_; if (S.next(ui + 2, u2_)) { PG8_TOK(vAnn, u2_); } else { _Pragma("unroll") for (int h_ = 0; h_ < 2; ++h_) _Pragma("unroll") for (int i_ = 0; i_ < 2; ++i_) vAnn[h_][i_] = vAn[h_][i_]; } }
#pragma unroll
        for (int a = 0; a < 2; ++a)
#pragma unroll
            for (int b = 0; b < 2; ++b)
#pragma unroll
                for (int m = 0; m < 4; ++m)
#pragma unroll
                    for (int n = 0; n < 2; ++n) acc[a][b][m][n] = (f32x4){0.f, 0.f, 0.f, 0.f};
        cur = nxt; cA = nA; cB = nB; ++ui;
        if constexpr (GA) { _Pragma("unroll") for (int h_ = 0; h_ < 2; ++h_) _Pragma("unroll") for (int i_ = 0; i_ < 2; ++i_) { vAc[h_][i_] = vAn[h_][i_]; vAn[h_][i_] = vAnn[h_][i_]; } }
    }
    PG8_WAIT_V(0);
    if (wr == 0) PG8_BAR;
    PG8_BAR;
#undef PG8_SA
#undef PG8_SB
#undef PG8_STAGE
#undef PG8_STAGE_A
#undef PG8_TOK
#undef PG8_LDA
#undef PG8_LDB
#undef PG8_MMA
#undef PG8_WAIT_V
#undef PG8_WAIT_L
#undef PG8_BAR
#undef PG8_SCHED
}
}

#define XB_TMO      128
#define XB_XCNT(j)  (256  + 64 * (j))
#define XB_XSUB(j)  (1280 + 64 * (j))
#define XB_XGEN(j)  (2304 + 64 * (j))
#define XB_TOP      3328
#define XB_TOPGEN   3392
#define XCD_BAR_WORDS 3456
#define XB_SPIN_CAP (1u << 20)
__device__ __forceinline__ unsigned xb_ld(unsigned* p)              { return __hip_atomic_load(p, __ATOMIC_RELAXED, __HIP_MEMORY_SCOPE_AGENT); }
__device__ __forceinline__ unsigned xb_add(unsigned* p, unsigned v) { return __hip_atomic_fetch_add(p, v, __ATOMIC_RELAXED, __HIP_MEMORY_SCOPE_AGENT); }
__device__ __forceinline__ unsigned xb_xcc_id() { return (unsigned)__builtin_amdgcn_s_getreg((3 << 11) | 20) & 0xFu; }
#define XB_SPIN(cond, bar) do { unsigned _sp = 0; while (cond) { __builtin_amdgcn_s_sleep(1); \
    if ((++_sp & 255u) == 0u) { if (xb_ld(&(bar)[XB_TMO])) break; if (_sp > XB_SPIN_CAP) { atomicAdd(&(bar)[XB_TMO], 1u); break; } } } } while (0)
struct XcdBarrier { unsigned* bar; unsigned x; volatile LAS unsigned* st; };
__device__ __forceinline__ XcdBarrier xcd_barrier_post(unsigned* bar, volatile LAS unsigned* st) {
    XcdBarrier b; b.bar = bar; b.x = xb_xcc_id(); b.st = st;
    if (threadIdx.x == 0) (void)xb_add(&bar[XB_XCNT(b.x)], 1u);
    return b;
}
__device__ __forceinline__ void xcd_barrier_complete(unsigned* bar, unsigned x, unsigned& nloc, unsigned& nx) {
    const unsigned G = gridDim.x * gridDim.y * gridDim.z;
    unsigned sum, cnt, mine, sp = 0u;
    for (;;) {
        sum = 0u; cnt = 0u; mine = 0u;
#pragma unroll
        for (unsigned j = 0; j < 16; ++j) { const unsigned c = xb_ld(&bar[XB_XCNT(j)]); sum += c; cnt += (c > 0u) ? 1u : 0u; mine = (j == x) ? c : mine; }
        if (sum == G) break;
        __builtin_amdgcn_s_sleep(1);
        if ((++sp & 255u) == 0u) { if (xb_ld(&bar[XB_TMO])) break; if (sp > XB_SPIN_CAP) { atomicAdd(&bar[XB_TMO], 1u); break; } }
    }
    nloc = mine > 0u ? mine : 1u; nx = cnt > 0u ? cnt : 1u;
}
__device__ __forceinline__ void xcd_barrier(const XcdBarrier& b) {
    asm volatile("s_waitcnt vmcnt(0)" ::: "memory");
    __syncthreads();
    if (threadIdx.x == 0) {
        unsigned* bar = b.bar;
        __builtin_amdgcn_s_waitcnt(0);
        unsigned nloc = b.st[0], nx = b.st[1];
        if (nloc == 0u) { xcd_barrier_complete(bar, b.x, nloc, nx); b.st[0] = nloc; b.st[1] = nx; }
        const unsigned old = xb_add(&bar[XB_XSUB(b.x)], 1u);
        const unsigned gen = old / nloc;
        if (old + 1u == (gen + 1u) * nloc) {
            __builtin_amdgcn_fence(__ATOMIC_RELEASE, "agent");
            asm volatile("s_waitcnt vmcnt(0)" ::: "memory");
            const unsigned og = xb_add(&bar[XB_TOP], 1u);
            const unsigned tg = og / nx;
            if (og + 1u == (tg + 1u) * nx) xb_add(&bar[XB_TOPGEN], 1u);
            else XB_SPIN(xb_ld(&bar[XB_TOPGEN]) == tg, bar);
            __builtin_amdgcn_fence(__ATOMIC_ACQUIRE, "agent");
            xb_add(&bar[XB_XGEN(b.x)], 1u);
            asm volatile("s_waitcnt vmcnt(0)" ::: "memory");
        } else {
            XB_SPIN(xb_ld(&bar[XB_XGEN(b.x)]) == gen, bar);
            __builtin_amdgcn_fence(__ATOMIC_ACQUIRE, "agent");
            asm volatile("s_waitcnt vmcnt(0)" ::: "memory");
        }
    }
    __syncthreads();
}

struct Params {
    const float* in[27];
    float* out;
    unsigned char* ws;
    int ph_lo, ph_hi;
};
typedef const __attribute__((address_space(4))) Params* PP;
enum { I_X = 0, I_C, I_CTX, I_CCTX, I_WMOD, I_BMOD, I_NMIXG, I_WIN, I_QNG, I_KNG, I_LQ1, I_LK1, I_LQ2, I_LK2, I_SUBLN, I_CONVW, I_ALOG, I_DTB, I_GDNG, I_WOUT, I_NFFNG, I_RW, I_RB, I_WGU, I_BGU, I_WD, I_BD };

__device__ __forceinline__ const float* hrow_in(PP p, int layer, int r) {
    if (layer == 0) return r < NLAT ? p->in[I_X] + (size_t)r * D : p->in[I_CTX] + (size_t)(r - NLAT) * D;
    return (const float*)(p->ws + WS_H) + (size_t)r * D;
}
__device__ __forceinline__ int mod_sel(int r) { return r < NLAT ? (r >= SEQL ? 1 : 0) : 2; }

__device__ __forceinline__ void transpose_item(const float* W, size_t ldw, int k0, int n0, bf16_t* WT, int drow0, LAS float* scr, int lane) {
#pragma unroll 8
    for (int i = 0; i < 32; ++i) { const int kk = 2 * i + (lane >> 5); scr[kk * 33 + (lane & 31)] = W[(size_t)(k0 + kk) * ldw + n0 + (lane & 31)]; }
    LDS_WAIT(); asm volatile("" ::: "memory");
    const int c = lane & 7;
#pragma unroll
    for (int j = 0; j < 4; ++j) { const int n = (lane >> 3) + 8 * j; const LAS float* s = scr + (8 * c) * 33 + n;
        u32x4 o; o.x = pk2(s[0 * 33], s[1 * 33]); o.y = pk2(s[2 * 33], s[3 * 33]); o.z = pk2(s[4 * 33], s[5 * 33]); o.w = pk2(s[6 * 33], s[7 * 33]);
        *(u32x4*)(WT + (size_t)(drow0 + n) * 1024 + k0 + 8 * c) = o; }
    LDS_WAIT(); asm volatile("" ::: "memory");
}

__device__ __forceinline__ void phase_prologue(PP p, LAS unsigned char* lds) {
    int tid = threadIdx.x, bid = blockIdx.x, gdim = gridDim.x; asm volatile("" : "+v"(tid), "+s"(bid), "+s"(gdim)); const int lane = tid & 63, wave = __builtin_amdgcn_readfirstlane(tid >> 6);
    float* cf = (float*)(p->ws + WS_CONST);
    if (bid < 192) {
        const int l = bid / 96, cg = bid % 96;
        LAS float* sl = (LAS float*)lds;
        LAS float* red = sl + 3 * 1024;
        for (int i = tid; i < 3 * 1024; i += NTHR) { const int s = i >> 10, k = i & 1023; const float v = s < 2 ? p->in[I_C][s * D + k] : p->in[I_CCTX][k]; sl[i] = silu_f(v); }
        __syncthreads();
        const float* wm = p->in[I_WMOD] + (size_t)l * D * 6144 + cg * 64 + lane;
        float a0 = 0.f, a1 = 0.f, a2 = 0.f;
#pragma unroll 16
        for (int kk = 0; kk < 128; ++kk) { const int k = wave * 128 + kk; const float w = wm[(size_t)k * 6144]; a0 += sl[k] * w; a1 += sl[1024 + k] * w; a2 += sl[2048 + k] * w; }
        red[(wave * 3 + 0) * 64 + lane] = a0; red[(wave * 3 + 1) * 64 + lane] = a1; red[(wave * 3 + 2) * 64 + lane] = a2;
        __syncthreads();
        if (wave < 3) { float s = 0.f;
#pragma unroll
            for (int w = 0; w < 8; ++w) s += red[(w * 3 + wave) * 64 + lane];
            cf[CF_MODV + (l * 3 + wave) * 6144 + cg * 64 + lane] = s + p->in[I_BMOD][l * 6144 + cg * 64 + lane]; }
        __syncthreads();
    }
    if (bid >= 192 && bid < 202) {
        const int idx = (bid - 192) * NTHR + tid;
        if (idx < 320 * 16) { const int pos = idx >> 4, i = idx & 15; const float invf = powf(10000.f, -(float)i / 16.f);
            const float posf = (float)(pos < 256 ? pos : pos - 256); const float ang = posf * invf; const double a = (double)ang;
            const float cs = (float)cos(a), sn = (float)sin(a);
            if (pos < 256) { cf[CF_ROPE + pos * 16 + i] = cs; cf[CF_ROPE + 4096 + pos * 16 + i] = sn; }
            else { cf[CF_ROPE + 8192 + (pos - 256) * 16 + i] = cs; cf[CF_ROPE + 9216 + (pos - 256) * 16 + i] = sn; } }
    }
    if (bid == 202 && wave < 2) {
        const int l = wave;
        const float d1 = wave_sum(p->in[I_LQ1][l * 64 + lane] * p->in[I_LK1][l * 64 + lane]);
        const float d2 = wave_sum(p->in[I_LQ2][l * 64 + lane] * p->in[I_LK2][l * 64 + lane]);
        const float lam_init = 0.8f - 0.6f * expf(-0.3f * (float)l);
        const float mq = wave_max(fabsf(p->in[I_QNG][l * 64 + lane])), mk = wave_max(fabsf(p->in[I_KNG][l * 64 + lane]));
        if (lane == 0) { cf[CF_SC + l * 16 + 0] = expf(d1) - expf(d2) + lam_init; cf[CF_SC + l * 16 + 1] = LOG2E * 0.125f * 64.f * mq * mk * 1.0001f + 0.01f; cf[CF_SC + l * 16 + 2] = 1.f - lam_init; }
    }
    {
        LAS float* scr = (LAS float*)(lds + wave * 16384);
        const int gw = bid * NWAVES + wave, NGW = gdim * NWAVES;
        constexpr int I_IN = 16 * 112, I_OUT = 16 * 32, I_GU = 16 * 64, I_DN = 16 * 32;
        constexpr int PER_LAYER = I_IN + I_OUT + NEXP * I_GU + NEXP * I_DN;
        for (int it = gw; it < 2 * PER_LAYER; it += NGW) {
            const int l = it / PER_LAYER; int r = it % PER_LAYER;
            if (r < I_IN) { const int kb = r / 112, nb = r % 112;
                transpose_item(p->in[I_WIN] + (size_t)l * D * INC, INC, kb * 64, nb * 32, (bf16_t*)(p->ws + WS_WIN) + (size_t)l * PW * 1024, nb * 32, scr, lane); continue; }
            r -= I_IN;
            if (r < I_OUT) { const int kb = r / 32, nb = r % 32;
                transpose_item(p->in[I_WOUT] + (size_t)l * D * D, D, kb * 64, nb * 32, (bf16_t*)(p->ws + WS_WOUT) + (size_t)l * D * 1024, nb * 32, scr, lane); continue; }
            r -= I_OUT;
            if (r < NEXP * I_GU) { const int e = r / I_GU, q = r % I_GU, kb = q / 64, nb = q % 64; const int n0 = nb * 32, j = n0 & 1023, isup = n0 >> 10;
                const int drow = (j >> 7) * 256 + isup * 128 + (j & 127);
                transpose_item(p->in[I_WGU] + (size_t)(l * NEXP + e) * D * 2048, 2048, kb * 64, n0, (bf16_t*)(p->ws + WS_WGU) + (size_t)(l * NEXP + e) * 2048 * 1024, drow, scr, lane); continue; }
            r -= NEXP * I_GU;
            { const int e = r / I_DN, q = r % I_DN, kb = q / 32, nb = q % 32;
                transpose_item(p->in[I_WD] + (size_t)(l * NEXP + e) * D * D, D, kb * 64, nb * 32, (bf16_t*)(p->ws + WS_WD) + (size_t)(l * NEXP + e) * D * 1024, nb * 32, scr, lane); }
        }
    }
}

struct PlainSched {
    const char* A; const char* Bt; int K, nM, nN, nwg, G, c;
    __device__ __forceinline__ void init(const void* A_, const void* Bt_, int K_, int nM_, int nN_, int G_, int c_) { A = (const char*)A_; Bt = (const char*)Bt_; K = K_; nM = nM_; nN = nN_; nwg = nM * nN; G = G_; c = c_; }
    __device__ __forceinline__ bool next(int i, pg8::Unit& u) const {
        const long L = (long)i * G + c; if (L >= nwg) return false;
        int wgid = (int)L; { const int q = nwg / 8, r = nwg % 8, xcd = wgid % 8, off = wgid / 8; wgid = (xcd < r ? xcd * (q + 1) : r * (q + 1) + (xcd - r) * q) + off; }
        const int nig = 8 * nN, gid = wgid / nig, fm = gid * 8, gsz = (nM - fm) < 8 ? (nM - fm) : 8;
        u.pm = fm + ((wgid % nig) % gsz); u.pn = (wgid % nig) / gsz; return true;
    }
    __device__ __forceinline__ const char* aptr(const pg8::Unit& u) const { return A + (size_t)u.pm * 256 * K * 2; }
    __device__ __forceinline__ const char* bptr(const pg8::Unit& u) const { return Bt + (size_t)u.pn * 256 * K * 2; }
};
struct MoeSched {
    const char* A; const char* W; const int* blk_e; int nblk, nN, G, c;
    __device__ __forceinline__ bool next(int i, pg8::Unit& u) const {
        const int x = c & 7, w = c >> 3, nw = G >> 3;
        const int b0 = (int)(((long)nblk * x) >> 3), b1 = (int)(((long)nblk * (x + 1)) >> 3);
        const int j = i * nw + w, pm = b0 + j / nN; if (pm >= b1) return false;
        u.pm = pm; u.pn = j % nN; return true;
    }
    const int* tok;
    __device__ __forceinline__ const char* aptr(const pg8::Unit& u) const { return A + (size_t)u.pm * 256 * 1024 * 2; }
    __device__ __forceinline__ const char* abase() const { return A; }
    __device__ __forceinline__ const int* atok(const pg8::Unit& u) const { return tok + u.pm * 256; }
    __device__ __forceinline__ const char* bptr(const pg8::Unit& u) const { const int e = ((const __attribute__((address_space(4))) int*)blk_e)[u.pm];
        return W + ((size_t)e * nN + u.pn) * 256 * 1024 * 2; }
};
struct EpiStoreBf16 {
    static constexpr bool PERM = true;
    bf16_t* O; int ldc;
    __device__ __forceinline__ void operator()(const f32x4 (&acc)[2][2][4][2], const pg8::Unit& u, int wr, int wc, int fr, int fq) const {
        const int row0 = u.pm * 256 + wr * 64 + fr, col0 = u.pn * 256 + wc * 32 + 8 * fq;
#pragma unroll
        for (int ai = 0; ai < 2; ++ai)
#pragma unroll
            for (int m = 0; m < 4; ++m) { bf16_t* rowp = O + (size_t)(row0 + ai * 128 + m * 16) * ldc + col0;
#pragma unroll
                for (int bj = 0; bj < 2; ++bj) { const f32x4 v0 = acc[ai][bj][m][0], v1 = acc[ai][bj][m][1];
                    u32x4 w; w.x = cvt_pk_bf16(v0[0], v0[1]); w.y = cvt_pk_bf16(v0[2], v0[3]); w.z = cvt_pk_bf16(v1[0], v1[1]); w.w = cvt_pk_bf16(v1[2], v1[3]);
                    *(u32x4*)(rowp + bj * 128) = w; } }
    }
};
struct EpiResidual {
    static constexpr bool PERM = false;
    PP p; int layer; const float* gate;
    __device__ __forceinline__ void operator()(const f32x4 (&acc)[2][2][4][2], const pg8::Unit& u, int wr, int wc, int fr, int fq) const {
        const int row0 = u.pm * 256 + wr * 64 + fr, col0 = u.pn * 256 + wc * 32 + 4 * fq;
        float* H = (float*)(p->ws + WS_H);
#pragma unroll
        for (int ai = 0; ai < 2; ++ai)
#pragma unroll
            for (int m = 0; m < 4; ++m) { const int row = row0 + ai * 128 + m * 16; const float* hin = hrow_in(p, layer, row) + col0; const float* g = gate + mod_sel(row) * 6144 + col0;
                float* ho = H + (size_t)row * D + col0;
#pragma unroll
                for (int bj = 0; bj < 2; ++bj)
#pragma unroll
                    for (int n = 0; n < 2; ++n) { const f32x4 hv = *(const f32x4*)(hin + bj * 128 + n * 16), gv = *(const f32x4*)(g + bj * 128 + n * 16);
                        *(f32x4*)(ho + bj * 128 + n * 16) = hv + gv * acc[ai][bj][m][n]; } }
    }
};
struct EpiGateUp {
    static constexpr bool PERM = true;
    bf16_t* ACT; const float* bgu; const int* blk_e;
    __device__ __forceinline__ void operator()(const f32x4 (&acc)[2][2][4][2], const pg8::Unit& u, int wr, int wc, int fr, int fq) const {
        const int row0 = u.pm * 256 + wr * 64 + fr, col0 = u.pn * 128 + wc * 32 + 8 * fq; const int e = blk_e[u.pm];
        const float* bg = bgu + (size_t)e * 2048 + col0; const float* bu = bg + 1024;
        f32x4 bgv[2], buv[2];
#pragma unroll
        for (int n = 0; n < 2; ++n) { bgv[n] = *(const f32x4*)(bg + 4 * n); buv[n] = *(const f32x4*)(bu + 4 * n); }
#pragma unroll
        for (int ai = 0; ai < 2; ++ai)
#pragma unroll
            for (int m = 0; m < 4; ++m) { float o[8];
#pragma unroll
                for (int n = 0; n < 2; ++n)
#pragma unroll
                    for (int j = 0; j < 4; ++j) { float g = acc[ai][0][m][n][j] + bgv[n][j], up = acc[ai][1][m][n][j] + buv[n][j];
                        g = fminf(g, 7.f); up = fminf(fmaxf(up, -7.f), 7.f);
                        const float glu = g * __builtin_amdgcn_rcpf(1.f + __builtin_amdgcn_exp2f(-1.702f * LOG2E * g)); o[n * 4 + j] = (up + 1.f) * glu; }
                u32x4 w; w.x = cvt_pk_bf16(o[0], o[1]); w.y = cvt_pk_bf16(o[2], o[3]); w.z = cvt_pk_bf16(o[4], o[5]); w.w = cvt_pk_bf16(o[6], o[7]);
                *(u32x4*)(ACT + (size_t)(row0 + ai * 128 + m * 16) * 1024 + col0) = w; }
    }
};
struct EpiDown {
    static constexpr bool PERM = true;
    bf16_t* Y; const float* bd; const int* blk_e; const float* sgate;
    __device__ __forceinline__ void operator()(const f32x4 (&acc)[2][2][4][2], const pg8::Unit& u, int wr, int wc, int fr, int fq) const {
        const int row0 = u.pm * 256 + wr * 64 + fr, col0 = u.pn * 256 + wc * 32 + 8 * fq; const int e = blk_e[u.pm];
        const float* b = bd + (size_t)e * 1024 + col0;
        f32x4 bv[2][2];
#pragma unroll
        for (int bj = 0; bj < 2; ++bj)
#pragma unroll
            for (int n = 0; n < 2; ++n) bv[bj][n] = *(const f32x4*)(b + bj * 128 + 4 * n);
#pragma unroll
        for (int ai = 0; ai < 2; ++ai)
#pragma unroll
            for (int m = 0; m < 4; ++m) { const int row = row0 + ai * 128 + m * 16; const float sg = sgate[row]; bf16_t* rowp = Y + (size_t)row * 1024 + col0;
#pragma unroll
                for (int bj = 0; bj < 2; ++bj) { const f32x4 v0 = (acc[ai][bj][m][0] + bv[bj][0]) * sg, v1 = (acc[ai][bj][m][1] + bv[bj][1]) * sg;
                    u32x4 w; w.x = cvt_pk_bf16(v0[0], v0[1]); w.y = cvt_pk_bf16(v0[2], v0[3]); w.z = cvt_pk_bf16(v1[0], v1[1]); w.w = cvt_pk_bf16(v1[2], v1[3]);
                    *(u32x4*)(rowp + bj * 128) = w; } }
    }
};

__device__ __forceinline__ void norm_mod_vals(const float* g, const float* shift, const float* scale, int lane, f32x4 (&u)[4]) {
    float ss = 0.f;
#pragma unroll
    for (int j = 0; j < 4; ++j) ss += (u[j][0] * u[j][0] + u[j][1] * u[j][1]) + (u[j][2] * u[j][2] + u[j][3] * u[j][3]);
    const float rstd = rsqrtf(wave_sum(ss) * (1.f / D) + EPS);
#pragma unroll
    for (int j = 0; j < 4; ++j) { const int c = 4 * lane + 256 * j; const f32x4 gv = *(const f32x4*)(g + c), sh = *(const f32x4*)(shift + c), sc = *(const f32x4*)(scale + c);
        u[j] = (u[j] * rstd) * gv * (sc + 1.f) + sh; }
}
__device__ __forceinline__ void norm_mod_row(const float* hrow, const float* g, const float* shift, const float* scale, int lane, f32x4 (&u)[4]) {
#pragma unroll
    for (int j = 0; j < 4; ++j) u[j] = *(const f32x4*)(hrow + 4 * lane + 256 * j);
    norm_mod_vals(g, shift, scale, lane, u);
}
__device__ __forceinline__ void store_row_bf16(bf16_t* orow, int lane, const f32x4 (&u)[4]) {
#pragma unroll
    for (int j = 0; j < 4; ++j) { u32x2 w; w.x = cvt_pk_bf16(u[j][0], u[j][1]); w.y = cvt_pk_bf16(u[j][2], u[j][3]); *(u32x2*)(orow + 4 * lane + 256 * j) = w; }
}

__device__ __forceinline__ void norm_mix_stage_wab(PP p, int layer, LAS float* wab, int tid) {
    const float* win = p->in[I_WIN] + (size_t)layer * D * INC;
    for (int i = tid; i < 16 * 1024; i += NTHR) { const int k = i >> 4, j = i & 15; wab[j * 1024 + k] = win[(size_t)k * INC + PW + j]; }
}
__device__ __forceinline__ void norm_mix_row(PP p, int layer, int r, int lane, f32x4 (&u)[4], const LAS float* wab, float ea, float dtb) {
    const float* cf = (const float*)(p->ws + WS_CONST);
    const float* mv = cf + CF_MODV + (layer * 3 + mod_sel(r)) * 6144;
    norm_mod_vals(p->in[I_NMIXG] + layer * D, mv, mv + 1024, lane, u);
    store_row_bf16((bf16_t*)(p->ws + WS_U) + (size_t)r * D, lane, u);
    float ab = 0.f;
#pragma unroll
    for (int j = 0; j < 16; ++j) { float s = 0.f;
#pragma unroll
        for (int q = 0; q < 4; ++q) { const f32x4 w = *(const LAS f32x4*)(wab + j * 1024 + 4 * lane + 256 * q); s += (u[q][0] * w[0] + u[q][1] * w[1]) + (u[q][2] * w[2] + u[q][3] * w[3]); }
        s = wave_sum(s); if (lane == j) ab = s; }
    float outv;
    if (lane < 8) { const float z = ab + dtb; const float sp = z > 20.f ? z : log1pf(__expf(z)); outv = ea * sp; }
    else outv = 1.f / (1.f + __expf(-ab));
    if (lane < 16) ((float*)(p->ws + WS_GB))[(size_t)r * 16 + lane] = outv;
}
__device__ __forceinline__ void phase_norm_mix(PP p, int layer, LAS unsigned char* lds) {
    int tid = threadIdx.x, bid = blockIdx.x, gdim = gridDim.x; asm volatile("" : "+v"(tid), "+s"(bid), "+s"(gdim)); const int lane = tid & 63, wave = __builtin_amdgcn_readfirstlane(tid >> 6);
    LAS float* wab = (LAS float*)lds;
    norm_mix_stage_wab(p, layer, wab, tid);
    __syncthreads();
    float ea = 0.f, dtb = 0.f; if (lane < 8) { ea = -__expf(p->in[I_ALOG][layer * 8 + lane]); dtb = p->in[I_DTB][layer * 8 + lane]; }
    for (int r = bid * NWAVES + wave; r < NTOK; r += gdim * NWAVES) {
        const float* hrow = hrow_in(p, layer, r); f32x4 u[4];
#pragma unroll
        for (int j = 0; j < 4; ++j) u[j] = *(const f32x4*)(hrow + 4 * lane + 256 * j);
        norm_mix_row(p, layer, r, lane, u, wab, ea, dtb);
    }
}

__device__ __forceinline__ void phase_prep(PP p, int layer) {
    int tid = threadIdx.x, bid = blockIdx.x, gdim = gridDim.x; asm volatile("" : "+v"(tid), "+s"(bid), "+s"(gdim)); const int lane = tid & 63, wave = __builtin_amdgcn_readfirstlane(tid >> 6);
    const float* cf = (const float*)(p->ws + WS_CONST);
    bf16_t* P = (bf16_t*)(p->ws + WS_P); bf16_t* G = (bf16_t*)(p->ws + WS_G);
    const float* cw = p->in[I_CONVW] + (size_t)layer * 5 * 1536;
    float gain[16];
    { const float* gsrc = (lane < 32 ? p->in[I_QNG] : p->in[I_KNG]) + layer * 64 + 16 * (lane & 3);
#pragma unroll
      for (int e = 0; e < 16; ++e) gain[e] = gsrc[e]; }
    const float qscale = lane < 32 ? 0.125f * LOG2E : 1.f;
    for (int r = bid * NWAVES + wave; r < NTOK; r += gdim * NWAVES) {
        bf16_t* prow = P + (size_t)r * PW + 16 * lane;
        const u32x4 w0 = *(const u32x4*)prow, w1 = *(const u32x4*)(prow + 8);
        float x[16];
#pragma unroll
        for (int e = 0; e < 4; ++e) { x[2 * e] = bflo(w0[e]); x[2 * e + 1] = bfhi(w0[e]); x[8 + 2 * e] = bflo(w1[e]); x[8 + 2 * e + 1] = bfhi(w1[e]); }
        float ss = 0.f;
#pragma unroll
        for (int e = 0; e < 16; ++e) ss += x[e] * x[e];
        ss += __shfl_xor(ss, 1); ss += __shfl_xor(ss, 2);
        const float rstd = rsqrtf(ss * (1.f / 64.f) + EPS);
#pragma unroll
        for (int e = 0; e < 16; ++e) x[e] = x[e] * rstd * gain[e];
        if (r < NLAT) {
            const int t = r & (SEQL - 1); const int pos = (lane & 2) ? (t & 63) : (t >> 6);
            const float* ct = cf + CF_ROPE + ((lane & 2) ? 8192 : 0) + pos * 16; const float* st = ct + ((lane & 2) ? 1024 : 4096);
            const bool second = lane & 1;
#pragma unroll
            for (int e = 0; e < 16; ++e) { const float other = __shfl_xor(x[e], 1); const float cs = ct[e], sn = st[e];
                x[e] = second ? (x[e] * cs + other * sn) : (x[e] * cs - other * sn); }
        }
        u32x4 o0, o1;
#pragma unroll
        for (int e = 0; e < 4; ++e) { o0[e] = cvt_pk_bf16(x[2 * e] * qscale, x[2 * e + 1] * qscale); o1[e] = cvt_pk_bf16(x[8 + 2 * e] * qscale, x[8 + 2 * e + 1] * qscale); }
        *(u32x4*)prow = o0; *(u32x4*)(prow + 8) = o1;
    }
    for (int r = bid * NWAVES + wave; r < NTOK; r += gdim * NWAVES) {
        int seg0, seglen; if (r < NLAT) { seg0 = r & ~(SEQL - 1); seglen = SEQL; } else { seg0 = NLAT + ((r - NLAT) & ~(CTXL - 1)); seglen = CTXL; }
        const int tpos = r - seg0;
#pragma unroll
        for (int grp = 0; grp < 3; ++grp) {
            const int c0 = grp * 512 + 8 * lane;
            float a[8];
#pragma unroll
            for (int e = 0; e < 8; ++e) a[e] = 0.f;
#pragma unroll
            for (int j = 0; j < 5; ++j) { const int tp = tpos + j - 2;
                if (tp >= 0 && tp < seglen) { const u32x4 w = *(const u32x4*)(P + (size_t)(seg0 + tp) * PW + 1536 + c0);
                    const f32x4 k0 = *(const f32x4*)(cw + j * 1536 + c0), k1 = *(const f32x4*)(cw + j * 1536 + c0 + 4);
                    a[0] += bflo(w[0]) * k0[0]; a[1] += bfhi(w[0]) * k0[1]; a[2] += bflo(w[1]) * k0[2]; a[3] += bfhi(w[1]) * k0[3];
                    a[4] += bflo(w[2]) * k1[0]; a[5] += bfhi(w[2]) * k1[1]; a[6] += bflo(w[3]) * k1[2]; a[7] += bfhi(w[3]) * k1[3]; } }
            float ss = 0.f;
#pragma unroll
            for (int e = 0; e < 8; ++e) { a[e] = silu_f(a[e]); ss += a[e] * a[e]; }
            if (grp < 2) { ss += __shfl_xor(ss, 1); ss += __shfl_xor(ss, 2); ss += __shfl_xor(ss, 4); ss += __shfl_xor(ss, 8);
                const float rn = rsqrtf(ss + EPS);
#pragma unroll
                for (int e = 0; e < 8; ++e) a[e] *= rn; }
            u32x4 o; o.x = cvt_pk_bf16(a[0], a[1]); o.y = cvt_pk_bf16(a[2], a[3]); o.z = cvt_pk_bf16(a[4], a[5]); o.w = cvt_pk_bf16(a[6], a[7]);
            *(u32x4*)(G + (size_t)r * 1536 + c0) = o;
        }
    }
}

typedef short v4i16c_t __attribute__((ext_vector_type(4)));
__device__ __forceinline__ s16x4 vtr_c(const LAS unsigned char* ptr) { return __builtin_bit_cast(s16x4, __builtin_amdgcn_ds_read_tr16_b64_v4i16((LAS v4i16c_t*)ptr)); }
__device__ __forceinline__ void gdn_task_rows(int task, int& b, int& h, int& dir, int& rstart, int& rstep) {
    const int chain = task / NCHUNK, n = task % NCHUNK; dir = chain & 1; h = (chain >> 1) & 3; b = chain >> 3;
    if (n < 4) { const int base = NLAT + b * CTXL; if (dir == 0) { rstart = base + 64 * n; rstep = 1; } else { rstart = base + CTXL - 1 - 64 * n; rstep = -1; } }
    else { const int base = b * SEQL, m = n - 4; if (dir == 0) { rstart = base + 64 * m; rstep = 1; } else { rstart = base + SEQL - 1 - 64 * m; rstep = -1; } }
}
constexpr int CWL_BYTES = 6144, CWL_STG = 2048;
__device__ __forceinline__ void phase_gdn_chunk(PP p, LAS unsigned char* lds) {
    int tid = threadIdx.x, bid = blockIdx.x, gdim = gridDim.x; asm volatile("" : "+v"(tid), "+s"(bid), "+s"(gdim)); const int lane = tid & 63, wave = __builtin_amdgcn_readfirstlane(tid >> 6), r32 = lane & 31, hi = lane >> 5;
    const bf16_t* G = (const bf16_t*)(p->ws + WS_G); const float* GB = (const float*)(p->ws + WS_GB);
    float* cf = (float*)(p->ws + WS_CONST);
    LAS unsigned char* wl = lds + wave * CWL_BYTES;
    LAS float* gcv = (LAS float*)wl;
    LAS unsigned char* stg = wl + CWL_STG;
    const LAS unsigned char* stgp = stg + ((lane >> 4) & 1) * 32 + (lane & 3) * 8 + (4 * hi + ((lane & 15) >> 2)) * 64;
    const LAS unsigned char* stgn = stg + ((lane >> 4) & 1) * 32 + (lane & 3) * 8 + (8 * hi + ((lane & 15) >> 2)) * 64;
    const float SCALE = 0.08838834764831845f;
    for (int task = bid * NWAVES + wave; task < NTASK; task += gdim * NWAVES) {
        int b, h, dir, rstart, rstep; gdn_task_rows(task, b, h, dir, rstart, rstep);
        unsigned char* chb = p->ws + WS_CH + (size_t)task * CH_TASK_BYTES;
        const int myrow = rstart + rstep * lane;
        float gt = GB[(size_t)myrow * 16 + dir * 4 + h]; const float bt = GB[(size_t)myrow * 16 + 8 + dir * 4 + h];
#pragma unroll
        for (int o = 1; o < 64; o <<= 1) { const float t = __shfl_up(gt, o); if (lane >= o) gt += t; }
        const float glast = __shfl(gt, 63), egt = __expf(gt), begt = bt * egt, kdt = __expf(glast - gt);
        gcv[lane] = gt; gcv[64 + lane] = bt;
        if (lane == 0) cf[CF_EGL + task] = __expf(glast);
        const float gcs0 = __shfl(gt, r32), gcs1 = __shfl(gt, 32 + r32);
        const size_t rowA0 = (size_t)(rstart + rstep * r32) * 1536, rowA1 = (size_t)(rstart + rstep * (32 + r32)) * 1536;
        bf16x8 kfr[2][8];
        { const bf16_t* gk = G + 512 + h * 128 + 8 * hi;
#pragma unroll
          for (int ks = 0; ks < 8; ++ks) { kfr[0][ks] = *(const bf16x8*)(gk + rowA0 + 16 * ks); kfr[1][ks] = *(const bf16x8*)(gk + rowA1 + 16 * ks); } }
        LDS_WAIT();
        f32x16 am00, am10, am11;
#define KK_TILE(dst, mi, ni, gcs_) do { f32x16 acc_ = (f32x16){}; \
            _Pragma("unroll") for (int ks = 0; ks < 8; ++ks) acc_ = MFMA32(kfr[mi][ks], kfr[ni][ks], acc_); \
            _Pragma("unroll") for (int q = 0; q < 4; ++q) { const f32x4 g4 = *(const LAS f32x4*)(gcv + 32 * (mi) + 8 * q + 4 * hi), b4 = *(const LAS f32x4*)(gcv + 64 + 32 * (mi) + 8 * q + 4 * hi); \
                _Pragma("unroll") for (int e = 0; e < 4; ++e) { const int cc = 32 * (mi) + 8 * q + 4 * hi + e, ss = 32 * (ni) + r32; \
                    dst[4 * q + e] = (ss < cc) ? -b4[e] * acc_[4 * q + e] * __expf(fminf(g4[e] - (gcs_), 0.f)) : 0.f; } } } while (0)
        KK_TILE(am00, 0, 0, gcs0); KK_TILE(am10, 1, 0, gcs0); KK_TILE(am11, 1, 1, gcs1);
        __builtin_amdgcn_sched_barrier(0);
        { bf16x8 qfr[8]; const bf16_t* gq = G + h * 128 + 8 * hi;
#define KQ_TILE(n, mo, gcc_) do { f32x16 acc_ = (f32x16){}; \
            _Pragma("unroll") for (int ks = 0; ks < 8; ++ks) acc_ = MFMA32(kfr[n][ks], qfr[ks], acc_); \
            _Pragma("unroll") for (int q = 0; q < 4; ++q) { const f32x4 g4 = *(const LAS f32x4*)(gcv + 32 * (n) + 8 * q + 4 * hi); \
                _Pragma("unroll") for (int e = 0; e < 4; ++e) { const int ss = 32 * (n) + 8 * q + 4 * hi + e, cc = 32 * (mo) + r32; \
                    acc_[4 * q + e] = (ss <= cc) ? SCALE * acc_[4 * q + e] * __expf(fminf((gcc_) - g4[e], 0.f)) : 0.f; } } \
            _Pragma("unroll") for (int s = 0; s < 2; ++s) { u32x4 o_; o_.x = cvt_pk_bf16(acc_[8 * s], acc_[8 * s + 1]); o_.y = cvt_pk_bf16(acc_[8 * s + 2], acc_[8 * s + 3]); o_.z = cvt_pk_bf16(acc_[8 * s + 4], acc_[8 * s + 5]); o_.w = cvt_pk_bf16(acc_[8 * s + 6], acc_[8 * s + 7]); \
                *(u32x4*)(chb + CH_AF + (((mo) * 2 + (n)) * 2 + s) * 1024 + lane * 16) = o_; } } while (0)
#pragma unroll
          for (int ks = 0; ks < 8; ++ks) qfr[ks] = *(const bf16x8*)(gq + rowA0 + 16 * ks);
          KQ_TILE(0, 0, gcs0); __builtin_amdgcn_sched_barrier(0);
#pragma unroll
          for (int ks = 0; ks < 8; ++ks) qfr[ks] = *(const bf16x8*)(gq + rowA1 + 16 * ks);
          KQ_TILE(0, 1, gcs1); KQ_TILE(1, 1, gcs1); }
        __builtin_amdgcn_sched_barrier(0);
        { const float eg0 = __shfl(egt, r32) * SCALE, eg1 = __shfl(egt, 32 + r32) * SCALE;
#pragma unroll
          for (int m = 0; m < 2; ++m) { const bf16_t* gq = G + (m ? rowA1 : rowA0) + h * 128 + 4 * hi; const float sc = m ? eg1 : eg0;
#pragma unroll
              for (int ts = 0; ts < 8; ++ts) { const u32x2 a = *(const u32x2*)(gq + 16 * ts), bq = *(const u32x2*)(gq + 16 * ts + 8); u32x4 o_;
                  o_.x = cvt_pk_bf16(bflo(a.x) * sc, bfhi(a.x) * sc); o_.y = cvt_pk_bf16(bflo(a.y) * sc, bfhi(a.y) * sc); o_.z = cvt_pk_bf16(bflo(bq.x) * sc, bfhi(bq.x) * sc); o_.w = cvt_pk_bf16(bflo(bq.y) * sc, bfhi(bq.y) * sc);
                  *(u32x4*)(chb + CH_QF + (m * 8 + ts) * 1024 + lane * 16) = o_; } } }
        __builtin_amdgcn_sched_barrier(0);
        float x[64]; int lane_v = lane; asm volatile("" : "+v"(lane_v));
#pragma unroll
        for (int i = 63; i >= 0; --i) { float a0 = (lane_v == i) ? 1.f : 0.f, a1 = 0.f;
#pragma unroll
            for (int m = 63; m > i; --m) { const int ml = m & 31, hm = (ml >> 2) & 1, rm = (ml >> 3) * 4 + (ml & 3), ln = (i & 31) + 32 * hm;
                const float tv = (m >= 32) ? ((i >= 32) ? am11[rm] : am10[rm]) : am00[rm];
                const float s_ = __builtin_bit_cast(float, __builtin_amdgcn_readlane(__builtin_bit_cast(int, tv), ln));
                if (m & 1) asm("v_fmac_f32 %0, %1, %2" : "+v"(a1) : "s"(s_), "v"(x[m])); else asm("v_fmac_f32 %0, %1, %2" : "+v"(a0) : "s"(s_), "v"(x[m])); }
            x[i] = a0 + a1; __builtin_amdgcn_sched_barrier(0); }
        __builtin_amdgcn_sched_barrier(0);
        bf16x8 F0[4], F1[4];
#pragma unroll
        for (int ks = 0; ks < 4; ++ks) { u32x4 f0, f1;
#pragma unroll
            for (int w = 0; w < 4; ++w) { const unsigned pa = cvt_pk_bf16(x[16 * ks + 2 * w], x[16 * ks + 2 * w + 1]), pb = cvt_pk_bf16(x[16 * ks + 8 + 2 * w], x[16 * ks + 8 + 2 * w + 1]);
                const auto sw = __builtin_amdgcn_permlane32_swap(pa, pb, false, false);
                f0[w] = sw[0]; f1[w] = sw[1]; }
            F0[ks] = __builtin_bit_cast(bf16x8, f0); F1[ks] = __builtin_bit_cast(bf16x8, f1); }
        __builtin_amdgcn_sched_barrier(0);
#define STAGE_PIECE(col0, scal) do { __builtin_amdgcn_sched_barrier(0); const bf16_t* src_ = G + (size_t)myrow * 1536 + (col0); LDS_WAIT(); \
            _Pragma("unroll") for (int q = 0; q < 4; ++q) { const u32x4 w_ = *(const u32x4*)(src_ + 8 * q); u32x4 o_; \
                o_.x = cvt_pk_bf16(bflo(w_.x) * (scal), bfhi(w_.x) * (scal)); o_.y = cvt_pk_bf16(bflo(w_.y) * (scal), bfhi(w_.y) * (scal)); o_.z = cvt_pk_bf16(bflo(w_.z) * (scal), bfhi(w_.z) * (scal)); o_.w = cvt_pk_bf16(bflo(w_.w) * (scal), bfhi(w_.w) * (scal)); \
                *(LAS u32x4*)(stg + lane * 64 + 16 * q) = o_; } LDS_WAIT(); } while (0)
#define TR_FRAG(ks) ({ const s16x4 lo_ = vtr_c(stgp + (ks) * 1024), hi_ = vtr_c(stgp + (ks) * 1024 + 512); (bf16x8){lo_[0], lo_[1], lo_[2], lo_[3], hi_[0], hi_[1], hi_[2], hi_[3]}; })
#define TR_NAT(ks) ({ const s16x4 lo_ = vtr_c(stgn + (ks) * 1024), hi_ = vtr_c(stgn + (ks) * 1024 + 256); (bf16x8){lo_[0], lo_[1], lo_[2], lo_[3], hi_[0], hi_[1], hi_[2], hi_[3]}; })
#pragma unroll
        for (int t = 0; t < 4; ++t) { STAGE_PIECE(512 + h * 128 + 32 * t, begt);
            f32x16 a0 = (f32x16){}, a1 = (f32x16){};
#pragma unroll
            for (int ks = 0; ks < 4; ++ks) { const bf16x8 fr = TR_NAT(ks); a0 = MFMA32(fr, F0[ks], a0); a1 = MFMA32(fr, F1[ks], a1); }
#pragma unroll
            for (int s = 0; s < 2; ++s) { u32x4 o0, o1;
                o0.x = cvt_pk_bf16(-a0[8 * s], -a0[8 * s + 1]); o0.y = cvt_pk_bf16(-a0[8 * s + 2], -a0[8 * s + 3]); o0.z = cvt_pk_bf16(-a0[8 * s + 4], -a0[8 * s + 5]); o0.w = cvt_pk_bf16(-a0[8 * s + 6], -a0[8 * s + 7]);
                o1.x = cvt_pk_bf16(-a1[8 * s], -a1[8 * s + 1]); o1.y = cvt_pk_bf16(-a1[8 * s + 2], -a1[8 * s + 3]); o1.z = cvt_pk_bf16(-a1[8 * s + 4], -a1[8 * s + 5]); o1.w = cvt_pk_bf16(-a1[8 * s + 6], -a1[8 * s + 7]);
                *(u32x4*)(chb + CH_WF + ((0 * 4 + t) * 2 + s) * 1024 + lane * 16) = o0; *(u32x4*)(chb + CH_WF + ((1 * 4 + t) * 2 + s) * 1024 + lane * 16) = o1; } }
#pragma unroll
        for (int nj = 0; nj < 4; ++nj) { STAGE_PIECE(1024 + h * 128 + 32 * nj, bt);
            f32x16 a0 = (f32x16){}, a1 = (f32x16){};
#pragma unroll
            for (int ks = 0; ks < 4; ++ks) { const bf16x8 fr = TR_NAT(ks); a0 = MFMA32(F0[ks], fr, a0); a1 = MFMA32(F1[ks], fr, a1); }
            float* uc = (float*)(chb + CH_UC) + ((nj * 2) * 64 + lane) * 16;
#pragma unroll
            for (int q = 0; q < 4; ++q) { *(f32x4*)(uc + 4 * q) = (f32x4){a0[4 * q], a0[4 * q + 1], a0[4 * q + 2], a0[4 * q + 3]}; *(f32x4*)(uc + 1024 + 4 * q) = (f32x4){a1[4 * q], a1[4 * q + 1], a1[4 * q + 2], a1[4 * q + 3]}; } }
#pragma unroll
        for (int t = 0; t < 4; ++t) { STAGE_PIECE(512 + h * 128 + 32 * t, kdt);
#pragma unroll
            for (int ms = 0; ms < 4; ++ms) { const bf16x8 fr = TR_FRAG(ms); *(bf16x8*)(chb + CH_KF + (t * 4 + ms) * 1024 + lane * 16) = fr; } }
        LDS_WAIT();
#undef KK_TILE
#undef KQ_TILE
#undef STAGE_PIECE
#undef TR_FRAG
#undef TR_NAT
    }
}

__device__ __forceinline__ void gdn_scan_chain(PP p, LAS unsigned char* lds, const int chain) {
    int tid = threadIdx.x; asm volatile("" : "+v"(tid)); const int lane = tid & 63, wave = __builtin_amdgcn_readfirstlane(tid >> 6), r32 = lane & 31, hi = lane >> 5;
    const float* cf = (const float*)(p->ws + WS_CONST);
    bf16_t* OG = (bf16_t*)(p->ws + WS_OG);
    constexpr int STG = 2 * CH_DMA_BYTES;
    const int dir = chain & 1, h = (chain >> 1) & 3;
    f32x16 S[4];
#pragma unroll
    for (int t = 0; t < 4; ++t) S[t] = (f32x16){};
    f32x16 Un[2]; float egn = 0.f;
#pragma unroll
    for (int m = 0; m < 2; ++m) Un[m] = (f32x16){};
#define LOAD_U(task_) do { const float* uc_ = (const float*)(p->ws + WS_CH + (size_t)(task_) * CH_TASK_BYTES + CH_UC) + ((wave * 2) * 64 + lane) * 16; \
        _Pragma("unroll") for (int m = 0; m < 2; ++m) _Pragma("unroll") for (int q = 0; q < 4; ++q) { const f32x4 t4 = *(const f32x4*)(uc_ + m * 1024 + 4 * q); Un[m][4 * q] = t4[0]; Un[m][4 * q + 1] = t4[1]; Un[m][4 * q + 2] = t4[2]; Un[m][4 * q + 3] = t4[3]; } \
        egn = cf[CF_EGL + (task_)]; } while (0)
#define STAGE_CHUNK(task_, bufi) do { const unsigned char* src_ = p->ws + WS_CH + (size_t)(task_) * CH_TASK_BYTES; const unsigned dst_ = lds_addr(lds + (bufi) * CH_DMA_BYTES); \
        _Pragma("unroll") for (int i = 0; i < 14; ++i) { const int pc = wave * 14 + i; glds16(src_ + pc * 1024 + lane * 16, dst_ + pc * 1024); } } while (0)
    if (wave < 4) { LOAD_U(chain * NCHUNK); STAGE_CHUNK(chain * NCHUNK, 0); }
    for (int n = 0; n < NCHUNK; ++n) {
        const int task = chain * NCHUNK + n;
        int bq, hq, dq, rstart, rstep; gdn_task_rows(task, bq, hq, dq, rstart, rstep);
        if (wave < 4) VM_WAIT();
        asm volatile("s_waitcnt lgkmcnt(0)\n\ts_barrier" ::: "memory");
        if (wave < 4) {
            f32x16 V[2], O[2];
#pragma unroll
            for (int m = 0; m < 2; ++m) { V[m] = Un[m]; O[m] = (f32x16){}; }
            const float egl = egn;
            if (n + 1 < NCHUNK) { LOAD_U(task + 1); STAGE_CHUNK(task + 1, (n + 1) & 1); }
            const LAS unsigned char* buf = lds + (n & 1) * CH_DMA_BYTES + lane * 16;
            bf16x8 Sb[4][2];
#pragma unroll
            for (int t = 0; t < 4; ++t)
#pragma unroll
                for (int s = 0; s < 2; ++s) { u32x4 w; w.x = cvt_pk_bf16(S[t][8 * s], S[t][8 * s + 1]); w.y = cvt_pk_bf16(S[t][8 * s + 2], S[t][8 * s + 3]); w.z = cvt_pk_bf16(S[t][8 * s + 4], S[t][8 * s + 5]); w.w = cvt_pk_bf16(S[t][8 * s + 6], S[t][8 * s + 7]);
                    Sb[t][s] = __builtin_bit_cast(bf16x8, w); }
#pragma unroll
            for (int m = 0; m < 2; ++m)
#pragma unroll
                for (int t = 0; t < 4; ++t)
#pragma unroll
                    for (int s = 0; s < 2; ++s) { const int f = (m * 4 + t) * 2 + s;
                        V[m] = MFMA32(*(const LAS bf16x8*)(buf + CH_WF + f * 1024), Sb[t][s], V[m]);
                        O[m] = MFMA32(*(const LAS bf16x8*)(buf + CH_QF + f * 1024), Sb[t][s], O[m]);
                        if (s == 1 && (t & 1)) __builtin_amdgcn_sched_barrier(0); }
            bf16x8 Vb[2][2];
#pragma unroll
            for (int m = 0; m < 2; ++m)
#pragma unroll
                for (int s = 0; s < 2; ++s) { u32x4 w; w.x = cvt_pk_bf16(V[m][8 * s], V[m][8 * s + 1]); w.y = cvt_pk_bf16(V[m][8 * s + 2], V[m][8 * s + 3]); w.z = cvt_pk_bf16(V[m][8 * s + 4], V[m][8 * s + 5]); w.w = cvt_pk_bf16(V[m][8 * s + 6], V[m][8 * s + 7]);
                    Vb[m][s] = __builtin_bit_cast(bf16x8, w); }
#pragma unroll
            for (int mo = 0; mo < 2; ++mo)
#pragma unroll
                for (int m = 0; m <= mo; ++m)
#pragma unroll
                    for (int s = 0; s < 2; ++s) O[mo] = MFMA32(*(const LAS bf16x8*)(buf + CH_AF + ((mo * 2 + m) * 2 + s) * 1024), Vb[m][s], O[mo]);
            { LAS bf16_t* stg = (LAS bf16_t*)(lds + STG) + 32 * wave + r32;
#pragma unroll
              for (int m = 0; m < 2; ++m)
#pragma unroll
                  for (int r = 0; r < 16; ++r) stg[(32 * m + crow(r, hi)) * 128] = (bf16_t)f2bf(O[m][r]); }
#pragma unroll
            for (int t = 0; t < 4; ++t) {
                __builtin_amdgcn_sched_barrier(0);
#pragma unroll
                for (int r = 0; r < 16; ++r) S[t][r] *= egl;
#pragma unroll
                for (int m = 0; m < 2; ++m)
#pragma unroll
                    for (int s = 0; s < 2; ++s) S[t] = MFMA32(*(const LAS bf16x8*)(buf + CH_KF + ((t * 2 + m) * 2 + s) * 1024), Vb[m][s], S[t]); }
        }
        asm volatile("s_waitcnt lgkmcnt(0)\n\ts_barrier" ::: "memory");
        if (wave >= 4) { const int j = tid - 256, row = j >> 2; bf16_t* og = OG + (size_t)dir * NTOK * 512 + (size_t)(rstart + rstep * row) * 512 + h * 128 + (j & 3) * 8;
            const LAS bf16_t* stg = (const LAS bf16_t*)(lds + STG) + row * 128 + (j & 3) * 8;
#pragma unroll
            for (int it = 0; it < 4; ++it) *(u32x4*)(og + it * 32) = *(const LAS u32x4*)(stg + it * 32); }
    }
    VM_WAIT(); LDS_WAIT(); __syncthreads();
#undef LOAD_U
#undef STAGE_CHUNK
}

__device__ __forceinline__ void phase_gdn_out(PP p, int layer) {
    int tid = threadIdx.x, bid = blockIdx.x, gdim = gridDim.x; asm volatile("" : "+v"(tid), "+s"(bid), "+s"(gdim)); const int lane = tid & 63, wave = __builtin_amdgcn_readfirstlane(tid >> 6);
    const bf16_t* OG = (const bf16_t*)(p->ws + WS_OG); const bf16_t* OA = (const bf16_t*)(p->ws + WS_OA); const bf16_t* P = (const bf16_t*)(p->ws + WS_P); bf16_t* MIX = (bf16_t*)(p->ws + WS_MIX);
    const float* cf = (const float*)(p->ws + WS_CONST);
    const float lam = cf[CF_SC + layer * 16 + 0], oml = cf[CF_SC + layer * 16 + 2];
    const float* gn = p->in[I_GDNG] + layer * 128 + (8 * lane & 127); const float* sg = p->in[I_SUBLN] + layer * 128 + (8 * lane & 127);
    const f32x4 g0 = *(const f32x4*)gn, g1 = *(const f32x4*)(gn + 4), a0 = *(const f32x4*)sg * oml, a1 = *(const f32x4*)(sg + 4) * oml;
    const int nrows = layer == 0 ? NTOK : NLAT;
    for (int r = bid * NWAVES + wave; r < nrows; r += gdim * NWAVES) {
        {
            const bf16_t* a = OA + (size_t)r * 512 + 8 * lane; const float* la = (const float*)(p->ws + WS_LA) + (size_t)r * 4 + (lane >> 4);
            constexpr size_t PS = (size_t)NTOK * 512, LS = (size_t)NTOK * 4;
#define LD8(ptr, lo4, hi4) do { const u32x4 w_ = *(const u32x4*)(ptr); lo4 = (f32x4){bflo(w_.x), bfhi(w_.x), bflo(w_.y), bfhi(w_.y)}; hi4 = (f32x4){bflo(w_.z), bfhi(w_.z), bflo(w_.w), bfhi(w_.w)}; } while (0)
            f32x4 s0a, s0b, s1a, s1b; LD8(a, s0a, s0b); LD8(a + PS, s1a, s1b); float l0 = la[0], l1 = la[LS];
            if (r < NLAT) { f32x4 t0, t1; LD8(a + 2 * PS, t0, t1); s0a += t0; s0b += t1; LD8(a + 3 * PS, t0, t1); s1a += t0; s1b += t1; l0 += la[2 * LS]; l1 += la[3 * LS]; }
            const float r0 = 1.f / l0, r1 = lam / l1;
            f32x4 o0 = s0a * r0 - s1a * r1, o1 = s0b * r0 - s1b * r1;
            float ss = (o0[0] * o0[0] + o0[1] * o0[1]) + (o0[2] * o0[2] + o0[3] * o0[3]) + (o1[0] * o1[0] + o1[1] * o1[1]) + (o1[2] * o1[2] + o1[3] * o1[3]);
            ss += __shfl_xor(ss, 1); ss += __shfl_xor(ss, 2); ss += __shfl_xor(ss, 4); ss += __shfl_xor(ss, 8);
            const float rstd = rsqrtf(ss * (1.f / 128.f) + EPS);
            o0 = o0 * rstd * a0; o1 = o1 * rstd * a1;
            u32x4 w; w.x = cvt_pk_bf16(o0[0], o0[1]); w.y = cvt_pk_bf16(o0[2], o0[3]); w.z = cvt_pk_bf16(o1[0], o1[1]); w.w = cvt_pk_bf16(o1[2], o1[3]);
            *(u32x4*)(MIX + (size_t)r * D + 8 * lane) = w; }
        const bf16_t* a = OG + (size_t)r * 512 + 8 * lane; const bf16_t* bq = a + (size_t)NTOK * 512;
        f32x4 o0, o1; { f32x4 t0, t1; LD8(a, o0, o1); LD8(bq, t0, t1); o0 += t0; o1 += t1; }
        float ss = (o0[0] * o0[0] + o0[1] * o0[1]) + (o0[2] * o0[2] + o0[3] * o0[3]) + (o1[0] * o1[0] + o1[1] * o1[1]) + (o1[2] * o1[2] + o1[3] * o1[3]);
        ss += __shfl_xor(ss, 1); ss += __shfl_xor(ss, 2); ss += __shfl_xor(ss, 4); ss += __shfl_xor(ss, 8);
        const float rstd = rsqrtf(ss * (1.f / 128.f) + EPS);
        const u32x4 zw = *(const u32x4*)(P + (size_t)r * PW + 3072 + 8 * lane);
        o0 = o0 * rstd * g0; o1 = o1 * rstd * g1;
        u32x4 w; w.x = cvt_pk_bf16(o0[0] * silu_f(bflo(zw.x)), o0[1] * silu_f(bfhi(zw.x))); w.y = cvt_pk_bf16(o0[2] * silu_f(bflo(zw.y)), o0[3] * silu_f(bfhi(zw.y)));
        w.z = cvt_pk_bf16(o1[0] * silu_f(bflo(zw.z)), o1[1] * silu_f(bfhi(zw.z))); w.w = cvt_pk_bf16(o1[2] * silu_f(bflo(zw.w)), o1[3] * silu_f(bfhi(zw.w)));
        *(u32x4*)(MIX + (size_t)r * D + 512 + 8 * lane) = w;
    }
}

constexpr int AT_NS = 4, AT_SLOTK = 8192, AT_SLOTV = 16384, AT_K = 0, AT_V = AT_NS * AT_SLOTK, AT_WS = AT_V + AT_NS * AT_SLOTV;
typedef short v4i16_t __attribute__((ext_vector_type(4)));
__device__ __forceinline__ s16x4 vtr(const LAS unsigned char* ptr) { return __builtin_bit_cast(s16x4, __builtin_amdgcn_ds_read_tr16_b64_v4i16((LAS v4i16_t*)ptr)); }
__device__ __forceinline__ int att_keyrow(int b, int t, int nctx_tiles) {
    return t < nctx_tiles ? NLAT + b * CTXL + 64 * t : b * SEQL + 64 * (t - nctx_tiles);
}
#define AT_SBAR() __builtin_amdgcn_sched_barrier(0)
#define AT_PIN(x) asm volatile("" : "+v"(x))
#define AT_WAIT_BAR(N) asm volatile("s_waitcnt vmcnt(" #N ") lgkmcnt(0)\n\ts_barrier" ::: "memory")
__device__ __forceinline__ void attn_unit(PP p, int layer, LAS unsigned char* lds, int b, int h, int sub, int qrow0, int t0, int ntile, int nctx_tiles, int ksp) {
    int tid = threadIdx.x; asm volatile("" : "+v"(tid)); const int lane = tid & 63, wave = __builtin_amdgcn_readfirstlane(tid >> 6), r32 = lane & 31, hi = lane >> 5;
    const bf16_t* P = (const bf16_t*)(p->ws + WS_P);
    LAS float* wsf = (LAS float*)(lds + AT_WS) + wave * 64;
    const LAS unsigned char* kp0 = lds + AT_K + hi * 1024 + r32 * 16;
    const LAS unsigned char* vp0 = lds + AT_V + ((lane >> 4) & 1) * 32 + (lane & 3) * 8 + (4 * hi + ((lane & 15) >> 2)) * 64;
    const int kcol = 512 + h * 128 + sub * 64 + wave * 8, vcol = 1024 + h * 128;
    const size_t koff = (size_t)lane * PW + kcol;
    const size_t voff0 = (size_t)(16 * (wave & 3) + (lane >> 2)) * PW + vcol + 32 * (wave >> 2) + 8 * (lane & 3);
    const size_t voff1 = voff0 + 64;
    const unsigned kdst = lds_addr(lds + AT_K + wave * 1024), vdst = lds_addr(lds + AT_V + wave * 1024);
#define DMA_K(t, slot) do { if ((t) < ntile) glds16(P + (size_t)att_keyrow(b, t0 + (t), nctx_tiles) * PW + koff, kdst + (slot) * AT_SLOTK); } while (0)
#define DMA_V(t, slot) do { if ((t) < ntile) { const bf16_t* vb_ = P + (size_t)att_keyrow(b, t0 + (t), nctx_tiles) * PW; \
        glds16(vb_ + voff0, vdst + (slot) * AT_SLOTV); glds16(vb_ + voff1, vdst + (slot) * AT_SLOTV + 8192); } } while (0)
    DMA_K(0, 0); DMA_V(0, 0); DMA_K(1, 1); DMA_K(2, 2); DMA_K(3, 3); DMA_V(1, 1);
    bf16x8 qr[4];
    { const bf16_t* qp = P + (size_t)(qrow0 + wave * 32 + r32) * PW + h * 128 + sub * 64 + hi * 8;
#pragma unroll
      for (int d0 = 0; d0 < 4; ++d0) qr[d0] = *(const bf16x8*)(qp + d0 * 16); }
    f32x16 o[4];
#pragma unroll
    for (int dg = 0; dg < 4; ++dg) o[dg] = (f32x16){};
    float l_reg = 0.f;
    f32x16 pA0, pA1, pB0, pB1; bf16x8 kf[8]; u32x4 pw0, pw1, pw2, pw3; s16x4 vlo[4], vhi[4];
    f32x16 zero16 = (f32x16){}; AT_PIN(zero16);
    int sl_prev = 0, sl_cur = 0, sl_next = 1;
#define ROT() do { sl_prev = sl_cur; sl_cur = sl_next; sl_next = (sl_next + 1) & 3; } while (0)
#define KLD(i, kp_) kf[i] = *(const LAS bf16x8*)((kp_) + ((i) >> 1) * 2048 + ((i) & 1) * 512)
#define PKW(Pv, i) cvt_pk_bf16(Pv[i], Pv[(i) + 1])
#define PAF(k) __builtin_bit_cast(bf16x8, pw##k)
#define VRD(i, vp_) do { vlo[(i) & 3] = vtr((vp_) + ((i) & 3) * 4096 + ((i) >> 2) * 1024); vhi[(i) & 3] = vtr((vp_) + ((i) & 3) * 4096 + ((i) >> 2) * 1024 + 512); } while (0)
#define VFR(i) (bf16x8){vlo[(i) & 3][0], vlo[(i) & 3][1], vlo[(i) & 3][2], vlo[(i) & 3][3], vhi[(i) & 3][0], vhi[(i) & 3][1], vhi[(i) & 3][2], vhi[(i) & 3][3]}
#define EX2(Cv, i) do { Cv[i] = __builtin_amdgcn_exp2f(Cv[i]); Cv[(i) + 1] = __builtin_amdgcn_exp2f(Cv[(i) + 1]); } while (0)
#define GAPA(MF, a0, a1, a2, a3, W0, W1, PW_) do { MF; sacc += a0; sacc += a1; sacc += a2; sacc += a3; W0; W1; AT_PIN(PW_); AT_PIN(sacc); AT_SBAR(); } while (0)
#define GAPB(i, PA_, Cx, ci, GL) do { o[(i) & 3] = MFMA32(PA_, VFR(i), o[(i) & 3]); EX2(Cx, ci); AT_PIN(Cx); \
        if ((i) + 2 < 16) VRD((i) + 2, vpp_); if ((GL) && (i) < 8) KLD(i, kpn_); AT_SBAR(); } while (0)
#define STEP(C0, C1, P0, P1, t, GL) do { AT_SBAR(); \
    const LAS unsigned char* vpp_ = vp0 + sl_prev * AT_SLOTV; const LAS unsigned char* kpn_ = kp0 + sl_next * AT_SLOTK; \
    float sacc = P0[0] + P0[1]; \
    GAPA(C0 = MFMA32(kf[0], qr[0], zero16), P0[2], P0[3], P0[4], P0[5],     pw0[0] = PKW(P0, 0),  pw0[1] = PKW(P0, 2),  pw0); \
    GAPA(C1 = MFMA32(kf[1], qr[0], zero16), P0[6], P0[7], P0[8], P0[9],     pw0[2] = PKW(P0, 4),  pw0[3] = PKW(P0, 6),  pw0); \
    GAPA(C0 = MFMA32(kf[2], qr[1], C0),     P0[10], P0[11], P0[12], P0[13], pw1[0] = PKW(P0, 8),  pw1[1] = PKW(P0, 10), pw1); \
    GAPA(C1 = MFMA32(kf[3], qr[1], C1),     P0[14], P0[15], P1[0], P1[1],   pw1[2] = PKW(P0, 12), pw1[3] = PKW(P0, 14), pw1); \
    GAPA(C0 = MFMA32(kf[4], qr[2], C0),     P1[2], P1[3], P1[4], P1[5],     pw2[0] = PKW(P1, 0),  pw2[1] = PKW(P1, 2),  pw2); \
    GAPA(C1 = MFMA32(kf[5], qr[2], C1),     P1[6], P1[7], P1[8], P1[9],     pw2[2] = PKW(P1, 4),  pw2[3] = PKW(P1, 6),  pw2); \
    VRD(0, vpp_); \
    GAPA(C0 = MFMA32(kf[6], qr[3], C0),     P1[10], P1[11], P1[12], P1[13], pw3[0] = PKW(P1, 8),  pw3[1] = PKW(P1, 10), pw3); \
    VRD(1, vpp_); \
    GAPA(C1 = MFMA32(kf[7], qr[3], C1),     P1[14], P1[15], 0.f, 0.f,       pw3[2] = PKW(P1, 12), pw3[3] = PKW(P1, 14), pw3); \
    l_reg += sacc; \
    DMA_K((t) + 4, sl_cur); DMA_V((t) + 2, (sl_next + 1) & 3); AT_SBAR(); \
    GAPB(0, PAF(0), C0, 0, GL);  GAPB(1, PAF(0), C0, 2, GL);  GAPB(2, PAF(0), C0, 4, GL);  GAPB(3, PAF(0), C0, 6, GL); \
    GAPB(4, PAF(1), C0, 8, GL);  GAPB(5, PAF(1), C0, 10, GL); GAPB(6, PAF(1), C0, 12, GL); GAPB(7, PAF(1), C0, 14, GL); \
    GAPB(8, PAF(2), C1, 0, GL);  GAPB(9, PAF(2), C1, 2, GL);  GAPB(10, PAF(2), C1, 4, GL); GAPB(11, PAF(2), C1, 6, GL); \
    GAPB(12, PAF(3), C1, 8, GL); GAPB(13, PAF(3), C1, 10, GL); GAPB(14, PAF(3), C1, 12, GL); GAPB(15, PAF(3), C1, 14, GL); \
    } while (0)
#define ENDW(tt) do { if ((tt) + 4 < ntile) { AT_WAIT_BAR(6); } else { AT_WAIT_BAR(0); } } while (0)
    AT_WAIT_BAR(0);
#pragma unroll
    for (int i = 0; i < 8; ++i) KLD(i, kp0);
    pA0 = MFMA32(kf[0], qr[0], zero16); pA1 = MFMA32(kf[1], qr[0], zero16); pA0 = MFMA32(kf[2], qr[1], pA0); pA1 = MFMA32(kf[3], qr[1], pA1);
    pA0 = MFMA32(kf[4], qr[2], pA0); pA1 = MFMA32(kf[5], qr[2], pA1); pA0 = MFMA32(kf[6], qr[3], pA0); pA1 = MFMA32(kf[7], qr[3], pA1);
#pragma unroll
    for (int r = 0; r < 16; ++r) { pA0[r] = __builtin_amdgcn_exp2f(pA0[r]); pA1[r] = __builtin_amdgcn_exp2f(pA1[r]); }
    AT_WAIT_BAR(0);
    DMA_K(4, 0); DMA_V(2, 2); ROT();
#pragma unroll
    for (int i = 0; i < 8; ++i) KLD(i, kp0 + sl_cur * AT_SLOTK);
    if (ntile > 4) { AT_WAIT_BAR(3); } else { AT_WAIT_BAR(0); }
    int t = 1;
    for (; t + 1 < ntile; t += 2) {
        STEP(pB0, pB1, pA0, pA1, t, true);     ENDW(t);     ROT();
        STEP(pA0, pA1, pB0, pB1, t + 1, (t + 2 < ntile)); ENDW(t + 1); ROT();
    }
    if (t < ntile) { STEP(pB0, pB1, pA0, pA1, t, false); ENDW(t); ROT();
#pragma unroll
        for (int r = 0; r < 16; ++r) { pA0[r] = pB0[r]; pA1[r] = pB1[r]; } }
    { float sacc = 0.f;
#pragma unroll
      for (int r = 0; r < 16; ++r) sacc += pA0[r] + pA1[r];
      l_reg += sacc;
      pw0 = (u32x4){PKW(pA0, 0), PKW(pA0, 2), PKW(pA0, 4), PKW(pA0, 6)}; pw1 = (u32x4){PKW(pA0, 8), PKW(pA0, 10), PKW(pA0, 12), PKW(pA0, 14)};
      pw2 = (u32x4){PKW(pA1, 0), PKW(pA1, 2), PKW(pA1, 4), PKW(pA1, 6)}; pw3 = (u32x4){PKW(pA1, 8), PKW(pA1, 10), PKW(pA1, 12), PKW(pA1, 14)};
      const LAS unsigned char* vpp_ = vp0 + sl_prev * AT_SLOTV;
#pragma unroll
      for (int i = 0; i < 16; ++i) { VRD(i, vpp_); const bf16x8 pa = (i >> 2) == 0 ? PAF(0) : (i >> 2) == 1 ? PAF(1) : (i >> 2) == 2 ? PAF(2) : PAF(3); o[i & 3] = MFMA32(pa, VFR(i), o[i & 3]); } }
    l_reg += __shfl_xor(l_reg, 32);
    const size_t part = (size_t)(ksp * 2 + sub) * NTOK;
    if (hi == 0) ((float*)(p->ws + WS_LA))[(part + qrow0 + wave * 32 + r32) * 4 + h] = l_reg;
    bf16_t* OA = (bf16_t*)(p->ws + WS_OA) + part * 512 + h * 128 + r32;
#pragma unroll
    for (int r = 0; r < 16; ++r) { bf16_t* orow = OA + (size_t)(qrow0 + wave * 32 + crow(r, hi)) * 512;
#pragma unroll
        for (int dg = 0; dg < 4; ++dg) orow[32 * dg] = (bf16_t)f2bf(o[dg][r]); }
    AT_WAIT_BAR(0);
#undef DMA_K
#undef DMA_V
#undef ROT
#undef KLD
#undef PKW
#undef PAF
#undef VRD
#undef VFR
#undef EX2
#undef GAPA
#undef GAPB
#undef STEP
#undef ENDW
}
__device__ __forceinline__ void phase_attention(PP p, int layer, LAS unsigned char* lds, int qsel) {
    int bid = blockIdx.x; asm volatile("" : "+s"(bid));
    if (bid < 16) gdn_scan_chain(p, lds, bid);
    const int nlat = NB * 4 * 2 * 2 * 64, nunits = nlat + (layer == 0 ? NB * 4 * 2 : 0);
    unsigned* ctr = (unsigned*)(p->ws + WS_CTL) + CW_ATTQ + layer * 64 + qsel * 32;
    volatile LAS unsigned* slot = (volatile LAS unsigned*)(lds + MISC_OFF) + 16;
    for (;;) {
        if (threadIdx.x == 0) *slot = __hip_atomic_fetch_add(ctr, 1u, __ATOMIC_RELAXED, __HIP_MEMORY_SCOPE_AGENT);
        __syncthreads();
        const int u = (int)__builtin_amdgcn_readfirstlane((int)*slot);
        if (u >= nunits) break;
        if (u < nlat) { const int b = u >> 10, h = (u >> 8) & 3, sub = (u >> 7) & 1, ksp = (u >> 6) & 1, qb = u & 63; attn_unit(p, layer, lds, b, h, sub, b * SEQL + qb * 256, ksp * 130, 130, 4, ksp); }
        else { const int v = u - nlat, b = v >> 3, h = (v >> 1) & 3, sub = v & 1; attn_unit(p, layer, lds, b, h, sub, NLAT + b * CTXL, 0, 4, 4, 0); }
    }
}

__device__ __forceinline__ void phase_norm_router(PP p, int layer, LAS unsigned char* lds) {
    int tid = threadIdx.x, bid = blockIdx.x, gdim = gridDim.x; asm volatile("" : "+v"(tid), "+s"(bid), "+s"(gdim)); const int lane = tid & 63, wave = __builtin_amdgcn_readfirstlane(tid >> 6);
    const int T = layer == 0 ? NTOK : NLAT;
    LAS float* rw = (LAS float*)lds;
    LAS int* lcnt = (LAS int*)(lds + 131072);
    LAS int* lbase = lcnt + 32;
    LAS int* ent = lcnt + 64;
    const float* rwg = p->in[I_RW] + (size_t)layer * D * NEXP;
    for (int i = tid; i < NEXP * 1024; i += NTHR) { const int k = i >> 5, e = i & 31; rw[e * 1024 + k] = rwg[(size_t)k * NEXP + e]; }
    if (tid < 64) lcnt[tid] = 0;
    __syncthreads();
    const float* cf = (const float*)(p->ws + WS_CONST);
    const float* gn = p->in[I_NFFNG] + layer * D;
    const float rb = lane < NEXP ? p->in[I_RB][layer * NEXP + lane] : 0.f;
    const int rpw = (T + gdim - 1) / gdim;
    const int r0 = bid * rpw, r1 = (r0 + rpw < T) ? r0 + rpw : T;
    int* tope = (int*)(p->ws + WS_RT + RT_TOPE); float* gate = (float*)(p->ws + WS_RT + RT_GATE); int* rank = (int*)(p->ws + WS_RT + RT_RANK);
    const float* H = (const float*)(p->ws + WS_H);
    for (int r = r0 + wave; r < r1; r += NWAVES) {
        const float* mv = cf + CF_MODV + (layer * 3 + mod_sel(r)) * 6144;
        f32x4 u[4]; norm_mod_row(H + (size_t)r * D, gn, mv + 3 * 1024, mv + 4 * 1024, lane, u);
        store_row_bf16((bf16_t*)(p->ws + WS_U) + (size_t)r * D, lane, u);
        float logit = -INFINITY;
#pragma unroll 4
        for (int e = 0; e < NEXP; ++e) { float s = 0.f;
#pragma unroll
            for (int q = 0; q < 4; ++q) { const f32x4 w = *(const LAS f32x4*)(rw + e * 1024 + 4 * lane + 256 * q); s += (u[q][0] * w[0] + u[q][1] * w[1]) + (u[q][2] * w[2] + u[q][3] * w[3]); }
            s = wave_sum(s); if (lane == e) logit = s + rb; }
        float tl[4]; int te[4];
#pragma unroll
        for (int k = 0; k < 4; ++k) { const float m = wave_max(logit); const unsigned long long bal = __ballot(logit == m); const int idx = __ffsll((long long)bal) - 1;
            tl[k] = m; te[k] = idx; if (lane == idx) logit = -INFINITY; }
        const float e1 = __expf(tl[1] - tl[0]), e2 = __expf(tl[2] - tl[0]), e3 = __expf(tl[3] - tl[0]); const float inv = 1.f / (1.f + e1 + e2 + e3);
        if (lane < 4) { const int e = lane == 0 ? te[0] : lane == 1 ? te[1] : lane == 2 ? te[2] : te[3]; const float gv = (lane == 0 ? 1.f : lane == 1 ? e1 : lane == 2 ? e2 : e3) * inv;
            const int lr = atomicAdd((int*)&lcnt[e], 1);
            ent[(r - r0) * 4 + lane] = (e << 20) | lr; tope[(size_t)r * 4 + lane] = e; gate[(size_t)r * 4 + lane] = gv; }
    }
    __syncthreads();
    if (tid < NEXP) lbase[tid] = (int)atomicAdd((unsigned*)(p->ws + WS_CTL) + CW_CNT + layer * 64 + tid, (unsigned)lcnt[tid]);
    __syncthreads();
    for (int i = tid; i < (r1 - r0) * 4; i += NTHR) { const int v = ent[i]; rank[(size_t)r0 * 4 + i] = lbase[v >> 20] + (v & 0xfffff); }
}

__device__ __forceinline__ void phase_moe_gather(PP p, int layer, LAS unsigned char* lds) {
    int tid = threadIdx.x, bid = blockIdx.x, gdim = gridDim.x; asm volatile("" : "+v"(tid), "+s"(bid), "+s"(gdim)); const int lane = tid & 63, wave = __builtin_amdgcn_readfirstlane(tid >> 6);
    const int T = layer == 0 ? NTOK : NLAT;
    LAS int* pstart = (LAS int*)lds; LAS int* cnt = pstart + 64;
    const unsigned* gcnt = (const unsigned*)(p->ws + WS_CTL) + CW_CNT + layer * 64;
    int* mt = (int*)(p->ws + WS_CONST) + CF_MOE + layer * 1024;
    if (tid == 0) { int acc = 0; for (int e = 0; e < NEXP; ++e) { const int c = (int)__hip_atomic_load(gcnt + e, __ATOMIC_RELAXED, __HIP_MEMORY_SCOPE_AGENT); cnt[e] = c; pstart[e] = acc; acc += (c + 255) & ~255; } pstart[NEXP] = acc; }
    __syncthreads();
    if (bid == 0) {
        if (tid < NEXP) { mt[tid] = pstart[tid]; mt[64 + tid] = cnt[tid]; }
        if (tid == 0) mt[32] = pstart[NEXP] >> 8;
        for (int e = 0; e < NEXP; ++e) { const int b0 = pstart[e] >> 8, b1 = pstart[e + 1] >> 8; for (int bb = b0 + tid; bb < b1; bb += NTHR) mt[128 + bb] = e; }
    }
    const int* tope = (const int*)(p->ws + WS_RT + RT_TOPE); const float* gate = (const float*)(p->ws + WS_RT + RT_GATE); const int* rank = (const int*)(p->ws + WS_RT + RT_RANK);
    int* slot = (int*)(p->ws + WS_RT + RT_SLOT); float* sgate = (float*)(p->ws + WS_RT + RT_SGATE); int* stok = (int*)(p->ws + WS_RT + RT_STOK);
    const int gt = bid * NTHR + tid, NGT = gdim * NTHR;
    for (int a = gt; a < T * 4; a += NGT) {
        const int e = tope[a]; const int s = pstart[e] + rank[a];
        slot[a] = s; sgate[s] = gate[a]; stok[s] = a >> 2;
    }
    for (int e = 0; e < NEXP; ++e) { const int s0 = pstart[e] + cnt[e], s1 = pstart[e + 1];
        for (int s = s0 + gt; s < s1; s += NGT) { stok[s] = 0; sgate[s] = 0.f; } }
}

__device__ __forceinline__ void phase_moe_combine(PP p, int layer, LAS unsigned char* lds) {
    int tid = threadIdx.x, bid = blockIdx.x, gdim = gridDim.x; asm volatile("" : "+v"(tid), "+s"(bid), "+s"(gdim)); const int lane = tid & 63, wave = __builtin_amdgcn_readfirstlane(tid >> 6);
    const int T = layer == 0 ? NTOK : NLAT;
    const float* cf = (const float*)(p->ws + WS_CONST); const int* slot = (const int*)(p->ws + WS_RT + RT_SLOT); const bf16_t* Y = (const bf16_t*)(p->ws + WS_Y);
    float* H = (float*)(p->ws + WS_H);
    LAS float* wab = (LAS float*)lds; float ea = 0.f, dtb = 0.f;
    if (layer == 0) { norm_mix_stage_wab(p, 1, wab, tid); __syncthreads(); if (lane < 8) { ea = -__expf(p->in[I_ALOG][8 + lane]); dtb = p->in[I_DTB][8 + lane]; } }
    for (int r = bid * NWAVES + wave; r < T; r += gdim * NWAVES) {
        const float* g5 = cf + CF_MODV + (layer * 3 + mod_sel(r)) * 6144 + 5 * 1024;
        float* ho = layer == 0 ? H + (size_t)r * D : p->out + (size_t)r * D; const float* hi_ = H + (size_t)r * D;
        const int s0 = slot[r * 4], s1 = slot[r * 4 + 1], s2 = slot[r * 4 + 2], s3 = slot[r * 4 + 3];
        f32x4 hn[4];
#pragma unroll
        for (int j = 0; j < 4; ++j) { const int c = 4 * lane + 256 * j;
            const u32x2 a = *(const u32x2*)(Y + (size_t)s0 * D + c), b2 = *(const u32x2*)(Y + (size_t)s1 * D + c), c2 = *(const u32x2*)(Y + (size_t)s2 * D + c), d2 = *(const u32x2*)(Y + (size_t)s3 * D + c);
            f32x4 y; y[0] = (bflo(a.x) + bflo(b2.x)) + (bflo(c2.x) + bflo(d2.x)); y[1] = (bfhi(a.x) + bfhi(b2.x)) + (bfhi(c2.x) + bfhi(d2.x));
            y[2] = (bflo(a.y) + bflo(b2.y)) + (bflo(c2.y) + bflo(d2.y)); y[3] = (bfhi(a.y) + bfhi(b2.y)) + (bfhi(c2.y) + bfhi(d2.y));
            const f32x4 hv = *(const f32x4*)(hi_ + c), gv = *(const f32x4*)(g5 + c);
            hn[j] = hv + gv * y; *(f32x4*)(ho + c) = hn[j]; }
        if (layer == 0) norm_mix_row(p, 1, r, lane, hn, wab, ea, dtb);
    }
}

constexpr int NPH = 27;
#ifndef PH_MASK
#define PH_MASK 0xFFFF
#endif
#define IN(k) (lo <= (k) && (k) < hi)
#define EN(i) ((PH_MASK >> (i)) & 1)
#ifndef DUP_PH
#define DUP_PH -1
#endif
#define REP(i) for (int rep_ = 0; rep_ < ((DUP_PH == (i) && l == 0) ? 2 : 1); ++rep_)
#define SEAM(k) do { if (IN(k) && IN((k) + 1)) xcd_barrier(bar); } while (0)
#define LAUNDER() PP p = p0; LAS unsigned char* lds = lds0; int bid = blockIdx.x, gdim = gridDim.x; asm volatile("" : "+s"(p), "+s"(lds), "+s"(bid), "+s"(gdim))
template <int l> __device__ __forceinline__ void run_layer(PP p0, LAS unsigned char* lds0, const int lo, const int hi, const XcdBarrier& bar) {
        const int base = 1 + 13 * l;
        if (l == 0) { if (EN(1) && IN(base + 0)) REP(1) { LAUNDER(); phase_norm_mix(p, l, lds); __syncthreads(); }
            SEAM(base + 0); }
        if (EN(2) && IN(base + 1)) REP(2) { LAUNDER();
            PlainSched S; S.init(p->ws + WS_U, p->ws + WS_WIN + (size_t)l * PW * 1024 * 2, 1024, NTOK / 256, PW / 256, gdim, bid);
            EpiStoreBf16 E{(bf16_t*)(p->ws + WS_P), PW};
            pg8::gemm_phase<EpiStoreBf16, PlainSched>(lds, 1024, S, E);
        }
        SEAM(base + 1);
        if (EN(3) && IN(base + 2)) REP(3) { LAUNDER(); phase_prep(p, l); }
        SEAM(base + 2);
        if (EN(5) && IN(base + 3)) REP(5) { LAUNDER(); phase_gdn_chunk(p, lds); }
        SEAM(base + 3);
        if (EN(4) && IN(base + 4)) REP(4) { LAUNDER(); phase_attention(p, l, lds, rep_); }
        SEAM(base + 4);
        if (EN(7) && IN(base + 6)) REP(7) { LAUNDER(); phase_gdn_out(p, l); }
        SEAM(base + 6);
        if (EN(8) && IN(base + 7)) REP(8) { LAUNDER();
            const int T = l == 0 ? NTOK : NLAT;
            const float* cf = (const float*)(p->ws + WS_CONST);
            PlainSched S; S.init(p->ws + WS_MIX, p->ws + WS_WOUT + (size_t)l * D * 1024 * 2, 1024, T / 256, D / 256, gdim, bid);
            EpiResidual E{p, l, cf + CF_MODV + (l * 3) * 6144 + 2 * 1024};
            pg8::gemm_phase<EpiResidual, PlainSched>(lds, 1024, S, E);
        }
        SEAM(base + 7);
        if (EN(9) && IN(base + 8)) REP(9) { LAUNDER(); phase_norm_router(p, l, lds); __syncthreads(); }
        SEAM(base + 8);
        if (EN(10) && IN(base + 9)) REP(10) { LAUNDER(); phase_moe_gather(p, l, lds); __syncthreads(); }
        SEAM(base + 9);
        if (EN(11) && IN(base + 10)) REP(11) { LAUNDER();
            const int* mt = (const int*)(p->ws + WS_CONST) + CF_MOE + l * 1024;
            MoeSched S{(const char*)(p->ws + WS_U), (const char*)(p->ws + WS_WGU + (size_t)l * NEXP * 2048 * 1024 * 2), mt + 128, mt[32], 8, gdim, bid, (const int*)(p->ws + WS_RT + RT_STOK)};
            EpiGateUp E{(bf16_t*)(p->ws + WS_ACT), p->in[I_BGU] + (size_t)l * NEXP * 2048, mt + 128};
            pg8::gemm_phase<EpiGateUp, MoeSched, true>(lds, 1024, S, E);
        }
        SEAM(base + 10);
        if (EN(12) && IN(base + 11)) REP(12) { LAUNDER();
            const int* mt = (const int*)(p->ws + WS_CONST) + CF_MOE + l * 1024;
            MoeSched S{(const char*)(p->ws + WS_ACT), (const char*)(p->ws + WS_WD + (size_t)l * NEXP * 1024 * 1024 * 2), mt + 128, mt[32], 4, gdim, bid, nullptr};
            EpiDown E{(bf16_t*)(p->ws + WS_Y), p->in[I_BD] + (size_t)l * NEXP * 1024, mt + 128, (const float*)(p->ws + WS_RT + RT_SGATE)};
            pg8::gemm_phase<EpiDown, MoeSched>(lds, 1024, S, E);
        }
        SEAM(base + 11);
        if (EN(13) && IN(base + 12)) { LAUNDER(); phase_moe_combine(p, l, lds); __syncthreads(); }
        SEAM(base + 12);
    }

__global__ void __launch_bounds__(NTHR, 2) mega_fwd(Params p_by_value) {
    extern __shared__ __attribute__((aligned(16))) unsigned char lds_raw[];
    LAS unsigned char* lds0 = (LAS unsigned char*)lds_raw;
    PP p0 = (PP)__builtin_amdgcn_kernarg_segment_ptr();
    volatile LAS unsigned* MISC = (volatile LAS unsigned*)(lds0 + MISC_OFF);
    if (threadIdx.x < 64) MISC[threadIdx.x] = 0u;
    __syncthreads();
    const int lo = p0->ph_lo, hi = p0->ph_hi;
    XcdBarrier bar; bar.bar = (unsigned*)(p0->ws + WS_CTL) + CW_BAR; bar.x = 0; bar.st = nullptr;
    if (hi - lo > 1) bar = xcd_barrier_post((unsigned*)(p0->ws + WS_CTL) + CW_BAR, MISC + 8);
    if (EN(0) && IN(0)) for (int rep_ = 0; rep_ < (DUP_PH == 0 ? 2 : 1); ++rep_) { LAUNDER(); phase_prologue(p, lds); __syncthreads(); }
    SEAM(0);
    run_layer<0>(p0, lds0, lo, hi, bar);
    run_layer<1>(p0, lds0, lo, hi, bar);
#undef IN
#undef SEAM
}

extern "C" void kernel_launch(void* const* d_in, const int* in_sizes, int n_in, void* d_out, int out_size, void* d_ws, size_t ws_size, hipStream_t stream) {
    static int grid = 0;
    if (grid == 0) {
        if (n_in != 27 || out_size != NLAT * D || ws_size < WS_END) { fprintf(stderr, "kernel_launch: unexpected problem (n_in %d, out %d, ws %zu < %zu)\n", n_in, out_size, ws_size, (size_t)WS_END); grid = -1; return; }
        int dev = 0, cus = 0, per_cu = 0;
        if (hipGetDevice(&dev) != hipSuccess || hipDeviceGetAttribute(&cus, hipDeviceAttributeMultiprocessorCount, dev) != hipSuccess) { grid = -1; return; }
        if (hipFuncSetAttribute((const void*)mega_fwd, hipFuncAttributeMaxDynamicSharedMemorySize, LDS_BYTES) != hipSuccess) { fprintf(stderr, "kernel_launch: hipFuncSetAttribute failed\n"); grid = -1; return; }
        if (hipOccupancyMaxActiveBlocksPerMultiprocessor(&per_cu, (const void*)mega_fwd, NTHR, LDS_BYTES) != hipSuccess || per_cu < 1) { fprintf(stderr, "kernel_launch: occupancy query says %d\n", per_cu); }
        (void)hipGetLastError();
        grid = cus;
    }
    if (grid < 0) return;
    hipMemsetAsync((char*)d_ws + WS_CTL, 0, CTL_ZERO_BYTES, stream);
    Params p{};
    for (int i = 0; i < 27; ++i) p.in[i] = (const float*)d_in[i];
    p.out = (float*)d_out; p.ws = (unsigned char*)d_ws;
#if MK_PER_PHASE
    for (int ph = 0; ph < NPH; ++ph) { p.ph_lo = ph; p.ph_hi = ph + 1; hipLaunchKernelGGL(mega_fwd, dim3(grid), dim3(NTHR), LDS_BYTES, stream, p); }
#else
    p.ph_lo = 0; p.ph_hi = NPH;
    hipLaunchKernelGGL(mega_fwd, dim3(grid), dim3(NTHR), LDS_BYTES, stream, p);
#endif
}
```

```cpp
#include <hip/hip_runtime.h>
#include <cstdio>
#include <cstdint>

#ifndef MK_PER_PHASE
#define MK_PER_PHASE 0
#endif

#define LAS __attribute__((address_space(3)))
#define GAS __attribute__((address_space(1)))
typedef unsigned short bf16_t;
typedef short bf16x8 __attribute__((ext_vector_type(8)));
typedef short s16x4 __attribute__((ext_vector_type(4)));
typedef float f32x2 __attribute__((ext_vector_type(2)));
typedef float f32x4 __attribute__((ext_vector_type(4)));
typedef float f32x16 __attribute__((ext_vector_type(16)));
typedef unsigned u32x2 __attribute__((ext_vector_type(2)));
typedef unsigned u32x4 __attribute__((ext_vector_type(4)));

constexpr int D = 1024, NB = 2, SEQL = 16384, CTXL = 256;
constexpr int NLAT = NB * SEQL, NCTX = NB * CTXL, NTOK = NLAT + NCTX;
constexpr int PW = 3584, INC = 3600;
constexpr int NEXP = 32, MAXBLK = 552, MAXSLOT = MAXBLK * 256;
constexpr int NCHUNK = 260, NTASK = 16 * NCHUNK;
constexpr float EPS = 1e-6f;
constexpr float LOG2E = 1.4426950408889634f;
constexpr int NWAVES = 8, NTHR = 512;

constexpr size_t MiB = 1u << 20;
constexpr size_t WS_CTL = 0, CTL_ZERO_BYTES = 1 * MiB;
constexpr size_t WS_CONST = 1 * MiB;
constexpr size_t WS_WIN = 2 * MiB;
constexpr size_t WS_WOUT = 16 * MiB;
constexpr size_t WS_WGU = 20 * MiB;
constexpr size_t WS_WD = 276 * MiB;
constexpr size_t WS_H = 404 * MiB;
constexpr size_t WS_U = 534 * MiB;
constexpr size_t WS_GB = 599 * MiB;
constexpr size_t WS_MIX = 602 * MiB;
constexpr size_t WS_RT = 667 * MiB;
constexpr size_t WS_BIG = 671 * MiB;
constexpr size_t WS_P = WS_BIG;
constexpr size_t WS_G = WS_P + 228 * MiB;
constexpr size_t WS_CH = WS_G + 98 * MiB;
constexpr size_t WS_OG = WS_CH + 358 * MiB;
constexpr size_t WS_OA = WS_OG + 130 * MiB;
constexpr size_t WS_LA = WS_OA + 260 * MiB;
constexpr size_t WS_END = WS_LA + 5 * MiB;
constexpr size_t WS_XS = WS_BIG;
constexpr size_t WS_ACT = WS_BIG + 276 * MiB;
constexpr size_t WS_Y = WS_XS;
static_assert(WS_ACT + 276 * MiB <= WS_END, "moe overlay");
constexpr size_t CH_TASK_BYTES = 90112;
constexpr int CH_WF = 0, CH_QF = 16384, CH_AF = 32768, CH_KF = 40960, CH_UC = 57344, CH_DMA_BYTES = 57344;
static_assert((size_t)NTASK * CH_TASK_BYTES <= 358 * MiB, "chunk buffers");

constexpr int CW_BAR = 4096;
constexpr int CW_CNT = 16384;
constexpr int CW_ATTQ = 20480;
constexpr int CF_MODV = 0;
constexpr int CF_ROPE = 40960;
constexpr int CF_SC = 53248;
constexpr int CF_EGL = 53504;
constexpr int CF_MOE = 61440;
constexpr size_t RT_TOPE = 0, RT_GATE = 640 * 1024, RT_RANK = 1280 * 1024, RT_SLOT = 1920 * 1024, RT_SGATE = 2560 * 1024, RT_STOK = 3200 * 1024;

constexpr int LDS_BYTES = 147456;
constexpr int MISC_OFF = 143 * 1024;
static_assert(MISC_OFF + 256 <= LDS_BYTES, "lds");

__device__ __forceinline__ unsigned f2bf(float f) { unsigned u = __builtin_bit_cast(unsigned, f); return (u + 0x7fffu + ((u >> 16) & 1u)) >> 16; }
__device__ __forceinline__ unsigned pk2(float lo, float hi) { return f2bf(lo) | (f2bf(hi) << 16); }
__device__ __forceinline__ float bf2f(unsigned short b) { return __builtin_bit_cast(float, (unsigned)b << 16); }
__device__ __forceinline__ float bflo(unsigned w) { return __builtin_bit_cast(float, w << 16); }
__device__ __forceinline__ float bfhi(unsigned w) { return __builtin_bit_cast(float, w & 0xffff0000u); }
__device__ __forceinline__ unsigned cvt_pk_bf16(float lo, float hi) { unsigned r; asm volatile("v_cvt_pk_bf16_f32 %0, %1, %2" : "=v"(r) : "v"(lo), "v"(hi)); return r; }
__device__ __forceinline__ float wave_sum(float v) {
#pragma unroll
    for (int o = 1; o < 64; o <<= 1) v += __shfl_xor(v, o);
    return v;
}
__device__ __forceinline__ float wave_max(float v) {
#pragma unroll
    for (int o = 1; o < 64; o <<= 1) v = fmaxf(v, __shfl_xor(v, o));
    return v;
}
__device__ __forceinline__ float silu_f(float x) { return x / (1.f + __expf(-x)); }
__device__ __forceinline__ int crow(int r, int hi) { return (r & 3) + 8 * (r >> 2) + 4 * hi; }
__device__ __forceinline__ void glds16(const void* g, unsigned lds_base) {
    unsigned sv; asm volatile("s_mov_b32 %0, m0\n\ts_mov_b32 m0, %2\n\ts_nop 0\n\tglobal_load_lds_dwordx4 %1, off\n\ts_mov_b32 m0, %0" : "=&s"(sv) : "v"(g), "s"((unsigned)__builtin_amdgcn_readfirstlane((int)lds_base)) : "memory"); }
__device__ __forceinline__ unsigned lds_addr(const LAS void* q) { return (unsigned)__builtin_amdgcn_readfirstlane((int)(unsigned)(uintptr_t)q); }
#define LDS_WAIT() asm volatile("s_waitcnt lgkmcnt(0)" ::: "memory")
#define VM_WAIT() asm volatile("s_waitcnt vmcnt(0)" ::: "memory")
#define MFMA32(a, b, c) __builtin_amdgcn_mfma_f32_32x32x16_bf16(a, b, c, 0, 0, 0)

namespace pg8 {
constexpr int BM = 256, BK = 64, HALF = 128, HTB = HALF * BK * 2, STAGE_BYTES = 8 * HTB;
__host__ __device__ __forceinline__ int lds_byte(int r, int c) { const int st = (r >> 4) * 2 + (c >> 5), rr = r & 15, cc = c & 31, ob = rr * 64 + cc * 2; return st * 1024 + (ob ^ (((ob >> 9) & 1) << 5)); }
__host__ __device__ __forceinline__ void stage_rc(int b, int& R, int& C) { const int st = b / 1024, sb = b % 1024, swz = sb ^ (((sb >> 9) & 1) << 5); R = (st >> 1) * 16 + swz / 64; C = (st & 1) * 32 + (swz % 64) / 2; }
__host__ __device__ __forceinline__ int perm32(int rho) { const int n = rho >> 4, i = rho & 15; return 8 * (i >> 2) + 4 * n + (i & 3); }
struct Unit { int pm, pn; };
template <class Epi, class Sched, bool GA = false>
__device__ __forceinline__ void gemm_phase(LAS unsigned char* lds, const int K, const Sched& S, const Epi& E) {
    int tid = threadIdx.x, bid = blockIdx.x, gdim = gridDim.x; asm volatile("" : "+v"(tid), "+s"(bid), "+s"(gdim)); const int wid = __builtin_amdgcn_readfirstlane(tid >> 6), lane = tid & 63, wr = wid >> 2, wc = wid & 3, fr = lane & 15, fq = lane >> 4;
    const int nt = K / BK;
    unsigned voffA[2], voffB[2], colA2[2]; int rowA[2];
    unsigned vAc[2][2], vAn[2][2], vAnn[2][2];
#pragma unroll
    for (int i = 0; i < 2; ++i) { int R, C; stage_rc(tid * 16 + i * 8192, R, C); const int Rb = Epi::PERM ? ((R & ~31) + perm32(R & 31)) : R;
        voffA[i] = (unsigned)(R * K + C) * 2u; voffB[i] = (unsigned)(Rb * K + C) * 2u; rowA[i] = R; colA2[i] = (unsigned)C * 2u; }
    const size_t kstep = (size_t)(BK * 2);
    const size_t hstep = (size_t)HALF * K * 2;
    const unsigned ldsw = (unsigned)wid * 1024u;
    const int aoff = lds_byte(wr * 64 + fr, fq * 8), boff = lds_byte(wc * 32 + fr, fq * 8);
#define PG8_SA(b, h) (((b) * 2 + (h)) * HTB)
#define PG8_SB(b, h) ((4 + (b) * 2 + (h)) * HTB)
#define PG8_STAGE(bufoff, gbase, voff) do { _Pragma("unroll") for (int _i = 0; _i < 2; ++_i) \
        __builtin_amdgcn_global_load_lds((const unsigned*)((const char*)(gbase) + (voff)[_i]), (LAS unsigned*)(lds + (bufoff) + ldsw + _i * 8192), 16, 0, 0); } while (0)
#define PG8_TOK(v, u) do { if constexpr (GA) { const int* tk_ = S.atok(u); _Pragma("unroll") for (int h_ = 0; h_ < 2; ++h_) _Pragma("unroll") for (int i_ = 0; i_ < 2; ++i_) v[h_][i_] = (unsigned)tk_[rowA[i_] + 128 * h_] * (unsigned)(K * 2) + colA2[i_]; } } while (0)
#define PG8_STAGE_A(bufoff, gptr, koff, half, nx) do { if constexpr (GA) { const char* gb_ = S.abase() + (koff); _Pragma("unroll") for (int _i = 0; _i < 2; ++_i) { const unsigned vo_ = (nx) ? vAn[half][_i] : vAc[half][_i]; \
        __builtin_amdgcn_global_load_lds((const unsigned*)(gb_ + vo_), (LAS unsigned*)(lds + (bufoff) + ldsw + _i * 8192), 16, 0, 0); } } else { PG8_STAGE(bufoff, (gptr) + (half) * hstep, voffA); } } while (0)
#define PG8_LDA(dst, b, h) do { _Pragma("unroll") for (int m = 0; m < 4; ++m) _Pragma("unroll") for (int k = 0; k < 2; ++k) dst[m][k] = *(const LAS bf16x8*)(lds + PG8_SA(b, h) + aoff + m * 2048 + k * 1024); } while (0)
#define PG8_LDB(dst, b, h) do { _Pragma("unroll") for (int n = 0; n < 2; ++n) _Pragma("unroll") for (int k = 0; k < 2; ++k) dst[n][k] = *(const LAS bf16x8*)(lds + PG8_SB(b, h) + boff + n * 2048 + k * 1024); } while (0)
#define PG8_MMA(ai, bj, At, Bt) do { __builtin_amdgcn_s_setprio(1); _Pragma("unroll") for (int m = 0; m < 4; ++m) _Pragma("unroll") for (int n = 0; n < 2; ++n) _Pragma("unroll") for (int k = 0; k < 2; ++k) \
        acc[ai][bj][m][n] = __builtin_amdgcn_mfma_f32_16x16x32_bf16(Bt[n][k], At[m][k], acc[ai][bj][m][n], 0, 0, 0); __builtin_amdgcn_s_setprio(0); } while (0)
#define PG8_WAIT_V(n) asm volatile("s_waitcnt vmcnt(" #n ")" ::: "memory")
#define PG8_WAIT_L(n) asm volatile("s_waitcnt lgkmcnt(" #n ")" ::: "memory")
#define PG8_BAR __builtin_amdgcn_s_barrier()
#define PG8_SCHED __builtin_amdgcn_sched_barrier(0)
    Unit cur, nxt; int ui = 0;
    if (!S.next(0, cur)) return;
    f32x4 acc[2][2][4][2];
#pragma unroll
    for (int a = 0; a < 2; ++a)
#pragma unroll
        for (int b = 0; b < 2; ++b)
#pragma unroll
            for (int m = 0; m < 4; ++m)
#pragma unroll
                for (int n = 0; n < 2; ++n) acc[a][b][m][n] = (f32x4){0.f, 0.f, 0.f, 0.f};
    bf16x8 At[4][2], B0[2][2], B1[2][2];
    const char* cA = S.aptr(cur); const char* cB = S.bptr(cur);
    PG8_TOK(vAc, cur);
    if constexpr (GA) { Unit u1_; if (S.next(1, u1_)) { PG8_TOK(vAn, u1_); } else { _Pragma("unroll") for (int h_ = 0; h_ < 2; ++h_) _Pragma("unroll") for (int i_ = 0; i_ < 2; ++i_) vAn[h_][i_] = vAc[h_][i_]; } }
    PG8_STAGE(PG8_SB(0, 0), cB, voffB); PG8_STAGE_A(PG8_SA(0, 0), cA, 0, 0, false); PG8_STAGE(PG8_SB(0, 1), cB + hstep, voffB); PG8_STAGE_A(PG8_SA(0, 1), cA, 0, 1, false);
    if (wr == 1) PG8_BAR;
    PG8_WAIT_V(4); PG8_BAR;
    PG8_STAGE(PG8_SB(1, 0), cB + kstep, voffB); PG8_STAGE_A(PG8_SA(1, 0), cA + kstep, kstep, 0, false); PG8_STAGE(PG8_SB(1, 1), cB + hstep + kstep, voffB);
    PG8_WAIT_V(6); PG8_BAR;
    for (;;) {
        const bool has_next = S.next(ui + 1, nxt);
        const char* nA = has_next ? S.aptr(nxt) : cA; const char* nB = has_next ? S.bptr(nxt) : cB;
        for (int t = 0; t < nt; t += 2) {
            const bool last = (t == nt - 2);
            const char* a1 = cA + (size_t)(t + 1) * kstep;
            const char* a2 = last ? nA : cA + (size_t)(t + 2) * kstep; const char* b2 = last ? nB : cB + (size_t)(t + 2) * kstep;
            const char* a3 = a2 + kstep; const char* b3 = b2 + kstep;
            const size_t k1 = (size_t)(t + 1) * kstep, k2 = last ? 0 : (size_t)(t + 2) * kstep, k3 = k2 + kstep;
            PG8_LDB(B0, 0, 0); PG8_SCHED; PG8_LDA(At, 0, 0); PG8_STAGE_A(PG8_SA(1, 1), a1, k1, 1, false);
            PG8_WAIT_L(8); PG8_BAR; PG8_WAIT_L(0); PG8_MMA(0, 0, At, B0); PG8_BAR; PG8_SCHED;
            PG8_LDB(B1, 0, 1); PG8_STAGE(PG8_SB(0, 0), b2, voffB);
            PG8_BAR; PG8_WAIT_L(0); PG8_MMA(0, 1, At, B1); PG8_BAR;
            PG8_LDA(At, 0, 1); PG8_STAGE_A(PG8_SA(0, 0), a2, k2, 0, last);
            PG8_BAR; PG8_WAIT_L(0); PG8_MMA(1, 0, At, B0); PG8_BAR; PG8_SCHED;
            PG8_STAGE(PG8_SB(0, 1), b2 + hstep, voffB);
            PG8_WAIT_V(6); PG8_BAR; PG8_MMA(1, 1, At, B1); PG8_BAR;
            PG8_LDB(B0, 1, 0); PG8_SCHED; PG8_LDA(At, 1, 0); PG8_STAGE_A(PG8_SA(0, 1), a2, k2, 1, last);
            PG8_WAIT_L(8); PG8_BAR; PG8_WAIT_L(0); PG8_MMA(0, 0, At, B0); PG8_BAR; PG8_SCHED;
            PG8_LDB(B1, 1, 1); PG8_STAGE(PG8_SB(1, 0), b3, voffB);
            PG8_BAR; PG8_WAIT_L(0); PG8_MMA(0, 1, At, B1); PG8_BAR;
            PG8_LDA(At, 1, 1); PG8_STAGE_A(PG8_SA(1, 0), a3, k3, 0, last);
            PG8_BAR; PG8_WAIT_L(0); PG8_MMA(1, 0, At, B0); PG8_BAR; PG8_SCHED;
            PG8_STAGE(PG8_SB(1, 1), b3 + hstep, voffB);
            PG8_WAIT_V(6); PG8_BAR; PG8_MMA(1, 1, At, B1); PG8_BAR;
        }
        E(acc, cur, wr, wc, fr, fq);
        if (!has_next) break;
        if constexpr (GA) { Unit u2_; if (S.next(ui + 2, u2_)) { PG8_TOK(vAnn, u2_); } else { _Pragma("unroll") for (int h_ = 0; h_ < 2; ++h_) _Pragma("unroll") for (int i_ = 0; i_ < 2; ++i_) vAnn[h_][i_] = vAn[h_][i_]; } }
#pragma unroll
        for (int a = 0; a < 2; ++a)
#pragma unroll
            for (int b = 0; b < 2; ++b)
#pragma unroll
                for (int m = 0; m < 4; ++m)
#pragma unroll
                    for (int n = 0; n < 2; ++n) acc[a][b][m][n] = (f32x4){0.f, 0.f, 0.f, 0.f};
        cur = nxt; cA = nA; cB = nB; ++ui;
        if constexpr (GA) { _Pragma("unroll") for (int h_ = 0; h_ < 2; ++h_) _Pragma("unroll") for (int i_ = 0; i_ < 2; ++i_) { vAc[h_][i_] = vAn[h_][i_]; vAn[h_][i_] = vAnn[h_][i_]; } }
    }
    PG8_WAIT_V(0);
    if (wr == 0) PG8_BAR;
    PG8_BAR;
#undef PG8_SA
#undef PG8_SB
#undef PG8_STAGE
#undef PG8_STAGE_A
#undef PG8_TOK
#undef PG8_LDA
#undef PG8_LDB
#undef PG8_MMA
#undef PG8_WAIT_V
#undef PG8_WAIT_L
#undef PG8_BAR
#undef PG8_SCHED
}
}

#define XB_TMO      128
#define XB_XCNT(j)  (256  + 64 * (j))
#define XB_XSUB(j)  (1280 + 64 * (j))
#define XB_XGEN(j)  (2304 + 64 * (j))
#define XB_TOP      3328
#define XB_TOPGEN   3392
#define XCD_BAR_WORDS 3456
#define XB_SPIN_CAP (1u << 20)
__device__ __forceinline__ unsigned xb_ld(unsigned* p)              { return __hip_atomic_load(p, __ATOMIC_RELAXED, __HIP_MEMORY_SCOPE_AGENT); }
__device__ __forceinline__ unsigned xb_add(unsigned* p, unsigned v) { return __hip_atomic_fetch_add(p, v, __ATOMIC_RELAXED, __HIP_MEMORY_SCOPE_AGENT); }
__device__ __forceinline__ unsigned xb_xcc_id() { return (unsigned)__builtin_amdgcn_s_getreg((3 << 11) | 20) & 0xFu; }
#define XB_SPIN(cond, bar) do { unsigned _sp = 0; while (cond) { __builtin_amdgcn_s_sleep(1); \
    if ((++_sp & 255u) == 0u) { if (xb_ld(&(bar)[XB_TMO])) break; if (_sp > XB_SPIN_CAP) { atomicAdd(&(bar)[XB_TMO], 1u); break; } } } } while (0)
struct XcdBarrier { unsigned* bar; unsigned x; volatile LAS unsigned* st; };
__device__ __forceinline__ XcdBarrier xcd_barrier_post(unsigned* bar, volatile LAS unsigned* st) {
    XcdBarrier b; b.bar = bar; b.x = xb_xcc_id(); b.st = st;
    if (threadIdx.x == 0) (void)xb_add(&bar[XB_XCNT(b.x)], 1u);
    return b;
}
__device__ __forceinline__ void xcd_barrier_complete(unsigned* bar, unsigned x, unsigned& nloc, unsigned& nx) {
    const unsigned G = gridDim.x * gridDim.y * gridDim.z;
    unsigned sum, cnt, mine, sp = 0u;
    for (;;) {
        sum = 0u; cnt = 0u; mine = 0u;
#pragma unroll
        for (unsigned j = 0; j < 16; ++j) { const unsigned c = xb_ld(&bar[XB_XCNT(j)]); sum += c; cnt += (c > 0u) ? 1u : 0u; mine = (j == x) ? c : mine; }
        if (sum == G) break;
        __builtin_amdgcn_s_sleep(1);
        if ((++sp & 255u) == 0u) { if (xb_ld(&bar[XB_TMO])) break; if (sp > XB_SPIN_CAP) { atomicAdd(&bar[XB_TMO], 1u); break; } }
    }
    nloc = mine > 0u ? mine : 1u; nx = cnt > 0u ? cnt : 1u;
}
__device__ __forceinline__ void xcd_barrier(const XcdBarrier& b) {
    asm volatile("s_waitcnt vmcnt(0)" ::: "memory");
    __syncthreads();
    if (threadIdx.x == 0) {
        unsigned* bar = b.bar;
        __builtin_amdgcn_s_waitcnt(0);
        unsigned nloc = b.st[0], nx = b.st[1];
        if (nloc == 0u) { xcd_barrier_complete(bar, b.x, nloc, nx); b.st[0] = nloc; b.st[1] = nx; }
        const unsigned old = xb_add(&bar[XB_XSUB(b.x)], 1u);
        const unsigned gen = old / nloc;
        if (old + 1u == (gen + 1u) * nloc) {
            __builtin_amdgcn_fence(__ATOMIC_RELEASE, "agent");
            asm volatile("s_waitcnt vmcnt(0)" ::: "memory");
            const unsigned og = xb_add(&bar[XB_TOP], 1u);
            const unsigned tg = og / nx;
            if (og + 1u == (tg + 1u) * nx) xb_add(&bar[XB_TOPGEN], 1u);
            else XB_SPIN(xb_ld(&bar[XB_TOPGEN]) == tg, bar);
            __builtin_amdgcn_fence(__ATOMIC_ACQUIRE, "agent");
            xb_add(&bar[XB_XGEN(b.x)], 1u);
            asm volatile("s_waitcnt vmcnt(0)" ::: "memory");
        } else {
            XB_SPIN(xb_ld(&bar[XB_XGEN(b.x)]) == gen, bar);
            __builtin_amdgcn_fence(__ATOMIC_ACQUIRE, "agent");
            asm volatile("s_waitcnt vmcnt(0)" ::: "memory");
        }
    }
    __syncthreads();
}

struct Params {
    const float* in[27];
    float* out;
    unsigned char* ws;
    int ph_lo, ph_hi;
};
typedef const __attribute__((address_space(4))) Params* PP;
enum { I_X = 0, I_C, I_CTX, I_CCTX, I_WMOD, I_BMOD, I_NMIXG, I_WIN, I_QNG, I_KNG, I_LQ1, I_LK1, I_LQ2, I_LK2, I_SUBLN, I_CONVW, I_ALOG, I_DTB, I_GDNG, I_WOUT, I_NFFNG, I_RW, I_RB, I_WGU, I_BGU, I_WD, I_BD };

__device__ __forceinline__ const float* hrow_in(PP p, int layer, int r) {
    (void)layer; return r < NLAT ? p->in[I_X] + (size_t)r * D : p->in[I_CTX] + (size_t)(r - NLAT) * D;
}
__device__ __forceinline__ int mod_sel(int r) { return r < NLAT ? (r >= SEQL ? 1 : 0) : 2; }

__device__ __forceinline__ void transpose_item(const float* W, size_t ldw, int k0, int n0, bf16_t* WT, int drow0, LAS float* scr, int lane) {
#pragma unroll 8
    for (int i = 0; i < 32; ++i) { const int kk = 2 * i + (lane >> 5); scr[kk * 33 + (lane & 31)] = W[(size_t)(k0 + kk) * ldw + n0 + (lane & 31)]; }
    LDS_WAIT(); asm volatile("" ::: "memory");
    const int c = lane & 7;
#pragma unroll
    for (int j = 0; j < 4; ++j) { const int n = (lane >> 3) + 8 * j; const LAS float* s = scr + (8 * c) * 33 + n;
        u32x4 o; o.x = pk2(s[0 * 33], s[1 * 33]); o.y = pk2(s[2 * 33], s[3 * 33]); o.z = pk2(s[4 * 33], s[5 * 33]); o.w = pk2(s[6 * 33], s[7 * 33]);
        *(u32x4*)(WT + (size_t)(drow0 + n) * 1024 + k0 + 8 * c) = o; }
    LDS_WAIT(); asm volatile("" ::: "memory");
}

__device__ __forceinline__ void phase_prologue(PP p, LAS unsigned char* lds) {
    int tid = threadIdx.x, bid = blockIdx.x, gdim = gridDim.x; asm volatile("" : "+v"(tid), "+s"(bid), "+s"(gdim)); const int lane = tid & 63, wave = __builtin_amdgcn_readfirstlane(tid >> 6);
    float* cf = (float*)(p->ws + WS_CONST);
    if (bid < 192) {
        const int l = bid / 96, cg = bid % 96;
        LAS float* sl = (LAS float*)lds;
        LAS float* red = sl + 3 * 1024;
        for (int i = tid; i < 3 * 1024; i += NTHR) { const int s = i >> 10, k = i & 1023; const float v = s < 2 ? p->in[I_C][s * D + k] : p->in[I_CCTX][k]; sl[i] = silu_f(v); }
        __syncthreads();
        const float* wm = p->in[I_WMOD] + (size_t)l * D * 6144 + cg * 64 + lane;
        float a0 = 0.f, a1 = 0.f, a2 = 0.f;
#pragma unroll 16
        for (int kk = 0; kk < 128; ++kk) { const int k = wave * 128 + kk; const float w = wm[(size_t)k * 6144]; a0 += sl[k] * w; a1 += sl[1024 + k] * w; a2 += sl[2048 + k] * w; }
        red[(wave * 3 + 0) * 64 + lane] = a0; red[(wave * 3 + 1) * 64 + lane] = a1; red[(wave * 3 + 2) * 64 + lane] = a2;
        __syncthreads();
        if (wave < 3) { float s = 0.f;
#pragma unroll
            for (int w = 0; w < 8; ++w) s += red[(w * 3 + wave) * 64 + lane];
            cf[CF_MODV + (l * 3 + wave) * 6144 + cg * 64 + lane] = s + p->in[I_BMOD][l * 6144 + cg * 64 + lane]; }
        __syncthreads();
    }
    if (bid >= 192 && bid < 202) {
        const int idx = (bid - 192) * NTHR + tid;
        if (idx < 320 * 16) { const int pos = idx >> 4, i = idx & 15; const float invf = powf(10000.f, -(float)i / 16.f);
            const float posf = (float)(pos < 256 ? pos : pos - 256); const float ang = posf * invf; const double a = (double)ang;
            const float cs = (float)cos(a), sn = (float)sin(a);
            if (pos < 256) { cf[CF_ROPE + pos * 16 + i] = cs; cf[CF_ROPE + 4096 + pos * 16 + i] = sn; }
            else { cf[CF_ROPE + 8192 + (pos - 256) * 16 + i] = cs; cf[CF_ROPE + 9216 + (pos - 256) * 16 + i] = sn; } }
    }
    if (bid == 202 && wave < 2) {
        const int l = wave;
        const float d1 = wave_sum(p->in[I_LQ1][l * 64 + lane] * p->in[I_LK1][l * 64 + lane]);
        const float d2 = wave_sum(p->in[I_LQ2][l * 64 + lane] * p->in[I_LK2][l * 64 + lane]);
        const float lam_init = 0.8f - 0.6f * expf(-0.3f * (float)l);
        const float mq = wave_max(fabsf(p->in[I_QNG][l * 64 + lane])), mk = wave_max(fabsf(p->in[I_KNG][l * 64 + lane]));
        if (lane == 0) { cf[CF_SC + l * 16 + 0] = expf(d1) - expf(d2) + lam_init; cf[CF_SC + l * 16 + 1] = LOG2E * 0.125f * 64.f * mq * mk * 1.0001f + 0.01f; cf[CF_SC + l * 16 + 2] = 1.f - lam_init; }
    }
    {
        LAS float* scr = (LAS float*)(lds + wave * 16384);
        const int gw = bid * NWAVES + wave, NGW = gdim * NWAVES;
        constexpr int I_IN = 16 * 112, I_OUT = 16 * 32, I_GU = 16 * 64, I_DN = 16 * 32;
        constexpr int PER_LAYER = I_IN + I_OUT + NEXP * I_GU + NEXP * I_DN;
        for (int it = gw; it < 2 * PER_LAYER; it += NGW) {
            const int l = it / PER_LAYER; int r = it % PER_LAYER;
            if (r < I_IN) { const int kb = r / 112, nb = r % 112;
                transpose_item(p->in[I_WIN] + (size_t)l * D * INC, INC, kb * 64, nb * 32, (bf16_t*)(p->ws + WS_WIN) + (size_t)l * PW * 1024, nb * 32, scr, lane); continue; }
            r -= I_IN;
            if (r < I_OUT) { const int kb = r / 32, nb = r % 32;
                transpose_item(p->in[I_WOUT] + (size_t)l * D * D, D, kb * 64, nb * 32, (bf16_t*)(p->ws + WS_WOUT) + (size_t)l * D * 1024, nb * 32, scr, lane); continue; }
            r -= I_OUT;
            if (r < NEXP * I_GU) { const int e = r / I_GU, q = r % I_GU, kb = q / 64, nb = q % 64; const int n0 = nb * 32, j = n0 & 1023, isup = n0 >> 10;
                const int drow = (j >> 7) * 256 + isup * 128 + (j & 127);
                transpose_item(p->in[I_WGU] + (size_t)(l * NEXP + e) * D * 2048, 2048, kb * 64, n0, (bf16_t*)(p->ws + WS_WGU) + (size_t)(l * NEXP + e) * 2048 * 1024, drow, scr, lane); continue; }
            r -= NEXP * I_GU;
            { const int e = r / I_DN, q = r % I_DN, kb = q / 32, nb = q % 32;
                transpose_item(p->in[I_WD] + (size_t)(l * NEXP + e) * D * D, D, kb * 64, nb * 32, (bf16_t*)(p->ws + WS_WD) + (size_t)(l * NEXP + e) * D * 1024, nb * 32, scr, lane); }
        }
    }
}

struct PlainSched {
    const char* A; const char* Bt; int K, nM, nN, nwg, G, c;
    __device__ __forceinline__ void init(const void* A_, const void* Bt_, int K_, int nM_, int nN_, int G_, int c_) { A = (const char*)A_; Bt = (const char*)Bt_; K = K_; nM = nM_; nN = nN_; nwg = nM * nN; G = G_; c = c_; }
    __device__ __forceinline__ bool next(int i, pg8::Unit& u) const {
        const long L = (long)i * G + c; if (L >= nwg) return false;
        int wgid = (int)L; { const int q = nwg / 8, r = nwg % 8, xcd = wgid % 8, off = wgid / 8; wgid = (xcd < r ? xcd * (q + 1) : r * (q + 1) + (xcd - r) * q) + off; }
        const int nig = 8 * nN, gid = wgid / nig, fm = gid * 8, gsz = (nM - fm) < 8 ? (nM - fm) : 8;
        u.pm = fm + ((wgid % nig) % gsz); u.pn = (wgid % nig) / gsz; return true;
    }
    __device__ __forceinline__ const char* aptr(const pg8::Unit& u) const { return A + (size_t)u.pm * 256 * K * 2; }
    __device__ __forceinline__ const char* bptr(const pg8::Unit& u) const { return Bt + (size_t)u.pn * 256 * K * 2; }
};
struct MoeSched {
    const char* A; const char* W; const int* blk_e; int nblk, nN, G, c;
    __device__ __forceinline__ bool next(int i, pg8::Unit& u) const {
        const int x = c & 7, w = c >> 3, nw = G >> 3;
        const int b0 = (int)(((long)nblk * x) >> 3), b1 = (int)(((long)nblk * (x + 1)) >> 3);
        const int j = i * nw + w, pm = b0 + j / nN; if (pm >= b1) return false;
        u.pm = pm; u.pn = j % nN; return true;
    }
    const int* tok;
    __device__ __forceinline__ const char* aptr(const pg8::Unit& u) const { return A + (size_t)u.pm * 256 * 1024 * 2; }
    __device__ __forceinline__ const char* abase() const { return A; }
    __device__ __forceinline__ const int* atok(const pg8::Unit& u) const { return tok + u.pm * 256; }
    __device__ __forceinline__ const char* bptr(const pg8::Unit& u) const { const int e = ((const __attribute__((address_space(4))) int*)blk_e)[u.pm];
        return W + ((size_t)e * nN + u.pn) * 256 * 1024 * 2; }
};
struct EpiStoreBf16 {
    static constexpr bool PERM = true;
    bf16_t* O; int ldc;
    __device__ __forceinline__ void operator()(const f32x4 (&acc)[2][2][4][2], const pg8::Unit& u, int wr, int wc, int fr, int fq) const {
        const int row0 = u.pm * 256 + wr * 64 + fr, col0 = u.pn * 256 + wc * 32 + 8 * fq;
#pragma unroll
        for (int ai = 0; ai < 2; ++ai)
#pragma unroll
            for (int m = 0; m < 4; ++m) { bf16_t* rowp = O + (size_t)(row0 + ai * 128 + m * 16) * ldc + col0;
#pragma unroll
                for (int bj = 0; bj < 2; ++bj) { const f32x4 v0 = acc[ai][bj][m][0], v1 = acc[ai][bj][m][1];
                    u32x4 w; w.x = cvt_pk_bf16(v0[0], v0[1]); w.y = cvt_pk_bf16(v0[2], v0[3]); w.z = cvt_pk_bf16(v1[0], v1[1]); w.w = cvt_pk_bf16(v1[2], v1[3]);
                    *(u32x4*)(rowp + bj * 128) = w; } }
    }
};
struct EpiResidual {
    static constexpr bool PERM = true;
    PP p; int layer; const float* gate;
    __device__ __forceinline__ void operator()(const f32x4 (&acc)[2][2][4][2], const pg8::Unit& u, int wr, int wc, int fr, int fq) const {
        const int row0 = u.pm * 256 + wr * 64 + fr, col0 = u.pn * 256 + wc * 32 + 8 * fq;
        bf16_t* H = (bf16_t*)(p->ws + WS_H);
#pragma unroll
        for (int ai = 0; ai < 2; ++ai)
#pragma unroll
            for (int m = 0; m < 4; ++m) { const int row = row0 + ai * 128 + m * 16; const float* g = gate + mod_sel(row) * 6144 + col0;
                bf16_t* ho = H + (size_t)row * D + col0;
#pragma unroll
                for (int bj = 0; bj < 2; ++bj) { f32x4 h0, h1;
                    if (layer == 0) { const float* hin = hrow_in(p, 0, row) + col0 + bj * 128; h0 = *(const f32x4*)hin; h1 = *(const f32x4*)(hin + 4); }
                    else { const u32x4 w_ = *(const u32x4*)(ho + bj * 128); h0 = (f32x4){bflo(w_.x), bfhi(w_.x), bflo(w_.y), bfhi(w_.y)}; h1 = (f32x4){bflo(w_.z), bfhi(w_.z), bflo(w_.w), bfhi(w_.w)}; }
                    const f32x4 v0 = h0 + *(const f32x4*)(g + bj * 128) * acc[ai][bj][m][0], v1 = h1 + *(const f32x4*)(g + bj * 128 + 4) * acc[ai][bj][m][1];
                    u32x4 w; w.x = cvt_pk_bf16(v0[0], v0[1]); w.y = cvt_pk_bf16(v0[2], v0[3]); w.z = cvt_pk_bf16(v1[0], v1[1]); w.w = cvt_pk_bf16(v1[2], v1[3]);
                    *(u32x4*)(ho + bj * 128) = w; } }
    }
};
struct EpiGateUp {
    static constexpr bool PERM = true;
    bf16_t* ACT; const float* bgu; const int* blk_e;
    __device__ __forceinline__ void operator()(const f32x4 (&acc)[2][2][4][2], const pg8::Unit& u, int wr, int wc, int fr, int fq) const {
        const int row0 = u.pm * 256 + wr * 64 + fr, col0 = u.pn * 128 + wc * 32 + 8 * fq; const int e = blk_e[u.pm];
        const float* bg = bgu + (size_t)e * 2048 + col0; const float* bu = bg + 1024;
        f32x4 bgv[2], buv[2];
#pragma unroll
        for (int n = 0; n < 2; ++n) { bgv[n] = *(const f32x4*)(bg + 4 * n); buv[n] = *(const f32x4*)(bu + 4 * n); }
#pragma unroll
        for (int ai = 0; ai < 2; ++ai)
#pragma unroll
            for (int m = 0; m < 4; ++m) { float o[8];
#pragma unroll
                for (int n = 0; n < 2; ++n)
#pragma unroll
                    for (int j = 0; j < 4; ++j) { float g = acc[ai][0][m][n][j] + bgv[n][j], up = acc[ai][1][m][n][j] + buv[n][j];
                        g = fminf(g, 7.f); up = fminf(fmaxf(up, -7.f), 7.f);
                        const float glu = g * __builtin_amdgcn_rcpf(1.f + __builtin_amdgcn_exp2f(-1.702f * LOG2E * g)); o[n * 4 + j] = (up + 1.f) * glu; }
                u32x4 w; w.x = cvt_pk_bf16(o[0], o[1]); w.y = cvt_pk_bf16(o[2], o[3]); w.z = cvt_pk_bf16(o[4], o[5]); w.w = cvt_pk_bf16(o[6], o[7]);
                *(u32x4*)(ACT + (size_t)(row0 + ai * 128 + m * 16) * 1024 + col0) = w; }
    }
};
struct EpiDown {
    static constexpr bool PERM = true;
    bf16_t* Y; const float* bd; const int* blk_e; const float* sgate;
    __device__ __forceinline__ void operator()(const f32x4 (&acc)[2][2][4][2], const pg8::Unit& u, int wr, int wc, int fr, int fq) const {
        const int row0 = u.pm * 256 + wr * 64 + fr, col0 = u.pn * 256 + wc * 32 + 8 * fq; const int e = blk_e[u.pm];
        const float* b = bd + (size_t)e * 1024 + col0;
        f32x4 bv[2][2];
#pragma unroll
        for (int bj = 0; bj < 2; ++bj)
#pragma unroll
            for (int n = 0; n < 2; ++n) bv[bj][n] = *(const f32x4*)(b + bj * 128 + 4 * n);
#pragma unroll
        for (int ai = 0; ai < 2; ++ai)
#pragma unroll
            for (int m = 0; m < 4; ++m) { const int row = row0 + ai * 128 + m * 16; const float sg = sgate[row]; bf16_t* rowp = Y + (size_t)row * 1024 + col0;
#pragma unroll
                for (int bj = 0; bj < 2; ++bj) { const f32x4 v0 = (acc[ai][bj][m][0] + bv[bj][0]) * sg, v1 = (acc[ai][bj][m][1] + bv[bj][1]) * sg;
                    u32x4 w; w.x = cvt_pk_bf16(v0[0], v0[1]); w.y = cvt_pk_bf16(v0[2], v0[3]); w.z = cvt_pk_bf16(v1[0], v1[1]); w.w = cvt_pk_bf16(v1[2], v1[3]);
                    *(u32x4*)(rowp + bj * 128) = w; } }
    }
};

__device__ __forceinline__ void norm_mod_vals(const float* g, const float* shift, const float* scale, int lane, f32x4 (&u)[4]) {
    float ss = 0.f;
#pragma unroll
    for (int j = 0; j < 4; ++j) ss += (u[j][0] * u[j][0] + u[j][1] * u[j][1]) + (u[j][2] * u[j][2] + u[j][3] * u[j][3]);
    const float rstd = rsqrtf(wave_sum(ss) * (1.f / D) + EPS);
#pragma unroll
    for (int j = 0; j < 4; ++j) { const int c = 4 * lane + 256 * j; const f32x4 gv = *(const f32x4*)(g + c), sh = *(const f32x4*)(shift + c), sc = *(const f32x4*)(scale + c);
        u[j] = (u[j] * rstd) * gv * (sc + 1.f) + sh; }
}
__device__ __forceinline__ void norm_mod_row(const float* hrow, const float* g, const float* shift, const float* scale, int lane, f32x4 (&u)[4]) {
#pragma unroll
    for (int j = 0; j < 4; ++j) u[j] = *(const f32x4*)(hrow + 4 * lane + 256 * j);
    norm_mod_vals(g, shift, scale, lane, u);
}
__device__ __forceinline__ void store_row_bf16(bf16_t* orow, int lane, const f32x4 (&u)[4]) {
#pragma unroll
    for (int j = 0; j < 4; ++j) { u32x2 w; w.x = cvt_pk_bf16(u[j][0], u[j][1]); w.y = cvt_pk_bf16(u[j][2], u[j][3]); *(u32x2*)(orow + 4 * lane + 256 * j) = w; }
}

__device__ __forceinline__ void norm_mix_stage_wab(PP p, int layer, LAS float* wab, int tid) {
    const float* win = p->in[I_WIN] + (size_t)layer * D * INC;
    for (int i = tid; i < 16 * 1024; i += NTHR) { const int k = i >> 4, j = i & 15; wab[j * 1024 + k] = win[(size_t)k * INC + PW + j]; }
}
__device__ __forceinline__ void norm_mix_row(PP p, int layer, int r, int lane, f32x4 (&u)[4], const LAS float* wab, float ea, float dtb) {
    const float* cf = (const float*)(p->ws + WS_CONST);
    const float* mv = cf + CF_MODV + (layer * 3 + mod_sel(r)) * 6144;
    norm_mod_vals(p->in[I_NMIXG] + layer * D, mv, mv + 1024, lane, u);
    store_row_bf16((bf16_t*)(p->ws + WS_U) + (size_t)r * D, lane, u);
    float ab = 0.f;
#pragma unroll
    for (int j = 0; j < 16; ++j) { float s = 0.f;
#pragma unroll
        for (int q = 0; q < 4; ++q) { const f32x4 w = *(const LAS f32x4*)(wab + j * 1024 + 4 * lane + 256 * q); s += (u[q][0] * w[0] + u[q][1] * w[1]) + (u[q][2] * w[2] + u[q][3] * w[3]); }
        s = wave_sum(s); if (lane == j) ab = s; }
    float outv;
    if (lane < 8) { const float z = ab + dtb; const float sp = z > 20.f ? z : log1pf(__expf(z)); outv = ea * sp; }
    else outv = 1.f / (1.f + __expf(-ab));
    if (lane < 16) ((float*)(p->ws + WS_GB))[(size_t)r * 16 + lane] = outv;
}
__device__ __forceinline__ void phase_norm_mix(PP p, int layer, LAS unsigned char* lds) {
    int tid = threadIdx.x, bid = blockIdx.x, gdim = gridDim.x; asm volatile("" : "+v"(tid), "+s"(bid), "+s"(gdim)); const int lane = tid & 63, wave = __builtin_amdgcn_readfirstlane(tid >> 6);
    LAS float* wab = (LAS float*)lds;
    norm_mix_stage_wab(p, layer, wab, tid);
    __syncthreads();
    float ea = 0.f, dtb = 0.f; if (lane < 8) { ea = -__expf(p->in[I_ALOG][layer * 8 + lane]); dtb = p->in[I_DTB][layer * 8 + lane]; }
    for (int r = bid * NWAVES + wave; r < NTOK; r += gdim * NWAVES) {
        const float* hrow = hrow_in(p, layer, r); f32x4 u[4];
#pragma unroll
        for (int j = 0; j < 4; ++j) u[j] = *(const f32x4*)(hrow + 4 * lane + 256 * j);
        norm_mix_row(p, layer, r, lane, u, wab, ea, dtb);
    }
}

__device__ __forceinline__ void phase_prep(PP p, int layer) {
    int tid = threadIdx.x, bid = blockIdx.x, gdim = gridDim.x; asm volatile("" : "+v"(tid), "+s"(bid), "+s"(gdim)); const int lane = tid & 63, wave = __builtin_amdgcn_readfirstlane(tid >> 6);
    const float* cf = (const float*)(p->ws + WS_CONST);
    bf16_t* P = (bf16_t*)(p->ws + WS_P); bf16_t* G = (bf16_t*)(p->ws + WS_G);
    const float* cw = p->in[I_CONVW] + (size_t)layer * 5 * 1536;
    float gain[16];
    { const float* gsrc = (lane < 32 ? p->in[I_QNG] : p->in[I_KNG]) + layer * 64 + 16 * (lane & 3);
#pragma unroll
      for (int e = 0; e < 16; ++e) gain[e] = gsrc[e]; }
    const float qscale = lane < 32 ? 0.125f * LOG2E : 1.f;
    for (int r = bid * NWAVES + wave; r < NTOK; r += gdim * NWAVES) {
        bf16_t* prow = P + (size_t)r * PW + 16 * lane;
        const u32x4 w0 = *(const u32x4*)prow, w1 = *(const u32x4*)(prow + 8);
        float x[16];
#pragma unroll
        for (int e = 0; e < 4; ++e) { x[2 * e] = bflo(w0[e]); x[2 * e + 1] = bfhi(w0[e]); x[8 + 2 * e] = bflo(w1[e]); x[8 + 2 * e + 1] = bfhi(w1[e]); }
        float ss = 0.f;
#pragma unroll
        for (int e = 0; e < 16; ++e) ss += x[e] * x[e];
        ss += __shfl_xor(ss, 1); ss += __shfl_xor(ss, 2);
        const float rstd = rsqrtf(ss * (1.f / 64.f) + EPS);
#pragma unroll
        for (int e = 0; e < 16; ++e) x[e] = x[e] * rstd * gain[e];
        if (r < NLAT) {
            const int t = r & (SEQL - 1); const int pos = (lane & 2) ? (t & 63) : (t >> 6);
            const float* ct = cf + CF_ROPE + ((lane & 2) ? 8192 : 0) + pos * 16; const float* st = ct + ((lane & 2) ? 1024 : 4096);
            const bool second = lane & 1;
#pragma unroll
            for (int e = 0; e < 16; ++e) { const float other = __shfl_xor(x[e], 1); const float cs = ct[e], sn = st[e];
                x[e] = second ? (x[e] * cs + other * sn) : (x[e] * cs - other * sn); }
        }
        u32x4 o0, o1;
#pragma unroll
        for (int e = 0; e < 4; ++e) { o0[e] = cvt_pk_bf16(x[2 * e] * qscale, x[2 * e + 1] * qscale); o1[e] = cvt_pk_bf16(x[8 + 2 * e] * qscale, x[8 + 2 * e + 1] * qscale); }
        *(u32x4*)prow = o0; *(u32x4*)(prow + 8) = o1;
    }
    for (int r = bid * NWAVES + wave; r < NTOK; r += gdim * NWAVES) {
        int seg0, seglen; if (r < NLAT) { seg0 = r & ~(SEQL - 1); seglen = SEQL; } else { seg0 = NLAT + ((r - NLAT) & ~(CTXL - 1)); seglen = CTXL; }
        const int tpos = r - seg0;
#pragma unroll
        for (int grp = 0; grp < 3; ++grp) {
            const int c0 = grp * 512 + 8 * lane;
            float a[8];
#pragma unroll
            for (int e = 0; e < 8; ++e) a[e] = 0.f;
#pragma unroll
            for (int j = 0; j < 5; ++j) { const int tp = tpos + j - 2;
                if (tp >= 0 && tp < seglen) { const u32x4 w = *(const u32x4*)(P + (size_t)(seg0 + tp) * PW + 1536 + c0);
                    const f32x4 k0 = *(const f32x4*)(cw + j * 1536 + c0), k1 = *(const f32x4*)(cw + j * 1536 + c0 + 4);
                    a[0] += bflo(w[0]) * k0[0]; a[1] += bfhi(w[0]) * k0[1]; a[2] += bflo(w[1]) * k0[2]; a[3] += bfhi(w[1]) * k0[3];
                    a[4] += bflo(w[2]) * k1[0]; a[5] += bfhi(w[2]) * k1[1]; a[6] += bflo(w[3]) * k1[2]; a[7] += bfhi(w[3]) * k1[3]; } }
            float ss = 0.f;
#pragma unroll
            for (int e = 0; e < 8; ++e) { a[e] = silu_f(a[e]); ss += a[e] * a[e]; }
            if (grp < 2) { ss += __shfl_xor(ss, 1); ss += __shfl_xor(ss, 2); ss += __shfl_xor(ss, 4); ss += __shfl_xor(ss, 8);
                const float rn = rsqrtf(ss + EPS);
#pragma unroll
                for (int e = 0; e < 8; ++e) a[e] *= rn; }
            u32x4 o; o.x = cvt_pk_bf16(a[0], a[1]); o.y = cvt_pk_bf16(a[2], a[3]); o.z = cvt_pk_bf16(a[4], a[5]); o.w = cvt_pk_bf16(a[6], a[7]);
            *(u32x4*)(G + (size_t)r * 1536 + c0) = o;
        }
    }
}

typedef short v4i16c_t __attribute__((ext_vector_type(4)));
__device__ __forceinline__ s16x4 vtr_c(const LAS unsigned char* ptr) { return __builtin_bit_cast(s16x4, __builtin_amdgcn_ds_read_tr16_b64_v4i16((LAS v4i16c_t*)ptr)); }
__device__ __forceinline__ void gdn_task_rows(int task, int& b, int& h, int& dir, int& rstart, int& rstep) {
    const int chain = task / NCHUNK, n = task % NCHUNK; dir = chain & 1; h = (chain >> 1) & 3; b = chain >> 3;
    if (n < 4) { const int base = NLAT + b * CTXL; if (dir == 0) { rstart = base + 64 * n; rstep = 1; } else { rstart = base + CTXL - 1 - 64 * n; rstep = -1; } }
    else { const int base = b * SEQL, m = n - 4; if (dir == 0) { rstart = base + 64 * m; rstep = 1; } else { rstart = base + SEQL - 1 - 64 * m; rstep = -1; } }
}
constexpr int CWL_BYTES = 6144, CWL_STG = 2048;
__device__ __forceinline__ void gdn_chunk_task(PP p, LAS unsigned char* wl, const int task, const int lane) {
    const int r32 = lane & 31, hi = lane >> 5;
    const bf16_t* G = (const bf16_t*)(p->ws + WS_G); const float* GB = (const float*)(p->ws + WS_GB);
    float* cf = (float*)(p->ws + WS_CONST);
    LAS float* gcv = (LAS float*)wl;
    LAS unsigned char* stg = wl + CWL_STG;
    const LAS unsigned char* stgp = stg + ((lane >> 4) & 1) * 32 + (lane & 3) * 8 + (4 * hi + ((lane & 15) >> 2)) * 64;
    const LAS unsigned char* stgn = stg + ((lane >> 4) & 1) * 32 + (lane & 3) * 8 + (8 * hi + ((lane & 15) >> 2)) * 64;
    const float SCALE = 0.08838834764831845f;
    {
        int b, h, dir, rstart, rstep; gdn_task_rows(task, b, h, dir, rstart, rstep);
        unsigned char* chb = p->ws + WS_CH + (size_t)task * CH_TASK_BYTES;
        const int myrow = rstart + rstep * lane;
        float gt = GB[(size_t)myrow * 16 + dir * 4 + h]; const float bt = GB[(size_t)myrow * 16 + 8 + dir * 4 + h];
#pragma unroll
        for (int o = 1; o < 64; o <<= 1) { const float t = __shfl_up(gt, o); if (lane >= o) gt += t; }
        const float glast = __shfl(gt, 63), egt = __expf(gt), begt = bt * egt, kdt = __expf(glast - gt);
        gcv[lane] = gt; gcv[64 + lane] = bt;
        if (lane == 0) cf[CF_EGL + task] = __expf(glast);
        const float gcs0 = __shfl(gt, r32), gcs1 = __shfl(gt, 32 + r32);
        const size_t rowA0 = (size_t)(rstart + rstep * r32) * 1536, rowA1 = (size_t)(rstart + rstep * (32 + r32)) * 1536;
        bf16x8 kfr[2][8];
        { const bf16_t* gk = G + 512 + h * 128 + 8 * hi;
#pragma unroll
          for (int ks = 0; ks < 8; ++ks) { kfr[0][ks] = *(const bf16x8*)(gk + rowA0 + 16 * ks); kfr[1][ks] = *(const bf16x8*)(gk + rowA1 + 16 * ks); } }
        LDS_WAIT();
        f32x16 am00, am10, am11;
#define KK_TILE(dst, mi, ni, gcs_) do { f32x16 acc_ = (f32x16){}; \
            _Pragma("unroll") for (int ks = 0; ks < 8; ++ks) acc_ = MFMA32(kfr[mi][ks], kfr[ni][ks], acc_); \
            _Pragma("unroll") for (int q = 0; q < 4; ++q) { const f32x4 g4 = *(const LAS f32x4*)(gcv + 32 * (mi) + 8 * q + 4 * hi), b4 = *(const LAS f32x4*)(gcv + 64 + 32 * (mi) + 8 * q + 4 * hi); \
                _Pragma("unroll") for (int e = 0; e < 4; ++e) { const int cc = 32 * (mi) + 8 * q + 4 * hi + e, ss = 32 * (ni) + r32; \
                    dst[4 * q + e] = (ss < cc) ? -b4[e] * acc_[4 * q + e] * __expf(fminf(g4[e] - (gcs_), 0.f)) : 0.f; } } } while (0)
        KK_TILE(am00, 0, 0, gcs0); KK_TILE(am10, 1, 0, gcs0); KK_TILE(am11, 1, 1, gcs1);
        __builtin_amdgcn_sched_barrier(0);
        { bf16x8 qfr[8]; const bf16_t* gq = G + h * 128 + 8 * hi;
#define KQ_TILE(n, mo, gcc_) do { f32x16 acc_ = (f32x16){}; \
            _Pragma("unroll") for (int ks = 0; ks < 8; ++ks) acc_ = MFMA32(kfr[n][ks], qfr[ks], acc_); \
            _Pragma("unroll") for (int q = 0; q < 4; ++q) { const f32x4 g4 = *(const LAS f32x4*)(gcv + 32 * (n) + 8 * q + 4 * hi); \
                _Pragma("unroll") for (int e = 0; e < 4; ++e) { const int ss = 32 * (n) + 8 * q + 4 * hi + e, cc = 32 * (mo) + r32; \
                    acc_[4 * q + e] = (ss <= cc) ? SCALE * acc_[4 * q + e] * __expf(fminf((gcc_) - g4[e], 0.f)) : 0.f; } } \
            _Pragma("unroll") for (int s = 0; s < 2; ++s) { u32x4 o_; o_.x = cvt_pk_bf16(acc_[8 * s], acc_[8 * s + 1]); o_.y = cvt_pk_bf16(acc_[8 * s + 2], acc_[8 * s + 3]); o_.z = cvt_pk_bf16(acc_[8 * s + 4], acc_[8 * s + 5]); o_.w = cvt_pk_bf16(acc_[8 * s + 6], acc_[8 * s + 7]); \
                *(u32x4*)(chb + CH_AF + (((mo) * 2 + (n)) * 2 + s) * 1024 + lane * 16) = o_; } } while (0)
#pragma unroll
          for (int ks = 0; ks < 8; ++ks) qfr[ks] = *(const bf16x8*)(gq + rowA0 + 16 * ks);
          KQ_TILE(0, 0, gcs0); __builtin_amdgcn_sched_barrier(0);
#pragma unroll
          for (int ks = 0; ks < 8; ++ks) qfr[ks] = *(const bf16x8*)(gq + rowA1 + 16 * ks);
          KQ_TILE(0, 1, gcs1); KQ_TILE(1, 1, gcs1); }
        __builtin_amdgcn_sched_barrier(0);
        { const float eg0 = __shfl(egt, r32) * SCALE, eg1 = __shfl(egt, 32 + r32) * SCALE;
#pragma unroll
          for (int m = 0; m < 2; ++m) { const bf16_t* gq = G + (m ? rowA1 : rowA0) + h * 128 + 4 * hi; const float sc = m ? eg1 : eg0;
#pragma unroll
              for (int ts = 0; ts < 8; ++ts) { const u32x2 a = *(const u32x2*)(gq + 16 * ts), bq = *(const u32x2*)(gq + 16 * ts + 8); u32x4 o_;
                  o_.x = cvt_pk_bf16(bflo(a.x) * sc, bfhi(a.x) * sc); o_.y = cvt_pk_bf16(bflo(a.y) * sc, bfhi(a.y) * sc); o_.z = cvt_pk_bf16(bflo(bq.x) * sc, bfhi(bq.x) * sc); o_.w = cvt_pk_bf16(bflo(bq.y) * sc, bfhi(bq.y) * sc);
                  *(u32x4*)(chb + CH_QF + (m * 8 + ts) * 1024 + lane * 16) = o_; } } }
        __builtin_amdgcn_sched_barrier(0);
        float x[64]; int lane_v = lane; asm volatile("" : "+v"(lane_v));
#pragma unroll
        for (int i = 63; i >= 0; --i) { float a0 = (lane_v == i) ? 1.f : 0.f, a1 = 0.f;
#pragma unroll
            for (int m = 63; m > i; --m) { const int ml = m & 31, hm = (ml >> 2) & 1, rm = (ml >> 3) * 4 + (ml & 3), ln = (i & 31) + 32 * hm;
                const float tv = (m >= 32) ? ((i >= 32) ? am11[rm] : am10[rm]) : am00[rm];
                const float s_ = __builtin_bit_cast(float, __builtin_amdgcn_readlane(__builtin_bit_cast(int, tv), ln));
                if (m & 1) asm("v_fmac_f32 %0, %1, %2" : "+v"(a1) : "s"(s_), "v"(x[m])); else asm("v_fmac_f32 %0, %1, %2" : "+v"(a0) : "s"(s_), "v"(x[m])); }
            x[i] = a0 + a1; __builtin_amdgcn_sched_barrier(0); }
        __builtin_amdgcn_sched_barrier(0);
        bf16x8 F0[4], F1[4];
#pragma unroll
        for (int ks = 0; ks < 4; ++ks) { u32x4 f0, f1;
#pragma unroll
            for (int w = 0; w < 4; ++w) { const unsigned pa = cvt_pk_bf16(x[16 * ks + 2 * w], x[16 * ks + 2 * w + 1]), pb = cvt_pk_bf16(x[16 * ks + 8 + 2 * w], x[16 * ks + 8 + 2 * w + 1]);
                const auto sw = __builtin_amdgcn_permlane32_swap(pa, pb, false, false);
                f0[w] = sw[0]; f1[w] = sw[1]; }
            F0[ks] = __builtin_bit_cast(bf16x8, f0); F1[ks] = __builtin_bit_cast(bf16x8, f1); }
        __builtin_amdgcn_sched_barrier(0);
#define PIECE_COL(pc) ((pc) < 4 ? 512 + h * 128 + 32 * (pc) : (pc) < 8 ? 1024 + h * 128 + 32 * ((pc) - 4) : 512 + h * 128 + 32 * ((pc) - 8))
#define PIECE_LOAD(pc, buf) do { const bf16_t* src_ = G + (size_t)myrow * 1536 + PIECE_COL(pc); _Pragma("unroll") for (int q = 0; q < 4; ++q) raw[buf][q] = *(const u32x4*)(src_ + 8 * q); } while (0)
#define PIECE_STAGE(buf, scal) do { LDS_WAIT(); \
            _Pragma("unroll") for (int q = 0; q < 4; ++q) { const u32x4 w_ = raw[buf][q]; u32x4 o_; \
                o_.x = cvt_pk_bf16(bflo(w_.x) * (scal), bfhi(w_.x) * (scal)); o_.y = cvt_pk_bf16(bflo(w_.y) * (scal), bfhi(w_.y) * (scal)); o_.z = cvt_pk_bf16(bflo(w_.z) * (scal), bfhi(w_.z) * (scal)); o_.w = cvt_pk_bf16(bflo(w_.w) * (scal), bfhi(w_.w) * (scal)); \
                *(LAS u32x4*)(stg + lane * 64 + 16 * q) = o_; } LDS_WAIT(); } while (0)
#define TR_FRAG(ks) ({ const s16x4 lo_ = vtr_c(stgp + (ks) * 1024), hi_ = vtr_c(stgp + (ks) * 1024 + 512); (bf16x8){lo_[0], lo_[1], lo_[2], lo_[3], hi_[0], hi_[1], hi_[2], hi_[3]}; })
#define TR_NAT(ks) ({ const s16x4 lo_ = vtr_c(stgn + (ks) * 1024), hi_ = vtr_c(stgn + (ks) * 1024 + 256); (bf16x8){lo_[0], lo_[1], lo_[2], lo_[3], hi_[0], hi_[1], hi_[2], hi_[3]}; })
        u32x4 raw[2][4];
        PIECE_LOAD(0, 0);
#pragma unroll
        for (int pc = 0; pc < 12; ++pc) {
            __builtin_amdgcn_sched_barrier(0);
            if (pc + 1 < 12) PIECE_LOAD(pc + 1, (pc + 1) & 1);
            if (pc < 4) {
                const int t = pc; PIECE_STAGE(pc & 1, begt);
                f32x16 a0 = (f32x16){}, a1 = (f32x16){};
#pragma unroll
                for (int ks = 0; ks < 4; ++ks) { const bf16x8 fr = TR_NAT(ks); a0 = MFMA32(fr, F0[ks], a0); a1 = MFMA32(fr, F1[ks], a1); }
#pragma unroll
                for (int s = 0; s < 2; ++s) { u32x4 o0, o1;
                    o0.x = cvt_pk_bf16(-a0[8 * s], -a0[8 * s + 1]); o0.y = cvt_pk_bf16(-a0[8 * s + 2], -a0[8 * s + 3]); o0.z = cvt_pk_bf16(-a0[8 * s + 4], -a0[8 * s + 5]); o0.w = cvt_pk_bf16(-a0[8 * s + 6], -a0[8 * s + 7]);
                    o1.x = cvt_pk_bf16(-a1[8 * s], -a1[8 * s + 1]); o1.y = cvt_pk_bf16(-a1[8 * s + 2], -a1[8 * s + 3]); o1.z = cvt_pk_bf16(-a1[8 * s + 4], -a1[8 * s + 5]); o1.w = cvt_pk_bf16(-a1[8 * s + 6], -a1[8 * s + 7]);
                    *(u32x4*)(chb + CH_WF + ((0 * 4 + t) * 2 + s) * 1024 + lane * 16) = o0; *(u32x4*)(chb + CH_WF + ((1 * 4 + t) * 2 + s) * 1024 + lane * 16) = o1; }
            } else if (pc < 8) {
                const int nj = pc - 4; PIECE_STAGE(pc & 1, bt);
                f32x16 a0 = (f32x16){}, a1 = (f32x16){};
#pragma unroll
                for (int ks = 0; ks < 4; ++ks) { const bf16x8 fr = TR_NAT(ks); a0 = MFMA32(F0[ks], fr, a0); a1 = MFMA32(F1[ks], fr, a1); }
                float* uc = (float*)(chb + CH_UC) + ((nj * 2) * 64 + lane) * 16;
#pragma unroll
                for (int q = 0; q < 4; ++q) { *(f32x4*)(uc + 4 * q) = (f32x4){a0[4 * q], a0[4 * q + 1], a0[4 * q + 2], a0[4 * q + 3]}; *(f32x4*)(uc + 1024 + 4 * q) = (f32x4){a1[4 * q], a1[4 * q + 1], a1[4 * q + 2], a1[4 * q + 3]}; }
            } else {
                const int t = pc - 8; PIECE_STAGE(pc & 1, kdt);
#pragma unroll
                for (int ms = 0; ms < 4; ++ms) { const bf16x8 fr = TR_FRAG(ms); *(bf16x8*)(chb + CH_KF + (t * 4 + ms) * 1024 + lane * 16) = fr; }
            }
        }
        LDS_WAIT();
#undef KK_TILE
#undef KQ_TILE
#undef PIECE_COL
#undef PIECE_LOAD
#undef PIECE_STAGE
#undef TR_FRAG
#undef TR_NAT
    }
}
__device__ __forceinline__ void phase_gdn_chunk(PP p, LAS unsigned char* lds) {
    int tid = threadIdx.x, bid = blockIdx.x, gdim = gridDim.x; asm volatile("" : "+v"(tid), "+s"(bid), "+s"(gdim)); const int lane = tid & 63, wave = __builtin_amdgcn_readfirstlane(tid >> 6);
    for (int q = bid * NWAVES + wave; q < 16 * 256; q += gdim * NWAVES) gdn_chunk_task(p, lds + wave * CWL_BYTES, (q >> 8) * NCHUNK + 4 + (q & 255), lane);
}

__device__ __forceinline__ void gdn_scan_chain(PP p, LAS unsigned char* lds, const int chain) {
    int tid = threadIdx.x; asm volatile("" : "+v"(tid)); const int lane = tid & 63, wave = __builtin_amdgcn_readfirstlane(tid >> 6), r32 = lane & 31, hi = lane >> 5;
    const float* cf = (const float*)(p->ws + WS_CONST);
    bf16_t* OG = (bf16_t*)(p->ws + WS_OG);
    constexpr int STG = 2 * CH_DMA_BYTES;
    const int dir = chain & 1, h = (chain >> 1) & 3;
    f32x16 S[4];
#pragma unroll
    for (int t = 0; t < 4; ++t) S[t] = (f32x16){};
    f32x16 Un[2]; float egn = 0.f;
#pragma unroll
    for (int m = 0; m < 2; ++m) Un[m] = (f32x16){};
#define LOAD_U(task_) do { const float* uc_ = (const float*)(p->ws + WS_CH + (size_t)(task_) * CH_TASK_BYTES + CH_UC) + ((wave * 2) * 64 + lane) * 16; \
        _Pragma("unroll") for (int m = 0; m < 2; ++m) _Pragma("unroll") for (int q = 0; q < 4; ++q) { const f32x4 t4 = *(const f32x4*)(uc_ + m * 1024 + 4 * q); Un[m][4 * q] = t4[0]; Un[m][4 * q + 1] = t4[1]; Un[m][4 * q + 2] = t4[2]; Un[m][4 * q + 3] = t4[3]; } \
        egn = cf[CF_EGL + (task_)]; } while (0)
#define STAGE_CHUNK(task_, bufi) do { const unsigned char* src_ = p->ws + WS_CH + (size_t)(task_) * CH_TASK_BYTES; const unsigned dst_ = lds_addr(lds + (bufi) * CH_DMA_BYTES); \
        _Pragma("unroll") for (int i = 0; i < 14; ++i) { const int pc = wave * 14 + i; glds16(src_ + pc * 1024 + lane * 16, dst_ + pc * 1024); } } while (0)
    if (wave >= 4) gdn_chunk_task(p, lds + (wave - 4) * CWL_BYTES, chain * NCHUNK + (wave - 4), lane);
    VM_WAIT(); LDS_WAIT(); __syncthreads();
    if (wave < 4) { LOAD_U(chain * NCHUNK); STAGE_CHUNK(chain * NCHUNK, 0); }
    for (int n = 0; n < NCHUNK; ++n) {
        const int task = chain * NCHUNK + n;
        int bq, hq, dq, rstart, rstep; gdn_task_rows(task, bq, hq, dq, rstart, rstep);
        if (wave < 4) VM_WAIT();
        asm volatile("s_waitcnt lgkmcnt(0)\n\ts_barrier" ::: "memory");
        if (wave < 4) {
            f32x16 V[2], O[2];
#pragma unroll
            for (int m = 0; m < 2; ++m) { V[m] = Un[m]; O[m] = (f32x16){}; }
            const float egl = egn;
            if (n + 1 < NCHUNK) { LOAD_U(task + 1); STAGE_CHUNK(task + 1, (n + 1) & 1); }
            const LAS unsigned char* buf = lds + (n & 1) * CH_DMA_BYTES + lane * 16;
            bf16x8 Sb[4][2];
#pragma unroll
            for (int t = 0; t < 4; ++t)
#pragma unroll
                for (int s = 0; s < 2; ++s) { u32x4 w; w.x = cvt_pk_bf16(S[t][8 * s], S[t][8 * s + 1]); w.y = cvt_pk_bf16(S[t][8 * s + 2], S[t][8 * s + 3]); w.z = cvt_pk_bf16(S[t][8 * s + 4], S[t][8 * s + 5]); w.w = cvt_pk_bf16(S[t][8 * s + 6], S[t][8 * s + 7]);
                    Sb[t][s] = __builtin_bit_cast(bf16x8, w); }
#pragma unroll
            for (int m = 0; m < 2; ++m)
#pragma unroll
                for (int t = 0; t < 4; ++t)
#pragma unroll
                    for (int s = 0; s < 2; ++s) { const int f = (m * 4 + t) * 2 + s;
                        V[m] = MFMA32(*(const LAS bf16x8*)(buf + CH_WF + f * 1024), Sb[t][s], V[m]);
                        O[m] = MFMA32(*(const LAS bf16x8*)(buf + CH_QF + f * 1024), Sb[t][s], O[m]);
                        if (s == 1 && (t & 1)) __builtin_amdgcn_sched_barrier(0); }
            bf16x8 Vb[2][2];
#pragma unroll
            for (int m = 0; m < 2; ++m)
#pragma unroll
                for (int s = 0; s < 2; ++s) { u32x4 w; w.x = cvt_pk_bf16(V[m][8 * s], V[m][8 * s + 1]); w.y = cvt_pk_bf16(V[m][8 * s + 2], V[m][8 * s + 3]); w.z = cvt_pk_bf16(V[m][8 * s + 4], V[m][8 * s + 5]); w.w = cvt_pk_bf16(V[m][8 * s + 6], V[m][8 * s + 7]);
                    Vb[m][s] = __builtin_bit_cast(bf16x8, w); }
#pragma unroll
            for (int mo = 0; mo < 2; ++mo)
#pragma unroll
                for (int m = 0; m <= mo; ++m)
#pragma unroll
                    for (int s = 0; s < 2; ++s) O[mo] = MFMA32(*(const LAS bf16x8*)(buf + CH_AF + ((mo * 2 + m) * 2 + s) * 1024), Vb[m][s], O[mo]);
            { LAS bf16_t* stg = (LAS bf16_t*)(lds + STG) + 32 * wave + r32;
#pragma unroll
              for (int m = 0; m < 2; ++m)
#pragma unroll
                  for (int r = 0; r < 16; ++r) stg[(32 * m + crow(r, hi)) * 128] = (bf16_t)f2bf(O[m][r]); }
#pragma unroll
            for (int t = 0; t < 4; ++t) {
                __builtin_amdgcn_sched_barrier(0);
#pragma unroll
                for (int r = 0; r < 16; ++r) S[t][r] *= egl;
#pragma unroll
                for (int m = 0; m < 2; ++m)
#pragma unroll
                    for (int s = 0; s < 2; ++s) S[t] = MFMA32(*(const LAS bf16x8*)(buf + CH_KF + ((t * 2 + m) * 2 + s) * 1024), Vb[m][s], S[t]); }
        }
        asm volatile("s_waitcnt lgkmcnt(0)\n\ts_barrier" ::: "memory");
        if (wave >= 4) { const int j = tid - 256, row = j >> 2; bf16_t* og = OG + (size_t)dir * NTOK * 512 + (size_t)(rstart + rstep * row) * 512 + h * 128 + (j & 3) * 8;
            const LAS bf16_t* stg = (const LAS bf16_t*)(lds + STG) + row * 128 + (j & 3) * 8;
#pragma unroll
            for (int it = 0; it < 4; ++it) *(u32x4*)(og + it * 32) = *(const LAS u32x4*)(stg + it * 32); }
    }
    VM_WAIT(); LDS_WAIT(); __syncthreads();
#undef LOAD_U
#undef STAGE_CHUNK
}

__device__ __forceinline__ void phase_gdn_out(PP p, int layer) {
    int tid = threadIdx.x, bid = blockIdx.x, gdim = gridDim.x; asm volatile("" : "+v"(tid), "+s"(bid), "+s"(gdim)); const int lane = tid & 63, wave = __builtin_amdgcn_readfirstlane(tid >> 6);
    const bf16_t* OG = (const bf16_t*)(p->ws + WS_OG); const bf16_t* OA = (const bf16_t*)(p->ws + WS_OA); const bf16_t* P = (const bf16_t*)(p->ws + WS_P); bf16_t* MIX = (bf16_t*)(p->ws + WS_MIX);
    const float* cf = (const float*)(p->ws + WS_CONST);
    const float lam = cf[CF_SC + layer * 16 + 0], oml = cf[CF_SC + layer * 16 + 2];
    const float* gn = p->in[I_GDNG] + layer * 128 + (8 * lane & 127); const float* sg = p->in[I_SUBLN] + layer * 128 + (8 * lane & 127);
    const f32x4 g0 = *(const f32x4*)gn, g1 = *(const f32x4*)(gn + 4), a0 = *(const f32x4*)sg * oml, a1 = *(const f32x4*)(sg + 4) * oml;
    const int nrows = layer == 0 ? NTOK : NLAT;
    for (int r = bid * NWAVES + wave; r < nrows; r += gdim * NWAVES) {
        {
            const bf16_t* a = OA + (size_t)r * 512 + 8 * lane; const float* la = (const float*)(p->ws + WS_LA) + (size_t)r * 4 + (lane >> 4);
            constexpr size_t PS = (size_t)NTOK * 512, LS = (size_t)NTOK * 4;
#define LD8(ptr, lo4, hi4) do { const u32x4 w_ = *(const u32x4*)(ptr); lo4 = (f32x4){bflo(w_.x), bfhi(w_.x), bflo(w_.y), bfhi(w_.y)}; hi4 = (f32x4){bflo(w_.z), bfhi(w_.z), bflo(w_.w), bfhi(w_.w)}; } while (0)
            f32x4 s0a, s0b, s1a, s1b; LD8(a, s0a, s0b); LD8(a + PS, s1a, s1b); float l0 = la[0], l1 = la[LS];
            if (r < NLAT) { f32x4 t0, t1; LD8(a + 2 * PS, t0, t1); s0a += t0; s0b += t1; LD8(a + 3 * PS, t0, t1); s1a += t0; s1b += t1; l0 += la[2 * LS]; l1 += la[3 * LS];
                if (r >= SEQL && (lane >> 4) == 3) {
#pragma unroll
                    for (int q = 2; q < 4; ++q) { LD8(a + (2 * q) * PS, t0, t1); s0a += t0; s0b += t1; LD8(a + (2 * q + 1) * PS, t0, t1); s1a += t0; s1b += t1; l0 += la[(2 * q) * LS]; l1 += la[(2 * q + 1) * LS]; } } }
            const float r0 = 1.f / l0, r1 = lam / l1;
            f32x4 o0 = s0a * r0 - s1a * r1, o1 = s0b * r0 - s1b * r1;
            float ss = (o0[0] * o0[0] + o0[1] * o0[1]) + (o0[2] * o0[2] + o0[3] * o0[3]) + (o1[0] * o1[0] + o1[1] * o1[1]) + (o1[2] * o1[2] + o1[3] * o1[3]);
            ss += __shfl_xor(ss, 1); ss += __shfl_xor(ss, 2); ss += __shfl_xor(ss, 4); ss += __shfl_xor(ss, 8);
            const float rstd = rsqrtf(ss * (1.f / 128.f) + EPS);
            o0 = o0 * rstd * a0; o1 = o1 * rstd * a1;
            u32x4 w; w.x = cvt_pk_bf16(o0[0], o0[1]); w.y = cvt_pk_bf16(o0[2], o0[3]); w.z = cvt_pk_bf16(o1[0], o1[1]); w.w = cvt_pk_bf16(o1[2], o1[3]);
            *(u32x4*)(MIX + (size_t)r * D + 8 * lane) = w; }
        const bf16_t* a = OG + (size_t)r * 512 + 8 * lane; const bf16_t* bq = a + (size_t)NTOK * 512;
        f32x4 o0, o1; { f32x4 t0, t1; LD8(a, o0, o1); LD8(bq, t0, t1); o0 += t0; o1 += t1; }
        float ss = (o0[0] * o0[0] + o0[1] * o0[1]) + (o0[2] * o0[2] + o0[3] * o0[3]) + (o1[0] * o1[0] + o1[1] * o1[1]) + (o1[2] * o1[2] + o1[3] * o1[3]);
        ss += __shfl_xor(ss, 1); ss += __shfl_xor(ss, 2); ss += __shfl_xor(ss, 4); ss += __shfl_xor(ss, 8);
        const float rstd = rsqrtf(ss * (1.f / 128.f) + EPS);
        const u32x4 zw = *(const u32x4*)(P + (size_t)r * PW + 3072 + 8 * lane);
        o0 = o0 * rstd * g0; o1 = o1 * rstd * g1;
        u32x4 w; w.x = cvt_pk_bf16(o0[0] * silu_f(bflo(zw.x)), o0[1] * silu_f(bfhi(zw.x))); w.y = cvt_pk_bf16(o0[2] * silu_f(bflo(zw.y)), o0[3] * silu_f(bfhi(zw.y)));
        w.z = cvt_pk_bf16(o1[0] * silu_f(bflo(zw.z)), o1[1] * silu_f(bfhi(zw.z))); w.w = cvt_pk_bf16(o1[2] * silu_f(bflo(zw.w)), o1[3] * silu_f(bfhi(zw.w)));
        *(u32x4*)(MIX + (size_t)r * D + 512 + 8 * lane) = w;
    }
}

constexpr int AT_NS = 4, AT_SLOTK = 8192, AT_SLOTV = 16384, AT_K = 0, AT_V = AT_NS * AT_SLOTK, AT_WS = AT_V + AT_NS * AT_SLOTV;
typedef short v4i16_t __attribute__((ext_vector_type(4)));
__device__ __forceinline__ s16x4 vtr(const LAS unsigned char* ptr) { return __builtin_bit_cast(s16x4, __builtin_amdgcn_ds_read_tr16_b64_v4i16((LAS v4i16_t*)ptr)); }
__device__ __forceinline__ int att_keyrow(int b, int t, int nctx_tiles) {
    return t < nctx_tiles ? NLAT + b * CTXL + 64 * t : b * SEQL + 64 * (t - nctx_tiles);
}
#define AT_SBAR() __builtin_amdgcn_sched_barrier(0)
#define AT_PIN(x) asm volatile("" : "+v"(x))
#define AT_WAIT_BAR(N) asm volatile("s_waitcnt vmcnt(" #N ") lgkmcnt(0)\n\ts_barrier" ::: "memory")
__device__ __forceinline__ void attn_unit(PP p, int layer, LAS unsigned char* lds, int b, int h, int sub, int qrow0, int t0, int ntile, int nctx_tiles, int ksp) {
    int tid = threadIdx.x; asm volatile("" : "+v"(tid)); const int lane = tid & 63, wave = __builtin_amdgcn_readfirstlane(tid >> 6), r32 = lane & 31, hi = lane >> 5;
    const bf16_t* P = (const bf16_t*)(p->ws + WS_P);
    LAS float* wsf = (LAS float*)(lds + AT_WS) + wave * 64;
    const LAS unsigned char* kp0 = lds + AT_K + hi * 1024 + r32 * 16;
    const LAS unsigned char* vp0 = lds + AT_V + ((lane >> 4) & 1) * 32 + (lane & 3) * 8 + (4 * hi + ((lane & 15) >> 2)) * 64;
    const int kcol = 512 + h * 128 + sub * 64 + wave * 8, vcol = 1024 + h * 128;
    const size_t koff = (size_t)lane * PW + kcol;
    const size_t voff0 = (size_t)(16 * (wave & 3) + (lane >> 2)) * PW + vcol + 32 * (wave >> 2) + 8 * (lane & 3);
    const size_t voff1 = voff0 + 64;
    const unsigned kdst = lds_addr(lds + AT_K + wave * 1024), vdst = lds_addr(lds + AT_V + wave * 1024);
#define DMA_K(t, slot) do { if ((t) < ntile) glds16(P + (size_t)att_keyrow(b, t0 + (t), nctx_tiles) * PW + koff, kdst + (slot) * AT_SLOTK); } while (0)
#define DMA_V(t, slot) do { if ((t) < ntile) { const bf16_t* vb_ = P + (size_t)att_keyrow(b, t0 + (t), nctx_tiles) * PW; \
        glds16(vb_ + voff0, vdst + (slot) * AT_SLOTV); glds16(vb_ + voff1, vdst + (slot) * AT_SLOTV + 8192); } } while (0)
    DMA_K(0, 0); DMA_V(0, 0); DMA_K(1, 1); DMA_K(2, 2); DMA_K(3, 3); DMA_V(1, 1);
    bf16x8 qr[4];
    { const bf16_t* qp = P + (size_t)(qrow0 + wave * 32 + r32) * PW + h * 128 + sub * 64 + hi * 8;
#pragma unroll
      for (int d0 = 0; d0 < 4; ++d0) qr[d0] = *(const bf16x8*)(qp + d0 * 16); }
    f32x16 o[4];
#pragma unroll
    for (int dg = 0; dg < 4; ++dg) o[dg] = (f32x16){};
    float l_reg = 0.f;
    f32x16 pA0, pA1, pB0, pB1; bf16x8 kf[8]; u32x4 pw0, pw1, pw2, pw3; s16x4 vlo[4], vhi[4];
    f32x16 zero16 = (f32x16){}; AT_PIN(zero16);
    int sl_prev = 0, sl_cur = 0, sl_next = 1;
#define ROT() do { sl_prev = sl_cur; sl_cur = sl_next; sl_next = (sl_next + 1) & 3; } while (0)
#define KLD(i, kp_) kf[i] = *(const LAS bf16x8*)((kp_) + ((i) >> 1) * 2048 + ((i) & 1) * 512)
#define PKW(Pv, i) cvt_pk_bf16(Pv[i], Pv[(i) + 1])
#define PAF(k) __builtin_bit_cast(bf16x8, pw##k)
#define VRD(i, vp_) do { vlo[(i) & 3] = vtr((vp_) + ((i) & 3) * 4096 + ((i) >> 2) * 1024); vhi[(i) & 3] = vtr((vp_) + ((i) & 3) * 4096 + ((i) >> 2) * 1024 + 512); } while (0)
#define VFR(i) (bf16x8){vlo[(i) & 3][0], vlo[(i) & 3][1], vlo[(i) & 3][2], vlo[(i) & 3][3], vhi[(i) & 3][0], vhi[(i) & 3][1], vhi[(i) & 3][2], vhi[(i) & 3][3]}
#define EX2(Cv, i) do { Cv[i] = __builtin_amdgcn_exp2f(Cv[i]); Cv[(i) + 1] = __builtin_amdgcn_exp2f(Cv[(i) + 1]); } while (0)
#define GAPA(MF, a0, a1, a2, a3, W0, W1, PW_) do { MF; sacc += a0; sacc += a1; sacc += a2; sacc += a3; W0; W1; AT_PIN(PW_); AT_PIN(sacc); AT_SBAR(); } while (0)
#define GAPB(i, PA_, Cx, ci, GL) do { o[(i) & 3] = MFMA32(PA_, VFR(i), o[(i) & 3]); EX2(Cx, ci); AT_PIN(Cx); \
        if ((i) + 2 < 16) VRD((i) + 2, vpp_); if ((GL) && (i) < 8) KLD(i, kpn_); AT_SBAR(); } while (0)
#define STEP(C0, C1, P0, P1, t, GL) do { AT_SBAR(); \
    const LAS unsigned char* vpp_ = vp0 + sl_prev * AT_SLOTV; const LAS unsigned char* kpn_ = kp0 + sl_next * AT_SLOTK; \
    float sacc = P0[0] + P0[1]; \
    GAPA(C0 = MFMA32(kf[0], qr[0], zero16), P0[2], P0[3], P0[4], P0[5],     pw0[0] = PKW(P0, 0),  pw0[1] = PKW(P0, 2),  pw0); \
    GAPA(C1 = MFMA32(kf[1], qr[0], zero16), P0[6], P0[7], P0[8], P0[9],     pw0[2] = PKW(P0, 4),  pw0[3] = PKW(P0, 6),  pw0); \
    GAPA(C0 = MFMA32(kf[2], qr[1], C0),     P0[10], P0[11], P0[12], P0[13], pw1[0] = PKW(P0, 8),  pw1[1] = PKW(P0, 10), pw1); \
    GAPA(C1 = MFMA32(kf[3], qr[1], C1),     P0[14], P0[15], P1[0], P1[1],   pw1[2] = PKW(P0, 12), pw1[3] = PKW(P0, 14), pw1); \
    GAPA(C0 = MFMA32(kf[4], qr[2], C0),     P1[2], P1[3], P1[4], P1[5],     pw2[0] = PKW(P1, 0),  pw2[1] = PKW(P1, 2),  pw2); \
    GAPA(C1 = MFMA32(kf[5], qr[2], C1),     P1[6], P1[7], P1[8], P1[9],     pw2[2] = PKW(P1, 4),  pw2[3] = PKW(P1, 6),  pw2); \
    VRD(0, vpp_); \
    GAPA(C0 = MFMA32(kf[6], qr[3], C0),     P1[10], P1[11], P1[12], P1[13], pw3[0] = PKW(P1, 8),  pw3[1] = PKW(P1, 10), pw3); \
    VRD(1, vpp_); \
    GAPA(C1 = MFMA32(kf[7], qr[3], C1),     P1[14], P1[15], 0.f, 0.f,       pw3[2] = PKW(P1, 12), pw3[3] = PKW(P1, 14), pw3); \
    l_reg += sacc; \
    DMA_K((t) + 4, sl_cur); DMA_V((t) + 2, (sl_next + 1) & 3); AT_SBAR(); \
    GAPB(0, PAF(0), C0, 0, GL);  GAPB(1, PAF(0), C0, 2, GL);  GAPB(2, PAF(0), C0, 4, GL);  GAPB(3, PAF(0), C0, 6, GL); \
    GAPB(4, PAF(1), C0, 8, GL);  GAPB(5, PAF(1), C0, 10, GL); GAPB(6, PAF(1), C0, 12, GL); GAPB(7, PAF(1), C0, 14, GL); \
    GAPB(8, PAF(2), C1, 0, GL);  GAPB(9, PAF(2), C1, 2, GL);  GAPB(10, PAF(2), C1, 4, GL); GAPB(11, PAF(2), C1, 6, GL); \
    GAPB(12, PAF(3), C1, 8, GL); GAPB(13, PAF(3), C1, 10, GL); GAPB(14, PAF(3), C1, 12, GL); GAPB(15, PAF(3), C1, 14, GL); \
    } while (0)
#define ENDW(tt) do { if ((tt) + 4 < ntile) { AT_WAIT_BAR(6); } else { AT_WAIT_BAR(0); } } while (0)
    AT_WAIT_BAR(0);
#pragma unroll
    for (int i = 0; i < 8; ++i) KLD(i, kp0);
    pA0 = MFMA32(kf[0], qr[0], zero16); pA1 = MFMA32(kf[1], qr[0], zero16); pA0 = MFMA32(kf[2], qr[1], pA0); pA1 = MFMA32(kf[3], qr[1], pA1);
    pA0 = MFMA32(kf[4], qr[2], pA0); pA1 = MFMA32(kf[5], qr[2], pA1); pA0 = MFMA32(kf[6], qr[3], pA0); pA1 = MFMA32(kf[7], qr[3], pA1);
#pragma unroll
    for (int r = 0; r < 16; ++r) { pA0[r] = __builtin_amdgcn_exp2f(pA0[r]); pA1[r] = __builtin_amdgcn_exp2f(pA1[r]); }
    AT_WAIT_BAR(0);
    DMA_K(4, 0); DMA_V(2, 2); ROT();
#pragma unroll
    for (int i = 0; i < 8; ++i) KLD(i, kp0 + sl_cur * AT_SLOTK);
    if (ntile > 4) { AT_WAIT_BAR(3); } else { AT_WAIT_BAR(0); }
    int t = 1;
    for (; t + 1 < ntile; t += 2) {
        STEP(pB0, pB1, pA0, pA1, t, true);     ENDW(t);     ROT();
        STEP(pA0, pA1, pB0, pB1, t + 1, (t + 2 < ntile)); ENDW(t + 1); ROT();
    }
    if (t < ntile) { STEP(pB0, pB1, pA0, pA1, t, false); ENDW(t); ROT();
#pragma unroll
        for (int r = 0; r < 16; ++r) { pA0[r] = pB0[r]; pA1[r] = pB1[r]; } }
    { float sacc = 0.f;
#pragma unroll
      for (int r = 0; r < 16; ++r) sacc += pA0[r] + pA1[r];
      l_reg += sacc;
      pw0 = (u32x4){PKW(pA0, 0), PKW(pA0, 2), PKW(pA0, 4), PKW(pA0, 6)}; pw1 = (u32x4){PKW(pA0, 8), PKW(pA0, 10), PKW(pA0, 12), PKW(pA0, 14)};
      pw2 = (u32x4){PKW(pA1, 0), PKW(pA1, 2), PKW(pA1, 4), PKW(pA1, 6)}; pw3 = (u32x4){PKW(pA1, 8), PKW(pA1, 10), PKW(pA1, 12), PKW(pA1, 14)};
      const LAS unsigned char* vpp_ = vp0 + sl_prev * AT_SLOTV;
#pragma unroll
      for (int i = 0; i < 16; ++i) { VRD(i, vpp_); const bf16x8 pa = (i >> 2) == 0 ? PAF(0) : (i >> 2) == 1 ? PAF(1) : (i >> 2) == 2 ? PAF(2) : PAF(3); o[i & 3] = MFMA32(pa, VFR(i), o[i & 3]); } }
    l_reg += __shfl_xor(l_reg, 32);
    const size_t part = (size_t)(ksp * 2 + sub) * NTOK;
    if (hi == 0) ((float*)(p->ws + WS_LA))[(part + qrow0 + wave * 32 + r32) * 4 + h] = l_reg;
    bf16_t* OA = (bf16_t*)(p->ws + WS_OA) + part * 512 + h * 128 + r32;
#pragma unroll
    for (int r = 0; r < 16; ++r) { bf16_t* orow = OA + (size_t)(qrow0 + wave * 32 + crow(r, hi)) * 512;
#pragma unroll
        for (int dg = 0; dg < 4; ++dg) orow[32 * dg] = (bf16_t)f2bf(o[dg][r]); }
    AT_WAIT_BAR(0);
#undef DMA_K
#undef DMA_V
#undef ROT
#undef KLD
#undef PKW
#undef PAF
#undef VRD
#undef VFR
#undef EX2
#undef GAPA
#undef GAPB
#undef STEP
#undef ENDW
}
__device__ __forceinline__ void phase_attention(PP p, int layer, LAS unsigned char* lds, int qsel) {
    int bid = blockIdx.x; asm volatile("" : "+s"(bid));
    if (bid < 16) gdn_scan_chain(p, lds, bid);
    constexpr int NBIG = 1792, NSMALL = 512;
    const int nlat = NBIG + NSMALL, nunits = nlat + (layer == 0 ? NB * 4 * 2 : 0);
    unsigned* ctr = (unsigned*)(p->ws + WS_CTL) + CW_ATTQ + layer * 64 + qsel * 32;
    volatile LAS unsigned* slot = (volatile LAS unsigned*)(lds + MISC_OFF) + 16;
    for (;;) {
        if (threadIdx.x == 0) *slot = __hip_atomic_fetch_add(ctr, 1u, __ATOMIC_RELAXED, __HIP_MEMORY_SCOPE_AGENT);
        __syncthreads();
        const int u = (int)__builtin_amdgcn_readfirstlane((int)*slot);
        if (u >= nunits) break;
        if (u < NBIG) { const int b = u >> 10, h = (u >> 8) & 3, sub = (u >> 7) & 1, ksp = (u >> 6) & 1, qb = u & 63; attn_unit(p, layer, lds, b, h, sub, b * SEQL + qb * 256, ksp * 130, 130, 4, ksp); }
        else if (u < nlat) { const int v = u - NBIG, sub = v >> 8, kq = (v >> 6) & 3, qb = v & 63; attn_unit(p, layer, lds, 1, 3, sub, SEQL + qb * 256, kq * 65, 65, 4, kq); }
        else { const int v = u - nlat, b = v >> 3, h = (v >> 1) & 3, sub = v & 1; attn_unit(p, layer, lds, b, h, sub, NLAT + b * CTXL, 0, 4, 4, 0); }
    }
}

__device__ __forceinline__ void phase_norm_router(PP p, int layer, LAS unsigned char* lds) {
    int tid = threadIdx.x, bid = blockIdx.x, gdim = gridDim.x; asm volatile("" : "+v"(tid), "+s"(bid), "+s"(gdim)); const int lane = tid & 63, wave = __builtin_amdgcn_readfirstlane(tid >> 6);
    const int T = layer == 0 ? NTOK : NLAT;
    LAS float* rw = (LAS float*)lds;
    LAS int* lcnt = (LAS int*)(lds + 131072);
    LAS int* lbase = lcnt + 32;
    LAS int* ent = lcnt + 64;
    const float* rwg = p->in[I_RW] + (size_t)layer * D * NEXP;
    for (int i = tid; i < NEXP * 1024; i += NTHR) { const int k = i >> 5, e = i & 31; rw[e * 1024 + k] = rwg[(size_t)k * NEXP + e]; }
    if (tid < 64) lcnt[tid] = 0;
    __syncthreads();
    const float* cf = (const float*)(p->ws + WS_CONST);
    const float* gn = p->in[I_NFFNG] + layer * D;
    const float rb = lane < NEXP ? p->in[I_RB][layer * NEXP + lane] : 0.f;
    const int rpw = (T + gdim - 1) / gdim;
    const int r0 = bid * rpw, r1 = (r0 + rpw < T) ? r0 + rpw : T;
    int* tope = (int*)(p->ws + WS_RT + RT_TOPE); float* gate = (float*)(p->ws + WS_RT + RT_GATE); int* rank = (int*)(p->ws + WS_RT + RT_RANK);
    const bf16_t* H = (const bf16_t*)(p->ws + WS_H);
    for (int r = r0 + wave; r < r1; r += NWAVES) {
        const float* mv = cf + CF_MODV + (layer * 3 + mod_sel(r)) * 6144;
        f32x4 u[4];
#pragma unroll
        for (int j = 0; j < 4; ++j) { const u32x2 w_ = *(const u32x2*)(H + (size_t)r * D + 4 * lane + 256 * j); u[j] = (f32x4){bflo(w_.x), bfhi(w_.x), bflo(w_.y), bfhi(w_.y)}; }
        norm_mod_vals(gn, mv + 3 * 1024, mv + 4 * 1024, lane, u);
        store_row_bf16((bf16_t*)(p->ws + WS_U) + (size_t)r * D, lane, u);
        float logit = -INFINITY;
#pragma unroll 4
        for (int e = 0; e < NEXP; ++e) { float s = 0.f;
#pragma unroll
            for (int q = 0; q < 4; ++q) { const f32x4 w = *(const LAS f32x4*)(rw + e * 1024 + 4 * lane + 256 * q); s += (u[q][0] * w[0] + u[q][1] * w[1]) + (u[q][2] * w[2] + u[q][3] * w[3]); }
            s = wave_sum(s); if (lane == e) logit = s + rb; }
        float tl[4]; int te[4];
#pragma unroll
        for (int k = 0; k < 4; ++k) { const float m = wave_max(logit); const unsigned long long bal = __ballot(logit == m); const int idx = __ffsll((long long)bal) - 1;
            tl[k] = m; te[k] = idx; if (lane == idx) logit = -INFINITY; }
        const float e1 = __expf(tl[1] - tl[0]), e2 = __expf(tl[2] - tl[0]), e3 = __expf(tl[3] - tl[0]); const float inv = 1.f / (1.f + e1 + e2 + e3);
        if (lane < 4) { const int e = lane == 0 ? te[0] : lane == 1 ? te[1] : lane == 2 ? te[2] : te[3]; const float gv = (lane == 0 ? 1.f : lane == 1 ? e1 : lane == 2 ? e2 : e3) * inv;
            const int lr = atomicAdd((int*)&lcnt[e], 1);
            ent[(r - r0) * 4 + lane] = (e << 20) | lr; tope[(size_t)r * 4 + lane] = e; gate[(size_t)r * 4 + lane] = gv; }
    }
    __syncthreads();
    if (tid < NEXP) lbase[tid] = (int)atomicAdd((unsigned*)(p->ws + WS_CTL) + CW_CNT + layer * 64 + tid, (unsigned)lcnt[tid]);
    __syncthreads();
    for (int i = tid; i < (r1 - r0) * 4; i += NTHR) { const int v = ent[i]; rank[(size_t)r0 * 4 + i] = lbase[v >> 20] + (v & 0xfffff); }
}

__device__ __forceinline__ void phase_moe_gather(PP p, int layer, LAS unsigned char* lds) {
    int tid = threadIdx.x, bid = blockIdx.x, gdim = gridDim.x; asm volatile("" : "+v"(tid), "+s"(bid), "+s"(gdim)); const int lane = tid & 63, wave = __builtin_amdgcn_readfirstlane(tid >> 6);
    const int T = layer == 0 ? NTOK : NLAT;
    LAS int* pstart = (LAS int*)lds; LAS int* cnt = pstart + 64;
    const unsigned* gcnt = (const unsigned*)(p->ws + WS_CTL) + CW_CNT + layer * 64;
    int* mt = (int*)(p->ws + WS_CONST) + CF_MOE + layer * 1024;
    if (tid == 0) { int acc = 0; for (int e = 0; e < NEXP; ++e) { const int c = (int)__hip_atomic_load(gcnt + e, __ATOMIC_RELAXED, __HIP_MEMORY_SCOPE_AGENT); cnt[e] = c; pstart[e] = acc; acc += (c + 255) & ~255; } pstart[NEXP] = acc; }
    __syncthreads();
    if (bid == 0) {
        if (tid < NEXP) { mt[tid] = pstart[tid]; mt[64 + tid] = cnt[tid]; }
        if (tid == 0) mt[32] = pstart[NEXP] >> 8;
        for (int e = 0; e < NEXP; ++e) { const int b0 = pstart[e] >> 8, b1 = pstart[e + 1] >> 8; for (int bb = b0 + tid; bb < b1; bb += NTHR) mt[128 + bb] = e; }
    }
    const int* tope = (const int*)(p->ws + WS_RT + RT_TOPE); const float* gate = (const float*)(p->ws + WS_RT + RT_GATE); const int* rank = (const int*)(p->ws + WS_RT + RT_RANK);
    int* slot = (int*)(p->ws + WS_RT + RT_SLOT); float* sgate = (float*)(p->ws + WS_RT + RT_SGATE); int* stok = (int*)(p->ws + WS_RT + RT_STOK);
    const int gt = bid * NTHR + tid, NGT = gdim * NTHR;
    for (int a = gt; a < T * 4; a += NGT) {
        const int e = tope[a]; const int s = pstart[e] + rank[a];
        slot[a] = s; sgate[s] = gate[a]; stok[s] = a >> 2;
    }
    for (int e = 0; e < NEXP; ++e) { const int s0 = pstart[e] + cnt[e], s1 = pstart[e + 1];
        for (int s = s0 + gt; s < s1; s += NGT) { stok[s] = 0; sgate[s] = 0.f; } }
}

__device__ __forceinline__ void phase_moe_combine(PP p, int layer, LAS unsigned char* lds) {
    int tid = threadIdx.x, bid = blockIdx.x, gdim = gridDim.x; asm volatile("" : "+v"(tid), "+s"(bid), "+s"(gdim)); const int lane = tid & 63, wave = __builtin_amdgcn_readfirstlane(tid >> 6);
    const int T = layer == 0 ? NTOK : NLAT;
    const float* cf = (const float*)(p->ws + WS_CONST); const int* slot = (const int*)(p->ws + WS_RT + RT_SLOT); const bf16_t* Y = (const bf16_t*)(p->ws + WS_Y);
    bf16_t* H = (bf16_t*)(p->ws + WS_H);
    LAS float* wab = (LAS float*)lds; float ea = 0.f, dtb = 0.f;
    if (layer == 0) { norm_mix_stage_wab(p, 1, wab, tid); __syncthreads(); if (lane < 8) { ea = -__expf(p->in[I_ALOG][8 + lane]); dtb = p->in[I_DTB][8 + lane]; } }
    for (int r = bid * NWAVES + wave; r < T; r += gdim * NWAVES) {
        const float* g5 = cf + CF_MODV + (layer * 3 + mod_sel(r)) * 6144 + 5 * 1024;
        bf16_t* hrow = H + (size_t)r * D;
        const int s0 = slot[r * 4], s1 = slot[r * 4 + 1], s2 = slot[r * 4 + 2], s3 = slot[r * 4 + 3];
        f32x4 hn[4];
#pragma unroll
        for (int j = 0; j < 4; ++j) { const int c = 4 * lane + 256 * j;
            const u32x2 a = *(const u32x2*)(Y + (size_t)s0 * D + c), b2 = *(const u32x2*)(Y + (size_t)s1 * D + c), c2 = *(const u32x2*)(Y + (size_t)s2 * D + c), d2 = *(const u32x2*)(Y + (size_t)s3 * D + c);
            f32x4 y; y[0] = (bflo(a.x) + bflo(b2.x)) + (bflo(c2.x) + bflo(d2.x)); y[1] = (bfhi(a.x) + bfhi(b2.x)) + (bfhi(c2.x) + bfhi(d2.x));
            y[2] = (bflo(a.y) + bflo(b2.y)) + (bflo(c2.y) + bflo(d2.y)); y[3] = (bfhi(a.y) + bfhi(b2.y)) + (bfhi(c2.y) + bfhi(d2.y));
            const u32x2 hw = *(const u32x2*)(hrow + c); const f32x4 hv = (f32x4){bflo(hw.x), bfhi(hw.x), bflo(hw.y), bfhi(hw.y)}, gv = *(const f32x4*)(g5 + c);
            hn[j] = hv + gv * y;
            if (layer == 0) { u32x2 w; w.x = cvt_pk_bf16(hn[j][0], hn[j][1]); w.y = cvt_pk_bf16(hn[j][2], hn[j][3]); *(u32x2*)(hrow + c) = w; }
            else *(f32x4*)(p->out + (size_t)r * D + c) = hn[j]; }
        if (layer == 0) norm_mix_row(p, 1, r, lane, hn, wab, ea, dtb);
    }
}

constexpr int NPH = 27;
#ifndef PH_MASK
#define PH_MASK 0xFFFF
#endif
#define IN(k) (lo <= (k) && (k) < hi)
#define EN(i) ((PH_MASK >> (i)) & 1)
#ifndef DUP_PH
#define DUP_PH -1
#endif
#define REP(i) for (int rep_ = 0; rep_ < ((DUP_PH == (i) && l == 0) ? 2 : 1); ++rep_)
#define SEAM(k) do { if (IN(k) && IN((k) + 1)) xcd_barrier(bar); } while (0)
#define LAUNDER() PP p = p0; LAS unsigned char* lds = lds0; int bid = blockIdx.x, gdim = gridDim.x; asm volatile("" : "+s"(p), "+s"(lds), "+s"(bid), "+s"(gdim))
template <int l> __device__ __forceinline__ void run_layer(PP p0, LAS unsigned char* lds0, const int lo, const int hi, const XcdBarrier& bar) {
        const int base = 1 + 13 * l;
        if (l == 0) { if (EN(1) && IN(base + 0)) REP(1) { LAUNDER(); phase_norm_mix(p, l, lds); __syncthreads(); }
            SEAM(base + 0); }
        if (EN(2) && IN(base + 1)) REP(2) { LAUNDER();
            PlainSched S; S.init(p->ws + WS_U, p->ws + WS_WIN + (size_t)l * PW * 1024 * 2, 1024, NTOK / 256, PW / 256, gdim, bid);
            EpiStoreBf16 E{(bf16_t*)(p->ws + WS_P), PW};
            pg8::gemm_phase<EpiStoreBf16, PlainSched>(lds, 1024, S, E);
        }
        SEAM(base + 1);
        if (EN(3) && IN(base + 2)) REP(3) { LAUNDER(); phase_prep(p, l); }
        SEAM(base + 2);
        if (EN(5) && IN(base + 3)) REP(5) { LAUNDER(); phase_gdn_chunk(p, lds); }
        SEAM(base + 3);
        if (EN(4) && IN(base + 4)) REP(4) { LAUNDER(); phase_attention(p, l, lds, rep_); }
        SEAM(base + 4);
        if (EN(7) && IN(base + 6)) REP(7) { LAUNDER(); phase_gdn_out(p, l); }
        SEAM(base + 6);
        if (EN(8) && IN(base + 7)) REP(8) { LAUNDER();
            const int T = l == 0 ? NTOK : NLAT;
            const float* cf = (const float*)(p->ws + WS_CONST);
            PlainSched S; S.init(p->ws + WS_MIX, p->ws + WS_WOUT + (size_t)l * D * 1024 * 2, 1024, T / 256, D / 256, gdim, bid);
            EpiResidual E{p, l, cf + CF_MODV + (l * 3) * 6144 + 2 * 1024};
            pg8::gemm_phase<EpiResidual, PlainSched>(lds, 1024, S, E);
        }
        SEAM(base + 7);
        if (EN(9) && IN(base + 8)) REP(9) { LAUNDER(); phase_norm_router(p, l, lds); __syncthreads(); }
        SEAM(base + 8);
        if (EN(10) && IN(base + 9)) REP(10) { LAUNDER(); phase_moe_gather(p, l, lds); __syncthreads(); }
        SEAM(base + 9);
        if (EN(11) && IN(base + 10)) REP(11) { LAUNDER();
            const int* mt = (const int*)(p->ws + WS_CONST) + CF_MOE + l * 1024;
            MoeSched S{(const char*)(p->ws + WS_U), (const char*)(p->ws + WS_WGU + (size_t)l * NEXP * 2048 * 1024 * 2), mt + 128, mt[32], 8, gdim, bid, (const int*)(p->ws + WS_RT + RT_STOK)};
            EpiGateUp E{(bf16_t*)(p->ws + WS_ACT), p->in[I_BGU] + (size_t)l * NEXP * 2048, mt + 128};
            pg8::gemm_phase<EpiGateUp, MoeSched, true>(lds, 1024, S, E);
        }
        SEAM(base + 10);
        if (EN(12) && IN(base + 11)) REP(12) { LAUNDER();
            const int* mt = (const int*)(p->ws + WS_CONST) + CF_MOE + l * 1024;
            MoeSched S{(const char*)(p->ws + WS_ACT), (const char*)(p->ws + WS_WD + (size_t)l * NEXP * 1024 * 1024 * 2), mt + 128, mt[32], 4, gdim, bid, nullptr};
            EpiDown E{(bf16_t*)(p->ws + WS_Y), p->in[I_BD] + (size_t)l * NEXP * 1024, mt + 128, (const float*)(p->ws + WS_RT + RT_SGATE)};
            pg8::gemm_phase<EpiDown, MoeSched>(lds, 1024, S, E);
        }
        SEAM(base + 11);
        if (EN(13) && IN(base + 12)) { LAUNDER(); phase_moe_combine(p, l, lds); __syncthreads(); }
        SEAM(base + 12);
    }

__global__ void __launch_bounds__(NTHR, 2) mega_fwd(Params p_by_value) {
    extern __shared__ __attribute__((aligned(16))) unsigned char lds_raw[];
    LAS unsigned char* lds0 = (LAS unsigned char*)lds_raw;
    PP p0 = (PP)__builtin_amdgcn_kernarg_segment_ptr();
    volatile LAS unsigned* MISC = (volatile LAS unsigned*)(lds0 + MISC_OFF);
    if (threadIdx.x < 64) MISC[threadIdx.x] = 0u;
    __syncthreads();
    const int lo = p0->ph_lo, hi = p0->ph_hi;
    XcdBarrier bar; bar.bar = (unsigned*)(p0->ws + WS_CTL) + CW_BAR; bar.x = 0; bar.st = nullptr;
    if (hi - lo > 1) bar = xcd_barrier_post((unsigned*)(p0->ws + WS_CTL) + CW_BAR, MISC + 8);
    if (EN(0) && IN(0)) for (int rep_ = 0; rep_ < (DUP_PH == 0 ? 2 : 1); ++rep_) { LAUNDER(); phase_prologue(p, lds); __syncthreads(); }
    SEAM(0);
    run_layer<0>(p0, lds0, lo, hi, bar);
    run_layer<1>(p0, lds0, lo, hi, bar);
#undef IN
#undef SEAM
}

extern "C" void kernel_launch(void* const* d_in, const int* in_sizes, int n_in, void* d_out, int out_size, void* d_ws, size_t ws_size, hipStream_t stream) {
    static int grid = 0;
    if (grid == 0) {
        if (n_in != 27 || out_size != NLAT * D || ws_size < WS_END) { fprintf(stderr, "kernel_launch: unexpected problem (n_in %d, out %d, ws %zu < %zu)\n", n_in, out_size, ws_size, (size_t)WS_END); grid = -1; return; }
        int dev = 0, cus = 0, per_cu = 0;
        if (hipGetDevice(&dev) != hipSuccess || hipDeviceGetAttribute(&cus, hipDeviceAttributeMultiprocessorCount, dev) != hipSuccess) { grid = -1; return; }
        if (hipFuncSetAttribute((const void*)mega_fwd, hipFuncAttributeMaxDynamicSharedMemorySize, LDS_BYTES) != hipSuccess) { fprintf(stderr, "kernel_launch: hipFuncSetAttribute failed\n"); grid = -1; return; }
        if (hipOccupancyMaxActiveBlocksPerMultiprocessor(&per_cu, (const void*)mega_fwd, NTHR, LDS_BYTES) != hipSuccess || per_cu < 1) { fprintf(stderr, "kernel_launch: occupancy query says %d\n", per_cu); }
        (void)hipGetLastError();
        grid = cus;
    }
    if (grid < 0) return;
    hipMemsetAsync((char*)d_ws + WS_CTL, 0, CTL_ZERO_BYTES, stream);
    Params p{};
    for (int i = 0; i < 27; ++i) p.in[i] = (const float*)d_in[i];
    p.out = (float*)d_out; p.ws = (unsigned char*)d_ws;
#if MK_PER_PHASE
    for (int ph = 0; ph < NPH; ++ph) { p.ph_lo = ph; p.ph_hi = ph + 1; hipLaunchKernelGGL(mega_fwd, dim3(grid), dim3(NTHR), LDS_BYTES, stream, p); }
#else
    p.ph_lo = 0; p.ph_hi = NPH;
    hipLaunchKernelGGL(mega_fwd, dim3(grid), dim3(NTHR), LDS_BYTES, stream, p);
#endif
}
```

```cpp
#include <hip/hip_runtime.h>
#include <cstdio>
#include <cstdint>

#ifndef MK_PER_PHASE
#define MK_PER_PHASE 0
#endif

#define LAS __attribute__((address_space(3)))
#define GAS __attribute__((address_space(1)))
typedef unsigned short bf16_t;
typedef short bf16x8 __attribute__((ext_vector_type(8)));
typedef short s16x4 __attribute__((ext_vector_type(4)));
typedef float f32x2 __attribute__((ext_vector_type(2)));
typedef float f32x4 __attribute__((ext_vector_type(4)));
typedef float f32x16 __attribute__((ext_vector_type(16)));
typedef unsigned u32x2 __attribute__((ext_vector_type(2)));
typedef unsigned u32x4 __attribute__((ext_vector_type(4)));

constexpr int D = 1024, NB = 2, SEQL = 16384, CTXL = 256;
constexpr int NLAT = NB * SEQL, NCTX = NB * CTXL, NTOK = NLAT + NCTX;
constexpr int PW = 3584, INC = 3600;
constexpr int NEXP = 32, MAXBLK = 552, MAXSLOT = MAXBLK * 256;
constexpr int NCHUNK = 260, NTASK = 16 * NCHUNK;
constexpr float EPS = 1e-6f;
constexpr float LOG2E = 1.4426950408889634f;
constexpr int NWAVES = 8, NTHR = 512;

constexpr size_t MiB = 1u << 20;
constexpr size_t WS_CTL = 0, CTL_ZERO_BYTES = 1 * MiB;
constexpr size_t WS_CONST = 1 * MiB;
constexpr size_t WS_WIN = 2 * MiB;
constexpr size_t WS_WOUT = 16 * MiB;
constexpr size_t WS_WGU = 20 * MiB;
constexpr size_t WS_WD = 276 * MiB;
constexpr size_t WS_H = 404 * MiB;
constexpr size_t WS_U = 534 * MiB;
constexpr size_t WS_GB = 599 * MiB;
constexpr size_t WS_MIX = 602 * MiB;
constexpr size_t WS_RT = 667 * MiB;
constexpr size_t WS_BIG = 671 * MiB;
constexpr size_t WS_P = WS_BIG;
constexpr size_t WS_G = WS_P + 228 * MiB;
constexpr size_t WS_CH = WS_G + 98 * MiB;
constexpr size_t WS_OG = WS_CH + 358 * MiB;
constexpr size_t WS_OA = WS_OG + 130 * MiB;
constexpr size_t WS_LA = WS_OA + 260 * MiB;
constexpr size_t WS_END = WS_LA + 5 * MiB;
constexpr size_t WS_XS = WS_BIG;
constexpr size_t WS_ACT = WS_BIG + 276 * MiB;
constexpr size_t WS_Y = WS_XS;
static_assert(WS_ACT + 276 * MiB <= WS_END, "moe overlay");
constexpr size_t CH_TASK_BYTES = 90112;
constexpr int CH_WF = 0, CH_QF = 16384, CH_AF = 32768, CH_KF = 40960, CH_UC = 57344, CH_DMA_BYTES = 57344;
static_assert((size_t)NTASK * CH_TASK_BYTES <= 358 * MiB, "chunk buffers");

constexpr int CW_BAR = 4096;
constexpr int CW_CNT = 16384;
constexpr int CW_ATTQ = 20480;
constexpr int CF_MODV = 0;
constexpr int CF_ROPE = 40960;
constexpr int CF_SC = 53248;
constexpr int CF_EGL = 53504;
constexpr int CF_MOE = 61440;
constexpr size_t RT_TOPE = 0, RT_GATE = 640 * 1024, RT_RANK = 1280 * 1024, RT_SLOT = 1920 * 1024, RT_SGATE = 2560 * 1024, RT_STOK = 3200 * 1024;

constexpr int LDS_BYTES = 147456;
constexpr int MISC_OFF = 143 * 1024;
static_assert(MISC_OFF + 256 <= LDS_BYTES, "lds");

__device__ __forceinline__ unsigned f2bf(float f) { unsigned u = __builtin_bit_cast(unsigned, f); return (u + 0x7fffu + ((u >> 16) & 1u)) >> 16; }
__device__ __forceinline__ unsigned pk2(float lo, float hi) { return f2bf(lo) | (f2bf(hi) << 16); }
__device__ __forceinline__ float bf2f(unsigned short b) { return __builtin_bit_cast(float, (unsigned)b << 16); }
__device__ __forceinline__ float bflo(unsigned w) { return __builtin_bit_cast(float, w << 16); }
__device__ __forceinline__ float bfhi(unsigned w) { return __builtin_bit_cast(float, w & 0xffff0000u); }
__device__ __forceinline__ unsigned cvt_pk_bf16(float lo, float hi) { unsigned r; asm volatile("v_cvt_pk_bf16_f32 %0, %1, %2" : "=v"(r) : "v"(lo), "v"(hi)); return r; }
typedef float f32x2c_t __attribute__((ext_vector_type(2)));
typedef __bf16 bf16x2c_t __attribute__((ext_vector_type(2)));
__device__ __forceinline__ unsigned cvt_pk_bf16_c(float lo, float hi) { const f32x2c_t v = {lo, hi}; const bf16x2c_t b = __builtin_convertvector(v, bf16x2c_t); return __builtin_bit_cast(unsigned, b); }
__device__ __forceinline__ float wave_sum(float v) {
#pragma unroll
    for (int o = 1; o < 64; o <<= 1) v += __shfl_xor(v, o);
    return v;
}
__device__ __forceinline__ float wave_max(float v) {
#pragma unroll
    for (int o = 1; o < 64; o <<= 1) v = fmaxf(v, __shfl_xor(v, o));
    return v;
}
__device__ __forceinline__ float silu_f(float x) { return x / (1.f + __expf(-x)); }
__device__ __forceinline__ int crow(int r, int hi) { return (r & 3) + 8 * (r >> 2) + 4 * hi; }
__device__ __forceinline__ void glds16(const void* g, unsigned lds_base) {
    unsigned sv; asm volatile("s_mov_b32 %0, m0\n\ts_mov_b32 m0, %2\n\ts_nop 0\n\tglobal_load_lds_dwordx4 %1, off\n\ts_mov_b32 m0, %0" : "=&s"(sv) : "v"(g), "s"((unsigned)__builtin_amdgcn_readfirstlane((int)lds_base)) : "memory"); }
__device__ __forceinline__ unsigned lds_addr(const LAS void* q) { return (unsigned)__builtin_amdgcn_readfirstlane((int)(unsigned)(uintptr_t)q); }
#define LDS_WAIT() asm volatile("s_waitcnt lgkmcnt(0)" ::: "memory")
#define VM_WAIT() asm volatile("s_waitcnt vmcnt(0)" ::: "memory")
#define MFMA32(a, b, c) __builtin_amdgcn_mfma_f32_32x32x16_bf16(a, b, c, 0, 0, 0)

namespace pg8 {
constexpr int BM = 256, BK = 64, HALF = 128, HTB = HALF * BK * 2, STAGE_BYTES = 8 * HTB;
__host__ __device__ __forceinline__ int lds_byte(int r, int c) { const int st = (r >> 4) * 2 + (c >> 5), rr = r & 15, cc = c & 31, ob = rr * 64 + cc * 2; return st * 1024 + (ob ^ (((ob >> 9) & 1) << 5)); }
__host__ __device__ __forceinline__ void stage_rc(int b, int& R, int& C) { const int st = b / 1024, sb = b % 1024, swz = sb ^ (((sb >> 9) & 1) << 5); R = (st >> 1) * 16 + swz / 64; C = (st & 1) * 32 + (swz % 64) / 2; }
__host__ __device__ __forceinline__ int perm32(int rho) { const int n = rho >> 4, i = rho & 15; return 8 * (i >> 2) + 4 * n + (i & 3); }
struct Unit { int pm, pn; };
template <class Epi, class Sched, bool GA = false>
__device__ __forceinline__ void gemm_phase(LAS unsigned char* lds, const int K, const Sched& S, const Epi& E) {
    int tid = threadIdx.x, bid = blockIdx.x, gdim = gridDim.x; asm volatile("" : "+v"(tid), "+s"(bid), "+s"(gdim)); const int wid = __builtin_amdgcn_readfirstlane(tid >> 6), lane = tid & 63, wr = wid >> 2, wc = wid & 3, fr = lane & 15, fq = lane >> 4;
    const int nt = K / BK;
    unsigned voffA[2], voffB[2], colA2[2]; int rowA[2];
    unsigned vAc[2][2], vAn[2][2], vAnn[2][2];
#pragma unroll
    for (int i = 0; i < 2; ++i) { int R, C; stage_rc(tid * 16 + i * 8192, R, C); const int Rb = Epi::PERM ? ((R & ~31) + perm32(R & 31)) : R;
        voffA[i] = (unsigned)(R * K + C) * 2u; voffB[i] = (unsigned)(Rb * K + C) * 2u; rowA[i] = R; colA2[i] = (unsigned)C * 2u; }
    const size_t kstep = (size_t)(BK * 2);
    const size_t hstep = (size_t)HALF * K * 2;
    const unsigned ldsw = (unsigned)wid * 1024u;
    const int aoff = lds_byte(wr * 64 + fr, fq * 8), boff = lds_byte(wc * 32 + fr, fq * 8);
#define PG8_SA(b, h) (((b) * 2 + (h)) * HTB)
#define PG8_SB(b, h) ((4 + (b) * 2 + (h)) * HTB)
#define PG8_STAGE(bufoff, gbase, voff) do { _Pragma("unroll") for (int _i = 0; _i < 2; ++_i) \
        __builtin_amdgcn_global_load_lds((const unsigned*)((const char*)(gbase) + (voff)[_i]), (LAS unsigned*)(lds + (bufoff) + ldsw + _i * 8192), 16, 0, 0); } while (0)
#define PG8_TOK(v, u) do { if constexpr (GA) { const int* tk_ = S.atok(u); _Pragma("unroll") for (int h_ = 0; h_ < 2; ++h_) _Pragma("unroll") for (int i_ = 0; i_ < 2; ++i_) v[h_][i_] = (unsigned)tk_[rowA[i_] + 128 * h_] * (unsigned)(K * 2) + colA2[i_]; } } while (0)
#define PG8_STAGE_A(bufoff, gptr, koff, half, nx) do { if constexpr (GA) { const char* gb_ = S.abase() + (koff); _Pragma("unroll") for (int _i = 0; _i < 2; ++_i) { const unsigned vo_ = (nx) ? vAn[half][_i] : vAc[half][_i]; \
        __builtin_amdgcn_global_load_lds((const unsigned*)(gb_ + vo_), (LAS unsigned*)(lds + (bufoff) + ldsw + _i * 8192), 16, 0, 0); } } else { PG8_STAGE(bufoff, (gptr) + (half) * hstep, voffA); } } while (0)
#define PG8_LDA(dst, b, h) do { _Pragma("unroll") for (int m = 0; m < 4; ++m) _Pragma("unroll") for (int k = 0; k < 2; ++k) dst[m][k] = *(const LAS bf16x8*)(lds + PG8_SA(b, h) + aoff + m * 2048 + k * 1024); } while (0)
#define PG8_LDB(dst, b, h) do { _Pragma("unroll") for (int n = 0; n < 2; ++n) _Pragma("unroll") for (int k = 0; k < 2; ++k) dst[n][k] = *(const LAS bf16x8*)(lds + PG8_SB(b, h) + boff + n * 2048 + k * 1024); } while (0)
#define PG8_MMA(ai, bj, At, Bt) do { __builtin_amdgcn_s_setprio(1); _Pragma("unroll") for (int m = 0; m < 4; ++m) _Pragma("unroll") for (int n = 0; n < 2; ++n) _Pragma("unroll") for (int k = 0; k < 2; ++k) \
        acc[ai][bj][m][n] = __builtin_amdgcn_mfma_f32_16x16x32_bf16(Bt[n][k], At[m][k], acc[ai][bj][m][n], 0, 0, 0); __builtin_amdgcn_s_setprio(0); } while (0)
#define PG8_WAIT_V(n) asm volatile("s_waitcnt vmcnt(" #n ")" ::: "memory")
#define PG8_WAIT_L(n) asm volatile("s_waitcnt lgkmcnt(" #n ")" ::: "memory")
#define PG8_BAR __builtin_amdgcn_s_barrier()
#define PG8_SCHED __builtin_amdgcn_sched_barrier(0)
    Unit cur, nxt; int ui = 0;
    if (!S.next(0, cur)) return;
    f32x4 acc[2][2][4][2];
#pragma unroll
    for (int a = 0; a < 2; ++a)
#pragma unroll
        for (int b = 0; b < 2; ++b)
#pragma unroll
            for (int m = 0; m < 4; ++m)
#pragma unroll
                for (int n = 0; n < 2; ++n) acc[a][b][m][n] = (f32x4){0.f, 0.f, 0.f, 0.f};
    bf16x8 At[4][2], B0[2][2], B1[2][2];
    const char* cA = S.aptr(cur); const char* cB = S.bptr(cur);
    PG8_TOK(vAc, cur);
    if constexpr (GA) { Unit u1_; if (S.next(1, u1_)) { PG8_TOK(vAn, u1_); } else { _Pragma("unroll") for (int h_ = 0; h_ < 2; ++h_) _Pragma("unroll") for (int i_ = 0; i_ < 2; ++i_) vAn[h_][i_] = vAc[h_][i_]; } }
    PG8_STAGE(PG8_SB(0, 0), cB, voffB); PG8_STAGE_A(PG8_SA(0, 0), cA, 0, 0, false); PG8_STAGE(PG8_SB(0, 1), cB + hstep, voffB); PG8_STAGE_A(PG8_SA(0, 1), cA, 0, 1, false);
    if (wr == 1) PG8_BAR;
    PG8_WAIT_V(4); PG8_BAR;
    PG8_STAGE(PG8_SB(1, 0), cB + kstep, voffB); PG8_STAGE_A(PG8_SA(1, 0), cA + kstep, kstep, 0, false); PG8_STAGE(PG8_SB(1, 1), cB + hstep + kstep, voffB);
    PG8_WAIT_V(6); PG8_BAR;
    for (;;) {
        const bool has_next = S.next(ui + 1, nxt);
        const char* nA = has_next ? S.aptr(nxt) : cA; const char* nB = has_next ? S.bptr(nxt) : cB;
        for (int t = 0; t < nt; t += 2) {
            const bool last = (t == nt - 2);
            const char* a1 = cA + (size_t)(t + 1) * kstep;
            const char* a2 = last ? nA : cA + (size_t)(t + 2) * kstep; const char* b2 = last ? nB : cB + (size_t)(t + 2) * kstep;
            const char* a3 = a2 + kstep; const char* b3 = b2 + kstep;
            const size_t k1 = (size_t)(t + 1) * kstep, k2 = last ? 0 : (size_t)(t + 2) * kstep, k3 = k2 + kstep;
            PG8_LDB(B0, 0, 0); PG8_SCHED; PG8_LDA(At, 0, 0); PG8_STAGE_A(PG8_SA(1, 1), a1, k1, 1, false);
            PG8_WAIT_L(8); PG8_BAR; PG8_WAIT_L(0); PG8_MMA(0, 0, At, B0); PG8_BAR; PG8_SCHED;
            PG8_LDB(B1, 0, 1); PG8_STAGE(PG8_SB(0, 0), b2, voffB);
            PG8_BAR; PG8_WAIT_L(0); PG8_MMA(0, 1, At, B1); PG8_BAR;
            PG8_LDA(At, 0, 1); PG8_STAGE_A(PG8_SA(0, 0), a2, k2, 0, last);
            PG8_BAR; PG8_WAIT_L(0); PG8_MMA(1, 0, At, B0); PG8_BAR; PG8_SCHED;
            PG8_STAGE(PG8_SB(0, 1), b2 + hstep, voffB);
            PG8_WAIT_V(6); PG8_BAR; PG8_MMA(1, 1, At, B1); PG8_BAR;
            PG8_LDB(B0, 1, 0); PG8_SCHED; PG8_LDA(At, 1, 0); PG8_STAGE_A(PG8_SA(0, 1), a2, k2, 1, last);
            PG8_WAIT_L(8); PG8_BAR; PG8_WAIT_L(0); PG8_MMA(0, 0, At, B0); PG8_BAR; PG8_SCHED;
            PG8_LDB(B1, 1, 1); PG8_STAGE(PG8_SB(1, 0), b3, voffB);
            PG8_BAR; PG8_WAIT_L(0); PG8_MMA(0, 1, At, B1); PG8_BAR;
            PG8_LDA(At, 1, 1); PG8_STAGE_A(PG8_SA(1, 0), a3, k3, 0, last);
            PG8_BAR; PG8_WAIT_L(0); PG8_MMA(1, 0, At, B0); PG8_BAR; PG8_SCHED;
            PG8_STAGE(PG8_SB(1, 1), b3 + hstep, voffB);
            PG8_WAIT_V(6); PG8_BAR; PG8_MMA(1, 1, At, B1); PG8_BAR;
        }
        E(acc, cur, wr, wc, fr, fq);
        if (!has_next) break;
        if constexpr (GA) { Unit u2_; if (S.next(ui + 2, u2_)) { PG8_TOK(vAnn, u2_); } else { _Pragma("unroll") for (int h_ = 0; h_ < 2; ++h_) _Pragma("unroll") for (int i_ = 0; i_ < 2; ++i_) vAnn[h_][i_] = vAn[h_][i_]; } }
#pragma unroll
        for (int a = 0; a < 2; ++a)
#pragma unroll
            for (int b = 0; b < 2; ++b)
#pragma unroll
                for (int m = 0; m < 4; ++m)
#pragma unroll
                    for (int n = 0; n < 2; ++n) acc[a][b][m][n] = (f32x4){0.f, 0.f, 0.f, 0.f};
        cur = nxt; cA = nA; cB = nB; ++ui;
        if constexpr (GA) { _Pragma("unroll") for (int h_ = 0; h_ < 2; ++h_) _Pragma("unroll") for (int i_ = 0; i_ < 2; ++i_) { vAc[h_][i_] = vAn[h_][i_]; vAn[h_][i_] = vAnn[h_][i_]; } }
    }
    PG8_WAIT_V(0);
    if (wr == 0) PG8_BAR;
    PG8_BAR;
#undef PG8_SA
#undef PG8_SB
#undef PG8_STAGE
#undef PG8_STAGE_A
#undef PG8_TOK
#undef PG8_LDA
#undef PG8_LDB
#undef PG8_MMA
#undef PG8_WAIT_V
#undef PG8_WAIT_L
#undef PG8_BAR
#undef PG8_SCHED
}
}

#define XB_TMO      128
#define XB_XCNT(j)  (256  + 64 * (j))
#define XB_XSUB(j)  (1280 + 64 * (j))
#define XB_XGEN(j)  (2304 + 64 * (j))
#define XB_TOP      3328
#define XB_TOPGEN   3392
#define XCD_BAR_WORDS 3456
#define XB_SPIN_CAP (1u << 20)
__device__ __forceinline__ unsigned xb_ld(unsigned* p)              { return __hip_atomic_load(p, __ATOMIC_RELAXED, __HIP_MEMORY_SCOPE_AGENT); }
__device__ __forceinline__ unsigned xb_add(unsigned* p, unsigned v) { return __hip_atomic_fetch_add(p, v, __ATOMIC_RELAXED, __HIP_MEMORY_SCOPE_AGENT); }
__device__ __forceinline__ unsigned xb_xcc_id() { return (unsigned)__builtin_amdgcn_s_getreg((3 << 11) | 20) & 0xFu; }
#define XB_SPIN(cond, bar) do { unsigned _sp = 0; while (cond) { __builtin_amdgcn_s_sleep(1); \
    if ((++_sp & 255u) == 0u) { if (xb_ld(&(bar)[XB_TMO])) break; if (_sp > XB_SPIN_CAP) { atomicAdd(&(bar)[XB_TMO], 1u); break; } } } } while (0)
struct XcdBarrier { unsigned* bar; unsigned x; volatile LAS unsigned* st; };
__device__ __forceinline__ XcdBarrier xcd_barrier_post(unsigned* bar, volatile LAS unsigned* st) {
    XcdBarrier b; b.bar = bar; b.x = xb_xcc_id(); b.st = st;
    if (threadIdx.x == 0) (void)xb_add(&bar[XB_XCNT(b.x)], 1u);
    return b;
}
__device__ __forceinline__ void xcd_barrier_complete(unsigned* bar, unsigned x, unsigned& nloc, unsigned& nx) {
    const unsigned G = gridDim.x * gridDim.y * gridDim.z;
    unsigned sum, cnt, mine, sp = 0u;
    for (;;) {
        sum = 0u; cnt = 0u; mine = 0u;
#pragma unroll
        for (unsigned j = 0; j < 16; ++j) { const unsigned c = xb_ld(&bar[XB_XCNT(j)]); sum += c; cnt += (c > 0u) ? 1u : 0u; mine = (j == x) ? c : mine; }
        if (sum == G) break;
        __builtin_amdgcn_s_sleep(1);
        if ((++sp & 255u) == 0u) { if (xb_ld(&bar[XB_TMO])) break; if (sp > XB_SPIN_CAP) { atomicAdd(&bar[XB_TMO], 1u); break; } }
    }
    nloc = mine > 0u ? mine : 1u; nx = cnt > 0u ? cnt : 1u;
}
__device__ __forceinline__ void xcd_barrier(const XcdBarrier& b) {
    asm volatile("s_waitcnt vmcnt(0)" ::: "memory");
    __syncthreads();
    if (threadIdx.x == 0) {
        unsigned* bar = b.bar;
        __builtin_amdgcn_s_waitcnt(0);
        unsigned nloc = b.st[0], nx = b.st[1];
        if (nloc == 0u) { xcd_barrier_complete(bar, b.x, nloc, nx); b.st[0] = nloc; b.st[1] = nx; }
        const unsigned old = xb_add(&bar[XB_XSUB(b.x)], 1u);
        const unsigned gen = old / nloc;
        if (old + 1u == (gen + 1u) * nloc) {
            __builtin_amdgcn_fence(__ATOMIC_RELEASE, "agent");
            asm volatile("s_waitcnt vmcnt(0)" ::: "memory");
            const unsigned og = xb_add(&bar[XB_TOP], 1u);
            const unsigned tg = og / nx;
            if (og + 1u == (tg + 1u) * nx) xb_add(&bar[XB_TOPGEN], 1u);
            else XB_SPIN(xb_ld(&bar[XB_TOPGEN]) == tg, bar);
            __builtin_amdgcn_fence(__ATOMIC_ACQUIRE, "agent");
            xb_add(&bar[XB_XGEN(b.x)], 1u);
            asm volatile("s_waitcnt vmcnt(0)" ::: "memory");
        } else {
            XB_SPIN(xb_ld(&bar[XB_XGEN(b.x)]) == gen, bar);
            __builtin_amdgcn_fence(__ATOMIC_ACQUIRE, "agent");
            asm volatile("s_waitcnt vmcnt(0)" ::: "memory");
        }
    }
    __syncthreads();
}

struct Params {
    const float* in[27];
    float* out;
    unsigned char* ws;
    int ph_lo, ph_hi;
};
typedef const __attribute__((address_space(4))) Params* PP;
enum { I_X = 0, I_C, I_CTX, I_CCTX, I_WMOD, I_BMOD, I_NMIXG, I_WIN, I_QNG, I_KNG, I_LQ1, I_LK1, I_LQ2, I_LK2, I_SUBLN, I_CONVW, I_ALOG, I_DTB, I_GDNG, I_WOUT, I_NFFNG, I_RW, I_RB, I_WGU, I_BGU, I_WD, I_BD };

__device__ __forceinline__ const float* hrow_in(PP p, int layer, int r) {
    (void)layer; return r < NLAT ? p->in[I_X] + (size_t)r * D : p->in[I_CTX] + (size_t)(r - NLAT) * D;
}
__device__ __forceinline__ int mod_sel(int r) { return r < NLAT ? (r >= SEQL ? 1 : 0) : 2; }

__device__ __forceinline__ void transpose_item(const float* W, size_t ldw, int k0, int n0, bf16_t* WT, int drow0, LAS float* scr, int lane) {
#pragma unroll 8
    for (int i = 0; i < 32; ++i) { const int kk = 2 * i + (lane >> 5); scr[kk * 33 + (lane & 31)] = W[(size_t)(k0 + kk) * ldw + n0 + (lane & 31)]; }
    LDS_WAIT(); asm volatile("" ::: "memory");
    const int c = lane & 7;
#pragma unroll
    for (int j = 0; j < 4; ++j) { const int n = (lane >> 3) + 8 * j; const LAS float* s = scr + (8 * c) * 33 + n;
        u32x4 o; o.x = pk2(s[0 * 33], s[1 * 33]); o.y = pk2(s[2 * 33], s[3 * 33]); o.z = pk2(s[4 * 33], s[5 * 33]); o.w = pk2(s[6 * 33], s[7 * 33]);
        *(u32x4*)(WT + (size_t)(drow0 + n) * 1024 + k0 + 8 * c) = o; }
    LDS_WAIT(); asm volatile("" ::: "memory");
}

__device__ __forceinline__ void phase_prologue(PP p, LAS unsigned char* lds) {
    int tid = threadIdx.x, bid = blockIdx.x, gdim = gridDim.x; asm volatile("" : "+v"(tid), "+s"(bid), "+s"(gdim)); const int lane = tid & 63, wave = __builtin_amdgcn_readfirstlane(tid >> 6);
    float* cf = (float*)(p->ws + WS_CONST);
    if (bid < 192) {
        const int l = bid / 96, cg = bid % 96;
        LAS float* sl = (LAS float*)lds;
        LAS float* red = sl + 3 * 1024;
        for (int i = tid; i < 3 * 1024; i += NTHR) { const int s = i >> 10, k = i & 1023; const float v = s < 2 ? p->in[I_C][s * D + k] : p->in[I_CCTX][k]; sl[i] = silu_f(v); }
        __syncthreads();
        const float* wm = p->in[I_WMOD] + (size_t)l * D * 6144 + cg * 64 + lane;
        float a0 = 0.f, a1 = 0.f, a2 = 0.f;
#pragma unroll 16
        for (int kk = 0; kk < 128; ++kk) { const int k = wave * 128 + kk; const float w = wm[(size_t)k * 6144]; a0 += sl[k] * w; a1 += sl[1024 + k] * w; a2 += sl[2048 + k] * w; }
        red[(wave * 3 + 0) * 64 + lane] = a0; red[(wave * 3 + 1) * 64 + lane] = a1; red[(wave * 3 + 2) * 64 + lane] = a2;
        __syncthreads();
        if (wave < 3) { float s = 0.f;
#pragma unroll
            for (int w = 0; w < 8; ++w) s += red[(w * 3 + wave) * 64 + lane];
            cf[CF_MODV + (l * 3 + wave) * 6144 + cg * 64 + lane] = s + p->in[I_BMOD][l * 6144 + cg * 64 + lane]; }
        __syncthreads();
    }
    if (bid >= 192 && bid < 202) {
        const int idx = (bid - 192) * NTHR + tid;
        if (idx < 320 * 16) { const int pos = idx >> 4, i = idx & 15; const float invf = powf(10000.f, -(float)i / 16.f);
            const float posf = (float)(pos < 256 ? pos : pos - 256); const float ang = posf * invf; const double a = (double)ang;
            const float cs = (float)cos(a), sn = (float)sin(a);
            if (pos < 256) { cf[CF_ROPE + pos * 16 + i] = cs; cf[CF_ROPE + 4096 + pos * 16 + i] = sn; }
            else { cf[CF_ROPE + 8192 + (pos - 256) * 16 + i] = cs; cf[CF_ROPE + 9216 + (pos - 256) * 16 + i] = sn; } }
    }
    if (bid == 202 && wave < 2) {
        const int l = wave;
        const float d1 = wave_sum(p->in[I_LQ1][l * 64 + lane] * p->in[I_LK1][l * 64 + lane]);
        const float d2 = wave_sum(p->in[I_LQ2][l * 64 + lane] * p->in[I_LK2][l * 64 + lane]);
        const float lam_init = 0.8f - 0.6f * expf(-0.3f * (float)l);
        const float mq = wave_max(fabsf(p->in[I_QNG][l * 64 + lane])), mk = wave_max(fabsf(p->in[I_KNG][l * 64 + lane]));
        if (lane == 0) { cf[CF_SC + l * 16 + 0] = expf(d1) - expf(d2) + lam_init; cf[CF_SC + l * 16 + 1] = LOG2E * 0.125f * 64.f * mq * mk * 1.0001f + 0.01f; cf[CF_SC + l * 16 + 2] = 1.f - lam_init; }
    }
    {
        LAS float* scr = (LAS float*)(lds + wave * 16384);
        const int gw = bid * NWAVES + wave, NGW = gdim * NWAVES;
        constexpr int I_IN = 16 * 112, I_OUT = 16 * 32, I_GU = 16 * 64, I_DN = 16 * 32;
        constexpr int PER_LAYER = I_IN + I_OUT + NEXP * I_GU + NEXP * I_DN;
        for (int it = gw; it < 2 * PER_LAYER; it += NGW) {
            const int l = it / PER_LAYER; int r = it % PER_LAYER;
            if (r < I_IN) { const int kb = r / 112, nb = r % 112;
                transpose_item(p->in[I_WIN] + (size_t)l * D * INC, INC, kb * 64, nb * 32, (bf16_t*)(p->ws + WS_WIN) + (size_t)l * PW * 1024, nb * 32, scr, lane); continue; }
            r -= I_IN;
            if (r < I_OUT) { const int kb = r / 32, nb = r % 32;
                transpose_item(p->in[I_WOUT] + (size_t)l * D * D, D, kb * 64, nb * 32, (bf16_t*)(p->ws + WS_WOUT) + (size_t)l * D * 1024, nb * 32, scr, lane); continue; }
            r -= I_OUT;
            if (r < NEXP * I_GU) { const int e = r / I_GU, q = r % I_GU, kb = q / 64, nb = q % 64; const int n0 = nb * 32, j = n0 & 1023, isup = n0 >> 10;
                const int drow = (j >> 7) * 256 + isup * 128 + (j & 127);
                transpose_item(p->in[I_WGU] + (size_t)(l * NEXP + e) * D * 2048, 2048, kb * 64, n0, (bf16_t*)(p->ws + WS_WGU) + (size_t)(l * NEXP + e) * 2048 * 1024, drow, scr, lane); continue; }
            r -= NEXP * I_GU;
            { const int e = r / I_DN, q = r % I_DN, kb = q / 32, nb = q % 32;
                transpose_item(p->in[I_WD] + (size_t)(l * NEXP + e) * D * D, D, kb * 64, nb * 32, (bf16_t*)(p->ws + WS_WD) + (size_t)(l * NEXP + e) * D * 1024, nb * 32, scr, lane); }
        }
    }
}

struct PlainSched {
    const char* A; const char* Bt; int K, nM, nN, nwg, G, c;
    __device__ __forceinline__ void init(const void* A_, const void* Bt_, int K_, int nM_, int nN_, int G_, int c_) { A = (const char*)A_; Bt = (const char*)Bt_; K = K_; nM = nM_; nN = nN_; nwg = nM * nN; G = G_; c = c_; }
    __device__ __forceinline__ bool next(int i, pg8::Unit& u) const {
        const long L = (long)i * G + c; if (L >= nwg) return false;
        int wgid = (int)L; { const int q = nwg / 8, r = nwg % 8, xcd = wgid % 8, off = wgid / 8; wgid = (xcd < r ? xcd * (q + 1) : r * (q + 1) + (xcd - r) * q) + off; }
        const int nig = 8 * nN, gid = wgid / nig, fm = gid * 8, gsz = (nM - fm) < 8 ? (nM - fm) : 8;
        u.pm = fm + ((wgid % nig) % gsz); u.pn = (wgid % nig) / gsz; return true;
    }
    __device__ __forceinline__ const char* aptr(const pg8::Unit& u) const { return A + (size_t)u.pm * 256 * K * 2; }
    __device__ __forceinline__ const char* bptr(const pg8::Unit& u) const { return Bt + (size_t)u.pn * 256 * K * 2; }
};
struct MoeSched {
    const char* A; const char* W; const int* blk_e; int nblk, nN, G, c;
    __device__ __forceinline__ bool next(int i, pg8::Unit& u) const {
        const int x = c & 7, w = c >> 3, nw = G >> 3;
        const int b0 = (int)(((long)nblk * x) >> 3), b1 = (int)(((long)nblk * (x + 1)) >> 3);
        const int j = i * nw + w, pm = b0 + j / nN; if (pm >= b1) return false;
        u.pm = pm; u.pn = j % nN; return true;
    }
    const int* tok;
    __device__ __forceinline__ const char* aptr(const pg8::Unit& u) const { return A + (size_t)u.pm * 256 * 1024 * 2; }
    __device__ __forceinline__ const char* abase() const { return A; }
    __device__ __forceinline__ const int* atok(const pg8::Unit& u) const { return tok + u.pm * 256; }
    __device__ __forceinline__ const char* bptr(const pg8::Unit& u) const { const int e = ((const __attribute__((address_space(4))) int*)blk_e)[u.pm];
        return W + ((size_t)e * nN + u.pn) * 256 * 1024 * 2; }
};
struct EpiStoreBf16 {
    static constexpr bool PERM = true;
    bf16_t* O; int ldc;
    __device__ __forceinline__ void operator()(const f32x4 (&acc)[2][2][4][2], const pg8::Unit& u, int wr, int wc, int fr, int fq) const {
        const int row0 = u.pm * 256 + wr * 64 + fr, col0 = u.pn * 256 + wc * 32 + 8 * fq;
#pragma unroll
        for (int ai = 0; ai < 2; ++ai)
#pragma unroll
            for (int m = 0; m < 4; ++m) { bf16_t* rowp = O + (size_t)(row0 + ai * 128 + m * 16) * ldc + col0;
#pragma unroll
                for (int bj = 0; bj < 2; ++bj) { const f32x4 v0 = acc[ai][bj][m][0], v1 = acc[ai][bj][m][1];
                    u32x4 w; w.x = cvt_pk_bf16(v0[0], v0[1]); w.y = cvt_pk_bf16(v0[2], v0[3]); w.z = cvt_pk_bf16(v1[0], v1[1]); w.w = cvt_pk_bf16(v1[2], v1[3]);
                    *(u32x4*)(rowp + bj * 128) = w; } }
    }
};
struct EpiResidual {
    static constexpr bool PERM = true;
    PP p; int layer; const float* gate;
    __device__ __forceinline__ void operator()(const f32x4 (&acc)[2][2][4][2], const pg8::Unit& u, int wr, int wc, int fr, int fq) const {
        const int row0 = u.pm * 256 + wr * 64 + fr, col0 = u.pn * 256 + wc * 32 + 8 * fq;
        bf16_t* H = (bf16_t*)(p->ws + WS_H);
#pragma unroll
        for (int ai = 0; ai < 2; ++ai)
#pragma unroll
            for (int m = 0; m < 4; ++m) { const int row = row0 + ai * 128 + m * 16; const float* g = gate + mod_sel(row) * 6144 + col0;
                bf16_t* ho = H + (size_t)row * D + col0;
#pragma unroll
                for (int bj = 0; bj < 2; ++bj) { f32x4 h0, h1;
                    if (layer == 0) { const float* hin = hrow_in(p, 0, row) + col0 + bj * 128; h0 = *(const f32x4*)hin; h1 = *(const f32x4*)(hin + 4); }
                    else { const u32x4 w_ = *(const u32x4*)(ho + bj * 128); h0 = (f32x4){bflo(w_.x), bfhi(w_.x), bflo(w_.y), bfhi(w_.y)}; h1 = (f32x4){bflo(w_.z), bfhi(w_.z), bflo(w_.w), bfhi(w_.w)}; }
                    const f32x4 v0 = h0 + *(const f32x4*)(g + bj * 128) * acc[ai][bj][m][0], v1 = h1 + *(const f32x4*)(g + bj * 128 + 4) * acc[ai][bj][m][1];
                    u32x4 w; w.x = cvt_pk_bf16(v0[0], v0[1]); w.y = cvt_pk_bf16(v0[2], v0[3]); w.z = cvt_pk_bf16(v1[0], v1[1]); w.w = cvt_pk_bf16(v1[2], v1[3]);
                    *(u32x4*)(ho + bj * 128) = w; } }
    }
};
struct EpiGateUp {
    static constexpr bool PERM = true;
    bf16_t* ACT; const float* bgu; const int* blk_e;
    __device__ __forceinline__ void operator()(const f32x4 (&acc)[2][2][4][2], const pg8::Unit& u, int wr, int wc, int fr, int fq) const {
        const int row0 = u.pm * 256 + wr * 64 + fr, col0 = u.pn * 128 + wc * 32 + 8 * fq; const int e = blk_e[u.pm];
        const float* bg = bgu + (size_t)e * 2048 + col0; const float* bu = bg + 1024;
        f32x4 bgv[2], buv[2];
#pragma unroll
        for (int n = 0; n < 2; ++n) { bgv[n] = *(const f32x4*)(bg + 4 * n); buv[n] = *(const f32x4*)(bu + 4 * n); }
#pragma unroll
        for (int ai = 0; ai < 2; ++ai)
#pragma unroll
            for (int m = 0; m < 4; ++m) { float o[8];
#pragma unroll
                for (int n = 0; n < 2; ++n)
#pragma unroll
                    for (int j = 0; j < 4; ++j) { float g = acc[ai][0][m][n][j] + bgv[n][j], up = acc[ai][1][m][n][j] + buv[n][j];
                        g = fminf(g, 7.f); up = fminf(fmaxf(up, -7.f), 7.f);
                        const float glu = g * __builtin_amdgcn_rcpf(1.f + __builtin_amdgcn_exp2f(-1.702f * LOG2E * g)); o[n * 4 + j] = (up + 1.f) * glu; }
                u32x4 w; w.x = cvt_pk_bf16(o[0], o[1]); w.y = cvt_pk_bf16(o[2], o[3]); w.z = cvt_pk_bf16(o[4], o[5]); w.w = cvt_pk_bf16(o[6], o[7]);
                *(u32x4*)(ACT + (size_t)(row0 + ai * 128 + m * 16) * 1024 + col0) = w; }
    }
};
struct EpiDown {
    static constexpr bool PERM = true;
    bf16_t* Y; const float* bd; const int* blk_e; const float* sgate;
    __device__ __forceinline__ void operator()(const f32x4 (&acc)[2][2][4][2], const pg8::Unit& u, int wr, int wc, int fr, int fq) const {
        const int row0 = u.pm * 256 + wr * 64 + fr, col0 = u.pn * 256 + wc * 32 + 8 * fq; const int e = blk_e[u.pm];
        const float* b = bd + (size_t)e * 1024 + col0;
        f32x4 bv[2][2];
#pragma unroll
        for (int bj = 0; bj < 2; ++bj)
#pragma unroll
            for (int n = 0; n < 2; ++n) bv[bj][n] = *(const f32x4*)(b + bj * 128 + 4 * n);
#pragma unroll
        for (int ai = 0; ai < 2; ++ai)
#pragma unroll
            for (int m = 0; m < 4; ++m) { const int row = row0 + ai * 128 + m * 16; const float sg = sgate[row]; bf16_t* rowp = Y + (size_t)row * 1024 + col0;
#pragma unroll
                for (int bj = 0; bj < 2; ++bj) { const f32x4 v0 = (acc[ai][bj][m][0] + bv[bj][0]) * sg, v1 = (acc[ai][bj][m][1] + bv[bj][1]) * sg;
                    u32x4 w; w.x = cvt_pk_bf16(v0[0], v0[1]); w.y = cvt_pk_bf16(v0[2], v0[3]); w.z = cvt_pk_bf16(v1[0], v1[1]); w.w = cvt_pk_bf16(v1[2], v1[3]);
                    *(u32x4*)(rowp + bj * 128) = w; } }
    }
};

__device__ __forceinline__ void norm_mod_vals(const float* g, const float* shift, const float* scale, int lane, f32x4 (&u)[4]) {
    float ss = 0.f;
#pragma unroll
    for (int j = 0; j < 4; ++j) ss += (u[j][0] * u[j][0] + u[j][1] * u[j][1]) + (u[j][2] * u[j][2] + u[j][3] * u[j][3]);
    const float rstd = rsqrtf(wave_sum(ss) * (1.f / D) + EPS);
#pragma unroll
    for (int j = 0; j < 4; ++j) { const int c = 4 * lane + 256 * j; const f32x4 gv = *(const f32x4*)(g + c), sh = *(const f32x4*)(shift + c), sc = *(const f32x4*)(scale + c);
        u[j] = (u[j] * rstd) * gv * (sc + 1.f) + sh; }
}
__device__ __forceinline__ void norm_mod_row(const float* hrow, const float* g, const float* shift, const float* scale, int lane, f32x4 (&u)[4]) {
#pragma unroll
    for (int j = 0; j < 4; ++j) u[j] = *(const f32x4*)(hrow + 4 * lane + 256 * j);
    norm_mod_vals(g, shift, scale, lane, u);
}
__device__ __forceinline__ void store_row_bf16(bf16_t* orow, int lane, const f32x4 (&u)[4]) {
#pragma unroll
    for (int j = 0; j < 4; ++j) { u32x2 w; w.x = cvt_pk_bf16(u[j][0], u[j][1]); w.y = cvt_pk_bf16(u[j][2], u[j][3]); *(u32x2*)(orow + 4 * lane + 256 * j) = w; }
}

__device__ __forceinline__ void norm_mix_stage_wab(PP p, int layer, LAS float* wab, int tid) {
    const float* win = p->in[I_WIN] + (size_t)layer * D * INC;
    for (int i = tid; i < 16 * 1024; i += NTHR) { const int k = i >> 4, j = i & 15; wab[j * 1024 + k] = win[(size_t)k * INC + PW + j]; }
}
__device__ __forceinline__ void norm_mix_row(PP p, int layer, int r, int lane, f32x4 (&u)[4], const LAS float* wab, float ea, float dtb) {
    const float* cf = (const float*)(p->ws + WS_CONST);
    const float* mv = cf + CF_MODV + (layer * 3 + mod_sel(r)) * 6144;
    norm_mod_vals(p->in[I_NMIXG] + layer * D, mv, mv + 1024, lane, u);
    store_row_bf16((bf16_t*)(p->ws + WS_U) + (size_t)r * D, lane, u);
    float ab = 0.f;
#pragma unroll
    for (int j = 0; j < 16; ++j) { float s = 0.f;
#pragma unroll
        for (int q = 0; q < 4; ++q) { const f32x4 w = *(const LAS f32x4*)(wab + j * 1024 + 4 * lane + 256 * q); s += (u[q][0] * w[0] + u[q][1] * w[1]) + (u[q][2] * w[2] + u[q][3] * w[3]); }
        s = wave_sum(s); if (lane == j) ab = s; }
    float outv;
    if (lane < 8) { const float z = ab + dtb; const float sp = z > 20.f ? z : log1pf(__expf(z)); outv = ea * sp; }
    else outv = 1.f / (1.f + __expf(-ab));
    if (lane < 16) ((float*)(p->ws + WS_GB))[(size_t)r * 16 + lane] = outv;
}
__device__ __forceinline__ void phase_norm_mix(PP p, int layer, LAS unsigned char* lds) {
    int tid = threadIdx.x, bid = blockIdx.x, gdim = gridDim.x; asm volatile("" : "+v"(tid), "+s"(bid), "+s"(gdim)); const int lane = tid & 63, wave = __builtin_amdgcn_readfirstlane(tid >> 6);
    LAS float* wab = (LAS float*)lds;
    norm_mix_stage_wab(p, layer, wab, tid);
    __syncthreads();
    float ea = 0.f, dtb = 0.f; if (lane < 8) { ea = -__expf(p->in[I_ALOG][layer * 8 + lane]); dtb = p->in[I_DTB][layer * 8 + lane]; }
    for (int r = bid * NWAVES + wave; r < NTOK; r += gdim * NWAVES) {
        const float* hrow = hrow_in(p, layer, r); f32x4 u[4];
#pragma unroll
        for (int j = 0; j < 4; ++j) u[j] = *(const f32x4*)(hrow + 4 * lane + 256 * j);
        norm_mix_row(p, layer, r, lane, u, wab, ea, dtb);
    }
}

__device__ __forceinline__ void phase_prep(PP p, int layer) {
    int tid = threadIdx.x, bid = blockIdx.x, gdim = gridDim.x; asm volatile("" : "+v"(tid), "+s"(bid), "+s"(gdim)); const int lane = tid & 63, wave = __builtin_amdgcn_readfirstlane(tid >> 6);
    const float* cf = (const float*)(p->ws + WS_CONST);
    bf16_t* P = (bf16_t*)(p->ws + WS_P); bf16_t* G = (bf16_t*)(p->ws + WS_G);
    const float* cw = p->in[I_CONVW] + (size_t)layer * 5 * 1536;
    float gain[16];
    { const float* gsrc = (lane < 32 ? p->in[I_QNG] : p->in[I_KNG]) + layer * 64 + 16 * (lane & 3);
#pragma unroll
      for (int e = 0; e < 16; ++e) gain[e] = gsrc[e]; }
    const float qscale = lane < 32 ? 0.125f * LOG2E : 1.f;
    for (int r = bid * NWAVES + wave; r < NTOK; r += gdim * NWAVES) {
        bf16_t* prow = P + (size_t)r * PW + 16 * lane;
        const u32x4 w0 = *(const u32x4*)prow, w1 = *(const u32x4*)(prow + 8);
        float x[16];
#pragma unroll
        for (int e = 0; e < 4; ++e) { x[2 * e] = bflo(w0[e]); x[2 * e + 1] = bfhi(w0[e]); x[8 + 2 * e] = bflo(w1[e]); x[8 + 2 * e + 1] = bfhi(w1[e]); }
        float ss = 0.f;
#pragma unroll
        for (int e = 0; e < 16; ++e) ss += x[e] * x[e];
        ss += __shfl_xor(ss, 1); ss += __shfl_xor(ss, 2);
        const float rstd = rsqrtf(ss * (1.f / 64.f) + EPS);
#pragma unroll
        for (int e = 0; e < 16; ++e) x[e] = x[e] * rstd * gain[e];
        if (r < NLAT) {
            const int t = r & (SEQL - 1); const int pos = (lane & 2) ? (t & 63) : (t >> 6);
            const float* ct = cf + CF_ROPE + ((lane & 2) ? 8192 : 0) + pos * 16; const float* st = ct + ((lane & 2) ? 1024 : 4096);
            const bool second = lane & 1;
#pragma unroll
            for (int e = 0; e < 16; ++e) { const float other = __shfl_xor(x[e], 1); const float cs = ct[e], sn = st[e];
                x[e] = second ? (x[e] * cs + other * sn) : (x[e] * cs - other * sn); }
        }
        u32x4 o0, o1;
#pragma unroll
        for (int e = 0; e < 4; ++e) { o0[e] = cvt_pk_bf16(x[2 * e] * qscale, x[2 * e + 1] * qscale); o1[e] = cvt_pk_bf16(x[8 + 2 * e] * qscale, x[8 + 2 * e + 1] * qscale); }
        *(u32x4*)prow = o0; *(u32x4*)(prow + 8) = o1;
    }
    for (int r = bid * NWAVES + wave; r < NTOK; r += gdim * NWAVES) {
        int seg0, seglen; if (r < NLAT) { seg0 = r & ~(SEQL - 1); seglen = SEQL; } else { seg0 = NLAT + ((r - NLAT) & ~(CTXL - 1)); seglen = CTXL; }
        const int tpos = r - seg0;
#pragma unroll
        for (int grp = 0; grp < 3; ++grp) {
            const int c0 = grp * 512 + 8 * lane;
            float a[8];
#pragma unroll
            for (int e = 0; e < 8; ++e) a[e] = 0.f;
#pragma unroll
            for (int j = 0; j < 5; ++j) { const int tp = tpos + j - 2;
                if (tp >= 0 && tp < seglen) { const u32x4 w = *(const u32x4*)(P + (size_t)(seg0 + tp) * PW + 1536 + c0);
                    const f32x4 k0 = *(const f32x4*)(cw + j * 1536 + c0), k1 = *(const f32x4*)(cw + j * 1536 + c0 + 4);
                    a[0] += bflo(w[0]) * k0[0]; a[1] += bfhi(w[0]) * k0[1]; a[2] += bflo(w[1]) * k0[2]; a[3] += bfhi(w[1]) * k0[3];
                    a[4] += bflo(w[2]) * k1[0]; a[5] += bfhi(w[2]) * k1[1]; a[6] += bflo(w[3]) * k1[2]; a[7] += bfhi(w[3]) * k1[3]; } }
            float ss = 0.f;
#pragma unroll
            for (int e = 0; e < 8; ++e) { a[e] = silu_f(a[e]); ss += a[e] * a[e]; }
            if (grp < 2) { ss += __shfl_xor(ss, 1); ss += __shfl_xor(ss, 2); ss += __shfl_xor(ss, 4); ss += __shfl_xor(ss, 8);
                const float rn = rsqrtf(ss + EPS);
#pragma unroll
                for (int e = 0; e < 8; ++e) a[e] *= rn; }
            u32x4 o; o.x = cvt_pk_bf16(a[0], a[1]); o.y = cvt_pk_bf16(a[2], a[3]); o.z = cvt_pk_bf16(a[4], a[5]); o.w = cvt_pk_bf16(a[6], a[7]);
            *(u32x4*)(G + (size_t)r * 1536 + c0) = o;
        }
    }
}

typedef short v4i16c_t __attribute__((ext_vector_type(4)));
__device__ __forceinline__ s16x4 vtr_c(const LAS unsigned char* ptr) { return __builtin_bit_cast(s16x4, __builtin_amdgcn_ds_read_tr16_b64_v4i16((LAS v4i16c_t*)ptr)); }
__device__ __forceinline__ void gdn_task_rows(int task, int& b, int& h, int& dir, int& rstart, int& rstep) {
    const int chain = task / NCHUNK, n = task % NCHUNK; dir = chain & 1; h = (chain >> 1) & 3; b = chain >> 3;
    if (n < 4) { const int base = NLAT + b * CTXL; if (dir == 0) { rstart = base + 64 * n; rstep = 1; } else { rstart = base + CTXL - 1 - 64 * n; rstep = -1; } }
    else { const int base = b * SEQL, m = n - 4; if (dir == 0) { rstart = base + 64 * m; rstep = 1; } else { rstart = base + SEQL - 1 - 64 * m; rstep = -1; } }
}
constexpr int CWL_BYTES = 6144, CWL_STG = 2048;
__device__ __forceinline__ void gdn_chunk_task(PP p, LAS unsigned char* wl, const int task, const int lane) {
    const int r32 = lane & 31, hi = lane >> 5;
    const bf16_t* G = (const bf16_t*)(p->ws + WS_G); const float* GB = (const float*)(p->ws + WS_GB);
    float* cf = (float*)(p->ws + WS_CONST);
    LAS float* gcv = (LAS float*)wl;
    LAS unsigned char* stg = wl + CWL_STG;
    const LAS unsigned char* stgp = stg + ((lane >> 4) & 1) * 32 + (lane & 3) * 8 + (4 * hi + ((lane & 15) >> 2)) * 64;
    const LAS unsigned char* stgn = stg + ((lane >> 4) & 1) * 32 + (lane & 3) * 8 + (8 * hi + ((lane & 15) >> 2)) * 64;
    const float SCALE = 0.08838834764831845f;
    {
        int b, h, dir, rstart, rstep; gdn_task_rows(task, b, h, dir, rstart, rstep);
        unsigned char* chb = p->ws + WS_CH + (size_t)task * CH_TASK_BYTES;
        const int myrow = rstart + rstep * lane;
        float gt = GB[(size_t)myrow * 16 + dir * 4 + h]; const float bt = GB[(size_t)myrow * 16 + 8 + dir * 4 + h];
#pragma unroll
        for (int o = 1; o < 64; o <<= 1) { const float t = __shfl_up(gt, o); if (lane >= o) gt += t; }
        const float glast = __shfl(gt, 63), egt = __expf(gt), begt = bt * egt, kdt = __expf(glast - gt);
        gcv[lane] = gt; gcv[64 + lane] = bt;
        if (lane == 0) cf[CF_EGL + task] = __expf(glast);
        const float gcs0 = __shfl(gt, r32), gcs1 = __shfl(gt, 32 + r32);
        const size_t rowA0 = (size_t)(rstart + rstep * r32) * 1536, rowA1 = (size_t)(rstart + rstep * (32 + r32)) * 1536;
        bf16x8 kfr[2][8];
        { const bf16_t* gk = G + 512 + h * 128 + 8 * hi;
#pragma unroll
          for (int ks = 0; ks < 8; ++ks) { kfr[0][ks] = *(const bf16x8*)(gk + rowA0 + 16 * ks); kfr[1][ks] = *(const bf16x8*)(gk + rowA1 + 16 * ks); } }
        LDS_WAIT();
        f32x16 am00, am10, am11;
#define KK_TILE(dst, mi, ni, gcs_) do { f32x16 acc_ = (f32x16){}; \
            _Pragma("unroll") for (int ks = 0; ks < 8; ++ks) acc_ = MFMA32(kfr[mi][ks], kfr[ni][ks], acc_); \
            _Pragma("unroll") for (int q = 0; q < 4; ++q) { const f32x4 g4 = *(const LAS f32x4*)(gcv + 32 * (mi) + 8 * q + 4 * hi), b4 = *(const LAS f32x4*)(gcv + 64 + 32 * (mi) + 8 * q + 4 * hi); \
                _Pragma("unroll") for (int e = 0; e < 4; ++e) { const int cc = 32 * (mi) + 8 * q + 4 * hi + e, ss = 32 * (ni) + r32; \
                    dst[4 * q + e] = (ss < cc) ? -b4[e] * acc_[4 * q + e] * __expf(fminf(g4[e] - (gcs_), 0.f)) : 0.f; } } } while (0)
        KK_TILE(am00, 0, 0, gcs0); KK_TILE(am10, 1, 0, gcs0); KK_TILE(am11, 1, 1, gcs1);
        __builtin_amdgcn_sched_barrier(0);
        { bf16x8 qfr[8]; const bf16_t* gq = G + h * 128 + 8 * hi;
#define KQ_TILE(n, mo, gcc_) do { f32x16 acc_ = (f32x16){}; \
            _Pragma("unroll") for (int ks = 0; ks < 8; ++ks) acc_ = MFMA32(kfr[n][ks], qfr[ks], acc_); \
            _Pragma("unroll") for (int q = 0; q < 4; ++q) { const f32x4 g4 = *(const LAS f32x4*)(gcv + 32 * (n) + 8 * q + 4 * hi); \
                _Pragma("unroll") for (int e = 0; e < 4; ++e) { const int ss = 32 * (n) + 8 * q + 4 * hi + e, cc = 32 * (mo) + r32; \
                    acc_[4 * q + e] = (ss <= cc) ? SCALE * acc_[4 * q + e] * __expf(fminf((gcc_) - g4[e], 0.f)) : 0.f; } } \
            _Pragma("unroll") for (int s = 0; s < 2; ++s) { u32x4 o_; o_.x = cvt_pk_bf16(acc_[8 * s], acc_[8 * s + 1]); o_.y = cvt_pk_bf16(acc_[8 * s + 2], acc_[8 * s + 3]); o_.z = cvt_pk_bf16(acc_[8 * s + 4], acc_[8 * s + 5]); o_.w = cvt_pk_bf16(acc_[8 * s + 6], acc_[8 * s + 7]); \
                *(u32x4*)(chb + CH_AF + (((mo) * 2 + (n)) * 2 + s) * 1024 + lane * 16) = o_; } } while (0)
#pragma unroll
          for (int ks = 0; ks < 8; ++ks) qfr[ks] = *(const bf16x8*)(gq + rowA0 + 16 * ks);
          KQ_TILE(0, 0, gcs0); __builtin_amdgcn_sched_barrier(0);
#pragma unroll
          for (int ks = 0; ks < 8; ++ks) qfr[ks] = *(const bf16x8*)(gq + rowA1 + 16 * ks);
          KQ_TILE(0, 1, gcs1); KQ_TILE(1, 1, gcs1); }
        __builtin_amdgcn_sched_barrier(0);
        { const float eg0 = __shfl(egt, r32) * SCALE, eg1 = __shfl(egt, 32 + r32) * SCALE;
#pragma unroll
          for (int m = 0; m < 2; ++m) { const bf16_t* gq = G + (m ? rowA1 : rowA0) + h * 128 + 4 * hi; const float sc = m ? eg1 : eg0;
#pragma unroll
              for (int ts = 0; ts < 8; ++ts) { const u32x2 a = *(const u32x2*)(gq + 16 * ts), bq = *(const u32x2*)(gq + 16 * ts + 8); u32x4 o_;
                  o_.x = cvt_pk_bf16(bflo(a.x) * sc, bfhi(a.x) * sc); o_.y = cvt_pk_bf16(bflo(a.y) * sc, bfhi(a.y) * sc); o_.z = cvt_pk_bf16(bflo(bq.x) * sc, bfhi(bq.x) * sc); o_.w = cvt_pk_bf16(bflo(bq.y) * sc, bfhi(bq.y) * sc);
                  *(u32x4*)(chb + CH_QF + (m * 8 + ts) * 1024 + lane * 16) = o_; } } }
        __builtin_amdgcn_sched_barrier(0);
        float x[64]; int lane_v = lane; asm volatile("" : "+v"(lane_v));
#pragma unroll
        for (int i = 63; i >= 0; --i) { float a0 = (lane_v == i) ? 1.f : 0.f, a1 = 0.f;
#pragma unroll
            for (int m = 63; m > i; --m) { const int ml = m & 31, hm = (ml >> 2) & 1, rm = (ml >> 3) * 4 + (ml & 3), ln = (i & 31) + 32 * hm;
                const float tv = (m >= 32) ? ((i >= 32) ? am11[rm] : am10[rm]) : am00[rm];
                const float s_ = __builtin_bit_cast(float, __builtin_amdgcn_readlane(__builtin_bit_cast(int, tv), ln));
                if (m & 1) asm("v_fmac_f32 %0, %1, %2" : "+v"(a1) : "s"(s_), "v"(x[m])); else asm("v_fmac_f32 %0, %1, %2" : "+v"(a0) : "s"(s_), "v"(x[m])); }
            x[i] = a0 + a1; __builtin_amdgcn_sched_barrier(0); }
        __builtin_amdgcn_sched_barrier(0);
        bf16x8 F0[4], F1[4];
#pragma unroll
        for (int ks = 0; ks < 4; ++ks) { u32x4 f0, f1;
#pragma unroll
            for (int w = 0; w < 4; ++w) { const unsigned pa = cvt_pk_bf16(x[16 * ks + 2 * w], x[16 * ks + 2 * w + 1]), pb = cvt_pk_bf16(x[16 * ks + 8 + 2 * w], x[16 * ks + 8 + 2 * w + 1]);
                const auto sw = __builtin_amdgcn_permlane32_swap(pa, pb, false, false);
                f0[w] = sw[0]; f1[w] = sw[1]; }
            F0[ks] = __builtin_bit_cast(bf16x8, f0); F1[ks] = __builtin_bit_cast(bf16x8, f1); }
        __builtin_amdgcn_sched_barrier(0);
#define PIECE_COL(pc) ((pc) < 4 ? 512 + h * 128 + 32 * (pc) : (pc) < 8 ? 1024 + h * 128 + 32 * ((pc) - 4) : 512 + h * 128 + 32 * ((pc) - 8))
#define PIECE_LOAD(pc, buf) do { const bf16_t* src_ = G + (size_t)myrow * 1536 + PIECE_COL(pc); _Pragma("unroll") for (int q = 0; q < 4; ++q) raw[buf][q] = *(const u32x4*)(src_ + 8 * q); } while (0)
#define PIECE_STAGE(buf, scal) do { LDS_WAIT(); \
            _Pragma("unroll") for (int q = 0; q < 4; ++q) { const u32x4 w_ = raw[buf][q]; u32x4 o_; \
                o_.x = cvt_pk_bf16(bflo(w_.x) * (scal), bfhi(w_.x) * (scal)); o_.y = cvt_pk_bf16(bflo(w_.y) * (scal), bfhi(w_.y) * (scal)); o_.z = cvt_pk_bf16(bflo(w_.z) * (scal), bfhi(w_.z) * (scal)); o_.w = cvt_pk_bf16(bflo(w_.w) * (scal), bfhi(w_.w) * (scal)); \
                *(LAS u32x4*)(stg + lane * 64 + 16 * q) = o_; } LDS_WAIT(); } while (0)
#define TR_FRAG(ks) ({ const s16x4 lo_ = vtr_c(stgp + (ks) * 1024), hi_ = vtr_c(stgp + (ks) * 1024 + 512); (bf16x8){lo_[0], lo_[1], lo_[2], lo_[3], hi_[0], hi_[1], hi_[2], hi_[3]}; })
#define TR_NAT(ks) ({ const s16x4 lo_ = vtr_c(stgn + (ks) * 1024), hi_ = vtr_c(stgn + (ks) * 1024 + 256); (bf16x8){lo_[0], lo_[1], lo_[2], lo_[3], hi_[0], hi_[1], hi_[2], hi_[3]}; })
        u32x4 raw[2][4];
        PIECE_LOAD(0, 0);
#pragma unroll
        for (int pc = 0; pc < 12; ++pc) {
            __builtin_amdgcn_sched_barrier(0);
            if (pc + 1 < 12) PIECE_LOAD(pc + 1, (pc + 1) & 1);
            if (pc < 4) {
                const int t = pc; PIECE_STAGE(pc & 1, begt);
                f32x16 a0 = (f32x16){}, a1 = (f32x16){};
#pragma unroll
                for (int ks = 0; ks < 4; ++ks) { const bf16x8 fr = TR_NAT(ks); a0 = MFMA32(fr, F0[ks], a0); a1 = MFMA32(fr, F1[ks], a1); }
#pragma unroll
                for (int s = 0; s < 2; ++s) { u32x4 o0, o1;
                    o0.x = cvt_pk_bf16(-a0[8 * s], -a0[8 * s + 1]); o0.y = cvt_pk_bf16(-a0[8 * s + 2], -a0[8 * s + 3]); o0.z = cvt_pk_bf16(-a0[8 * s + 4], -a0[8 * s + 5]); o0.w = cvt_pk_bf16(-a0[8 * s + 6], -a0[8 * s + 7]);
                    o1.x = cvt_pk_bf16(-a1[8 * s], -a1[8 * s + 1]); o1.y = cvt_pk_bf16(-a1[8 * s + 2], -a1[8 * s + 3]); o1.z = cvt_pk_bf16(-a1[8 * s + 4], -a1[8 * s + 5]); o1.w = cvt_pk_bf16(-a1[8 * s + 6], -a1[8 * s + 7]);
                    *(u32x4*)(chb + CH_WF + ((0 * 4 + t) * 2 + s) * 1024 + lane * 16) = o0; *(u32x4*)(chb + CH_WF + ((1 * 4 + t) * 2 + s) * 1024 + lane * 16) = o1; }
            } else if (pc < 8) {
                const int nj = pc - 4; PIECE_STAGE(pc & 1, bt);
                f32x16 a0 = (f32x16){}, a1 = (f32x16){};
#pragma unroll
                for (int ks = 0; ks < 4; ++ks) { const bf16x8 fr = TR_NAT(ks); a0 = MFMA32(F0[ks], fr, a0); a1 = MFMA32(F1[ks], fr, a1); }
                unsigned* uc = (unsigned*)(chb + CH_UC) + ((nj * 2) * 64 + lane) * 8;
#pragma unroll
                for (int q = 0; q < 2; ++q) { u32x4 w0, w1;
#pragma unroll
                    for (int e = 0; e < 4; ++e) { w0[e] = cvt_pk_bf16_c(a0[8 * q + 2 * e], a0[8 * q + 2 * e + 1]); w1[e] = cvt_pk_bf16_c(a1[8 * q + 2 * e], a1[8 * q + 2 * e + 1]); }
                    *(u32x4*)(uc + 4 * q) = w0; *(u32x4*)(uc + 512 + 4 * q) = w1; }
            } else {
                const int t = pc - 8; PIECE_STAGE(pc & 1, kdt);
#pragma unroll
                for (int ms = 0; ms < 4; ++ms) { const bf16x8 fr = TR_FRAG(ms); *(bf16x8*)(chb + CH_KF + (t * 4 + ms) * 1024 + lane * 16) = fr; }
            }
        }
        LDS_WAIT();
#undef KK_TILE
#undef KQ_TILE
#undef PIECE_COL
#undef PIECE_LOAD
#undef PIECE_STAGE
#undef TR_FRAG
#undef TR_NAT
    }
}
__device__ __forceinline__ void phase_gdn_chunk(PP p, LAS unsigned char* lds) {
    int tid = threadIdx.x, bid = blockIdx.x, gdim = gridDim.x; asm volatile("" : "+v"(tid), "+s"(bid), "+s"(gdim)); const int lane = tid & 63, wave = __builtin_amdgcn_readfirstlane(tid >> 6);
    for (int q = bid * NWAVES + wave; q < 16 * 256; q += gdim * NWAVES) gdn_chunk_task(p, lds + wave * CWL_BYTES, (q >> 8) * NCHUNK + 4 + (q & 255), lane);
}

__device__ __forceinline__ void gdn_scan_chain(PP p, LAS unsigned char* lds, const int chain) {
    int tid = threadIdx.x; asm volatile("" : "+v"(tid)); const int lane = tid & 63, wave = __builtin_amdgcn_readfirstlane(tid >> 6), r32 = lane & 31, hi = lane >> 5;
    const float* cf = (const float*)(p->ws + WS_CONST);
    bf16_t* OG = (bf16_t*)(p->ws + WS_OG);
    constexpr int STG = 2 * CH_DMA_BYTES;
    const int dir = chain & 1, h = (chain >> 1) & 3;
    f32x16 S[4];
#pragma unroll
    for (int t = 0; t < 4; ++t) S[t] = (f32x16){};
    f32x16 Un[2]; float egn = 0.f;
#pragma unroll
    for (int m = 0; m < 2; ++m) Un[m] = (f32x16){};
#define LOAD_U(task_) do { const u32x4* uc_ = (const u32x4*)(p->ws + WS_CH + (size_t)(task_) * CH_TASK_BYTES + CH_UC) + ((wave * 2) * 64 + lane) * 2; \
        _Pragma("unroll") for (int m = 0; m < 2; ++m) _Pragma("unroll") for (int q = 0; q < 2; ++q) { const u32x4 w_ = uc_[m * 128 + q]; \
            Un[m][8 * q] = bflo(w_.x); Un[m][8 * q + 1] = bfhi(w_.x); Un[m][8 * q + 2] = bflo(w_.y); Un[m][8 * q + 3] = bfhi(w_.y); Un[m][8 * q + 4] = bflo(w_.z); Un[m][8 * q + 5] = bfhi(w_.z); Un[m][8 * q + 6] = bflo(w_.w); Un[m][8 * q + 7] = bfhi(w_.w); } \
        egn = cf[CF_EGL + (task_)]; } while (0)
#define STAGE_CHUNK(task_, bufi) do { const unsigned char* src_ = p->ws + WS_CH + (size_t)(task_) * CH_TASK_BYTES; const unsigned dst_ = lds_addr(lds + (bufi) * CH_DMA_BYTES); \
        _Pragma("unroll") for (int i = 0; i < 14; ++i) { const int pc = wave * 14 + i; glds16(src_ + pc * 1024 + lane * 16, dst_ + pc * 1024); } } while (0)
    if (wave >= 4) gdn_chunk_task(p, lds + (wave - 4) * CWL_BYTES, chain * NCHUNK + (wave - 4), lane);
    VM_WAIT(); LDS_WAIT(); __syncthreads();
    if (wave < 4) { LOAD_U(chain * NCHUNK); STAGE_CHUNK(chain * NCHUNK, 0); }
    for (int n = 0; n < NCHUNK; ++n) {
        const int task = chain * NCHUNK + n;
        int bq, hq, dq, rstart, rstep; gdn_task_rows(task, bq, hq, dq, rstart, rstep);
        if (wave < 4) VM_WAIT();
        asm volatile("s_waitcnt lgkmcnt(0)\n\ts_barrier" ::: "memory");
        if (wave < 4) {
            f32x16 V[2], O[2];
#pragma unroll
            for (int m = 0; m < 2; ++m) { V[m] = Un[m]; O[m] = (f32x16){}; }
            const float egl = egn;
            if (n + 1 < NCHUNK) { LOAD_U(task + 1); STAGE_CHUNK(task + 1, (n + 1) & 1); }
            const LAS unsigned char* buf = lds + (n & 1) * CH_DMA_BYTES + lane * 16;
            bf16x8 Sb[4][2];
#pragma unroll
            for (int t = 0; t < 4; ++t)
#pragma unroll
                for (int s = 0; s < 2; ++s) { u32x4 w; w.x = cvt_pk_bf16(S[t][8 * s], S[t][8 * s + 1]); w.y = cvt_pk_bf16(S[t][8 * s + 2], S[t][8 * s + 3]); w.z = cvt_pk_bf16(S[t][8 * s + 4], S[t][8 * s + 5]); w.w = cvt_pk_bf16(S[t][8 * s + 6], S[t][8 * s + 7]);
                    Sb[t][s] = __builtin_bit_cast(bf16x8, w); }
#pragma unroll
            for (int m = 0; m < 2; ++m)
#pragma unroll
                for (int t = 0; t < 4; ++t)
#pragma unroll
                    for (int s = 0; s < 2; ++s) { const int f = (m * 4 + t) * 2 + s;
                        V[m] = MFMA32(*(const LAS bf16x8*)(buf + CH_WF + f * 1024), Sb[t][s], V[m]);
                        O[m] = MFMA32(*(const LAS bf16x8*)(buf + CH_QF + f * 1024), Sb[t][s], O[m]);
                        if (s == 1 && (t & 1)) __builtin_amdgcn_sched_barrier(0); }
            bf16x8 Vb[2][2];
#pragma unroll
            for (int m = 0; m < 2; ++m)
#pragma unroll
                for (int s = 0; s < 2; ++s) { u32x4 w; w.x = cvt_pk_bf16(V[m][8 * s], V[m][8 * s + 1]); w.y = cvt_pk_bf16(V[m][8 * s + 2], V[m][8 * s + 3]); w.z = cvt_pk_bf16(V[m][8 * s + 4], V[m][8 * s + 5]); w.w = cvt_pk_bf16(V[m][8 * s + 6], V[m][8 * s + 7]);
                    Vb[m][s] = __builtin_bit_cast(bf16x8, w); }
#pragma unroll
            for (int mo = 0; mo < 2; ++mo)
#pragma unroll
                for (int m = 0; m <= mo; ++m)
#pragma unroll
                    for (int s = 0; s < 2; ++s) O[mo] = MFMA32(*(const LAS bf16x8*)(buf + CH_AF + ((mo * 2 + m) * 2 + s) * 1024), Vb[m][s], O[mo]);
            { LAS bf16_t* stg = (LAS bf16_t*)(lds + STG) + 32 * wave + r32;
#pragma unroll
              for (int m = 0; m < 2; ++m)
#pragma unroll
                  for (int r = 0; r < 16; ++r) stg[(32 * m + crow(r, hi)) * 128] = (bf16_t)f2bf(O[m][r]); }
#pragma unroll
            for (int t = 0; t < 4; ++t) {
                __builtin_amdgcn_sched_barrier(0);
#pragma unroll
                for (int r = 0; r < 16; ++r) S[t][r] *= egl;
#pragma unroll
                for (int m = 0; m < 2; ++m)
#pragma unroll
                    for (int s = 0; s < 2; ++s) S[t] = MFMA32(*(const LAS bf16x8*)(buf + CH_KF + ((t * 2 + m) * 2 + s) * 1024), Vb[m][s], S[t]); }
        }
        asm volatile("s_waitcnt lgkmcnt(0)\n\ts_barrier" ::: "memory");
        if (wave >= 4) { const int j = tid - 256, row = j >> 2; bf16_t* og = OG + (size_t)dir * NTOK * 512 + (size_t)(rstart + rstep * row) * 512 + h * 128 + (j & 3) * 8;
            const LAS bf16_t* stg = (const LAS bf16_t*)(lds + STG) + row * 128 + (j & 3) * 8;
#pragma unroll
            for (int it = 0; it < 4; ++it) *(u32x4*)(og + it * 32) = *(const LAS u32x4*)(stg + it * 32); }
    }
    VM_WAIT(); LDS_WAIT(); __syncthreads();
#undef LOAD_U
#undef STAGE_CHUNK
}

__device__ __forceinline__ void phase_gdn_out(PP p, int layer) {
    int tid = threadIdx.x, bid = blockIdx.x, gdim = gridDim.x; asm volatile("" : "+v"(tid), "+s"(bid), "+s"(gdim)); const int lane = tid & 63, wave = __builtin_amdgcn_readfirstlane(tid >> 6);
    const bf16_t* OG = (const bf16_t*)(p->ws + WS_OG); const bf16_t* OA = (const bf16_t*)(p->ws + WS_OA); const bf16_t* P = (const bf16_t*)(p->ws + WS_P); bf16_t* MIX = (bf16_t*)(p->ws + WS_MIX);
    const float* cf = (const float*)(p->ws + WS_CONST);
    const float lam = cf[CF_SC + layer * 16 + 0], oml = cf[CF_SC + layer * 16 + 2];
    const float* gn = p->in[I_GDNG] + layer * 128 + (8 * lane & 127); const float* sg = p->in[I_SUBLN] + layer * 128 + (8 * lane & 127);
    const f32x4 g0 = *(const f32x4*)gn, g1 = *(const f32x4*)(gn + 4), a0 = *(const f32x4*)sg * oml, a1 = *(const f32x4*)(sg + 4) * oml;
    const int nrows = layer == 0 ? NTOK : NLAT;
    for (int r = bid * NWAVES + wave; r < nrows; r += gdim * NWAVES) {
        {
            const bf16_t* a = OA + (size_t)r * 512 + 8 * lane; const float* la = (const float*)(p->ws + WS_LA) + (size_t)r * 4 + (lane >> 4);
            constexpr size_t PS = (size_t)NTOK * 512, LS = (size_t)NTOK * 4;
#define LD8(ptr, lo4, hi4) do { const u32x4 w_ = *(const u32x4*)(ptr); lo4 = (f32x4){bflo(w_.x), bfhi(w_.x), bflo(w_.y), bfhi(w_.y)}; hi4 = (f32x4){bflo(w_.z), bfhi(w_.z), bflo(w_.w), bfhi(w_.w)}; } while (0)
            f32x4 s0a, s0b, s1a, s1b; LD8(a, s0a, s0b); LD8(a + PS, s1a, s1b); float l0 = la[0], l1 = la[LS];
            if (r < NLAT) { f32x4 t0, t1; LD8(a + 2 * PS, t0, t1); s0a += t0; s0b += t1; LD8(a + 3 * PS, t0, t1); s1a += t0; s1b += t1; l0 += la[2 * LS]; l1 += la[3 * LS];
                if (r >= SEQL && (lane >> 4) == 3) {
#pragma unroll
                    for (int q = 2; q < 4; ++q) { LD8(a + (2 * q) * PS, t0, t1); s0a += t0; s0b += t1; LD8(a + (2 * q + 1) * PS, t0, t1); s1a += t0; s1b += t1; l0 += la[(2 * q) * LS]; l1 += la[(2 * q + 1) * LS]; } } }
            const float r0 = 1.f / l0, r1 = lam / l1;
            f32x4 o0 = s0a * r0 - s1a * r1, o1 = s0b * r0 - s1b * r1;
            float ss = (o0[0] * o0[0] + o0[1] * o0[1]) + (o0[2] * o0[2] + o0[3] * o0[3]) + (o1[0] * o1[0] + o1[1] * o1[1]) + (o1[2] * o1[2] + o1[3] * o1[3]);
            ss += __shfl_xor(ss, 1); ss += __shfl_xor(ss, 2); ss += __shfl_xor(ss, 4); ss += __shfl_xor(ss, 8);
            const float rstd = rsqrtf(ss * (1.f / 128.f) + EPS);
            o0 = o0 * rstd * a0; o1 = o1 * rstd * a1;
            u32x4 w; w.x = cvt_pk_bf16(o0[0], o0[1]); w.y = cvt_pk_bf16(o0[2], o0[3]); w.z = cvt_pk_bf16(o1[0], o1[1]); w.w = cvt_pk_bf16(o1[2], o1[3]);
            *(u32x4*)(MIX + (size_t)r * D + 8 * lane) = w; }
        const bf16_t* a = OG + (size_t)r * 512 + 8 * lane; const bf16_t* bq = a + (size_t)NTOK * 512;
        f32x4 o0, o1; { f32x4 t0, t1; LD8(a, o0, o1); LD8(bq, t0, t1); o0 += t0; o1 += t1; }
        float ss = (o0[0] * o0[0] + o0[1] * o0[1]) + (o0[2] * o0[2] + o0[3] * o0[3]) + (o1[0] * o1[0] + o1[1] * o1[1]) + (o1[2] * o1[2] + o1[3] * o1[3]);
        ss += __shfl_xor(ss, 1); ss += __shfl_xor(ss, 2); ss += __shfl_xor(ss, 4); ss += __shfl_xor(ss, 8);
        const float rstd = rsqrtf(ss * (1.f / 128.f) + EPS);
        const u32x4 zw = *(const u32x4*)(P + (size_t)r * PW + 3072 + 8 * lane);
        o0 = o0 * rstd * g0; o1 = o1 * rstd * g1;
        u32x4 w; w.x = cvt_pk_bf16(o0[0] * silu_f(bflo(zw.x)), o0[1] * silu_f(bfhi(zw.x))); w.y = cvt_pk_bf16(o0[2] * silu_f(bflo(zw.y)), o0[3] * silu_f(bfhi(zw.y)));
        w.z = cvt_pk_bf16(o1[0] * silu_f(bflo(zw.z)), o1[1] * silu_f(bfhi(zw.z))); w.w = cvt_pk_bf16(o1[2] * silu_f(bflo(zw.w)), o1[3] * silu_f(bfhi(zw.w)));
        *(u32x4*)(MIX + (size_t)r * D + 512 + 8 * lane) = w;
    }
}

constexpr int AT_NS = 4, AT_SLOTK = 8192, AT_SLOTV = 16384, AT_K = 0, AT_V = AT_NS * AT_SLOTK, AT_WS = AT_V + AT_NS * AT_SLOTV;
typedef short v4i16_t __attribute__((ext_vector_type(4)));
__device__ __forceinline__ s16x4 vtr(const LAS unsigned char* ptr) { return __builtin_bit_cast(s16x4, __builtin_amdgcn_ds_read_tr16_b64_v4i16((LAS v4i16_t*)ptr)); }
__device__ __forceinline__ int att_keyrow(int b, int t, int nctx_tiles) {
    return t < nctx_tiles ? NLAT + b * CTXL + 64 * t : b * SEQL + 64 * (t - nctx_tiles);
}
#define AT_SBAR() __builtin_amdgcn_sched_barrier(0)
#define AT_PIN(x) asm volatile("" : "+v"(x))
#define AT_WAIT_BAR(N) asm volatile("s_waitcnt vmcnt(" #N ") lgkmcnt(0)\n\ts_barrier" ::: "memory")
__device__ __forceinline__ void attn_unit(PP p, int layer, LAS unsigned char* lds, int b, int h, int sub, int qrow0, int t0, int ntile, int nctx_tiles, int ksp) {
    int tid = threadIdx.x; asm volatile("" : "+v"(tid)); const int lane = tid & 63, wave = __builtin_amdgcn_readfirstlane(tid >> 6), r32 = lane & 31, hi = lane >> 5;
    const bf16_t* P = (const bf16_t*)(p->ws + WS_P);
    LAS float* wsf = (LAS float*)(lds + AT_WS) + wave * 64;
    const LAS unsigned char* kp0 = lds + AT_K + hi * 1024 + r32 * 16;
    const LAS unsigned char* vp0 = lds + AT_V + ((lane >> 4) & 1) * 32 + (lane & 3) * 8 + (4 * hi + ((lane & 15) >> 2)) * 64;
    const int kcol = 512 + h * 128 + sub * 64 + wave * 8, vcol = 1024 + h * 128;
    const size_t koff = (size_t)lane * PW + kcol;
    const size_t voff0 = (size_t)(16 * (wave & 3) + (lane >> 2)) * PW + vcol + 32 * (wave >> 2) + 8 * (lane & 3);
    const size_t voff1 = voff0 + 64;
    const unsigned kdst = lds_addr(lds + AT_K + wave * 1024), vdst = lds_addr(lds + AT_V + wave * 1024);
#define DMA_K(t, slot) do { if ((t) < ntile) glds16(P + (size_t)att_keyrow(b, t0 + (t), nctx_tiles) * PW + koff, kdst + (slot) * AT_SLOTK); } while (0)
#define DMA_V(t, slot) do { if ((t) < ntile) { const bf16_t* vb_ = P + (size_t)att_keyrow(b, t0 + (t), nctx_tiles) * PW; \
        glds16(vb_ + voff0, vdst + (slot) * AT_SLOTV); glds16(vb_ + voff1, vdst + (slot) * AT_SLOTV + 8192); } } while (0)
    DMA_K(0, 0); DMA_V(0, 0); DMA_K(1, 1); DMA_K(2, 2); DMA_K(3, 3); DMA_V(1, 1);
    bf16x8 qr[4];
    { const bf16_t* qp = P + (size_t)(qrow0 + wave * 32 + r32) * PW + h * 128 + sub * 64 + hi * 8;
#pragma unroll
      for (int d0 = 0; d0 < 4; ++d0) qr[d0] = *(const bf16x8*)(qp + d0 * 16); }
    f32x16 o[4];
#pragma unroll
    for (int dg = 0; dg < 4; ++dg) o[dg] = (f32x16){};
    float l_reg = 0.f;
    f32x16 pA0, pA1, pB0, pB1; bf16x8 kf[8]; u32x4 pw0, pw1, pw2, pw3; s16x4 vlo[4], vhi[4];
    f32x16 zero16 = (f32x16){}; AT_PIN(zero16);
    int sl_prev = 0, sl_cur = 0, sl_next = 1;
#define ROT() do { sl_prev = sl_cur; sl_cur = sl_next; sl_next = (sl_next + 1) & 3; } while (0)
#define KLD(i, kp_) kf[i] = *(const LAS bf16x8*)((kp_) + ((i) >> 1) * 2048 + ((i) & 1) * 512)
#define PKW(Pv, i) cvt_pk_bf16(Pv[i], Pv[(i) + 1])
#define PAF(k) __builtin_bit_cast(bf16x8, pw##k)
#define VRD(i, vp_) do { vlo[(i) & 3] = vtr((vp_) + ((i) & 3) * 4096 + ((i) >> 2) * 1024); vhi[(i) & 3] = vtr((vp_) + ((i) & 3) * 4096 + ((i) >> 2) * 1024 + 512); } while (0)
#define VFR(i) (bf16x8){vlo[(i) & 3][0], vlo[(i) & 3][1], vlo[(i) & 3][2], vlo[(i) & 3][3], vhi[(i) & 3][0], vhi[(i) & 3][1], vhi[(i) & 3][2], vhi[(i) & 3][3]}
#define EX2(Cv, i) do { Cv[i] = __builtin_amdgcn_exp2f(Cv[i]); Cv[(i) + 1] = __builtin_amdgcn_exp2f(Cv[(i) + 1]); } while (0)
#define GAPA(MF, a0, a1, a2, a3, W0, W1, PW_) do { MF; sacc += a0; sacc += a1; sacc += a2; sacc += a3; W0; W1; AT_PIN(PW_); AT_PIN(sacc); AT_SBAR(); } while (0)
#define GAPB(i, PA_, Cx, ci, GL) do { o[(i) & 3] = MFMA32(PA_, VFR(i), o[(i) & 3]); EX2(Cx, ci); AT_PIN(Cx); \
        if ((i) + 2 < 16) VRD((i) + 2, vpp_); if ((GL) && (i) < 8) KLD(i, kpn_); AT_SBAR(); } while (0)
#define STEP(C0, C1, P0, P1, t, GL) do { AT_SBAR(); \
    const LAS unsigned char* vpp_ = vp0 + sl_prev * AT_SLOTV; const LAS unsigned char* kpn_ = kp0 + sl_next * AT_SLOTK; \
    float sacc = P0[0] + P0[1]; \
    GAPA(C0 = MFMA32(kf[0], qr[0], zero16), P0[2], P0[3], P0[4], P0[5],     pw0[0] = PKW(P0, 0),  pw0[1] = PKW(P0, 2),  pw0); \
    GAPA(C1 = MFMA32(kf[1], qr[0], zero16), P0[6], P0[7], P0[8], P0[9],     pw0[2] = PKW(P0, 4),  pw0[3] = PKW(P0, 6),  pw0); \
    GAPA(C0 = MFMA32(kf[2], qr[1], C0),     P0[10], P0[11], P0[12], P0[13], pw1[0] = PKW(P0, 8),  pw1[1] = PKW(P0, 10), pw1); \
    GAPA(C1 = MFMA32(kf[3], qr[1], C1),     P0[14], P0[15], P1[0], P1[1],   pw1[2] = PKW(P0, 12), pw1[3] = PKW(P0, 14), pw1); \
    GAPA(C0 = MFMA32(kf[4], qr[2], C0),     P1[2], P1[3], P1[4], P1[5],     pw2[0] = PKW(P1, 0),  pw2[1] = PKW(P1, 2),  pw2); \
    GAPA(C1 = MFMA32(kf[5], qr[2], C1),     P1[6], P1[7], P1[8], P1[9],     pw2[2] = PKW(P1, 4),  pw2[3] = PKW(P1, 6),  pw2); \
    VRD(0, vpp_); \
    GAPA(C0 = MFMA32(kf[6], qr[3], C0),     P1[10], P1[11], P1[12], P1[13], pw3[0] = PKW(P1, 8),  pw3[1] = PKW(P1, 10), pw3); \
    VRD(1, vpp_); \
    GAPA(C1 = MFMA32(kf[7], qr[3], C1),     P1[14], P1[15], 0.f, 0.f,       pw3[2] = PKW(P1, 12), pw3[3] = PKW(P1, 14), pw3); \
    l_reg += sacc; \
    DMA_K((t) + 4, sl_cur); DMA_V((t) + 2, (sl_next + 1) & 3); AT_SBAR(); \
    GAPB(0, PAF(0), C0, 0, GL);  GAPB(1, PAF(0), C0, 2, GL);  GAPB(2, PAF(0), C0, 4, GL);  GAPB(3, PAF(0), C0, 6, GL); \
    GAPB(4, PAF(1), C0, 8, GL);  GAPB(5, PAF(1), C0, 10, GL); GAPB(6, PAF(1), C0, 12, GL); GAPB(7, PAF(1), C0, 14, GL); \
    GAPB(8, PAF(2), C1, 0, GL);  GAPB(9, PAF(2), C1, 2, GL);  GAPB(10, PAF(2), C1, 4, GL); GAPB(11, PAF(2), C1, 6, GL); \
    GAPB(12, PAF(3), C1, 8, GL); GAPB(13, PAF(3), C1, 10, GL); GAPB(14, PAF(3), C1, 12, GL); GAPB(15, PAF(3), C1, 14, GL); \
    } while (0)
#define ENDW(tt) do { if ((tt) + 4 < ntile) { AT_WAIT_BAR(6); } else { AT_WAIT_BAR(0); } } while (0)
    AT_WAIT_BAR(0);
#pragma unroll
    for (int i = 0; i < 8; ++i) KLD(i, kp0);
    pA0 = MFMA32(kf[0], qr[0], zero16); pA1 = MFMA32(kf[1], qr[0], zero16); pA0 = MFMA32(kf[2], qr[1], pA0); pA1 = MFMA32(kf[3], qr[1], pA1);
    pA0 = MFMA32(kf[4], qr[2], pA0); pA1 = MFMA32(kf[5], qr[2], pA1); pA0 = MFMA32(kf[6], qr[3], pA0); pA1 = MFMA32(kf[7], qr[3], pA1);
#pragma unroll
    for (int r = 0; r < 16; ++r) { pA0[r] = __builtin_amdgcn_exp2f(pA0[r]); pA1[r] = __builtin_amdgcn_exp2f(pA1[r]); }
    AT_WAIT_BAR(0);
    DMA_K(4, 0); DMA_V(2, 2); ROT();
#pragma unroll
    for (int i = 0; i < 8; ++i) KLD(i, kp0 + sl_cur * AT_SLOTK);
    if (ntile > 4) { AT_WAIT_BAR(3); } else { AT_WAIT_BAR(0); }
    int t = 1;
    for (; t + 1 < ntile; t += 2) {
        STEP(pB0, pB1, pA0, pA1, t, true);     ENDW(t);     ROT();
        STEP(pA0, pA1, pB0, pB1, t + 1, (t + 2 < ntile)); ENDW(t + 1); ROT();
    }
    if (t < ntile) { STEP(pB0, pB1, pA0, pA1, t, false); ENDW(t); ROT();
#pragma unroll
        for (int r = 0; r < 16; ++r) { pA0[r] = pB0[r]; pA1[r] = pB1[r]; } }
    { float sacc = 0.f;
#pragma unroll
      for (int r = 0; r < 16; ++r) sacc += pA0[r] + pA1[r];
      l_reg += sacc;
      pw0 = (u32x4){PKW(pA0, 0), PKW(pA0, 2), PKW(pA0, 4), PKW(pA0, 6)}; pw1 = (u32x4){PKW(pA0, 8), PKW(pA0, 10), PKW(pA0, 12), PKW(pA0, 14)};
      pw2 = (u32x4){PKW(pA1, 0), PKW(pA1, 2), PKW(pA1, 4), PKW(pA1, 6)}; pw3 = (u32x4){PKW(pA1, 8), PKW(pA1, 10), PKW(pA1, 12), PKW(pA1, 14)};
      const LAS unsigned char* vpp_ = vp0 + sl_prev * AT_SLOTV;
#pragma unroll
      for (int i = 0; i < 16; ++i) { VRD(i, vpp_); const bf16x8 pa = (i >> 2) == 0 ? PAF(0) : (i >> 2) == 1 ? PAF(1) : (i >> 2) == 2 ? PAF(2) : PAF(3); o[i & 3] = MFMA32(pa, VFR(i), o[i & 3]); } }
    l_reg += __shfl_xor(l_reg, 32);
    const size_t part = (size_t)(ksp * 2 + sub) * NTOK;
    if (hi == 0) ((float*)(p->ws + WS_LA))[(part + qrow0 + wave * 32 + r32) * 4 + h] = l_reg;
    bf16_t* OA = (bf16_t*)(p->ws + WS_OA) + part * 512 + h * 128 + r32;
#pragma unroll
    for (int r = 0; r < 16; ++r) { bf16_t* orow = OA + (size_t)(qrow0 + wave * 32 + crow(r, hi)) * 512;
#pragma unroll
        for (int dg = 0; dg < 4; ++dg) orow[32 * dg] = (bf16_t)f2bf(o[dg][r]); }
    AT_WAIT_BAR(0);
#undef DMA_K
#undef DMA_V
#undef ROT
#undef KLD
#undef PKW
#undef PAF
#undef VRD
#undef VFR
#undef EX2
#undef GAPA
#undef GAPB
#undef STEP
#undef ENDW
}
__device__ __forceinline__ void phase_attention(PP p, int layer, LAS unsigned char* lds, int qsel) {
    int bid = blockIdx.x; asm volatile("" : "+s"(bid));
    if (bid < 16) gdn_scan_chain(p, lds, bid);
    constexpr int NBIG = 1792, NSMALL = 512;
    const int nlat = NBIG + NSMALL, nunits = nlat + (layer == 0 ? NB * 4 * 2 : 0);
    unsigned* ctr = (unsigned*)(p->ws + WS_CTL) + CW_ATTQ + layer * 64 + qsel * 32;
    volatile LAS unsigned* slot = (volatile LAS unsigned*)(lds + MISC_OFF) + 16;
    for (;;) {
        if (threadIdx.x == 0) *slot = __hip_atomic_fetch_add(ctr, 1u, __ATOMIC_RELAXED, __HIP_MEMORY_SCOPE_AGENT);
        __syncthreads();
        const int u = (int)__builtin_amdgcn_readfirstlane((int)*slot);
        if (u >= nunits) break;
        if (u < NBIG) { const int b = u >> 10, h = (u >> 8) & 3, sub = (u >> 7) & 1, ksp = (u >> 6) & 1, qb = u & 63; attn_unit(p, layer, lds, b, h, sub, b * SEQL + qb * 256, ksp * 130, 130, 4, ksp); }
        else if (u < nlat) { const int v = u - NBIG, sub = v >> 8, kq = (v >> 6) & 3, qb = v & 63; attn_unit(p, layer, lds, 1, 3, sub, SEQL + qb * 256, kq * 65, 65, 4, kq); }
        else { const int v = u - nlat, b = v >> 3, h = (v >> 1) & 3, sub = v & 1; attn_unit(p, layer, lds, b, h, sub, NLAT + b * CTXL, 0, 4, 4, 0); }
    }
}

__device__ __forceinline__ void phase_norm_router(PP p, int layer, LAS unsigned char* lds) {
    int tid = threadIdx.x, bid = blockIdx.x, gdim = gridDim.x; asm volatile("" : "+v"(tid), "+s"(bid), "+s"(gdim)); const int lane = tid & 63, wave = __builtin_amdgcn_readfirstlane(tid >> 6);
    const int T = layer == 0 ? NTOK : NLAT;
    LAS float* rw = (LAS float*)lds;
    LAS int* lcnt = (LAS int*)(lds + 131072);
    LAS int* lbase = lcnt + 32;
    LAS int* ent = lcnt + 64;
    const float* rwg = p->in[I_RW] + (size_t)layer * D * NEXP;
    for (int i = tid; i < NEXP * 1024; i += NTHR) { const int k = i >> 5, e = i & 31; rw[e * 1024 + k] = rwg[(size_t)k * NEXP + e]; }
    if (tid < 64) lcnt[tid] = 0;
    __syncthreads();
    const float* cf = (const float*)(p->ws + WS_CONST);
    const float* gn = p->in[I_NFFNG] + layer * D;
    const float rb = lane < NEXP ? p->in[I_RB][layer * NEXP + lane] : 0.f;
    const int rpw = (T + gdim - 1) / gdim;
    const int r0 = bid * rpw, r1 = (r0 + rpw < T) ? r0 + rpw : T;
    int* tope = (int*)(p->ws + WS_RT + RT_TOPE); float* gate = (float*)(p->ws + WS_RT + RT_GATE); int* rank = (int*)(p->ws + WS_RT + RT_RANK);
    const bf16_t* H = (const bf16_t*)(p->ws + WS_H);
    for (int r = r0 + wave; r < r1; r += NWAVES) {
        const float* mv = cf + CF_MODV + (layer * 3 + mod_sel(r)) * 6144;
        f32x4 u[4];
#pragma unroll
        for (int j = 0; j < 4; ++j) { const u32x2 w_ = *(const u32x2*)(H + (size_t)r * D + 4 * lane + 256 * j); u[j] = (f32x4){bflo(w_.x), bfhi(w_.x), bflo(w_.y), bfhi(w_.y)}; }
        norm_mod_vals(gn, mv + 3 * 1024, mv + 4 * 1024, lane, u);
        store_row_bf16((bf16_t*)(p->ws + WS_U) + (size_t)r * D, lane, u);
        float logit = -INFINITY;
#pragma unroll 4
        for (int e = 0; e < NEXP; ++e) { float s = 0.f;
#pragma unroll
            for (int q = 0; q < 4; ++q) { const f32x4 w = *(const LAS f32x4*)(rw + e * 1024 + 4 * lane + 256 * q); s += (u[q][0] * w[0] + u[q][1] * w[1]) + (u[q][2] * w[2] + u[q][3] * w[3]); }
            s = wave_sum(s); if (lane == e) logit = s + rb; }
        float tl[4]; int te[4];
#pragma unroll
        for (int k = 0; k < 4; ++k) { const float m = wave_max(logit); const unsigned long long bal = __ballot(logit == m); const int idx = __ffsll((long long)bal) - 1;
            tl[k] = m; te[k] = idx; if (lane == idx) logit = -INFINITY; }
        const float e1 = __expf(tl[1] - tl[0]), e2 = __expf(tl[2] - tl[0]), e3 = __expf(tl[3] - tl[0]); const float inv = 1.f / (1.f + e1 + e2 + e3);
        if (lane < 4) { const int e = lane == 0 ? te[0] : lane == 1 ? te[1] : lane == 2 ? te[2] : te[3]; const float gv = (lane == 0 ? 1.f : lane == 1 ? e1 : lane == 2 ? e2 : e3) * inv;
            const int lr = atomicAdd((int*)&lcnt[e], 1);
            ent[(r - r0) * 4 + lane] = (e << 20) | lr; tope[(size_t)r * 4 + lane] = e; gate[(size_t)r * 4 + lane] = gv; }
    }
    __syncthreads();
    if (tid < NEXP) lbase[tid] = (int)atomicAdd((unsigned*)(p->ws + WS_CTL) + CW_CNT + layer * 64 + tid, (unsigned)lcnt[tid]);
    __syncthreads();
    for (int i = tid; i < (r1 - r0) * 4; i += NTHR) { const int v = ent[i]; rank[(size_t)r0 * 4 + i] = lbase[v >> 20] + (v & 0xfffff); }
}

__device__ __forceinline__ void phase_moe_gather(PP p, int layer, LAS unsigned char* lds) {
    int tid = threadIdx.x, bid = blockIdx.x, gdim = gridDim.x; asm volatile("" : "+v"(tid), "+s"(bid), "+s"(gdim)); const int lane = tid & 63, wave = __builtin_amdgcn_readfirstlane(tid >> 6);
    const int T = layer == 0 ? NTOK : NLAT;
    LAS int* pstart = (LAS int*)lds; LAS int* cnt = pstart + 64;
    const unsigned* gcnt = (const unsigned*)(p->ws + WS_CTL) + CW_CNT + layer * 64;
    int* mt = (int*)(p->ws + WS_CONST) + CF_MOE + layer * 1024;
    if (tid == 0) { int acc = 0; for (int e = 0; e < NEXP; ++e) { const int c = (int)__hip_atomic_load(gcnt + e, __ATOMIC_RELAXED, __HIP_MEMORY_SCOPE_AGENT); cnt[e] = c; pstart[e] = acc; acc += (c + 255) & ~255; } pstart[NEXP] = acc; }
    __syncthreads();
    if (bid == 0) {
        if (tid < NEXP) { mt[tid] = pstart[tid]; mt[64 + tid] = cnt[tid]; }
        if (tid == 0) mt[32] = pstart[NEXP] >> 8;
        for (int e = 0; e < NEXP; ++e) { const int b0 = pstart[e] >> 8, b1 = pstart[e + 1] >> 8; for (int bb = b0 + tid; bb < b1; bb += NTHR) mt[128 + bb] = e; }
    }
    const int* tope = (const int*)(p->ws + WS_RT + RT_TOPE); const float* gate = (const float*)(p->ws + WS_RT + RT_GATE); const int* rank = (const int*)(p->ws + WS_RT + RT_RANK);
    int* slot = (int*)(p->ws + WS_RT + RT_SLOT); float* sgate = (float*)(p->ws + WS_RT + RT_SGATE); int* stok = (int*)(p->ws + WS_RT + RT_STOK);
    const int gt = bid * NTHR + tid, NGT = gdim * NTHR;
    for (int a = gt; a < T * 4; a += NGT) {
        const int e = tope[a]; const int s = pstart[e] + rank[a];
        slot[a] = s; sgate[s] = gate[a]; stok[s] = a >> 2;
    }
    for (int e = 0; e < NEXP; ++e) { const int s0 = pstart[e] + cnt[e], s1 = pstart[e + 1];
        for (int s = s0 + gt; s < s1; s += NGT) { stok[s] = 0; sgate[s] = 0.f; } }
}

__device__ __forceinline__ void phase_moe_combine(PP p, int layer, LAS unsigned char* lds) {
    int tid = threadIdx.x, bid = blockIdx.x, gdim = gridDim.x; asm volatile("" : "+v"(tid), "+s"(bid), "+s"(gdim)); const int lane = tid & 63, wave = __builtin_amdgcn_readfirstlane(tid >> 6);
    const int T = layer == 0 ? NTOK : NLAT;
    const float* cf = (const float*)(p->ws + WS_CONST); const int* slot = (const int*)(p->ws + WS_RT + RT_SLOT); const bf16_t* Y = (const bf16_t*)(p->ws + WS_Y);
    bf16_t* H = (bf16_t*)(p->ws + WS_H);
    LAS float* wab = (LAS float*)lds; float ea = 0.f, dtb = 0.f;
    if (layer == 0) { norm_mix_stage_wab(p, 1, wab, tid); __syncthreads(); if (lane < 8) { ea = -__expf(p->in[I_ALOG][8 + lane]); dtb = p->in[I_DTB][8 + lane]; } }
    for (int r = bid * NWAVES + wave; r < T; r += gdim * NWAVES) {
        const float* g5 = cf + CF_MODV + (layer * 3 + mod_sel(r)) * 6144 + 5 * 1024;
        bf16_t* hrow = H + (size_t)r * D;
        const int s0 = slot[r * 4], s1 = slot[r * 4 + 1], s2 = slot[r * 4 + 2], s3 = slot[r * 4 + 3];
        f32x4 hn[4];
#pragma unroll
        for (int j = 0; j < 4; ++j) { const int c = 4 * lane + 256 * j;
            const u32x2 a = *(const u32x2*)(Y + (size_t)s0 * D + c), b2 = *(const u32x2*)(Y + (size_t)s1 * D + c), c2 = *(const u32x2*)(Y + (size_t)s2 * D + c), d2 = *(const u32x2*)(Y + (size_t)s3 * D + c);
            f32x4 y; y[0] = (bflo(a.x) + bflo(b2.x)) + (bflo(c2.x) + bflo(d2.x)); y[1] = (bfhi(a.x) + bfhi(b2.x)) + (bfhi(c2.x) + bfhi(d2.x));
            y[2] = (bflo(a.y) + bflo(b2.y)) + (bflo(c2.y) + bflo(d2.y)); y[3] = (bfhi(a.y) + bfhi(b2.y)) + (bfhi(c2.y) + bfhi(d2.y));
            const u32x2 hw = *(const u32x2*)(hrow + c); const f32x4 hv = (f32x4){bflo(hw.x), bfhi(hw.x), bflo(hw.y), bfhi(hw.y)}, gv = *(const f32x4*)(g5 + c);
            hn[j] = hv + gv * y;
            if (layer == 0) { u32x2 w; w.x = cvt_pk_bf16(hn[j][0], hn[j][1]); w.y = cvt_pk_bf16(hn[j][2], hn[j][3]); *(u32x2*)(hrow + c) = w; }
            else *(f32x4*)(p->out + (size_t)r * D + c) = hn[j]; }
        if (layer == 0) norm_mix_row(p, 1, r, lane, hn, wab, ea, dtb);
    }
}

constexpr int NPH = 27;
#ifndef PH_MASK
#define PH_MASK 0xFFFF
#endif
#define IN(k) (lo <= (k) && (k) < hi)
#define EN(i) ((PH_MASK >> (i)) & 1)
#ifndef DUP_PH
#define DUP_PH -1
#endif
#define REP(i) for (int rep_ = 0; rep_ < ((DUP_PH == (i) && l == 0) ? 2 : 1); ++rep_)
#define SEAM(k) do { if (IN(k) && IN((k) + 1)) xcd_barrier(bar); } while (0)
#define LAUNDER() PP p = p0; LAS unsigned char* lds = lds0; int bid = blockIdx.x, gdim = gridDim.x; asm volatile("" : "+s"(p), "+s"(lds), "+s"(bid), "+s"(gdim))
template <int l> __device__ __forceinline__ void run_layer(PP p0, LAS unsigned char* lds0, const int lo, const int hi, const XcdBarrier& bar) {
        const int base = 1 + 13 * l;
        if (l == 0) { if (EN(1) && IN(base + 0)) REP(1) { LAUNDER(); phase_norm_mix(p, l, lds); __syncthreads(); }
            SEAM(base + 0); }
        if (EN(2) && IN(base + 1)) REP(2) { LAUNDER();
            PlainSched S; S.init(p->ws + WS_U, p->ws + WS_WIN + (size_t)l * PW * 1024 * 2, 1024, NTOK / 256, PW / 256, gdim, bid);
            EpiStoreBf16 E{(bf16_t*)(p->ws + WS_P), PW};
            pg8::gemm_phase<EpiStoreBf16, PlainSched>(lds, 1024, S, E);
        }
        SEAM(base + 1);
        if (EN(3) && IN(base + 2)) REP(3) { LAUNDER(); phase_prep(p, l); }
        SEAM(base + 2);
        if (EN(5) && IN(base + 3)) REP(5) { LAUNDER(); phase_gdn_chunk(p, lds); }
        SEAM(base + 3);
        if (EN(4) && IN(base + 4)) REP(4) { LAUNDER(); phase_attention(p, l, lds, rep_); }
        SEAM(base + 4);
        if (EN(7) && IN(base + 6)) REP(7) { LAUNDER(); phase_gdn_out(p, l); }
        SEAM(base + 6);
        if (EN(8) && IN(base + 7)) REP(8) { LAUNDER();
            const int T = l == 0 ? NTOK : NLAT;
            const float* cf = (const float*)(p->ws + WS_CONST);
            PlainSched S; S.init(p->ws + WS_MIX, p->ws + WS_WOUT + (size_t)l * D * 1024 * 2, 1024, T / 256, D / 256, gdim, bid);
            EpiResidual E{p, l, cf + CF_MODV + (l * 3) * 6144 + 2 * 1024};
            pg8::gemm_phase<EpiResidual, PlainSched>(lds, 1024, S, E);
        }
        SEAM(base + 7);
        if (EN(9) && IN(base + 8)) REP(9) { LAUNDER(); phase_norm_router(p, l, lds); __syncthreads(); }
        SEAM(base + 8);
        if (EN(10) && IN(base + 9)) REP(10) { LAUNDER(); phase_moe_gather(p, l, lds); __syncthreads(); }
        SEAM(base + 9);
        if (EN(11) && IN(base + 10)) REP(11) { LAUNDER();
            const int* mt = (const int*)(p->ws + WS_CONST) + CF_MOE + l * 1024;
            MoeSched S{(const char*)(p->ws + WS_U), (const char*)(p->ws + WS_WGU + (size_t)l * NEXP * 2048 * 1024 * 2), mt + 128, mt[32], 8, gdim, bid, (const int*)(p->ws + WS_RT + RT_STOK)};
            EpiGateUp E{(bf16_t*)(p->ws + WS_ACT), p->in[I_BGU] + (size_t)l * NEXP * 2048, mt + 128};
            pg8::gemm_phase<EpiGateUp, MoeSched, true>(lds, 1024, S, E);
        }
        SEAM(base + 10);
        if (EN(12) && IN(base + 11)) REP(12) { LAUNDER();
            const int* mt = (const int*)(p->ws + WS_CONST) + CF_MOE + l * 1024;
            MoeSched S{(const char*)(p->ws + WS_ACT), (const char*)(p->ws + WS_WD + (size_t)l * NEXP * 1024 * 1024 * 2), mt + 128, mt[32], 4, gdim, bid, nullptr};
            EpiDown E{(bf16_t*)(p->ws + WS_Y), p->in[I_BD] + (size_t)l * NEXP * 1024, mt + 128, (const float*)(p->ws + WS_RT + RT_SGATE)};
            pg8::gemm_phase<EpiDown, MoeSched>(lds, 1024, S, E);
        }
        SEAM(base + 11);
        if (EN(13) && IN(base + 12)) { LAUNDER(); phase_moe_combine(p, l, lds); __syncthreads(); }
        SEAM(base + 12);
    }

__global__ void __launch_bounds__(NTHR, 2) mega_fwd(Params p_by_value) {
    extern __shared__ __attribute__((aligned(16))) unsigned char lds_raw[];
    LAS unsigned char* lds0 = (LAS unsigned char*)lds_raw;
    PP p0 = (PP)__builtin_amdgcn_kernarg_segment_ptr();
    volatile LAS unsigned* MISC = (volatile LAS unsigned*)(lds0 + MISC_OFF);
    if (threadIdx.x < 64) MISC[threadIdx.x] = 0u;
    __syncthreads();
    const int lo = p0->ph_lo, hi = p0->ph_hi;
    XcdBarrier bar; bar.bar = (unsigned*)(p0->ws + WS_CTL) + CW_BAR; bar.x = 0; bar.st = nullptr;
    if (hi - lo > 1) bar = xcd_barrier_post((unsigned*)(p0->ws + WS_CTL) + CW_BAR, MISC + 8);
    if (EN(0) && IN(0)) for (int rep_ = 0; rep_ < (DUP_PH == 0 ? 2 : 1); ++rep_) { LAUNDER(); phase_prologue(p, lds); __syncthreads(); }
    SEAM(0);
    run_layer<0>(p0, lds0, lo, hi, bar);
    run_layer<1>(p0, lds0, lo, hi, bar);
#undef IN
#undef SEAM
}

extern "C" void kernel_launch(void* const* d_in, const int* in_sizes, int n_in, void* d_out, int out_size, void* d_ws, size_t ws_size, hipStream_t stream) {
    static int grid = 0;
    if (grid == 0) {
        if (n_in != 27 || out_size != NLAT * D || ws_size < WS_END) { fprintf(stderr, "kernel_launch: unexpected problem (n_in %d, out %d, ws %zu < %zu)\n", n_in, out_size, ws_size, (size_t)WS_END); grid = -1; return; }
        int dev = 0, cus = 0, per_cu = 0;
        if (hipGetDevice(&dev) != hipSuccess || hipDeviceGetAttribute(&cus, hipDeviceAttributeMultiprocessorCount, dev) != hipSuccess) { grid = -1; return; }
        if (hipFuncSetAttribute((const void*)mega_fwd, hipFuncAttributeMaxDynamicSharedMemorySize, LDS_BYTES) != hipSuccess) { fprintf(stderr, "kernel_launch: hipFuncSetAttribute failed\n"); grid = -1; return; }
        if (hipOccupancyMaxActiveBlocksPerMultiprocessor(&per_cu, (const void*)mega_fwd, NTHR, LDS_BYTES) != hipSuccess || per_cu < 1) { fprintf(stderr, "kernel_launch: occupancy query says %d\n", per_cu); }
        (void)hipGetLastError();
        grid = cus;
    }
    if (grid < 0) return;
    hipMemsetAsync((char*)d_ws + WS_CTL, 0, CTL_ZERO_BYTES, stream);
    Params p{};
    for (int i = 0; i < 27; ++i) p.in[i] = (const float*)d_in[i];
    p.out = (float*)d_out; p.ws = (unsigned char*)d_ws;
#if MK_PER_PHASE
    for (int ph = 0; ph < NPH; ++ph) { p.ph_lo = ph; p.ph_hi = ph + 1; hipLaunchKernelGGL(mega_fwd, dim3(grid), dim3(NTHR), LDS_BYTES, stream, p); }
#else
    p.ph_lo = 0; p.ph_hi = NPH;
    hipLaunchKernelGGL(mega_fwd, dim3(grid), dim3(NTHR), LDS_BYTES, stream, p);
#endif
}
```

```cpp
#include <hip/hip_runtime.h>
#include <cstdio>
#include <cstdint>

#ifndef MK_PER_PHASE
#define MK_PER_PHASE 0
#endif

#define LAS __attribute__((address_space(3)))
#define GAS __attribute__((address_space(1)))
typedef unsigned short bf16_t;
typedef short bf16x8 __attribute__((ext_vector_type(8)));
typedef short s16x4 __attribute__((ext_vector_type(4)));
typedef float f32x2 __attribute__((ext_vector_type(2)));
typedef float f32x4 __attribute__((ext_vector_type(4)));
typedef float f32x16 __attribute__((ext_vector_type(16)));
typedef unsigned u32x2 __attribute__((ext_vector_type(2)));
typedef unsigned u32x4 __attribute__((ext_vector_type(4)));

constexpr int D = 1024, NB = 2, SEQL = 16384, CTXL = 256;
constexpr int NLAT = NB * SEQL, NCTX = NB * CTXL, NTOK = NLAT + NCTX;
constexpr int PW = 3584, INC = 3600;
constexpr int NEXP = 32, MAXBLK = 552, MAXSLOT = MAXBLK * 256;
constexpr int NCHUNK = 260, NTASK = 16 * NCHUNK;
constexpr float EPS = 1e-6f;
constexpr float LOG2E = 1.4426950408889634f;
constexpr int NWAVES = 8, NTHR = 512;

constexpr size_t MiB = 1u << 20;
constexpr size_t WS_CTL = 0, CTL_ZERO_BYTES = 1 * MiB;
constexpr size_t WS_CONST = 1 * MiB;
constexpr size_t WS_WIN = 2 * MiB;
constexpr size_t WS_WOUT = 16 * MiB;
constexpr size_t WS_WGU = 20 * MiB;
constexpr size_t WS_WD = 276 * MiB;
constexpr size_t WS_H = 404 * MiB;
constexpr size_t WS_U = 534 * MiB;
constexpr size_t WS_GB = 599 * MiB;
constexpr size_t WS_MIX = 602 * MiB;
constexpr size_t WS_RT = 667 * MiB;
constexpr size_t WS_BIG = 671 * MiB;
constexpr size_t WS_P = WS_BIG;
constexpr size_t WS_G = WS_P + 228 * MiB;
constexpr size_t WS_CH = WS_G + 98 * MiB;
constexpr size_t WS_OG = WS_CH + 358 * MiB;
constexpr size_t WS_OA = WS_OG + 130 * MiB;
constexpr size_t WS_LA = WS_OA + 260 * MiB;
constexpr size_t WS_END = WS_LA + 5 * MiB;
constexpr size_t WS_XS = WS_BIG;
constexpr size_t WS_ACT = WS_BIG + 276 * MiB;
constexpr size_t WS_Y = WS_XS;
static_assert(WS_ACT + 276 * MiB <= WS_END, "moe overlay");
constexpr size_t CH_TASK_BYTES = 90112;
constexpr int CH_WF = 0, CH_QF = 16384, CH_AF = 32768, CH_KF = 40960, CH_UC = 57344, CH_DMA_BYTES = 57344;
static_assert((size_t)NTASK * CH_TASK_BYTES <= 358 * MiB, "chunk buffers");

constexpr int CW_BAR = 4096;
constexpr int CW_CNT = 16384;
constexpr int CW_ATTQ = 20480;
constexpr int CF_MODV = 0;
constexpr int CF_ROPE = 40960;
constexpr int CF_SC = 53248;
constexpr int CF_EGL = 53504;
constexpr int CF_MOE = 61440;
constexpr size_t RT_TOPE = 0, RT_GATE = 640 * 1024, RT_RANK = 1280 * 1024, RT_SLOT = 1920 * 1024, RT_SGATE = 2560 * 1024, RT_STOK = 3200 * 1024;

constexpr int LDS_BYTES = 147456;
constexpr int MISC_OFF = 143 * 1024;
static_assert(MISC_OFF + 256 <= LDS_BYTES, "lds");

__device__ __forceinline__ unsigned f2bf(float f) { unsigned u = __builtin_bit_cast(unsigned, f); return (u + 0x7fffu + ((u >> 16) & 1u)) >> 16; }
__device__ __forceinline__ unsigned pk2(float lo, float hi) { return f2bf(lo) | (f2bf(hi) << 16); }
__device__ __forceinline__ float bf2f(unsigned short b) { return __builtin_bit_cast(float, (unsigned)b << 16); }
__device__ __forceinline__ float bflo(unsigned w) { return __builtin_bit_cast(float, w << 16); }
__device__ __forceinline__ float bfhi(unsigned w) { return __builtin_bit_cast(float, w & 0xffff0000u); }
__device__ __forceinline__ unsigned cvt_pk_bf16(float lo, float hi) { unsigned r; asm volatile("v_cvt_pk_bf16_f32 %0, %1, %2" : "=v"(r) : "v"(lo), "v"(hi)); return r; }
typedef float f32x2c_t __attribute__((ext_vector_type(2)));
typedef __bf16 bf16x2c_t __attribute__((ext_vector_type(2)));
__device__ __forceinline__ unsigned cvt_pk_bf16_c(float lo, float hi) { const f32x2c_t v = {lo, hi}; const bf16x2c_t b = __builtin_convertvector(v, bf16x2c_t); return __builtin_bit_cast(unsigned, b); }
__device__ __forceinline__ float wave_sum(float v) {
#pragma unroll
    for (int o = 1; o < 64; o <<= 1) v += __shfl_xor(v, o);
    return v;
}
__device__ __forceinline__ float wave_max(float v) {
#pragma unroll
    for (int o = 1; o < 64; o <<= 1) v = fmaxf(v, __shfl_xor(v, o));
    return v;
}
__device__ __forceinline__ float silu_f(float x) { return x / (1.f + __expf(-x)); }
__device__ __forceinline__ int crow(int r, int hi) { return (r & 3) + 8 * (r >> 2) + 4 * hi; }
__device__ __forceinline__ void glds16(const void* g, unsigned lds_base) {
    unsigned sv; asm volatile("s_mov_b32 %0, m0\n\ts_mov_b32 m0, %2\n\ts_nop 0\n\tglobal_load_lds_dwordx4 %1, off\n\ts_mov_b32 m0, %0" : "=&s"(sv) : "v"(g), "s"((unsigned)__builtin_amdgcn_readfirstlane((int)lds_base)) : "memory"); }
__device__ __forceinline__ unsigned lds_addr(const LAS void* q) { return (unsigned)__builtin_amdgcn_readfirstlane((int)(unsigned)(uintptr_t)q); }
#define LDS_WAIT() asm volatile("s_waitcnt lgkmcnt(0)" ::: "memory")
#define VM_WAIT() asm volatile("s_waitcnt vmcnt(0)" ::: "memory")
#define MFMA32(a, b, c) __builtin_amdgcn_mfma_f32_32x32x16_bf16(a, b, c, 0, 0, 0)

namespace pg8 {
constexpr int BM = 256, BK = 64, HALF = 128, HTB = HALF * BK * 2, STAGE_BYTES = 8 * HTB;
__host__ __device__ __forceinline__ int lds_byte(int r, int c) { const int st = (r >> 4) * 2 + (c >> 5), rr = r & 15, cc = c & 31, ob = rr * 64 + cc * 2; return st * 1024 + (ob ^ (((ob >> 9) & 1) << 5)); }
__host__ __device__ __forceinline__ void stage_rc(int b, int& R, int& C) { const int st = b / 1024, sb = b % 1024, swz = sb ^ (((sb >> 9) & 1) << 5); R = (st >> 1) * 16 + swz / 64; C = (st & 1) * 32 + (swz % 64) / 2; }
__host__ __device__ __forceinline__ int perm32(int rho) { const int n = rho >> 4, i = rho & 15; return 8 * (i >> 2) + 4 * n + (i & 3); }
struct Unit { int pm, pn; };
template <class Epi, class Sched, bool GA = false>
__device__ __forceinline__ void gemm_phase(LAS unsigned char* lds, const int K, const Sched& S, const Epi& E) {
    int tid = threadIdx.x, bid = blockIdx.x, gdim = gridDim.x; asm volatile("" : "+v"(tid), "+s"(bid), "+s"(gdim)); const int wid = __builtin_amdgcn_readfirstlane(tid >> 6), lane = tid & 63, wr = wid >> 2, wc = wid & 3, fr = lane & 15, fq = lane >> 4;
    const int nt = K / BK;
    unsigned voffA[2], voffB[2], colA2[2]; int rowA[2];
    unsigned vAc[2][2], vAn[2][2], vAnn[2][2];
#pragma unroll
    for (int i = 0; i < 2; ++i) { int R, C; stage_rc(tid * 16 + i * 8192, R, C); const int Rb = Epi::PERM ? ((R & ~31) + perm32(R & 31)) : R;
        voffA[i] = (unsigned)(R * K + C) * 2u; voffB[i] = (unsigned)(Rb * K + C) * 2u; rowA[i] = R; colA2[i] = (unsigned)C * 2u; }
    const size_t kstep = (size_t)(BK * 2);
    const size_t hstep = (size_t)HALF * K * 2;
    const unsigned ldsw = (unsigned)wid * 1024u;
    const int aoff = lds_byte(wr * 64 + fr, fq * 8), boff = lds_byte(wc * 32 + fr, fq * 8);
#define PG8_SA(b, h) (((b) * 2 + (h)) * HTB)
#define PG8_SB(b, h) ((4 + (b) * 2 + (h)) * HTB)
#define PG8_STAGE(bufoff, gbase, voff) do { _Pragma("unroll") for (int _i = 0; _i < 2; ++_i) \
        __builtin_amdgcn_global_load_lds((const unsigned*)((const char*)(gbase) + (voff)[_i]), (LAS unsigned*)(lds + (bufoff) + ldsw + _i * 8192), 16, 0, 0); } while (0)
#define PG8_TOK(v, u) do { if constexpr (GA) { const int* tk_ = S.atok(u); _Pragma("unroll") for (int h_ = 0; h_ < 2; ++h_) _Pragma("unroll") for (int i_ = 0; i_ < 2; ++i_) v[h_][i_] = (unsigned)tk_[rowA[i_] + 128 * h_] * (unsigned)(K * 2) + colA2[i_]; } } while (0)
#define PG8_STAGE_A(bufoff, gptr, koff, half, nx) do { if constexpr (GA) { const char* gb_ = S.abase() + (koff); _Pragma("unroll") for (int _i = 0; _i < 2; ++_i) { const unsigned vo_ = (nx) ? vAn[half][_i] : vAc[half][_i]; \
        __builtin_amdgcn_global_load_lds((const unsigned*)(gb_ + vo_), (LAS unsigned*)(lds + (bufoff) + ldsw + _i * 8192), 16, 0, 0); } } else { PG8_STAGE(bufoff, (gptr) + (half) * hstep, voffA); } } while (0)
#define PG8_LDA(dst, b, h) do { _Pragma("unroll") for (int m = 0; m < 4; ++m) _Pragma("unroll") for (int k = 0; k < 2; ++k) dst[m][k] = *(const LAS bf16x8*)(lds + PG8_SA(b, h) + aoff + m * 2048 + k * 1024); } while (0)
#define PG8_LDB(dst, b, h) do { _Pragma("unroll") for (int n = 0; n < 2; ++n) _Pragma("unroll") for (int k = 0; k < 2; ++k) dst[n][k] = *(const LAS bf16x8*)(lds + PG8_SB(b, h) + boff + n * 2048 + k * 1024); } while (0)
#define PG8_MMA(ai, bj, At, Bt) do { __builtin_amdgcn_s_setprio(1); _Pragma("unroll") for (int m = 0; m < 4; ++m) _Pragma("unroll") for (int n = 0; n < 2; ++n) _Pragma("unroll") for (int k = 0; k < 2; ++k) \
        acc[ai][bj][m][n] = __builtin_amdgcn_mfma_f32_16x16x32_bf16(Bt[n][k], At[m][k], acc[ai][bj][m][n], 0, 0, 0); __builtin_amdgcn_s_setprio(0); } while (0)
#define PG8_WAIT_V(n) asm volatile("s_waitcnt vmcnt(" #n ")" ::: "memory")
#define PG8_WAIT_L(n) asm volatile("s_waitcnt lgkmcnt(" #n ")" ::: "memory")
#define PG8_BAR __builtin_amdgcn_s_barrier()
#define PG8_SCHED __builtin_amdgcn_sched_barrier(0)
    Unit cur, nxt; int ui = 0;
    if (!S.next(0, cur)) return;
    f32x4 acc[2][2][4][2];
#pragma unroll
    for (int a = 0; a < 2; ++a)
#pragma unroll
        for (int b = 0; b < 2; ++b)
#pragma unroll
            for (int m = 0; m < 4; ++m)
#pragma unroll
                for (int n = 0; n < 2; ++n) acc[a][b][m][n] = (f32x4){0.f, 0.f, 0.f, 0.f};
    bf16x8 At[4][2], B0[2][2], B1[2][2];
    const char* cA = S.aptr(cur); const char* cB = S.bptr(cur);
    PG8_TOK(vAc, cur);
    if constexpr (GA) { Unit u1_; if (S.next(1, u1_)) { PG8_TOK(vAn, u1_); } else { _Pragma("unroll") for (int h_ = 0; h_ < 2; ++h_) _Pragma("unroll") for (int i_ = 0; i_ < 2; ++i_) vAn[h_][i_] = vAc[h_][i_]; } }
    PG8_STAGE(PG8_SB(0, 0), cB, voffB); PG8_STAGE_A(PG8_SA(0, 0), cA, 0, 0, false); PG8_STAGE(PG8_SB(0, 1), cB + hstep, voffB); PG8_STAGE_A(PG8_SA(0, 1), cA, 0, 1, false);
    if (wr == 1) PG8_BAR;
    PG8_WAIT_V(4); PG8_BAR;
    PG8_STAGE(PG8_SB(1, 0), cB + kstep, voffB); PG8_STAGE_A(PG8_SA(1, 0), cA + kstep, kstep, 0, false); PG8_STAGE(PG8_SB(1, 1), cB + hstep + kstep, voffB);
    PG8_WAIT_V(6); PG8_BAR;
    for (;;) {
        const bool has_next = S.next(ui + 1, nxt);
        const char* nA = has_next ? S.aptr(nxt) : cA; const char* nB = has_next ? S.bptr(nxt) : cB;
        for (int t = 0; t < nt; t += 2) {
            const bool last = (t == nt - 2);
            const char* a1 = cA + (size_t)(t + 1) * kstep;
            const char* a2 = last ? nA : cA + (size_t)(t + 2) * kstep; const char* b2 = last ? nB : cB + (size_t)(t + 2) * kstep;
            const char* a3 = a2 + kstep; const char* b3 = b2 + kstep;
            const size_t k1 = (size_t)(t + 1) * kstep, k2 = last ? 0 : (size_t)(t + 2) * kstep, k3 = k2 + kstep;
            PG8_LDB(B0, 0, 0); PG8_SCHED; PG8_LDA(At, 0, 0); PG8_STAGE_A(PG8_SA(1, 1), a1, k1, 1, false);
            PG8_WAIT_L(8); PG8_BAR; PG8_WAIT_L(0); PG8_MMA(0, 0, At, B0); PG8_BAR; PG8_SCHED;
            PG8_LDB(B1, 0, 1); PG8_STAGE(PG8_SB(0, 0), b2, voffB);
            PG8_BAR; PG8_WAIT_L(0); PG8_MMA(0, 1, At, B1); PG8_BAR;
            PG8_LDA(At, 0, 1); PG8_STAGE_A(PG8_SA(0, 0), a2, k2, 0, last);
            PG8_BAR; PG8_WAIT_L(0); PG8_MMA(1, 0, At, B0); PG8_BAR; PG8_SCHED;
            PG8_STAGE(PG8_SB(0, 1), b2 + hstep, voffB);
            PG8_WAIT_V(6); PG8_BAR; PG8_MMA(1, 1, At, B1); PG8_BAR;
            PG8_LDB(B0, 1, 0); PG8_SCHED; PG8_LDA(At, 1, 0); PG8_STAGE_A(PG8_SA(0, 1), a2, k2, 1, last);
            PG8_WAIT_L(8); PG8_BAR; PG8_WAIT_L(0); PG8_MMA(0, 0, At, B0); PG8_BAR; PG8_SCHED;
            PG8_LDB(B1, 1, 1); PG8_STAGE(PG8_SB(1, 0), b3, voffB);
            PG8_BAR; PG8_WAIT_L(0); PG8_MMA(0, 1, At, B1); PG8_BAR;
            PG8_LDA(At, 1, 1); PG8_STAGE_A(PG8_SA(1, 0), a3, k3, 0, last);
            PG8_BAR; PG8_WAIT_L(0); PG8_MMA(1, 0, At, B0); PG8_BAR; PG8_SCHED;
            PG8_STAGE(PG8_SB(1, 1), b3 + hstep, voffB);
            PG8_WAIT_V(6); PG8_BAR; PG8_MMA(1, 1, At, B1); PG8_BAR;
        }
        E(acc, cur, wr, wc, fr, fq);
        if (!has_next) break;
        if constexpr (GA) { Unit u2_; if (S.next(ui + 2, u2_)) { PG8_TOK(vAnn, u2_); } else { _Pragma("unroll") for (int h_ = 0; h_ < 2; ++h_) _Pragma("unroll") for (int i_ = 0; i_ < 2; ++i_) vAnn[h_][i_] = vAn[h_][i_]; } }
#pragma unroll
        for (int a = 0; a < 2; ++a)
#pragma unroll
            for (int b = 0; b < 2; ++b)
#pragma unroll
                for (int m = 0; m < 4; ++m)
#pragma unroll
                    for (int n = 0; n < 2; ++n) acc[a][b][m][n] = (f32x4){0.f, 0.f, 0.f, 0.f};
        cur = nxt; cA = nA; cB = nB; ++ui;
        if constexpr (GA) { _Pragma("unroll") for (int h_ = 0; h_ < 2; ++h_) _Pragma("unroll") for (int i_ = 0; i_ < 2; ++i_) { vAc[h_][i_] = vAn[h_][i_]; vAn[h_][i_] = vAnn[h_][i_]; } }
    }
    PG8_WAIT_V(0);
    if (wr == 0) PG8_BAR;
    PG8_BAR;
#undef PG8_SA
#undef PG8_SB
#undef PG8_STAGE
#undef PG8_STAGE_A
#undef PG8_TOK
#undef PG8_LDA
#undef PG8_LDB
#undef PG8_MMA
#undef PG8_WAIT_V
#undef PG8_WAIT_L
#undef PG8_BAR
#undef PG8_SCHED
}
}

#define XB_TMO      128
#define XB_XCNT(j)  (256  + 64 * (j))
#define XB_XSUB(j)  (1280 + 64 * (j))
#define XB_XGEN(j)  (2304 + 64 * (j))
#define XB_TOP      3328
#define XB_TOPGEN   3392
#define XCD_BAR_WORDS 3456
#define XB_SPIN_CAP (1u << 20)
__device__ __forceinline__ unsigned xb_ld(unsigned* p)              { return __hip_atomic_load(p, __ATOMIC_RELAXED, __HIP_MEMORY_SCOPE_AGENT); }
__device__ __forceinline__ unsigned xb_add(unsigned* p, unsigned v) { return __hip_atomic_fetch_add(p, v, __ATOMIC_RELAXED, __HIP_MEMORY_SCOPE_AGENT); }
__device__ __forceinline__ unsigned xb_xcc_id() { return (unsigned)__builtin_amdgcn_s_getreg((3 << 11) | 20) & 0xFu; }
#define XB_SPIN(cond, bar) do { unsigned _sp = 0; while (cond) { __builtin_amdgcn_s_sleep(1); \
    if ((++_sp & 255u) == 0u) { if (xb_ld(&(bar)[XB_TMO])) break; if (_sp > XB_SPIN_CAP) { atomicAdd(&(bar)[XB_TMO], 1u); break; } } } } while (0)
struct XcdBarrier { unsigned* bar; unsigned x; volatile LAS unsigned* st; };
__device__ __forceinline__ XcdBarrier xcd_barrier_post(unsigned* bar, volatile LAS unsigned* st) {
    XcdBarrier b; b.bar = bar; b.x = xb_xcc_id(); b.st = st;
    if (threadIdx.x == 0) (void)xb_add(&bar[XB_XCNT(b.x)], 1u);
    return b;
}
__device__ __forceinline__ void xcd_barrier_complete(unsigned* bar, unsigned x, unsigned& nloc, unsigned& nx) {
    const unsigned G = gridDim.x * gridDim.y * gridDim.z;
    unsigned sum, cnt, mine, sp = 0u;
    for (;;) {
        sum = 0u; cnt = 0u; mine = 0u;
#pragma unroll
        for (unsigned j = 0; j < 16; ++j) { const unsigned c = xb_ld(&bar[XB_XCNT(j)]); sum += c; cnt += (c > 0u) ? 1u : 0u; mine = (j == x) ? c : mine; }
        if (sum == G) break;
        __builtin_amdgcn_s_sleep(1);
        if ((++sp & 255u) == 0u) { if (xb_ld(&bar[XB_TMO])) break; if (sp > XB_SPIN_CAP) { atomicAdd(&bar[XB_TMO], 1u); break; } }
    }
    nloc = mine > 0u ? mine : 1u; nx = cnt > 0u ? cnt : 1u;
}
__device__ __forceinline__ void xcd_barrier(const XcdBarrier& b) {
    asm volatile("s_waitcnt vmcnt(0)" ::: "memory");
    __syncthreads();
    if (threadIdx.x == 0) {
        unsigned* bar = b.bar;
        __builtin_amdgcn_s_waitcnt(0);
        unsigned nloc = b.st[0], nx = b.st[1];
        if (nloc == 0u) { xcd_barrier_complete(bar, b.x, nloc, nx); b.st[0] = nloc; b.st[1] = nx; }
        const unsigned old = xb_add(&bar[XB_XSUB(b.x)], 1u);
        const unsigned gen = old / nloc;
        if (old + 1u == (gen + 1u) * nloc) {
            __builtin_amdgcn_fence(__ATOMIC_RELEASE, "agent");
            asm volatile("s_waitcnt vmcnt(0)" ::: "memory");
            const unsigned og = xb_add(&bar[XB_TOP], 1u);
            const unsigned tg = og / nx;
            if (og + 1u == (tg + 1u) * nx) xb_add(&bar[XB_TOPGEN], 1u);
            else XB_SPIN(xb_ld(&bar[XB_TOPGEN]) == tg, bar);
            __builtin_amdgcn_fence(__ATOMIC_ACQUIRE, "agent");
            xb_add(&bar[XB_XGEN(b.x)], 1u);
            asm volatile("s_waitcnt vmcnt(0)" ::: "memory");
        } else {
            XB_SPIN(xb_ld(&bar[XB_XGEN(b.x)]) == gen, bar);
            __builtin_amdgcn_fence(__ATOMIC_ACQUIRE, "agent");
            asm volatile("s_waitcnt vmcnt(0)" ::: "memory");
        }
    }
    __syncthreads();
}

struct Params {
    const float* in[27];
    float* out;
    unsigned char* ws;
    int ph_lo, ph_hi;
};
typedef const __attribute__((address_space(4))) Params* PP;
enum { I_X = 0, I_C, I_CTX, I_CCTX, I_WMOD, I_BMOD, I_NMIXG, I_WIN, I_QNG, I_KNG, I_LQ1, I_LK1, I_LQ2, I_LK2, I_SUBLN, I_CONVW, I_ALOG, I_DTB, I_GDNG, I_WOUT, I_NFFNG, I_RW, I_RB, I_WGU, I_BGU, I_WD, I_BD };

__device__ __forceinline__ const float* hrow_in(PP p, int layer, int r) {
    (void)layer; return r < NLAT ? p->in[I_X] + (size_t)r * D : p->in[I_CTX] + (size_t)(r - NLAT) * D;
}
__device__ __forceinline__ int mod_sel(int r) { return r < NLAT ? (r >= SEQL ? 1 : 0) : 2; }

__device__ __forceinline__ void transpose_item(const float* W, size_t ldw, int k0, int n0, bf16_t* WT, int drow0, LAS float* scr, int lane) {
#pragma unroll 8
    for (int i = 0; i < 32; ++i) { const int kk = 2 * i + (lane >> 5); scr[kk * 33 + (lane & 31)] = W[(size_t)(k0 + kk) * ldw + n0 + (lane & 31)]; }
    LDS_WAIT(); asm volatile("" ::: "memory");
    const int c = lane & 7;
#pragma unroll
    for (int j = 0; j < 4; ++j) { const int n = (lane >> 3) + 8 * j; const LAS float* s = scr + (8 * c) * 33 + n;
        u32x4 o; o.x = pk2(s[0 * 33], s[1 * 33]); o.y = pk2(s[2 * 33], s[3 * 33]); o.z = pk2(s[4 * 33], s[5 * 33]); o.w = pk2(s[6 * 33], s[7 * 33]);
        *(u32x4*)(WT + (size_t)(drow0 + n) * 1024 + k0 + 8 * c) = o; }
    LDS_WAIT(); asm volatile("" ::: "memory");
}

__device__ __forceinline__ void phase_prologue(PP p, LAS unsigned char* lds) {
    int tid = threadIdx.x, bid = blockIdx.x, gdim = gridDim.x; asm volatile("" : "+v"(tid), "+s"(bid), "+s"(gdim)); const int lane = tid & 63, wave = __builtin_amdgcn_readfirstlane(tid >> 6);
    float* cf = (float*)(p->ws + WS_CONST);
    if (bid < 192) {
        const int l = bid / 96, cg = bid % 96;
        LAS float* sl = (LAS float*)lds;
        LAS float* red = sl + 3 * 1024;
        for (int i = tid; i < 3 * 1024; i += NTHR) { const int s = i >> 10, k = i & 1023; const float v = s < 2 ? p->in[I_C][s * D + k] : p->in[I_CCTX][k]; sl[i] = silu_f(v); }
        __syncthreads();
        const float* wm = p->in[I_WMOD] + (size_t)l * D * 6144 + cg * 64 + lane;
        float a0 = 0.f, a1 = 0.f, a2 = 0.f;
#pragma unroll 16
        for (int kk = 0; kk < 128; ++kk) { const int k = wave * 128 + kk; const float w = wm[(size_t)k * 6144]; a0 += sl[k] * w; a1 += sl[1024 + k] * w; a2 += sl[2048 + k] * w; }
        red[(wave * 3 + 0) * 64 + lane] = a0; red[(wave * 3 + 1) * 64 + lane] = a1; red[(wave * 3 + 2) * 64 + lane] = a2;
        __syncthreads();
        if (wave < 3) { float s = 0.f;
#pragma unroll
            for (int w = 0; w < 8; ++w) s += red[(w * 3 + wave) * 64 + lane];
            cf[CF_MODV + (l * 3 + wave) * 6144 + cg * 64 + lane] = s + p->in[I_BMOD][l * 6144 + cg * 64 + lane]; }
        __syncthreads();
    }
    if (bid >= 192 && bid < 202) {
        const int idx = (bid - 192) * NTHR + tid;
        if (idx < 320 * 16) { const int pos = idx >> 4, i = idx & 15; const float invf = powf(10000.f, -(float)i / 16.f);
            const float posf = (float)(pos < 256 ? pos : pos - 256); const float ang = posf * invf; const double a = (double)ang;
            const float cs = (float)cos(a), sn = (float)sin(a);
            if (pos < 256) { cf[CF_ROPE + pos * 16 + i] = cs; cf[CF_ROPE + 4096 + pos * 16 + i] = sn; }
            else { cf[CF_ROPE + 8192 + (pos - 256) * 16 + i] = cs; cf[CF_ROPE + 9216 + (pos - 256) * 16 + i] = sn; } }
    }
    if (bid == 202 && wave < 2) {
        const int l = wave;
        const float d1 = wave_sum(p->in[I_LQ1][l * 64 + lane] * p->in[I_LK1][l * 64 + lane]);
        const float d2 = wave_sum(p->in[I_LQ2][l * 64 + lane] * p->in[I_LK2][l * 64 + lane]);
        const float lam_init = 0.8f - 0.6f * expf(-0.3f * (float)l);
        const float mq = wave_max(fabsf(p->in[I_QNG][l * 64 + lane])), mk = wave_max(fabsf(p->in[I_KNG][l * 64 + lane]));
        if (lane == 0) { cf[CF_SC + l * 16 + 0] = expf(d1) - expf(d2) + lam_init; cf[CF_SC + l * 16 + 1] = LOG2E * 0.125f * 64.f * mq * mk * 1.0001f + 0.01f; cf[CF_SC + l * 16 + 2] = 1.f - lam_init; }
    }
    {
        LAS float* scr = (LAS float*)(lds + wave * 16384);
        const int gw = bid * NWAVES + wave, NGW = gdim * NWAVES;
        constexpr int I_IN = 16 * 112, I_OUT = 16 * 32, I_GU = 16 * 64, I_DN = 16 * 32;
        constexpr int PER_LAYER = I_IN + I_OUT + NEXP * I_GU + NEXP * I_DN;
        for (int it = gw; it < 2 * PER_LAYER; it += NGW) {
            const int l = it / PER_LAYER; int r = it % PER_LAYER;
            if (r < I_IN) { const int kb = r / 112, nb = r % 112;
                transpose_item(p->in[I_WIN] + (size_t)l * D * INC, INC, kb * 64, nb * 32, (bf16_t*)(p->ws + WS_WIN) + (size_t)l * PW * 1024, nb * 32, scr, lane); continue; }
            r -= I_IN;
            if (r < I_OUT) { const int kb = r / 32, nb = r % 32;
                transpose_item(p->in[I_WOUT] + (size_t)l * D * D, D, kb * 64, nb * 32, (bf16_t*)(p->ws + WS_WOUT) + (size_t)l * D * 1024, nb * 32, scr, lane); continue; }
            r -= I_OUT;
            if (r < NEXP * I_GU) { const int e = r / I_GU, q = r % I_GU, kb = q / 64, nb = q % 64; const int n0 = nb * 32, j = n0 & 1023, isup = n0 >> 10;
                const int drow = (j >> 7) * 256 + isup * 128 + (j & 127);
                transpose_item(p->in[I_WGU] + (size_t)(l * NEXP + e) * D * 2048, 2048, kb * 64, n0, (bf16_t*)(p->ws + WS_WGU) + (size_t)(l * NEXP + e) * 2048 * 1024, drow, scr, lane); continue; }
            r -= NEXP * I_GU;
            { const int e = r / I_DN, q = r % I_DN, kb = q / 32, nb = q % 32;
                transpose_item(p->in[I_WD] + (size_t)(l * NEXP + e) * D * D, D, kb * 64, nb * 32, (bf16_t*)(p->ws + WS_WD) + (size_t)(l * NEXP + e) * D * 1024, nb * 32, scr, lane); }
        }
    }
}

struct PlainSched {
    const char* A; const char* Bt; int K, nM, nN, nwg, G, c;
    __device__ __forceinline__ void init(const void* A_, const void* Bt_, int K_, int nM_, int nN_, int G_, int c_) { A = (const char*)A_; Bt = (const char*)Bt_; K = K_; nM = nM_; nN = nN_; nwg = nM * nN; G = G_; c = c_; }
    __device__ __forceinline__ bool next(int i, pg8::Unit& u) const {
        const long L = (long)i * G + c; if (L >= nwg) return false;
        int wgid = (int)L; { const int q = nwg / 8, r = nwg % 8, xcd = wgid % 8, off = wgid / 8; wgid = (xcd < r ? xcd * (q + 1) : r * (q + 1) + (xcd - r) * q) + off; }
        const int nig = 8 * nN, gid = wgid / nig, fm = gid * 8, gsz = (nM - fm) < 8 ? (nM - fm) : 8;
        u.pm = fm + ((wgid % nig) % gsz); u.pn = (wgid % nig) / gsz; return true;
    }
    __device__ __forceinline__ const char* aptr(const pg8::Unit& u) const { return A + (size_t)u.pm * 256 * K * 2; }
    __device__ __forceinline__ const char* bptr(const pg8::Unit& u) const { return Bt + (size_t)u.pn * 256 * K * 2; }
};
struct MoeSched {
    const char* A; const char* W; const int* blk_e; int nblk, nN, G, c;
    __device__ __forceinline__ bool next(int i, pg8::Unit& u) const {
        const int x = c & 7, w = c >> 3, nw = G >> 3;
        const int b0 = (int)(((long)nblk * x) >> 3), b1 = (int)(((long)nblk * (x + 1)) >> 3);
        const int j = i * nw + w, pm = b0 + j / nN; if (pm >= b1) return false;
        u.pm = pm; u.pn = j % nN; return true;
    }
    const int* tok;
    __device__ __forceinline__ const char* aptr(const pg8::Unit& u) const { return A + (size_t)u.pm * 256 * 1024 * 2; }
    __device__ __forceinline__ const char* abase() const { return A; }
    __device__ __forceinline__ const int* atok(const pg8::Unit& u) const { return tok + u.pm * 256; }
    __device__ __forceinline__ const char* bptr(const pg8::Unit& u) const { const int e = ((const __attribute__((address_space(4))) int*)blk_e)[u.pm];
        return W + ((size_t)e * nN + u.pn) * 256 * 1024 * 2; }
};
struct EpiStoreBf16 {
    static constexpr bool PERM = true;
    bf16_t* O; int ldc;
    __device__ __forceinline__ void operator()(const f32x4 (&acc)[2][2][4][2], const pg8::Unit& u, int wr, int wc, int fr, int fq) const {
        const int row0 = u.pm * 256 + wr * 64 + fr, col0 = u.pn * 256 + wc * 32 + 8 * fq;
#pragma unroll
        for (int ai = 0; ai < 2; ++ai)
#pragma unroll
            for (int m = 0; m < 4; ++m) { bf16_t* rowp = O + (size_t)(row0 + ai * 128 + m * 16) * ldc + col0;
#pragma unroll
                for (int bj = 0; bj < 2; ++bj) { const f32x4 v0 = acc[ai][bj][m][0], v1 = acc[ai][bj][m][1];
                    u32x4 w; w.x = cvt_pk_bf16_c(v0[0], v0[1]); w.y = cvt_pk_bf16_c(v0[2], v0[3]); w.z = cvt_pk_bf16_c(v1[0], v1[1]); w.w = cvt_pk_bf16_c(v1[2], v1[3]);
                    *(u32x4*)(rowp + bj * 128) = w; } }
    }
};
struct EpiResidual {
    static constexpr bool PERM = true;
    PP p; int layer; const float* gate;
    __device__ __forceinline__ void operator()(const f32x4 (&acc)[2][2][4][2], const pg8::Unit& u, int wr, int wc, int fr, int fq) const {
        const int row0 = u.pm * 256 + wr * 64 + fr, col0 = u.pn * 256 + wc * 32 + 8 * fq;
        bf16_t* H = (bf16_t*)(p->ws + WS_H);
#pragma unroll
        for (int ai = 0; ai < 2; ++ai)
#pragma unroll
            for (int m = 0; m < 4; ++m) { const int row = row0 + ai * 128 + m * 16; const float* g = gate + mod_sel(row) * 6144 + col0;
                bf16_t* ho = H + (size_t)row * D + col0;
#pragma unroll
                for (int bj = 0; bj < 2; ++bj) { f32x4 h0, h1;
                    if (layer == 0) { const float* hin = hrow_in(p, 0, row) + col0 + bj * 128; h0 = *(const f32x4*)hin; h1 = *(const f32x4*)(hin + 4); }
                    else { const u32x4 w_ = *(const u32x4*)(ho + bj * 128); h0 = (f32x4){bflo(w_.x), bfhi(w_.x), bflo(w_.y), bfhi(w_.y)}; h1 = (f32x4){bflo(w_.z), bfhi(w_.z), bflo(w_.w), bfhi(w_.w)}; }
                    const f32x4 v0 = h0 + *(const f32x4*)(g + bj * 128) * acc[ai][bj][m][0], v1 = h1 + *(const f32x4*)(g + bj * 128 + 4) * acc[ai][bj][m][1];
                    u32x4 w; w.x = cvt_pk_bf16(v0[0], v0[1]); w.y = cvt_pk_bf16(v0[2], v0[3]); w.z = cvt_pk_bf16(v1[0], v1[1]); w.w = cvt_pk_bf16(v1[2], v1[3]);
                    *(u32x4*)(ho + bj * 128) = w; } }
    }
};
struct EpiGateUp {
    static constexpr bool PERM = true;
    bf16_t* ACT; const float* bgu; const int* blk_e;
    __device__ __forceinline__ void operator()(const f32x4 (&acc)[2][2][4][2], const pg8::Unit& u, int wr, int wc, int fr, int fq) const {
        const int row0 = u.pm * 256 + wr * 64 + fr, col0 = u.pn * 128 + wc * 32 + 8 * fq; const int e = blk_e[u.pm];
        const float* bg = bgu + (size_t)e * 2048 + col0; const float* bu = bg + 1024;
        f32x4 bgv[2], buv[2];
#pragma unroll
        for (int n = 0; n < 2; ++n) { bgv[n] = *(const f32x4*)(bg + 4 * n); buv[n] = *(const f32x4*)(bu + 4 * n); }
#pragma unroll
        for (int ai = 0; ai < 2; ++ai)
#pragma unroll
            for (int m = 0; m < 4; ++m) { float o[8];
#pragma unroll
                for (int n = 0; n < 2; ++n)
#pragma unroll
                    for (int j = 0; j < 4; ++j) { float g = acc[ai][0][m][n][j] + bgv[n][j], up = acc[ai][1][m][n][j] + buv[n][j];
                        g = fminf(g, 7.f); up = fminf(fmaxf(up, -7.f), 7.f);
                        const float glu = g * __builtin_amdgcn_rcpf(1.f + __builtin_amdgcn_exp2f(-1.702f * LOG2E * g)); o[n * 4 + j] = (up + 1.f) * glu; }
                u32x4 w; w.x = cvt_pk_bf16(o[0], o[1]); w.y = cvt_pk_bf16(o[2], o[3]); w.z = cvt_pk_bf16(o[4], o[5]); w.w = cvt_pk_bf16(o[6], o[7]);
                *(u32x4*)(ACT + (size_t)(row0 + ai * 128 + m * 16) * 1024 + col0) = w; }
    }
};
struct EpiDown {
    static constexpr bool PERM = true;
    bf16_t* Y; const float* bd; const int* blk_e; const float* sgate;
    __device__ __forceinline__ void operator()(const f32x4 (&acc)[2][2][4][2], const pg8::Unit& u, int wr, int wc, int fr, int fq) const {
        const int row0 = u.pm * 256 + wr * 64 + fr, col0 = u.pn * 256 + wc * 32 + 8 * fq; const int e = blk_e[u.pm];
        const float* b = bd + (size_t)e * 1024 + col0;
        f32x4 bv[2][2];
#pragma unroll
        for (int bj = 0; bj < 2; ++bj)
#pragma unroll
            for (int n = 0; n < 2; ++n) bv[bj][n] = *(const f32x4*)(b + bj * 128 + 4 * n);
#pragma unroll
        for (int ai = 0; ai < 2; ++ai)
#pragma unroll
            for (int m = 0; m < 4; ++m) { const int row = row0 + ai * 128 + m * 16; const float sg = sgate[row]; bf16_t* rowp = Y + (size_t)row * 1024 + col0;
#pragma unroll
                for (int bj = 0; bj < 2; ++bj) { const f32x4 v0 = (acc[ai][bj][m][0] + bv[bj][0]) * sg, v1 = (acc[ai][bj][m][1] + bv[bj][1]) * sg;
                    u32x4 w; w.x = cvt_pk_bf16(v0[0], v0[1]); w.y = cvt_pk_bf16(v0[2], v0[3]); w.z = cvt_pk_bf16(v1[0], v1[1]); w.w = cvt_pk_bf16(v1[2], v1[3]);
                    *(u32x4*)(rowp + bj * 128) = w; } }
    }
};

__device__ __forceinline__ void norm_mod_vals(const float* g, const float* shift, const float* scale, int lane, f32x4 (&u)[4]) {
    float ss = 0.f;
#pragma unroll
    for (int j = 0; j < 4; ++j) ss += (u[j][0] * u[j][0] + u[j][1] * u[j][1]) + (u[j][2] * u[j][2] + u[j][3] * u[j][3]);
    const float rstd = rsqrtf(wave_sum(ss) * (1.f / D) + EPS);
#pragma unroll
    for (int j = 0; j < 4; ++j) { const int c = 4 * lane + 256 * j; const f32x4 gv = *(const f32x4*)(g + c), sh = *(const f32x4*)(shift + c), sc = *(const f32x4*)(scale + c);
        u[j] = (u[j] * rstd) * gv * (sc + 1.f) + sh; }
}
__device__ __forceinline__ void norm_mod_row(const float* hrow, const float* g, const float* shift, const float* scale, int lane, f32x4 (&u)[4]) {
#pragma unroll
    for (int j = 0; j < 4; ++j) u[j] = *(const f32x4*)(hrow + 4 * lane + 256 * j);
    norm_mod_vals(g, shift, scale, lane, u);
}
__device__ __forceinline__ void store_row_bf16(bf16_t* orow, int lane, const f32x4 (&u)[4]) {
#pragma unroll
    for (int j = 0; j < 4; ++j) { u32x2 w; w.x = cvt_pk_bf16(u[j][0], u[j][1]); w.y = cvt_pk_bf16(u[j][2], u[j][3]); *(u32x2*)(orow + 4 * lane + 256 * j) = w; }
}

__device__ __forceinline__ void norm_mix_stage_wab(PP p, int layer, LAS float* wab, int tid) {
    const float* win = p->in[I_WIN] + (size_t)layer * D * INC;
    for (int i = tid; i < 16 * 1024; i += NTHR) { const int k = i >> 4, j = i & 15; wab[j * 1024 + k] = win[(size_t)k * INC + PW + j]; }
}
__device__ __forceinline__ void norm_mix_row(PP p, int layer, int r, int lane, f32x4 (&u)[4], const LAS float* wab, float ea, float dtb) {
    const float* cf = (const float*)(p->ws + WS_CONST);
    const float* mv = cf + CF_MODV + (layer * 3 + mod_sel(r)) * 6144;
    norm_mod_vals(p->in[I_NMIXG] + layer * D, mv, mv + 1024, lane, u);
    store_row_bf16((bf16_t*)(p->ws + WS_U) + (size_t)r * D, lane, u);
    float ab = 0.f;
#pragma unroll
    for (int j = 0; j < 16; ++j) { float s = 0.f;
#pragma unroll
        for (int q = 0; q < 4; ++q) { const f32x4 w = *(const LAS f32x4*)(wab + j * 1024 + 4 * lane + 256 * q); s += (u[q][0] * w[0] + u[q][1] * w[1]) + (u[q][2] * w[2] + u[q][3] * w[3]); }
        s = wave_sum(s); if (lane == j) ab = s; }
    float outv;
    if (lane < 8) { const float z = ab + dtb; const float sp = z > 20.f ? z : log1pf(__expf(z)); outv = ea * sp; }
    else outv = 1.f / (1.f + __expf(-ab));
    if (lane < 16) ((float*)(p->ws + WS_GB))[(size_t)r * 16 + lane] = outv;
}
__device__ __forceinline__ void phase_norm_mix(PP p, int layer, LAS unsigned char* lds) {
    int tid = threadIdx.x, bid = blockIdx.x, gdim = gridDim.x; asm volatile("" : "+v"(tid), "+s"(bid), "+s"(gdim)); const int lane = tid & 63, wave = __builtin_amdgcn_readfirstlane(tid >> 6);
    LAS float* wab = (LAS float*)lds;
    norm_mix_stage_wab(p, layer, wab, tid);
    __syncthreads();
    float ea = 0.f, dtb = 0.f; if (lane < 8) { ea = -__expf(p->in[I_ALOG][layer * 8 + lane]); dtb = p->in[I_DTB][layer * 8 + lane]; }
    for (int r = bid * NWAVES + wave; r < NTOK; r += gdim * NWAVES) {
        const float* hrow = hrow_in(p, layer, r); f32x4 u[4];
#pragma unroll
        for (int j = 0; j < 4; ++j) u[j] = *(const f32x4*)(hrow + 4 * lane + 256 * j);
        norm_mix_row(p, layer, r, lane, u, wab, ea, dtb);
    }
}

__device__ __forceinline__ void phase_prep(PP p, int layer) {
    int tid = threadIdx.x, bid = blockIdx.x, gdim = gridDim.x; asm volatile("" : "+v"(tid), "+s"(bid), "+s"(gdim)); const int lane = tid & 63, wave = __builtin_amdgcn_readfirstlane(tid >> 6);
    const float* cf = (const float*)(p->ws + WS_CONST);
    bf16_t* P = (bf16_t*)(p->ws + WS_P); bf16_t* G = (bf16_t*)(p->ws + WS_G);
    const float* cw = p->in[I_CONVW] + (size_t)layer * 5 * 1536;
    float gain[16];
    { const float* gsrc = (lane < 32 ? p->in[I_QNG] : p->in[I_KNG]) + layer * 64 + 16 * (lane & 3);
#pragma unroll
      for (int e = 0; e < 16; ++e) gain[e] = gsrc[e]; }
    const float qscale = lane < 32 ? 0.125f * LOG2E : 1.f;
    for (int r = bid * NWAVES + wave; r < NTOK; r += gdim * NWAVES) {
        bf16_t* prow = P + (size_t)r * PW + 16 * lane;
        const u32x4 w0 = *(const u32x4*)prow, w1 = *(const u32x4*)(prow + 8);
        float x[16];
#pragma unroll
        for (int e = 0; e < 4; ++e) { x[2 * e] = bflo(w0[e]); x[2 * e + 1] = bfhi(w0[e]); x[8 + 2 * e] = bflo(w1[e]); x[8 + 2 * e + 1] = bfhi(w1[e]); }
        float ss = 0.f;
#pragma unroll
        for (int e = 0; e < 16; ++e) ss += x[e] * x[e];
        ss += __shfl_xor(ss, 1); ss += __shfl_xor(ss, 2);
        const float rstd = rsqrtf(ss * (1.f / 64.f) + EPS);
#pragma unroll
        for (int e = 0; e < 16; ++e) x[e] = x[e] * rstd * gain[e];
        if (r < NLAT) {
            const int t = r & (SEQL - 1); const int pos = (lane & 2) ? (t & 63) : (t >> 6);
            const float* ct = cf + CF_ROPE + ((lane & 2) ? 8192 : 0) + pos * 16; const float* st = ct + ((lane & 2) ? 1024 : 4096);
            const bool second = lane & 1;
#pragma unroll
            for (int e = 0; e < 16; ++e) { const float other = __shfl_xor(x[e], 1); const float cs = ct[e], sn = st[e];
                x[e] = second ? (x[e] * cs + other * sn) : (x[e] * cs - other * sn); }
        }
        u32x4 o0, o1;
#pragma unroll
        for (int e = 0; e < 4; ++e) { o0[e] = cvt_pk_bf16(x[2 * e] * qscale, x[2 * e + 1] * qscale); o1[e] = cvt_pk_bf16(x[8 + 2 * e] * qscale, x[8 + 2 * e + 1] * qscale); }
        *(u32x4*)prow = o0; *(u32x4*)(prow + 8) = o1;
    }
    for (int r = bid * NWAVES + wave; r < NTOK; r += gdim * NWAVES) {
        int seg0, seglen; if (r < NLAT) { seg0 = r & ~(SEQL - 1); seglen = SEQL; } else { seg0 = NLAT + ((r - NLAT) & ~(CTXL - 1)); seglen = CTXL; }
        const int tpos = r - seg0;
#pragma unroll
        for (int grp = 0; grp < 3; ++grp) {
            const int c0 = grp * 512 + 8 * lane;
            float a[8];
#pragma unroll
            for (int e = 0; e < 8; ++e) a[e] = 0.f;
#pragma unroll
            for (int j = 0; j < 5; ++j) { const int tp = tpos + j - 2;
                if (tp >= 0 && tp < seglen) { const u32x4 w = *(const u32x4*)(P + (size_t)(seg0 + tp) * PW + 1536 + c0);
                    const f32x4 k0 = *(const f32x4*)(cw + j * 1536 + c0), k1 = *(const f32x4*)(cw + j * 1536 + c0 + 4);
                    a[0] += bflo(w[0]) * k0[0]; a[1] += bfhi(w[0]) * k0[1]; a[2] += bflo(w[1]) * k0[2]; a[3] += bfhi(w[1]) * k0[3];
                    a[4] += bflo(w[2]) * k1[0]; a[5] += bfhi(w[2]) * k1[1]; a[6] += bflo(w[3]) * k1[2]; a[7] += bfhi(w[3]) * k1[3]; } }
            float ss = 0.f;
#pragma unroll
            for (int e = 0; e < 8; ++e) { a[e] = silu_f(a[e]); ss += a[e] * a[e]; }
            if (grp < 2) { ss += __shfl_xor(ss, 1); ss += __shfl_xor(ss, 2); ss += __shfl_xor(ss, 4); ss += __shfl_xor(ss, 8);
                const float rn = rsqrtf(ss + EPS);
#pragma unroll
                for (int e = 0; e < 8; ++e) a[e] *= rn; }
            u32x4 o; o.x = cvt_pk_bf16(a[0], a[1]); o.y = cvt_pk_bf16(a[2], a[3]); o.z = cvt_pk_bf16(a[4], a[5]); o.w = cvt_pk_bf16(a[6], a[7]);
            *(u32x4*)(G + (size_t)r * 1536 + c0) = o;
        }
    }
}

typedef short v4i16c_t __attribute__((ext_vector_type(4)));
__device__ __forceinline__ s16x4 vtr_c(const LAS unsigned char* ptr) { return __builtin_bit_cast(s16x4, __builtin_amdgcn_ds_read_tr16_b64_v4i16((LAS v4i16c_t*)ptr)); }
__device__ __forceinline__ void gdn_task_rows(int task, int& b, int& h, int& dir, int& rstart, int& rstep) {
    const int chain = task / NCHUNK, n = task % NCHUNK; dir = chain & 1; h = (chain >> 1) & 3; b = chain >> 3;
    if (n < 4) { const int base = NLAT + b * CTXL; if (dir == 0) { rstart = base + 64 * n; rstep = 1; } else { rstart = base + CTXL - 1 - 64 * n; rstep = -1; } }
    else { const int base = b * SEQL, m = n - 4; if (dir == 0) { rstart = base + 64 * m; rstep = 1; } else { rstart = base + SEQL - 1 - 64 * m; rstep = -1; } }
}
constexpr int CWL_BYTES = 6144, CWL_STG = 2048;
__device__ __forceinline__ void gdn_chunk_task(PP p, LAS unsigned char* wl, const int task, const int lane) {
    const int r32 = lane & 31, hi = lane >> 5;
    const bf16_t* G = (const bf16_t*)(p->ws + WS_G); const float* GB = (const float*)(p->ws + WS_GB);
    float* cf = (float*)(p->ws + WS_CONST);
    LAS float* gcv = (LAS float*)wl;
    LAS unsigned char* stg = wl + CWL_STG;
    const LAS unsigned char* stgp = stg + ((lane >> 4) & 1) * 32 + (lane & 3) * 8 + (4 * hi + ((lane & 15) >> 2)) * 64;
    const LAS unsigned char* stgn = stg + ((lane >> 4) & 1) * 32 + (lane & 3) * 8 + (8 * hi + ((lane & 15) >> 2)) * 64;
    const float SCALE = 0.08838834764831845f;
    {
        int b, h, dir, rstart, rstep; gdn_task_rows(task, b, h, dir, rstart, rstep);
        unsigned char* chb = p->ws + WS_CH + (size_t)task * CH_TASK_BYTES;
        const int myrow = rstart + rstep * lane;
        float gt = GB[(size_t)myrow * 16 + dir * 4 + h]; const float bt = GB[(size_t)myrow * 16 + 8 + dir * 4 + h];
#pragma unroll
        for (int o = 1; o < 64; o <<= 1) { const float t = __shfl_up(gt, o); if (lane >= o) gt += t; }
        const float glast = __shfl(gt, 63), egt = __expf(gt), begt = bt * egt, kdt = __expf(glast - gt);
        gcv[lane] = gt; gcv[64 + lane] = bt;
        if (lane == 0) cf[CF_EGL + task] = __expf(glast);
        const float gcs0 = __shfl(gt, r32), gcs1 = __shfl(gt, 32 + r32);
        const size_t rowA0 = (size_t)(rstart + rstep * r32) * 1536, rowA1 = (size_t)(rstart + rstep * (32 + r32)) * 1536;
        bf16x8 kfr[2][8];
        { const bf16_t* gk = G + 512 + h * 128 + 8 * hi;
#pragma unroll
          for (int ks = 0; ks < 8; ++ks) { kfr[0][ks] = *(const bf16x8*)(gk + rowA0 + 16 * ks); kfr[1][ks] = *(const bf16x8*)(gk + rowA1 + 16 * ks); } }
        LDS_WAIT();
        f32x16 am00, am10, am11;
#define KK_TILE(dst, mi, ni, gcs_) do { f32x16 acc_ = (f32x16){}; \
            _Pragma("unroll") for (int ks = 0; ks < 8; ++ks) acc_ = MFMA32(kfr[mi][ks], kfr[ni][ks], acc_); \
            _Pragma("unroll") for (int q = 0; q < 4; ++q) { const f32x4 g4 = *(const LAS f32x4*)(gcv + 32 * (mi) + 8 * q + 4 * hi), b4 = *(const LAS f32x4*)(gcv + 64 + 32 * (mi) + 8 * q + 4 * hi); \
                _Pragma("unroll") for (int e = 0; e < 4; ++e) { const int cc = 32 * (mi) + 8 * q + 4 * hi + e, ss = 32 * (ni) + r32; \
                    dst[4 * q + e] = (ss < cc) ? -b4[e] * acc_[4 * q + e] * __expf(fminf(g4[e] - (gcs_), 0.f)) : 0.f; } } } while (0)
        KK_TILE(am00, 0, 0, gcs0); KK_TILE(am10, 1, 0, gcs0); KK_TILE(am11, 1, 1, gcs1);
        __builtin_amdgcn_sched_barrier(0);
        { bf16x8 qfr[8]; const bf16_t* gq = G + h * 128 + 8 * hi;
#define KQ_TILE(n, mo, gcc_) do { f32x16 acc_ = (f32x16){}; \
            _Pragma("unroll") for (int ks = 0; ks < 8; ++ks) acc_ = MFMA32(kfr[n][ks], qfr[ks], acc_); \
            _Pragma("unroll") for (int q = 0; q < 4; ++q) { const f32x4 g4 = *(const LAS f32x4*)(gcv + 32 * (n) + 8 * q + 4 * hi); \
                _Pragma("unroll") for (int e = 0; e < 4; ++e) { const int ss = 32 * (n) + 8 * q + 4 * hi + e, cc = 32 * (mo) + r32; \
                    acc_[4 * q + e] = (ss <= cc) ? SCALE * acc_[4 * q + e] * __expf(fminf((gcc_) - g4[e], 0.f)) : 0.f; } } \
            _Pragma("unroll") for (int s = 0; s < 2; ++s) { u32x4 o_; o_.x = cvt_pk_bf16(acc_[8 * s], acc_[8 * s + 1]); o_.y = cvt_pk_bf16(acc_[8 * s + 2], acc_[8 * s + 3]); o_.z = cvt_pk_bf16(acc_[8 * s + 4], acc_[8 * s + 5]); o_.w = cvt_pk_bf16(acc_[8 * s + 6], acc_[8 * s + 7]); \
                *(u32x4*)(chb + CH_AF + (((mo) * 2 + (n)) * 2 + s) * 1024 + lane * 16) = o_; } } while (0)
#pragma unroll
          for (int ks = 0; ks < 8; ++ks) qfr[ks] = *(const bf16x8*)(gq + rowA0 + 16 * ks);
          KQ_TILE(0, 0, gcs0); __builtin_amdgcn_sched_barrier(0);
#pragma unroll
          for (int ks = 0; ks < 8; ++ks) qfr[ks] = *(const bf16x8*)(gq + rowA1 + 16 * ks);
          KQ_TILE(0, 1, gcs1); KQ_TILE(1, 1, gcs1); }
        __builtin_amdgcn_sched_barrier(0);
        { const float eg0 = __shfl(egt, r32) * SCALE, eg1 = __shfl(egt, 32 + r32) * SCALE;
#pragma unroll
          for (int m = 0; m < 2; ++m) { const bf16_t* gq = G + (m ? rowA1 : rowA0) + h * 128 + 4 * hi; const float sc = m ? eg1 : eg0;
#pragma unroll
              for (int ts = 0; ts < 8; ++ts) { const u32x2 a = *(const u32x2*)(gq + 16 * ts), bq = *(const u32x2*)(gq + 16 * ts + 8); u32x4 o_;
                  o_.x = cvt_pk_bf16(bflo(a.x) * sc, bfhi(a.x) * sc); o_.y = cvt_pk_bf16(bflo(a.y) * sc, bfhi(a.y) * sc); o_.z = cvt_pk_bf16(bflo(bq.x) * sc, bfhi(bq.x) * sc); o_.w = cvt_pk_bf16(bflo(bq.y) * sc, bfhi(bq.y) * sc);
                  *(u32x4*)(chb + CH_QF + (m * 8 + ts) * 1024 + lane * 16) = o_; } } }
        __builtin_amdgcn_sched_barrier(0);
        float x[64]; int lane_v = lane; asm volatile("" : "+v"(lane_v));
#pragma unroll
        for (int i = 63; i >= 0; --i) { float a0 = (lane_v == i) ? 1.f : 0.f, a1 = 0.f;
#pragma unroll
            for (int m = 63; m > i; --m) { const int ml = m & 31, hm = (ml >> 2) & 1, rm = (ml >> 3) * 4 + (ml & 3), ln = (i & 31) + 32 * hm;
                const float tv = (m >= 32) ? ((i >= 32) ? am11[rm] : am10[rm]) : am00[rm];
                const float s_ = __builtin_bit_cast(float, __builtin_amdgcn_readlane(__builtin_bit_cast(int, tv), ln));
                if (m & 1) asm("v_fmac_f32 %0, %1, %2" : "+v"(a1) : "s"(s_), "v"(x[m])); else asm("v_fmac_f32 %0, %1, %2" : "+v"(a0) : "s"(s_), "v"(x[m])); }
            x[i] = a0 + a1; __builtin_amdgcn_sched_barrier(0); }
        __builtin_amdgcn_sched_barrier(0);
        bf16x8 F0[4], F1[4];
#pragma unroll
        for (int ks = 0; ks < 4; ++ks) { u32x4 f0, f1;
#pragma unroll
            for (int w = 0; w < 4; ++w) { const unsigned pa = cvt_pk_bf16(x[16 * ks + 2 * w], x[16 * ks + 2 * w + 1]), pb = cvt_pk_bf16(x[16 * ks + 8 + 2 * w], x[16 * ks + 8 + 2 * w + 1]);
                const auto sw = __builtin_amdgcn_permlane32_swap(pa, pb, false, false);
                f0[w] = sw[0]; f1[w] = sw[1]; }
            F0[ks] = __builtin_bit_cast(bf16x8, f0); F1[ks] = __builtin_bit_cast(bf16x8, f1); }
        __builtin_amdgcn_sched_barrier(0);
#define PIECE_COL(pc) ((pc) < 4 ? 512 + h * 128 + 32 * (pc) : (pc) < 8 ? 1024 + h * 128 + 32 * ((pc) - 4) : 512 + h * 128 + 32 * ((pc) - 8))
#define PIECE_LOAD(pc, buf) do { const bf16_t* src_ = G + (size_t)myrow * 1536 + PIECE_COL(pc); _Pragma("unroll") for (int q = 0; q < 4; ++q) raw[buf][q] = *(const u32x4*)(src_ + 8 * q); } while (0)
#define PIECE_STAGE(buf, scal) do { LDS_WAIT(); \
            _Pragma("unroll") for (int q = 0; q < 4; ++q) { const u32x4 w_ = raw[buf][q]; u32x4 o_; \
                o_.x = cvt_pk_bf16(bflo(w_.x) * (scal), bfhi(w_.x) * (scal)); o_.y = cvt_pk_bf16(bflo(w_.y) * (scal), bfhi(w_.y) * (scal)); o_.z = cvt_pk_bf16(bflo(w_.z) * (scal), bfhi(w_.z) * (scal)); o_.w = cvt_pk_bf16(bflo(w_.w) * (scal), bfhi(w_.w) * (scal)); \
                *(LAS u32x4*)(stg + lane * 64 + 16 * q) = o_; } LDS_WAIT(); } while (0)
#define TR_FRAG(ks) ({ const s16x4 lo_ = vtr_c(stgp + (ks) * 1024), hi_ = vtr_c(stgp + (ks) * 1024 + 512); (bf16x8){lo_[0], lo_[1], lo_[2], lo_[3], hi_[0], hi_[1], hi_[2], hi_[3]}; })
#define TR_NAT(ks) ({ const s16x4 lo_ = vtr_c(stgn + (ks) * 1024), hi_ = vtr_c(stgn + (ks) * 1024 + 256); (bf16x8){lo_[0], lo_[1], lo_[2], lo_[3], hi_[0], hi_[1], hi_[2], hi_[3]}; })
        u32x4 raw[2][4];
        PIECE_LOAD(0, 0);
#pragma unroll
        for (int pc = 0; pc < 12; ++pc) {
            __builtin_amdgcn_sched_barrier(0);
            if (pc + 1 < 12) PIECE_LOAD(pc + 1, (pc + 1) & 1);
            if (pc < 4) {
                const int t = pc; PIECE_STAGE(pc & 1, begt);
                f32x16 a0 = (f32x16){}, a1 = (f32x16){};
#pragma unroll
                for (int ks = 0; ks < 4; ++ks) { const bf16x8 fr = TR_NAT(ks); a0 = MFMA32(fr, F0[ks], a0); a1 = MFMA32(fr, F1[ks], a1); }
#pragma unroll
                for (int s = 0; s < 2; ++s) { u32x4 o0, o1;
                    o0.x = cvt_pk_bf16(-a0[8 * s], -a0[8 * s + 1]); o0.y = cvt_pk_bf16(-a0[8 * s + 2], -a0[8 * s + 3]); o0.z = cvt_pk_bf16(-a0[8 * s + 4], -a0[8 * s + 5]); o0.w = cvt_pk_bf16(-a0[8 * s + 6], -a0[8 * s + 7]);
                    o1.x = cvt_pk_bf16(-a1[8 * s], -a1[8 * s + 1]); o1.y = cvt_pk_bf16(-a1[8 * s + 2], -a1[8 * s + 3]); o1.z = cvt_pk_bf16(-a1[8 * s + 4], -a1[8 * s + 5]); o1.w = cvt_pk_bf16(-a1[8 * s + 6], -a1[8 * s + 7]);
                    *(u32x4*)(chb + CH_WF + ((0 * 4 + t) * 2 + s) * 1024 + lane * 16) = o0; *(u32x4*)(chb + CH_WF + ((1 * 4 + t) * 2 + s) * 1024 + lane * 16) = o1; }
            } else if (pc < 8) {
                const int nj = pc - 4; PIECE_STAGE(pc & 1, bt);
                f32x16 a0 = (f32x16){}, a1 = (f32x16){};
#pragma unroll
                for (int ks = 0; ks < 4; ++ks) { const bf16x8 fr = TR_NAT(ks); a0 = MFMA32(F0[ks], fr, a0); a1 = MFMA32(F1[ks], fr, a1); }
                unsigned* uc = (unsigned*)(chb + CH_UC) + ((nj * 2) * 64 + lane) * 8;
#pragma unroll
                for (int q = 0; q < 2; ++q) { u32x4 w0, w1;
#pragma unroll
                    for (int e = 0; e < 4; ++e) { w0[e] = cvt_pk_bf16_c(a0[8 * q + 2 * e], a0[8 * q + 2 * e + 1]); w1[e] = cvt_pk_bf16_c(a1[8 * q + 2 * e], a1[8 * q + 2 * e + 1]); }
                    *(u32x4*)(uc + 4 * q) = w0; *(u32x4*)(uc + 512 + 4 * q) = w1; }
            } else {
                const int t = pc - 8; PIECE_STAGE(pc & 1, kdt);
#pragma unroll
                for (int ms = 0; ms < 4; ++ms) { const bf16x8 fr = TR_FRAG(ms); *(bf16x8*)(chb + CH_KF + (t * 4 + ms) * 1024 + lane * 16) = fr; }
            }
        }
        LDS_WAIT();
#undef KK_TILE
#undef KQ_TILE
#undef PIECE_COL
#undef PIECE_LOAD
#undef PIECE_STAGE
#undef TR_FRAG
#undef TR_NAT
    }
}
__device__ __forceinline__ void phase_gdn_chunk(PP p, LAS unsigned char* lds) {
    int tid = threadIdx.x, bid = blockIdx.x, gdim = gridDim.x; asm volatile("" : "+v"(tid), "+s"(bid), "+s"(gdim)); const int lane = tid & 63, wave = __builtin_amdgcn_readfirstlane(tid >> 6);
    for (int q = bid * NWAVES + wave; q < 16 * 256; q += gdim * NWAVES) gdn_chunk_task(p, lds + wave * CWL_BYTES, (q >> 8) * NCHUNK + 4 + (q & 255), lane);
}

__device__ __forceinline__ void gdn_scan_chain(PP p, LAS unsigned char* lds, const int chain) {
    int tid = threadIdx.x; asm volatile("" : "+v"(tid)); const int lane = tid & 63, wave = __builtin_amdgcn_readfirstlane(tid >> 6), r32 = lane & 31, hi = lane >> 5;
    const float* cf = (const float*)(p->ws + WS_CONST);
    bf16_t* OG = (bf16_t*)(p->ws + WS_OG);
    constexpr int STG = 2 * CH_DMA_BYTES;
    const int dir = chain & 1, h = (chain >> 1) & 3;
    f32x16 S[4];
#pragma unroll
    for (int t = 0; t < 4; ++t) S[t] = (f32x16){};
    f32x16 Un[2]; float egn = 0.f;
#pragma unroll
    for (int m = 0; m < 2; ++m) Un[m] = (f32x16){};
#define LOAD_U(task_) do { const u32x4* uc_ = (const u32x4*)(p->ws + WS_CH + (size_t)(task_) * CH_TASK_BYTES + CH_UC) + ((wave * 2) * 64 + lane) * 2; \
        _Pragma("unroll") for (int m = 0; m < 2; ++m) _Pragma("unroll") for (int q = 0; q < 2; ++q) { const u32x4 w_ = uc_[m * 128 + q]; \
            Un[m][8 * q] = bflo(w_.x); Un[m][8 * q + 1] = bfhi(w_.x); Un[m][8 * q + 2] = bflo(w_.y); Un[m][8 * q + 3] = bfhi(w_.y); Un[m][8 * q + 4] = bflo(w_.z); Un[m][8 * q + 5] = bfhi(w_.z); Un[m][8 * q + 6] = bflo(w_.w); Un[m][8 * q + 7] = bfhi(w_.w); } \
        egn = cf[CF_EGL + (task_)]; } while (0)
#define STAGE_CHUNK(task_, bufi) do { const unsigned char* src_ = p->ws + WS_CH + (size_t)(task_) * CH_TASK_BYTES; const unsigned dst_ = lds_addr(lds + (bufi) * CH_DMA_BYTES); \
        _Pragma("unroll") for (int i = 0; i < 14; ++i) { const int pc = wave * 14 + i; glds16(src_ + pc * 1024 + lane * 16, dst_ + pc * 1024); } } while (0)
    if (wave >= 4) gdn_chunk_task(p, lds + (wave - 4) * CWL_BYTES, chain * NCHUNK + (wave - 4), lane);
    VM_WAIT(); LDS_WAIT(); __syncthreads();
    if (wave < 4) { LOAD_U(chain * NCHUNK); STAGE_CHUNK(chain * NCHUNK, 0); }
    for (int n = 0; n < NCHUNK; ++n) {
        const int task = chain * NCHUNK + n;
        int bq, hq, dq, rstart, rstep; gdn_task_rows(task, bq, hq, dq, rstart, rstep);
        if (wave < 4) VM_WAIT();
        asm volatile("s_waitcnt lgkmcnt(0)\n\ts_barrier" ::: "memory");
        if (wave < 4) {
            f32x16 V[2], O[2];
#pragma unroll
            for (int m = 0; m < 2; ++m) { V[m] = Un[m]; O[m] = (f32x16){}; }
            const float egl = egn;
            if (n + 1 < NCHUNK) { LOAD_U(task + 1); STAGE_CHUNK(task + 1, (n + 1) & 1); }
            const LAS unsigned char* buf = lds + (n & 1) * CH_DMA_BYTES + lane * 16;
            bf16x8 Sb[4][2];
#pragma unroll
            for (int t = 0; t < 4; ++t)
#pragma unroll
                for (int s = 0; s < 2; ++s) { u32x4 w; w.x = cvt_pk_bf16(S[t][8 * s], S[t][8 * s + 1]); w.y = cvt_pk_bf16(S[t][8 * s + 2], S[t][8 * s + 3]); w.z = cvt_pk_bf16(S[t][8 * s + 4], S[t][8 * s + 5]); w.w = cvt_pk_bf16(S[t][8 * s + 6], S[t][8 * s + 7]);
                    Sb[t][s] = __builtin_bit_cast(bf16x8, w); }
#pragma unroll
            for (int m = 0; m < 2; ++m)
#pragma unroll
                for (int t = 0; t < 4; ++t)
#pragma unroll
                    for (int s = 0; s < 2; ++s) { const int f = (m * 4 + t) * 2 + s;
                        V[m] = MFMA32(*(const LAS bf16x8*)(buf + CH_WF + f * 1024), Sb[t][s], V[m]);
                        O[m] = MFMA32(*(const LAS bf16x8*)(buf + CH_QF + f * 1024), Sb[t][s], O[m]);
                        if (s == 1 && (t & 1)) __builtin_amdgcn_sched_barrier(0); }
            bf16x8 Vb[2][2];
#pragma unroll
            for (int m = 0; m < 2; ++m)
#pragma unroll
                for (int s = 0; s < 2; ++s) { u32x4 w; w.x = cvt_pk_bf16_c(V[m][8 * s], V[m][8 * s + 1]); w.y = cvt_pk_bf16_c(V[m][8 * s + 2], V[m][8 * s + 3]); w.z = cvt_pk_bf16_c(V[m][8 * s + 4], V[m][8 * s + 5]); w.w = cvt_pk_bf16_c(V[m][8 * s + 6], V[m][8 * s + 7]);
                    Vb[m][s] = __builtin_bit_cast(bf16x8, w); }
#pragma unroll
            for (int mo = 0; mo < 2; ++mo)
#pragma unroll
                for (int m = 0; m <= mo; ++m)
#pragma unroll
                    for (int s = 0; s < 2; ++s) O[mo] = MFMA32(*(const LAS bf16x8*)(buf + CH_AF + ((mo * 2 + m) * 2 + s) * 1024), Vb[m][s], O[mo]);
            { LAS bf16_t* stg = (LAS bf16_t*)(lds + STG) + 32 * wave + r32;
#pragma unroll
              for (int m = 0; m < 2; ++m)
#pragma unroll
                  for (int r = 0; r < 16; ++r) stg[(32 * m + crow(r, hi)) * 128] = (bf16_t)f2bf(O[m][r]); }
#pragma unroll
            for (int t = 0; t < 4; ++t) {
                __builtin_amdgcn_sched_barrier(0);
#pragma unroll
                for (int r = 0; r < 16; ++r) S[t][r] *= egl;
#pragma unroll
                for (int m = 0; m < 2; ++m)
#pragma unroll
                    for (int s = 0; s < 2; ++s) S[t] = MFMA32(*(const LAS bf16x8*)(buf + CH_KF + ((t * 2 + m) * 2 + s) * 1024), Vb[m][s], S[t]); }
        }
        asm volatile("s_waitcnt lgkmcnt(0)\n\ts_barrier" ::: "memory");
        if (wave >= 4) { const int j = tid - 256, row = j >> 2; bf16_t* og = OG + (size_t)dir * NTOK * 512 + (size_t)(rstart + rstep * row) * 512 + h * 128 + (j & 3) * 8;
            const LAS bf16_t* stg = (const LAS bf16_t*)(lds + STG) + row * 128 + (j & 3) * 8;
#pragma unroll
            for (int it = 0; it < 4; ++it) *(u32x4*)(og + it * 32) = *(const LAS u32x4*)(stg + it * 32); }
    }
    VM_WAIT(); LDS_WAIT(); __syncthreads();
#undef LOAD_U
#undef STAGE_CHUNK
}

__device__ __forceinline__ void phase_gdn_out(PP p, int layer) {
    int tid = threadIdx.x, bid = blockIdx.x, gdim = gridDim.x; asm volatile("" : "+v"(tid), "+s"(bid), "+s"(gdim)); const int lane = tid & 63, wave = __builtin_amdgcn_readfirstlane(tid >> 6);
    const bf16_t* OG = (const bf16_t*)(p->ws + WS_OG); const bf16_t* OA = (const bf16_t*)(p->ws + WS_OA); const bf16_t* P = (const bf16_t*)(p->ws + WS_P); bf16_t* MIX = (bf16_t*)(p->ws + WS_MIX);
    const float* cf = (const float*)(p->ws + WS_CONST);
    const float lam = cf[CF_SC + layer * 16 + 0], oml = cf[CF_SC + layer * 16 + 2];
    const float* gn = p->in[I_GDNG] + layer * 128 + (8 * lane & 127); const float* sg = p->in[I_SUBLN] + layer * 128 + (8 * lane & 127);
    const f32x4 g0 = *(const f32x4*)gn, g1 = *(const f32x4*)(gn + 4), a0 = *(const f32x4*)sg * oml, a1 = *(const f32x4*)(sg + 4) * oml;
    const int nrows = layer == 0 ? NTOK : NLAT;
    for (int r = bid * NWAVES + wave; r < nrows; r += gdim * NWAVES) {
        {
            const bf16_t* a = OA + (size_t)r * 512 + 8 * lane; const float* la = (const float*)(p->ws + WS_LA) + (size_t)r * 4 + (lane >> 4);
            constexpr size_t PS = (size_t)NTOK * 512, LS = (size_t)NTOK * 4;
#define LD8(ptr, lo4, hi4) do { const u32x4 w_ = *(const u32x4*)(ptr); lo4 = (f32x4){bflo(w_.x), bfhi(w_.x), bflo(w_.y), bfhi(w_.y)}; hi4 = (f32x4){bflo(w_.z), bfhi(w_.z), bflo(w_.w), bfhi(w_.w)}; } while (0)
            f32x4 s0a, s0b, s1a, s1b; LD8(a, s0a, s0b); LD8(a + PS, s1a, s1b); float l0 = la[0], l1 = la[LS];
            if (r < NLAT) { f32x4 t0, t1; LD8(a + 2 * PS, t0, t1); s0a += t0; s0b += t1; LD8(a + 3 * PS, t0, t1); s1a += t0; s1b += t1; l0 += la[2 * LS]; l1 += la[3 * LS];
                if (r >= SEQL && (lane >> 4) == 3) {
#pragma unroll
                    for (int q = 2; q < 4; ++q) { LD8(a + (2 * q) * PS, t0, t1); s0a += t0; s0b += t1; LD8(a + (2 * q + 1) * PS, t0, t1); s1a += t0; s1b += t1; l0 += la[(2 * q) * LS]; l1 += la[(2 * q + 1) * LS]; } } }
            const float r0 = 1.f / l0, r1 = lam / l1;
            f32x4 o0 = s0a * r0 - s1a * r1, o1 = s0b * r0 - s1b * r1;
            float ss = (o0[0] * o0[0] + o0[1] * o0[1]) + (o0[2] * o0[2] + o0[3] * o0[3]) + (o1[0] * o1[0] + o1[1] * o1[1]) + (o1[2] * o1[2] + o1[3] * o1[3]);
            ss += __shfl_xor(ss, 1); ss += __shfl_xor(ss, 2); ss += __shfl_xor(ss, 4); ss += __shfl_xor(ss, 8);
            const float rstd = rsqrtf(ss * (1.f / 128.f) + EPS);
            o0 = o0 * rstd * a0; o1 = o1 * rstd * a1;
            u32x4 w; w.x = cvt_pk_bf16(o0[0], o0[1]); w.y = cvt_pk_bf16(o0[2], o0[3]); w.z = cvt_pk_bf16(o1[0], o1[1]); w.w = cvt_pk_bf16(o1[2], o1[3]);
            *(u32x4*)(MIX + (size_t)r * D + 8 * lane) = w; }
        const bf16_t* a = OG + (size_t)r * 512 + 8 * lane; const bf16_t* bq = a + (size_t)NTOK * 512;
        f32x4 o0, o1; { f32x4 t0, t1; LD8(a, o0, o1); LD8(bq, t0, t1); o0 += t0; o1 += t1; }
        float ss = (o0[0] * o0[0] + o0[1] * o0[1]) + (o0[2] * o0[2] + o0[3] * o0[3]) + (o1[0] * o1[0] + o1[1] * o1[1]) + (o1[2] * o1[2] + o1[3] * o1[3]);
        ss += __shfl_xor(ss, 1); ss += __shfl_xor(ss, 2); ss += __shfl_xor(ss, 4); ss += __shfl_xor(ss, 8);
        const float rstd = rsqrtf(ss * (1.f / 128.f) + EPS);
        const u32x4 zw = *(const u32x4*)(P + (size_t)r * PW + 3072 + 8 * lane);
        o0 = o0 * rstd * g0; o1 = o1 * rstd * g1;
        u32x4 w; w.x = cvt_pk_bf16(o0[0] * silu_f(bflo(zw.x)), o0[1] * silu_f(bfhi(zw.x))); w.y = cvt_pk_bf16(o0[2] * silu_f(bflo(zw.y)), o0[3] * silu_f(bfhi(zw.y)));
        w.z = cvt_pk_bf16(o1[0] * silu_f(bflo(zw.z)), o1[1] * silu_f(bfhi(zw.z))); w.w = cvt_pk_bf16(o1[2] * silu_f(bflo(zw.w)), o1[3] * silu_f(bfhi(zw.w)));
        *(u32x4*)(MIX + (size_t)r * D + 512 + 8 * lane) = w;
    }
}

constexpr int AT_NS = 4, AT_SLOTK = 8192, AT_SLOTV = 16384, AT_K = 0, AT_V = AT_NS * AT_SLOTK, AT_WS = AT_V + AT_NS * AT_SLOTV;
typedef short v4i16_t __attribute__((ext_vector_type(4)));
__device__ __forceinline__ s16x4 vtr(const LAS unsigned char* ptr) { return __builtin_bit_cast(s16x4, __builtin_amdgcn_ds_read_tr16_b64_v4i16((LAS v4i16_t*)ptr)); }
__device__ __forceinline__ int att_keyrow(int b, int t, int nctx_tiles) {
    return t < nctx_tiles ? NLAT + b * CTXL + 64 * t : b * SEQL + 64 * (t - nctx_tiles);
}
#define AT_SBAR() __builtin_amdgcn_sched_barrier(0)
#define AT_PIN(x) asm volatile("" : "+v"(x))
#define AT_WAIT_BAR(N) asm volatile("s_waitcnt vmcnt(" #N ") lgkmcnt(0)\n\ts_barrier" ::: "memory")
__device__ __forceinline__ void attn_unit(PP p, int layer, LAS unsigned char* lds, int b, int h, int sub, int qrow0, int t0, int ntile, int nctx_tiles, int ksp) {
    int tid = threadIdx.x; asm volatile("" : "+v"(tid)); const int lane = tid & 63, wave = __builtin_amdgcn_readfirstlane(tid >> 6), r32 = lane & 31, hi = lane >> 5;
    const bf16_t* P = (const bf16_t*)(p->ws + WS_P);
    LAS float* wsf = (LAS float*)(lds + AT_WS) + wave * 64;
    const LAS unsigned char* kp0 = lds + AT_K + hi * 1024 + r32 * 16;
    const LAS unsigned char* vp0 = lds + AT_V + ((lane >> 4) & 1) * 32 + (lane & 3) * 8 + (4 * hi + ((lane & 15) >> 2)) * 64;
    const int kcol = 512 + h * 128 + sub * 64 + wave * 8, vcol = 1024 + h * 128;
    const size_t koff = (size_t)lane * PW + kcol;
    const size_t voff0 = (size_t)(16 * (wave & 3) + (lane >> 2)) * PW + vcol + 32 * (wave >> 2) + 8 * (lane & 3);
    const size_t voff1 = voff0 + 64;
    const unsigned kdst = lds_addr(lds + AT_K + wave * 1024), vdst = lds_addr(lds + AT_V + wave * 1024);
#define DMA_K(t, slot) do { if ((t) < ntile) glds16(P + (size_t)att_keyrow(b, t0 + (t), nctx_tiles) * PW + koff, kdst + (slot) * AT_SLOTK); } while (0)
#define DMA_V(t, slot) do { if ((t) < ntile) { const bf16_t* vb_ = P + (size_t)att_keyrow(b, t0 + (t), nctx_tiles) * PW; \
        glds16(vb_ + voff0, vdst + (slot) * AT_SLOTV); glds16(vb_ + voff1, vdst + (slot) * AT_SLOTV + 8192); } } while (0)
    DMA_K(0, 0); DMA_V(0, 0); DMA_K(1, 1); DMA_K(2, 2); DMA_K(3, 3); DMA_V(1, 1);
    bf16x8 qr[4];
    { const bf16_t* qp = P + (size_t)(qrow0 + wave * 32 + r32) * PW + h * 128 + sub * 64 + hi * 8;
#pragma unroll
      for (int d0 = 0; d0 < 4; ++d0) qr[d0] = *(const bf16x8*)(qp + d0 * 16); }
    f32x16 o[4];
#pragma unroll
    for (int dg = 0; dg < 4; ++dg) o[dg] = (f32x16){};
    float l_reg = 0.f;
    f32x16 pA0, pA1, pB0, pB1; bf16x8 kf[8]; u32x4 pw0, pw1, pw2, pw3; s16x4 vlo[4], vhi[4];
    f32x16 zero16 = (f32x16){}; AT_PIN(zero16);
    int sl_prev = 0, sl_cur = 0, sl_next = 1;
#define ROT() do { sl_prev = sl_cur; sl_cur = sl_next; sl_next = (sl_next + 1) & 3; } while (0)
#define KLD(i, kp_) kf[i] = *(const LAS bf16x8*)((kp_) + ((i) >> 1) * 2048 + ((i) & 1) * 512)
#define PKW(Pv, i) cvt_pk_bf16(Pv[i], Pv[(i) + 1])
#define PAF(k) __builtin_bit_cast(bf16x8, pw##k)
#define VRD(i, vp_) do { vlo[(i) & 3] = vtr((vp_) + ((i) & 3) * 4096 + ((i) >> 2) * 1024); vhi[(i) & 3] = vtr((vp_) + ((i) & 3) * 4096 + ((i) >> 2) * 1024 + 512); } while (0)
#define VFR(i) (bf16x8){vlo[(i) & 3][0], vlo[(i) & 3][1], vlo[(i) & 3][2], vlo[(i) & 3][3], vhi[(i) & 3][0], vhi[(i) & 3][1], vhi[(i) & 3][2], vhi[(i) & 3][3]}
#define EX2(Cv, i) do { Cv[i] = __builtin_amdgcn_exp2f(Cv[i]); Cv[(i) + 1] = __builtin_amdgcn_exp2f(Cv[(i) + 1]); } while (0)
#define GAPA(MF, a0, a1, a2, a3, W0, W1, PW_) do { MF; sacc += a0; sacc += a1; sacc += a2; sacc += a3; W0; W1; AT_PIN(PW_); AT_PIN(sacc); AT_SBAR(); } while (0)
#define GAPB(i, PA_, Cx, ci, GL) do { o[(i) & 3] = MFMA32(PA_, VFR(i), o[(i) & 3]); EX2(Cx, ci); AT_PIN(Cx); \
        if ((i) + 2 < 16) VRD((i) + 2, vpp_); if ((GL) && (i) < 8) KLD(i, kpn_); AT_SBAR(); } while (0)
#define STEP(C0, C1, P0, P1, t, GL) do { AT_SBAR(); \
    const LAS unsigned char* vpp_ = vp0 + sl_prev * AT_SLOTV; const LAS unsigned char* kpn_ = kp0 + sl_next * AT_SLOTK; \
    float sacc = P0[0] + P0[1]; \
    GAPA(C0 = MFMA32(kf[0], qr[0], zero16), P0[2], P0[3], P0[4], P0[5],     pw0[0] = PKW(P0, 0),  pw0[1] = PKW(P0, 2),  pw0); \
    GAPA(C1 = MFMA32(kf[1], qr[0], zero16), P0[6], P0[7], P0[8], P0[9],     pw0[2] = PKW(P0, 4),  pw0[3] = PKW(P0, 6),  pw0); \
    GAPA(C0 = MFMA32(kf[2], qr[1], C0),     P0[10], P0[11], P0[12], P0[13], pw1[0] = PKW(P0, 8),  pw1[1] = PKW(P0, 10), pw1); \
    GAPA(C1 = MFMA32(kf[3], qr[1], C1),     P0[14], P0[15], P1[0], P1[1],   pw1[2] = PKW(P0, 12), pw1[3] = PKW(P0, 14), pw1); \
    GAPA(C0 = MFMA32(kf[4], qr[2], C0),     P1[2], P1[3], P1[4], P1[5],     pw2[0] = PKW(P1, 0),  pw2[1] = PKW(P1, 2),  pw2); \
    GAPA(C1 = MFMA32(kf[5], qr[2], C1),     P1[6], P1[7], P1[8], P1[9],     pw2[2] = PKW(P1, 4),  pw2[3] = PKW(P1, 6),  pw2); \
    VRD(0, vpp_); \
    GAPA(C0 = MFMA32(kf[6], qr[3], C0),     P1[10], P1[11], P1[12], P1[13], pw3[0] = PKW(P1, 8),  pw3[1] = PKW(P1, 10), pw3); \
    VRD(1, vpp_); \
    GAPA(C1 = MFMA32(kf[7], qr[3], C1),     P1[14], P1[15], 0.f, 0.f,       pw3[2] = PKW(P1, 12), pw3[3] = PKW(P1, 14), pw3); \
    l_reg += sacc; \
    DMA_K((t) + 4, sl_cur); DMA_V((t) + 2, (sl_next + 1) & 3); AT_SBAR(); \
    GAPB(0, PAF(0), C0, 0, GL);  GAPB(1, PAF(0), C0, 2, GL);  GAPB(2, PAF(0), C0, 4, GL);  GAPB(3, PAF(0), C0, 6, GL); \
    GAPB(4, PAF(1), C0, 8, GL);  GAPB(5, PAF(1), C0, 10, GL); GAPB(6, PAF(1), C0, 12, GL); GAPB(7, PAF(1), C0, 14, GL); \
    GAPB(8, PAF(2), C1, 0, GL);  GAPB(9, PAF(2), C1, 2, GL);  GAPB(10, PAF(2), C1, 4, GL); GAPB(11, PAF(2), C1, 6, GL); \
    GAPB(12, PAF(3), C1, 8, GL); GAPB(13, PAF(3), C1, 10, GL); GAPB(14, PAF(3), C1, 12, GL); GAPB(15, PAF(3), C1, 14, GL); \
    } while (0)
#define ENDW(tt) do { if ((tt) + 4 < ntile) { AT_WAIT_BAR(6); } else { AT_WAIT_BAR(0); } } while (0)
    AT_WAIT_BAR(0);
#pragma unroll
    for (int i = 0; i < 8; ++i) KLD(i, kp0);
    pA0 = MFMA32(kf[0], qr[0], zero16); pA1 = MFMA32(kf[1], qr[0], zero16); pA0 = MFMA32(kf[2], qr[1], pA0); pA1 = MFMA32(kf[3], qr[1], pA1);
    pA0 = MFMA32(kf[4], qr[2], pA0); pA1 = MFMA32(kf[5], qr[2], pA1); pA0 = MFMA32(kf[6], qr[3], pA0); pA1 = MFMA32(kf[7], qr[3], pA1);
#pragma unroll
    for (int r = 0; r < 16; ++r) { pA0[r] = __builtin_amdgcn_exp2f(pA0[r]); pA1[r] = __builtin_amdgcn_exp2f(pA1[r]); }
    AT_WAIT_BAR(0);
    DMA_K(4, 0); DMA_V(2, 2); ROT();
#pragma unroll
    for (int i = 0; i < 8; ++i) KLD(i, kp0 + sl_cur * AT_SLOTK);
    if (ntile > 4) { AT_WAIT_BAR(3); } else { AT_WAIT_BAR(0); }
    int t = 1;
    for (; t + 1 < ntile; t += 2) {
        STEP(pB0, pB1, pA0, pA1, t, true);     ENDW(t);     ROT();
        STEP(pA0, pA1, pB0, pB1, t + 1, (t + 2 < ntile)); ENDW(t + 1); ROT();
    }
    if (t < ntile) { STEP(pB0, pB1, pA0, pA1, t, false); ENDW(t); ROT();
#pragma unroll
        for (int r = 0; r < 16; ++r) { pA0[r] = pB0[r]; pA1[r] = pB1[r]; } }
    { float sacc = 0.f;
#pragma unroll
      for (int r = 0; r < 16; ++r) sacc += pA0[r] + pA1[r];
      l_reg += sacc;
      pw0 = (u32x4){PKW(pA0, 0), PKW(pA0, 2), PKW(pA0, 4), PKW(pA0, 6)}; pw1 = (u32x4){PKW(pA0, 8), PKW(pA0, 10), PKW(pA0, 12), PKW(pA0, 14)};
      pw2 = (u32x4){PKW(pA1, 0), PKW(pA1, 2), PKW(pA1, 4), PKW(pA1, 6)}; pw3 = (u32x4){PKW(pA1, 8), PKW(pA1, 10), PKW(pA1, 12), PKW(pA1, 14)};
      const LAS unsigned char* vpp_ = vp0 + sl_prev * AT_SLOTV;
#pragma unroll
      for (int i = 0; i < 16; ++i) { VRD(i, vpp_); const bf16x8 pa = (i >> 2) == 0 ? PAF(0) : (i >> 2) == 1 ? PAF(1) : (i >> 2) == 2 ? PAF(2) : PAF(3); o[i & 3] = MFMA32(pa, VFR(i), o[i & 3]); } }
    l_reg += __shfl_xor(l_reg, 32);
    const size_t part = (size_t)(ksp * 2 + sub) * NTOK;
    if (hi == 0) ((float*)(p->ws + WS_LA))[(part + qrow0 + wave * 32 + r32) * 4 + h] = l_reg;
    bf16_t* OA = (bf16_t*)(p->ws + WS_OA) + part * 512 + h * 128 + r32;
#pragma unroll
    for (int r = 0; r < 16; ++r) { bf16_t* orow = OA + (size_t)(qrow0 + wave * 32 + crow(r, hi)) * 512;
#pragma unroll
        for (int dg = 0; dg < 4; ++dg) orow[32 * dg] = (bf16_t)f2bf(o[dg][r]); }
    AT_WAIT_BAR(0);
#undef DMA_K
#undef DMA_V
#undef ROT
#undef KLD
#undef PKW
#undef PAF
#undef VRD
#undef VFR
#undef EX2
#undef GAPA
#undef GAPB
#undef STEP
#undef ENDW
}
__device__ __forceinline__ void phase_attention(PP p, int layer, LAS unsigned char* lds, int qsel) {
    int bid = blockIdx.x; asm volatile("" : "+s"(bid));
    if (bid < 16) gdn_scan_chain(p, lds, bid);
    constexpr int NBIG = 1792, NSMALL = 512;
    const int nlat = NBIG + NSMALL, nunits = nlat + (layer == 0 ? NB * 4 * 2 : 0);
    unsigned* ctr = (unsigned*)(p->ws + WS_CTL) + CW_ATTQ + layer * 64 + qsel * 32;
    volatile LAS unsigned* slot = (volatile LAS unsigned*)(lds + MISC_OFF) + 16;
    for (;;) {
        if (threadIdx.x == 0) *slot = __hip_atomic_fetch_add(ctr, 1u, __ATOMIC_RELAXED, __HIP_MEMORY_SCOPE_AGENT);
        __syncthreads();
        const int u = (int)__builtin_amdgcn_readfirstlane((int)*slot);
        if (u >= nunits) break;
        if (u < NBIG) { const int b = u >> 10, h = (u >> 8) & 3, sub = (u >> 7) & 1, ksp = (u >> 6) & 1, qb = u & 63; attn_unit(p, layer, lds, b, h, sub, b * SEQL + qb * 256, ksp * 130, 130, 4, ksp); }
        else if (u < nlat) { const int v = u - NBIG, sub = v >> 8, kq = (v >> 6) & 3, qb = v & 63; attn_unit(p, layer, lds, 1, 3, sub, SEQL + qb * 256, kq * 65, 65, 4, kq); }
        else { const int v = u - nlat, b = v >> 3, h = (v >> 1) & 3, sub = v & 1; attn_unit(p, layer, lds, b, h, sub, NLAT + b * CTXL, 0, 4, 4, 0); }
    }
}

__device__ __forceinline__ void phase_norm_router(PP p, int layer, LAS unsigned char* lds) {
    int tid = threadIdx.x, bid = blockIdx.x, gdim = gridDim.x; asm volatile("" : "+v"(tid), "+s"(bid), "+s"(gdim)); const int lane = tid & 63, wave = __builtin_amdgcn_readfirstlane(tid >> 6);
    const int T = layer == 0 ? NTOK : NLAT;
    LAS float* rw = (LAS float*)lds;
    LAS int* lcnt = (LAS int*)(lds + 131072);
    LAS int* lbase = lcnt + 32;
    LAS int* ent = lcnt + 64;
    const float* rwg = p->in[I_RW] + (size_t)layer * D * NEXP;
    for (int i = tid; i < NEXP * 1024; i += NTHR) { const int k = i >> 5, e = i & 31; rw[e * 1024 + k] = rwg[(size_t)k * NEXP + e]; }
    if (tid < 64) lcnt[tid] = 0;
    __syncthreads();
    const float* cf = (const float*)(p->ws + WS_CONST);
    const float* gn = p->in[I_NFFNG] + layer * D;
    const float rb = lane < NEXP ? p->in[I_RB][layer * NEXP + lane] : 0.f;
    const int rpw = (T + gdim - 1) / gdim;
    const int r0 = bid * rpw, r1 = (r0 + rpw < T) ? r0 + rpw : T;
    int* tope = (int*)(p->ws + WS_RT + RT_TOPE); float* gate = (float*)(p->ws + WS_RT + RT_GATE); int* rank = (int*)(p->ws + WS_RT + RT_RANK);
    const bf16_t* H = (const bf16_t*)(p->ws + WS_H);
    for (int r = r0 + wave; r < r1; r += NWAVES) {
        const float* mv = cf + CF_MODV + (layer * 3 + mod_sel(r)) * 6144;
        f32x4 u[4];
#pragma unroll
        for (int j = 0; j < 4; ++j) { const u32x2 w_ = *(const u32x2*)(H + (size_t)r * D + 4 * lane + 256 * j); u[j] = (f32x4){bflo(w_.x), bfhi(w_.x), bflo(w_.y), bfhi(w_.y)}; }
        norm_mod_vals(gn, mv + 3 * 1024, mv + 4 * 1024, lane, u);
        store_row_bf16((bf16_t*)(p->ws + WS_U) + (size_t)r * D, lane, u);
        float logit = -INFINITY;
#pragma unroll 4
        for (int e = 0; e < NEXP; ++e) { float s = 0.f;
#pragma unroll
            for (int q = 0; q < 4; ++q) { const f32x4 w = *(const LAS f32x4*)(rw + e * 1024 + 4 * lane + 256 * q); s += (u[q][0] * w[0] + u[q][1] * w[1]) + (u[q][2] * w[2] + u[q][3] * w[3]); }
            s = wave_sum(s); if (lane == e) logit = s + rb; }
        float tl[4]; int te[4];
#pragma unroll
        for (int k = 0; k < 4; ++k) { const float m = wave_max(logit); const unsigned long long bal = __ballot(logit == m); const int idx = __ffsll((long long)bal) - 1;
            tl[k] = m; te[k] = idx; if (lane == idx) logit = -INFINITY; }
        const float e1 = __expf(tl[1] - tl[0]), e2 = __expf(tl[2] - tl[0]), e3 = __expf(tl[3] - tl[0]); const float inv = 1.f / (1.f + e1 + e2 + e3);
        if (lane < 4) { const int e = lane == 0 ? te[0] : lane == 1 ? te[1] : lane == 2 ? te[2] : te[3]; const float gv = (lane == 0 ? 1.f : lane == 1 ? e1 : lane == 2 ? e2 : e3) * inv;
            const int lr = atomicAdd((int*)&lcnt[e], 1);
            ent[(r - r0) * 4 + lane] = (e << 20) | lr; tope[(size_t)r * 4 + lane] = e; gate[(size_t)r * 4 + lane] = gv; }
    }
    __syncthreads();
    if (tid < NEXP) lbase[tid] = (int)atomicAdd((unsigned*)(p->ws + WS_CTL) + CW_CNT + layer * 64 + tid, (unsigned)lcnt[tid]);
    __syncthreads();
    for (int i = tid; i < (r1 - r0) * 4; i += NTHR) { const int v = ent[i]; rank[(size_t)r0 * 4 + i] = lbase[v >> 20] + (v & 0xfffff); }
}

__device__ __forceinline__ void phase_moe_gather(PP p, int layer, LAS unsigned char* lds) {
    int tid = threadIdx.x, bid = blockIdx.x, gdim = gridDim.x; asm volatile("" : "+v"(tid), "+s"(bid), "+s"(gdim)); const int lane = tid & 63, wave = __builtin_amdgcn_readfirstlane(tid >> 6);
    const int T = layer == 0 ? NTOK : NLAT;
    LAS int* pstart = (LAS int*)lds; LAS int* cnt = pstart + 64;
    const unsigned* gcnt = (const unsigned*)(p->ws + WS_CTL) + CW_CNT + layer * 64;
    int* mt = (int*)(p->ws + WS_CONST) + CF_MOE + layer * 1024;
    if (tid == 0) { int acc = 0; for (int e = 0; e < NEXP; ++e) { const int c = (int)__hip_atomic_load(gcnt + e, __ATOMIC_RELAXED, __HIP_MEMORY_SCOPE_AGENT); cnt[e] = c; pstart[e] = acc; acc += (c + 255) & ~255; } pstart[NEXP] = acc; }
    __syncthreads();
    if (bid == 0) {
        if (tid < NEXP) { mt[tid] = pstart[tid]; mt[64 + tid] = cnt[tid]; }
        if (tid == 0) mt[32] = pstart[NEXP] >> 8;
        for (int e = 0; e < NEXP; ++e) { const int b0 = pstart[e] >> 8, b1 = pstart[e + 1] >> 8; for (int bb = b0 + tid; bb < b1; bb += NTHR) mt[128 + bb] = e; }
    }
    const int* tope = (const int*)(p->ws + WS_RT + RT_TOPE); const float* gate = (const float*)(p->ws + WS_RT + RT_GATE); const int* rank = (const int*)(p->ws + WS_RT + RT_RANK);
    int* slot = (int*)(p->ws + WS_RT + RT_SLOT); float* sgate = (float*)(p->ws + WS_RT + RT_SGATE); int* stok = (int*)(p->ws + WS_RT + RT_STOK);
    const int gt = bid * NTHR + tid, NGT = gdim * NTHR;
    for (int a = gt; a < T * 4; a += NGT) {
        const int e = tope[a]; const int s = pstart[e] + rank[a];
        slot[a] = s; sgate[s] = gate[a]; stok[s] = a >> 2;
    }
    for (int e = 0; e < NEXP; ++e) { const int s0 = pstart[e] + cnt[e], s1 = pstart[e + 1];
        for (int s = s0 + gt; s < s1; s += NGT) { stok[s] = 0; sgate[s] = 0.f; } }
}

__device__ __forceinline__ void phase_moe_combine(PP p, int layer, LAS unsigned char* lds) {
    int tid = threadIdx.x, bid = blockIdx.x, gdim = gridDim.x; asm volatile("" : "+v"(tid), "+s"(bid), "+s"(gdim)); const int lane = tid & 63, wave = __builtin_amdgcn_readfirstlane(tid >> 6);
    const int T = layer == 0 ? NTOK : NLAT;
    const float* cf = (const float*)(p->ws + WS_CONST); const int* slot = (const int*)(p->ws + WS_RT + RT_SLOT); const bf16_t* Y = (const bf16_t*)(p->ws + WS_Y);
    bf16_t* H = (bf16_t*)(p->ws + WS_H);
    LAS float* wab = (LAS float*)lds; float ea = 0.f, dtb = 0.f;
    if (layer == 0) { norm_mix_stage_wab(p, 1, wab, tid); __syncthreads(); if (lane < 8) { ea = -__expf(p->in[I_ALOG][8 + lane]); dtb = p->in[I_DTB][8 + lane]; } }
    for (int r = bid * NWAVES + wave; r < T; r += gdim * NWAVES) {
        const float* g5 = cf + CF_MODV + (layer * 3 + mod_sel(r)) * 6144 + 5 * 1024;
        bf16_t* hrow = H + (size_t)r * D;
        const int s0 = slot[r * 4], s1 = slot[r * 4 + 1], s2 = slot[r * 4 + 2], s3 = slot[r * 4 + 3];
        f32x4 hn[4];
#pragma unroll
        for (int j = 0; j < 4; ++j) { const int c = 4 * lane + 256 * j;
            const u32x2 a = *(const u32x2*)(Y + (size_t)s0 * D + c), b2 = *(const u32x2*)(Y + (size_t)s1 * D + c), c2 = *(const u32x2*)(Y + (size_t)s2 * D + c), d2 = *(const u32x2*)(Y + (size_t)s3 * D + c);
            f32x4 y; y[0] = (bflo(a.x) + bflo(b2.x)) + (bflo(c2.x) + bflo(d2.x)); y[1] = (bfhi(a.x) + bfhi(b2.x)) + (bfhi(c2.x) + bfhi(d2.x));
            y[2] = (bflo(a.y) + bflo(b2.y)) + (bflo(c2.y) + bflo(d2.y)); y[3] = (bfhi(a.y) + bfhi(b2.y)) + (bfhi(c2.y) + bfhi(d2.y));
            const u32x2 hw = *(const u32x2*)(hrow + c); const f32x4 hv = (f32x4){bflo(hw.x), bfhi(hw.x), bflo(hw.y), bfhi(hw.y)}, gv = *(const f32x4*)(g5 + c);
            hn[j] = hv + gv * y;
            if (layer == 0) { u32x2 w; w.x = cvt_pk_bf16(hn[j][0], hn[j][1]); w.y = cvt_pk_bf16(hn[j][2], hn[j][3]); *(u32x2*)(hrow + c) = w; }
            else *(f32x4*)(p->out + (size_t)r * D + c) = hn[j]; }
        if (layer == 0) norm_mix_row(p, 1, r, lane, hn, wab, ea, dtb);
    }
}

constexpr int NPH = 27;
#ifndef PH_MASK
#define PH_MASK 0xFFFF
#endif
#define IN(k) (lo <= (k) && (k) < hi)
#define EN(i) ((PH_MASK >> (i)) & 1)
#ifndef DUP_PH
#define DUP_PH -1
#endif
#define REP(i) for (int rep_ = 0; rep_ < ((DUP_PH == (i) && l == 0) ? 2 : 1); ++rep_)
#define SEAM(k) do { if (IN(k) && IN((k) + 1)) xcd_barrier(bar); } while (0)
#define LAUNDER() PP p = p0; LAS unsigned char* lds = lds0; int bid = blockIdx.x, gdim = gridDim.x; asm volatile("" : "+s"(p), "+s"(lds), "+s"(bid), "+s"(gdim))
template <int l> __device__ __forceinline__ void run_layer(PP p0, LAS unsigned char* lds0, const int lo, const int hi, const XcdBarrier& bar) {
        const int base = 1 + 13 * l;
        if (l == 0) { if (EN(1) && IN(base + 0)) REP(1) { LAUNDER(); phase_norm_mix(p, l, lds); __syncthreads(); }
            SEAM(base + 0); }
        if (EN(2) && IN(base + 1)) REP(2) { LAUNDER();
            PlainSched S; S.init(p->ws + WS_U, p->ws + WS_WIN + (size_t)l * PW * 1024 * 2, 1024, NTOK / 256, PW / 256, gdim, bid);
            EpiStoreBf16 E{(bf16_t*)(p->ws + WS_P), PW};
            pg8::gemm_phase<EpiStoreBf16, PlainSched>(lds, 1024, S, E);
        }
        SEAM(base + 1);
        if (EN(3) && IN(base + 2)) REP(3) { LAUNDER(); phase_prep(p, l); }
        SEAM(base + 2);
        if (EN(5) && IN(base + 3)) REP(5) { LAUNDER(); phase_gdn_chunk(p, lds); }
        SEAM(base + 3);
        if (EN(4) && IN(base + 4)) REP(4) { LAUNDER(); phase_attention(p, l, lds, rep_); }
        SEAM(base + 4);
        if (EN(7) && IN(base + 6)) REP(7) { LAUNDER(); phase_gdn_out(p, l); }
        SEAM(base + 6);
        if (EN(8) && IN(base + 7)) REP(8) { LAUNDER();
            const int T = l == 0 ? NTOK : NLAT;
            const float* cf = (const float*)(p->ws + WS_CONST);
            PlainSched S; S.init(p->ws + WS_MIX, p->ws + WS_WOUT + (size_t)l * D * 1024 * 2, 1024, T / 256, D / 256, gdim, bid);
            EpiResidual E{p, l, cf + CF_MODV + (l * 3) * 6144 + 2 * 1024};
            pg8::gemm_phase<EpiResidual, PlainSched>(lds, 1024, S, E);
        }
        SEAM(base + 7);
        if (EN(9) && IN(base + 8)) REP(9) { LAUNDER(); phase_norm_router(p, l, lds); __syncthreads(); }
        SEAM(base + 8);
        if (EN(10) && IN(base + 9)) REP(10) { LAUNDER(); phase_moe_gather(p, l, lds); __syncthreads(); }
        SEAM(base + 9);
        if (EN(11) && IN(base + 10)) REP(11) { LAUNDER();
            const int* mt = (const int*)(p->ws + WS_CONST) + CF_MOE + l * 1024;
            MoeSched S{(const char*)(p->ws + WS_U), (const char*)(p->ws + WS_WGU + (size_t)l * NEXP * 2048 * 1024 * 2), mt + 128, mt[32], 8, gdim, bid, (const int*)(p->ws + WS_RT + RT_STOK)};
            EpiGateUp E{(bf16_t*)(p->ws + WS_ACT), p->in[I_BGU] + (size_t)l * NEXP * 2048, mt + 128};
            pg8::gemm_phase<EpiGateUp, MoeSched, true>(lds, 1024, S, E);
        }
        SEAM(base + 10);
        if (EN(12) && IN(base + 11)) REP(12) { LAUNDER();
            const int* mt = (const int*)(p->ws + WS_CONST) + CF_MOE + l * 1024;
            MoeSched S{(const char*)(p->ws + WS_ACT), (const char*)(p->ws + WS_WD + (size_t)l * NEXP * 1024 * 1024 * 2), mt + 128, mt[32], 4, gdim, bid, nullptr};
            EpiDown E{(bf16_t*)(p->ws + WS_Y), p->in[I_BD] + (size_t)l * NEXP * 1024, mt + 128, (const float*)(p->ws + WS_RT + RT_SGATE)};
            pg8::gemm_phase<EpiDown, MoeSched>(lds, 1024, S, E);
        }
        SEAM(base + 11);
        if (EN(13) && IN(base + 12)) { LAUNDER(); phase_moe_combine(p, l, lds); __syncthreads(); }
        SEAM(base + 12);
    }

__global__ void __launch_bounds__(NTHR, 2) mega_fwd(Params p_by_value) {
    extern __shared__ __attribute__((aligned(16))) unsigned char lds_raw[];
    LAS unsigned char* lds0 = (LAS unsigned char*)lds_raw;
    PP p0 = (PP)__builtin_amdgcn_kernarg_segment_ptr();
    volatile LAS unsigned* MISC = (volatile LAS unsigned*)(lds0 + MISC_OFF);
    if (threadIdx.x < 64) MISC[threadIdx.x] = 0u;
    __syncthreads();
    const int lo = p0->ph_lo, hi = p0->ph_hi;
    XcdBarrier bar; bar.bar = (unsigned*)(p0->ws + WS_CTL) + CW_BAR; bar.x = 0; bar.st = nullptr;
    if (hi - lo > 1) bar = xcd_barrier_post((unsigned*)(p0->ws + WS_CTL) + CW_BAR, MISC + 8);
    if (EN(0) && IN(0)) for (int rep_ = 0; rep_ < (DUP_PH == 0 ? 2 : 1); ++rep_) { LAUNDER(); phase_prologue(p, lds); __syncthreads(); }
    SEAM(0);
    run_layer<0>(p0, lds0, lo, hi, bar);
    run_layer<1>(p0, lds0, lo, hi, bar);
#undef IN
#undef SEAM
}

extern "C" void kernel_launch(void* const* d_in, const int* in_sizes, int n_in, void* d_out, int out_size, void* d_ws, size_t ws_size, hipStream_t stream) {
    static int grid = 0;
    if (grid == 0) {
        if (n_in != 27 || out_size != NLAT * D || ws_size < WS_END) { fprintf(stderr, "kernel_launch: unexpected problem (n_in %d, out %d, ws %zu < %zu)\n", n_in, out_size, ws_size, (size_t)WS_END); grid = -1; return; }
        int dev = 0, cus = 0, per_cu = 0;
        if (hipGetDevice(&dev) != hipSuccess || hipDeviceGetAttribute(&cus, hipDeviceAttributeMultiprocessorCount, dev) != hipSuccess) { grid = -1; return; }
        if (hipFuncSetAttribute((const void*)mega_fwd, hipFuncAttributeMaxDynamicSharedMemorySize, LDS_BYTES) != hipSuccess) { fprintf(stderr, "kernel_launch: hipFuncSetAttribute failed\n"); grid = -1; return; }
        if (hipOccupancyMaxActiveBlocksPerMultiprocessor(&per_cu, (const void*)mega_fwd, NTHR, LDS_BYTES) != hipSuccess || per_cu < 1) { fprintf(stderr, "kernel_launch: occupancy query says %d\n", per_cu); }
        (void)hipGetLastError();
        grid = cus;
    }
    if (grid < 0) return;
    hipMemsetAsync((char*)d_ws + WS_CTL, 0, CTL_ZERO_BYTES, stream);
    Params p{};
    for (int i = 0; i < 27; ++i) p.in[i] = (const float*)d_in[i];
    p.out = (float*)d_out; p.ws = (unsigned char*)d_ws;
#if MK_PER_PHASE
    for (int ph = 0; ph < NPH; ++ph) { p.ph_lo = ph; p.ph_hi = ph + 1; hipLaunchKernelGGL(mega_fwd, dim3(grid), dim3(NTHR), LDS_BYTES, stream, p); }
#else
    p.ph_lo = 0; p.ph_hi = NPH;
    hipLaunchKernelGGL(mega_fwd, dim3(grid), dim3(NTHR), LDS_BYTES, stream, p);
#endif
}
```
